# Optimizing an MI355X kernel written in HIP

```python
import math
import jax
import jax.numpy as jnp
from jax import lax
import numpy as np

D_MODEL = 1024
BATCH = 16
SEQ = 2048
DEPTH = 2

CHUNK = 64
N_A_LAYERS = DEPTH // 2
N_B_LAYERS = DEPTH - N_A_LAYERS
EPS = 1e-6

RET_HEADS = 4
RET_DK = D_MODEL // RET_HEADS
RET_DV = 2 * RET_DK
RET_QK = RET_HEADS * RET_DK
RET_V = RET_HEADS * RET_DV
RET_IN = 2 * RET_QK + 2 * RET_V
ROPE_BASE = 10000.0

DIFF_HEAD_DIM = 64
DIFF_HEADS = D_MODEL // (2 * DIFF_HEAD_DIM)
DIFF_QK = DIFF_HEADS * 2 * DIFF_HEAD_DIM
DIFF_V = DIFF_HEADS * 2 * DIFF_HEAD_DIM
Q_BLOCK = 128

N_GROUPS = 4
EXPERTS_PER_GROUP = 4
N_EXPERTS = N_GROUPS * EXPERTS_PER_GROUP
TOP_K_IN_GROUP = 2
EXPERT_HIDDEN = D_MODEL
ROUTE_BLOCK = 128

kernel_name = 'yoco_retention_diffattn_hmoe_adaln'


def _rmsnorm(x, g):
    xf = x.astype(jnp.float32)
    y = xf * lax.rsqrt(jnp.mean(xf * xf, axis=-1, keepdims=True) + EPS)
    return (y * g.astype(jnp.float32)).astype(x.dtype)


def _modulate(h, shift, scale):
    return h * (1 + scale[:, None, :]) + shift[:, None, :]


def _rotary(x, pos):
    half = x.shape[-1] // 2
    inv_freq = 1.0 / (ROPE_BASE ** (jnp.arange(half, dtype=jnp.float32) / half))
    ang = pos[:, None] * inv_freq[None, :]
    cos = jnp.cos(ang)[None, :, None, :].astype(x.dtype)
    sin = jnp.sin(ang)[None, :, None, :].astype(x.dtype)
    x1, x2 = x[..., :half], x[..., half:]
    return jnp.concatenate([x1 * cos - x2 * sin, x2 * cos + x1 * sin], axis=-1)


def _retention(h, w_in, gn, w_out):
    bsz, seq, _ = h.shape
    n_chunks = seq // CHUNK
    f32 = jnp.float32
    proj = h @ w_in
    q, k, v, g = jnp.split(proj, [RET_QK, 2 * RET_QK, 2 * RET_QK + RET_V], axis=-1)
    pos = jnp.arange(seq, dtype=f32)
    q = _rotary(q.reshape(bsz, seq, RET_HEADS, RET_DK), pos).astype(f32)
    k = _rotary(k.reshape(bsz, seq, RET_HEADS, RET_DK), pos).astype(f32) * (RET_DK ** -0.5)
    v = v.reshape(bsz, seq, RET_HEADS, RET_DV).astype(f32)
    log_gamma = jnp.log1p(-jnp.exp2(-5.0 - jnp.arange(RET_HEADS, dtype=f32)))
    n = jnp.arange(CHUNK, dtype=f32)
    rel = n[:, None] - n[None, :]
    intra = jnp.where(rel >= 0, jnp.exp(jnp.maximum(rel, 0.0)[None] * log_gamma[:, None, None]), 0.0)
    q_decay = jnp.exp((n + 1.0)[None, :] * log_gamma[:, None])
    k_decay = jnp.exp((CHUNK - 1.0 - n)[None, :] * log_gamma[:, None])
    chunk_decay = jnp.exp(CHUNK * log_gamma)

    def to_chunks(t):
        return t.reshape(bsz, n_chunks, CHUNK, RET_HEADS, t.shape[-1]).transpose(1, 0, 3, 2, 4)

    def step(state, inp):
        qi, ki, vi = inp
        scores = jnp.einsum('bhnd,bhmd->bhnm', qi, ki) * intra
        out = (jnp.einsum('bhnm,bhmv->bhnv', scores, vi)
               + jnp.einsum('bhnd,bhdv->bhnv', qi * q_decay[:, :, None], state))
        state = state * chunk_decay[:, None, None] + jnp.einsum(
            'bhmd,bhmv->bhdv', ki * k_decay[:, :, None], vi)
        return state, out

    state0 = jnp.zeros((bsz, RET_HEADS, RET_DK, RET_DV), f32)
    _, o = lax.scan(step, state0, (to_chunks(q), to_chunks(k), to_chunks(v)))
    o = o.transpose(1, 0, 3, 2, 4).reshape(bsz, seq, RET_HEADS, RET_DV)
    o = o * lax.rsqrt(jnp.mean(o * o, axis=-1, keepdims=True) + EPS)
    o = o.reshape(bsz, seq, RET_V) * gn.astype(f32)
    y = jax.nn.silu(g) * o.astype(h.dtype)
    return y @ w_out


def _shared_kv(x, c_act, ada_w, ada_b, norm_g, w_kv, k_norm):
    bsz, seq, _ = x.shape
    shift, scale = jnp.split(c_act @ ada_w + ada_b, 2, axis=-1)
    h = _modulate(_rmsnorm(x, norm_g), shift, scale)
    kv = h @ w_kv
    k = _rmsnorm(kv[..., :DIFF_QK].reshape(bsz, seq, DIFF_HEADS, 2, DIFF_HEAD_DIM), k_norm)
    v = kv[..., DIFF_QK:].reshape(bsz, seq, DIFF_HEADS, 2 * DIFF_HEAD_DIM)
    return k, v


def _diff_attention(h, k, v, w_q, q_norm, lam, subln, w_out, lambda_init):
    bsz, seq, _ = h.shape
    f32 = jnp.float32
    q = _rmsnorm((h @ w_q).reshape(bsz, seq, DIFF_HEADS, 2, DIFF_HEAD_DIM), q_norm) * (DIFF_HEAD_DIM ** -0.5)
    lam_f = lam.astype(f32)
    lam_full = (jnp.exp(jnp.sum(lam_f[0] * lam_f[1])) - jnp.exp(jnp.sum(lam_f[2] * lam_f[3]))
                + lambda_init)
    n_qb = seq // Q_BLOCK
    qb = q.reshape(bsz, n_qb, Q_BLOCK, DIFF_HEADS, 2, DIFF_HEAD_DIM).transpose(1, 0, 2, 3, 4, 5)
    kpos = jnp.arange(seq)

    def block(args):
        qi, bi = args
        qpos = bi * Q_BLOCK + jnp.arange(Q_BLOCK)
        visible_end = (qpos // CHUNK + 1) * CHUNK
        mask = kpos[None, :] < visible_end[:, None]
        s = jnp.einsum('bqhtd,bkhtd->bhtqk', qi, k).astype(f32)
        p = jax.nn.softmax(jnp.where(mask, s, -jnp.inf), axis=-1)
        a = p[:, :, 0] - lam_full * p[:, :, 1]
        return jnp.einsum('bhqk,bkhv->bqhv', a.astype(v.dtype), v)

    o = lax.map(block, (qb, jnp.arange(n_qb)))
    o = o.transpose(1, 0, 2, 3, 4).reshape(bsz, seq, DIFF_HEADS, 2 * DIFF_HEAD_DIM)
    o = _rmsnorm(o, subln) * (1.0 - lambda_init)
    return o.reshape(bsz, seq, DIFF_V) @ w_out


def _hier_moe(h, w_group, b_group, w_expert, b_expert, w1, w3, w2):
    bsz, seq, dm = h.shape
    n_tok = bsz * seq
    f32 = jnp.float32
    t = h.reshape(n_tok, dm)
    g_logits = (t @ w_group + b_group).astype(f32)
    g_idx = jnp.argmax(g_logits, axis=-1)
    g_gate = jnp.take_along_axis(jax.nn.softmax(g_logits, axis=-1), g_idx[:, None], axis=-1)
    e_logits = (t @ w_expert + b_expert).astype(f32).reshape(n_tok, N_GROUPS, EXPERTS_PER_GROUP)
    e_sel = jnp.take_along_axis(e_logits, g_idx[:, None, None], axis=1)[:, 0]
    top_w, top_i = lax.top_k(jax.nn.softmax(e_sel, axis=-1), TOP_K_IN_GROUP)
    top_w = top_w / jnp.sum(top_w, axis=-1, keepdims=True) * g_gate
    expert_id = g_idx[:, None] * EXPERTS_PER_GROUP + top_i
    m = n_tok * TOP_K_IN_GROUP
    flat_e = expert_id.reshape(m)
    flat_w = top_w.reshape(m)
    flat_tok = jnp.repeat(jnp.arange(n_tok), TOP_K_IN_GROUP)
    order = jnp.argsort(flat_e)
    sorted_e = flat_e[order]
    counts = jnp.bincount(flat_e, length=N_EXPERTS)
    starts = jnp.cumsum(counts) - counts
    padded = (counts + ROUTE_BLOCK - 1) // ROUTE_BLOCK * ROUTE_BLOCK
    padded_ends = jnp.cumsum(padded)
    padded_starts = padded_ends - padded
    dest = padded_starts[sorted_e] + (jnp.arange(m) - starts[sorted_e])
    n_blocks = -(-m // ROUTE_BLOCK) + N_EXPERTS
    rows = n_blocks * ROUTE_BLOCK
    buf_tok = jnp.zeros((rows,), jnp.int32).at[dest].set(flat_tok[order])
    buf_w = jnp.zeros((rows,), f32).at[dest].set(flat_w[order])
    block_e = jnp.minimum(jnp.searchsorted(padded_ends, jnp.arange(n_blocks) * ROUTE_BLOCK, side='right'),
                          N_EXPERTS - 1)
    xb = t[buf_tok].reshape(n_blocks, ROUTE_BLOCK, dm)

    def expert_block(args):
        xi, e = args
        hid = jax.nn.silu(xi @ w1[e]) * (xi @ w3[e])
        return hid @ w2[e]

    yb = lax.map(expert_block, (xb, block_e)).reshape(rows, dm)
    out = jnp.zeros((n_tok, dm), yb.dtype).at[buf_tok].add(yb * buf_w[:, None].astype(yb.dtype))
    return out.reshape(bsz, seq, dm).astype(h.dtype)


def setup_inputs(seed: int = 0) -> dict:
    key = jax.random.key(seed)
    ks = jax.random.split(key, 32)
    f32 = jnp.float32
    D = D_MODEL

    def nrm(k, shape, fan_in):
        return jax.random.normal(k, shape, f32) * (fan_in ** -0.5)

    def gain(k, shape):
        return 1.0 + 0.02 * jax.random.normal(k, shape, f32)

    def small(k, shape):
        return 0.01 * jax.random.normal(k, shape, f32)

    return {
        'x': jax.random.normal(ks[0], (BATCH, SEQ, D), f32),
        'c': jax.random.normal(ks[1], (BATCH, D), f32),
        'ada_w': nrm(ks[2], (DEPTH, D, 6 * D), D),
        'ada_b': small(ks[3], (DEPTH, 6 * D)),
        'norm_mix': gain(ks[4], (DEPTH, D)),
        'norm_ffn': gain(ks[5], (DEPTH, D)),
        'ret_w_in': nrm(ks[6], (N_A_LAYERS, D, RET_IN), D),
        'ret_gn': gain(ks[7], (N_A_LAYERS, RET_V)),
        'ret_w_out': nrm(ks[8], (N_A_LAYERS, RET_V, D), RET_V),
        'kv_ada_w': nrm(ks[9], (D, 2 * D), D),
        'kv_ada_b': small(ks[10], (2 * D,)),
        'kv_norm': gain(ks[11], (D,)),
        'kv_w': nrm(ks[12], (D, DIFF_QK + DIFF_V), D),
        'k_norm': gain(ks[13], (DIFF_HEAD_DIM,)),
        'diff_w_q': nrm(ks[14], (N_B_LAYERS, D, DIFF_QK), D),
        'q_norm': gain(ks[15], (N_B_LAYERS, DIFF_HEAD_DIM)),
        'diff_lam': 0.1 * jax.random.normal(ks[16], (N_B_LAYERS, 4, DIFF_HEAD_DIM), f32),
        'diff_subln': gain(ks[17], (N_B_LAYERS, 2 * DIFF_HEAD_DIM)),
        'diff_w_out': nrm(ks[18], (N_B_LAYERS, DIFF_V, D), DIFF_V),
        'moe_w_group': nrm(ks[19], (DEPTH, D, N_GROUPS), D),
        'moe_b_group': small(ks[20], (DEPTH, N_GROUPS)),
        'moe_w_expert': nrm(ks[21], (DEPTH, D, N_EXPERTS), D),
        'moe_b_expert': small(ks[22], (DEPTH, N_EXPERTS)),
        'moe_w1': nrm(ks[23], (DEPTH, N_EXPERTS, D, EXPERT_HIDDEN), D),
        'moe_w3': nrm(ks[24], (DEPTH, N_EXPERTS, D, EXPERT_HIDDEN), D),
        'moe_w2': nrm(ks[25], (DEPTH, N_EXPERTS, EXPERT_HIDDEN, D), EXPERT_HIDDEN),
    }


def reference(x, c, ada_w, ada_b, norm_mix, norm_ffn, ret_w_in, ret_gn, ret_w_out,
              kv_ada_w, kv_ada_b, kv_norm, kv_w, k_norm, diff_w_q, q_norm, diff_lam,
              diff_subln, diff_w_out, moe_w_group, moe_b_group, moe_w_expert, moe_b_expert,
              moe_w1, moe_w3, moe_w2):
    c_act = jax.nn.silu(c)
    k_shared = None
    v_shared = None
    for layer in range(DEPTH):
        sh1, sc1, g1, sh2, sc2, g2 = jnp.split(c_act @ ada_w[layer] + ada_b[layer], 6, axis=-1)
        h = _modulate(_rmsnorm(x, norm_mix[layer]), sh1, sc1)
        if layer < N_A_LAYERS:
            a = layer
            y = _retention(h, ret_w_in[a], ret_gn[a], ret_w_out[a])
        else:
            b = layer - N_A_LAYERS
            if b == 0:
                k_shared, v_shared = _shared_kv(x, c_act, kv_ada_w, kv_ada_b, kv_norm, kv_w, k_norm)
            lambda_init = 0.8 - 0.6 * math.exp(-0.3 * layer)
            y = _diff_attention(h, k_shared, v_shared, diff_w_q[b], q_norm[b], diff_lam[b],
                                diff_subln[b], diff_w_out[b], lambda_init)
        x = x + g1[:, None, :] * y
        h = _modulate(_rmsnorm(x, norm_ffn[layer]), sh2, sc2)
        x = x + g2[:, None, :] * _hier_moe(h, moe_w_group[layer], moe_b_group[layer],
                                           moe_w_expert[layer], moe_b_expert[layer],
                                           moe_w1[layer], moe_w3[layer], moe_w2[layer])
    return x
```

```cpp
#include <hip/hip_runtime.h>
#include <cstdio>
#include <cstdint>

#define LAS __attribute__((address_space(3)))
#define GAS __attribute__((address_space(1)))
typedef unsigned short bf16_t;
typedef short bf16x8 __attribute__((ext_vector_type(8)));
typedef short s16x4 __attribute__((ext_vector_type(4)));
typedef float f32x2 __attribute__((ext_vector_type(2)));
typedef float f32x4 __attribute__((ext_vector_type(4)));
typedef float f32x16 __attribute__((ext_vector_type(16)));
typedef unsigned u32x2 __attribute__((ext_vector_type(2)));
typedef unsigned u32x4 __attribute__((ext_vector_type(4)));

constexpr int NTOK = 32768, DM = 1024, SEQ = 2048, NBATCH = 16;
constexpr float EPS = 1e-6f;
constexpr float LOG2E = 1.4426950408889634f;
constexpr int NWAVES = 8, NTHREADS = 512;

constexpr size_t MiB = 1u << 20;
constexpr size_t WS_CTL = 0, CTL_ZERO_BYTES = 1 * MiB;
constexpr size_t WS_MOD = 1 * MiB;
constexpr size_t WS_KVMOD = WS_MOD + 786432;
constexpr size_t WS_COS = 2 * MiB, WS_SIN = 3 * MiB;
constexpr size_t WS_LIST = 4 * MiB;
constexpr size_t WS_TOKSLOT = 6 * MiB;
constexpr size_t WS_TOKW = 6 * MiB + 512 * 1024;
constexpr size_t WS_WIN = 8 * MiB, WS_WRO = 20 * MiB, WS_WKV = 24 * MiB, WS_WQ = 28 * MiB, WS_WAO = 30 * MiB;
constexpr size_t WS_W13 = 32 * MiB, WS_W2 = 96 * MiB;
constexpr size_t WS_XB = 128 * MiB;
constexpr size_t WS_SG = WS_XB;
constexpr size_t WS_H = 256 * MiB;
constexpr size_t WS_QR = 320 * MiB, WS_KR = 384 * MiB, WS_VR = 448 * MiB;
constexpr size_t WS_HID = 320 * MiB, WS_YB = 456 * MiB;
constexpr size_t WS_HKV = 320 * MiB, WS_Q1 = 384 * MiB, WS_K1 = 448 * MiB, WS_V1 = 512 * MiB, WS_AO = 320 * MiB;
constexpr size_t WS_END = 592 * MiB;
constexpr int MAXROWS = 69632;

constexpr int CW_BAR = 4096, CW_CNT0 = 8192, CW_CNT1 = 8256;

constexpr int RING_BYTES = 131072, ROWTAB_OFF = 131072, ROWTAB_BYTES = 16384, MISC_OFF = ROWTAB_OFF + ROWTAB_BYTES, LDS_BYTES = MISC_OFF + 2048;

__device__ __forceinline__ unsigned f2bf(float f) { unsigned u = __builtin_bit_cast(unsigned, f); return (u + 0x7fffu + ((u >> 16) & 1u)) >> 16; }
__device__ __forceinline__ unsigned pk2(float lo, float hi) { unsigned r; asm volatile("v_cvt_pk_bf16_f32 %0, %1, %2" : "=v"(r) : "v"(lo), "v"(hi)); return r; }
__device__ __forceinline__ float bf_lo(unsigned u) { return __builtin_bit_cast(float, u << 16); }
__device__ __forceinline__ float bf_hi(unsigned u) { return __builtin_bit_cast(float, u & 0xffff0000u); }
__device__ __forceinline__ float wave_sum(float v) {
#pragma unroll
    for (int o = 1; o < 64; o <<= 1) v += __shfl_xor(v, o);
    return v;
}
__device__ __forceinline__ float wave_max(float v) {
#pragma unroll
    for (int o = 1; o < 64; o <<= 1) v = fmaxf(v, __shfl_xor(v, o));
    return v;
}
__device__ __forceinline__ float fast_silu(float x) { return x * __builtin_amdgcn_rcpf(1.0f + __builtin_amdgcn_exp2f(-x * LOG2E)); }
#define LDS_WAIT() asm volatile("s_waitcnt lgkmcnt(0)" ::: "memory")
#define VM_WAIT() asm volatile("s_waitcnt vmcnt(0)" ::: "memory")

#define XB_TMO      128
#define XB_XCNT(j)  (256  + 64 * (j))
#define XB_XSUB(j)  (1280 + 64 * (j))
#define XB_XGEN(j)  (2304 + 64 * (j))
#define XB_TOP      3328
#define XB_TOPGEN   3392
#define XCD_BAR_WORDS 3456
#define XB_SPIN_CAP (1u << 22)
__device__ __forceinline__ unsigned xb_ld(unsigned* p)              { return __hip_atomic_load(p, __ATOMIC_RELAXED, __HIP_MEMORY_SCOPE_AGENT); }
__device__ __forceinline__ unsigned xb_add(unsigned* p, unsigned v) { return __hip_atomic_fetch_add(p, v, __ATOMIC_RELAXED, __HIP_MEMORY_SCOPE_AGENT); }
__device__ __forceinline__ unsigned xb_xcc_id() { return (unsigned)__builtin_amdgcn_s_getreg((3 << 11) | 20) & 0xFu; }
#define XB_SPIN(cond, bar) do { unsigned _sp = 0; while (cond) { __builtin_amdgcn_s_sleep(1); \
    if ((++_sp & 255u) == 0u) { if (xb_ld(&(bar)[XB_TMO])) break; if (_sp > XB_SPIN_CAP) { atomicAdd(&(bar)[XB_TMO], 1u); break; } } } } while (0)
struct XcdBarrier { unsigned* bar; unsigned x; volatile LAS unsigned* st; };
__device__ __forceinline__ XcdBarrier xcd_barrier_post(unsigned* bar, volatile LAS unsigned* st) {
    XcdBarrier b; b.bar = bar; b.x = xb_xcc_id(); b.st = st;
    if (threadIdx.x == 0) (void)xb_add(&bar[XB_XCNT(b.x)], 1u);
    return b;
}
__device__ __forceinline__ void xcd_barrier_complete(unsigned* bar, unsigned x, unsigned& nloc, unsigned& nx) {
    const unsigned G = gridDim.x * gridDim.y * gridDim.z;
    unsigned sum, cnt, mine, sp = 0u;
    for (;;) {
        sum = 0u; cnt = 0u; mine = 0u;
#pragma unroll
        for (unsigned j = 0; j < 16; ++j) { const unsigned c = xb_ld(&bar[XB_XCNT(j)]); sum += c; cnt += (c > 0u) ? 1u : 0u; mine = (j == x) ? c : mine; }
        if (sum == G) break;
        __builtin_amdgcn_s_sleep(1);
        if ((++sp & 255u) == 0u) { if (xb_ld(&bar[XB_TMO])) break; if (sp > XB_SPIN_CAP) { atomicAdd(&bar[XB_TMO], 1u); break; } }
    }
    nloc = mine > 0u ? mine : 1u; nx = cnt > 0u ? cnt : 1u;
}
__device__ __forceinline__ void xcd_barrier(const XcdBarrier& b) {
    asm volatile("s_waitcnt vmcnt(0)" ::: "memory");
    __syncthreads();
    if (threadIdx.x == 0) {
        unsigned* bar = b.bar;
        __builtin_amdgcn_s_waitcnt(0);
        unsigned nloc = b.st[0], nx = b.st[1];
        if (nloc == 0u) { xcd_barrier_complete(bar, b.x, nloc, nx); b.st[0] = nloc; b.st[1] = nx; }
        const unsigned old = xb_add(&bar[XB_XSUB(b.x)], 1u);
        const unsigned gen = old / nloc;
        if (old + 1u == (gen + 1u) * nloc) {
            __builtin_amdgcn_fence(__ATOMIC_RELEASE, "agent");
            asm volatile("s_waitcnt vmcnt(0)" ::: "memory");
            const unsigned og = xb_add(&bar[XB_TOP], 1u);
            const unsigned tg = og / nx;
            if (og + 1u == (tg + 1u) * nx) xb_add(&bar[XB_TOPGEN], 1u);
            else XB_SPIN(xb_ld(&bar[XB_TOPGEN]) == tg, bar);
            __builtin_amdgcn_fence(__ATOMIC_ACQUIRE, "agent");
            xb_add(&bar[XB_XGEN(b.x)], 1u);
            asm volatile("s_waitcnt vmcnt(0)" ::: "memory");
        } else {
            XB_SPIN(xb_ld(&bar[XB_XGEN(b.x)]) == gen, bar);
            __builtin_amdgcn_fence(__ATOMIC_ACQUIRE, "agent");
            asm volatile("s_waitcnt vmcnt(0)" ::: "memory");
        }
    }
    __syncthreads();
}
namespace pg8 {
constexpr int BM = 256, BK = 64, HALF = 128, HTB = HALF * BK * 2, STAGE_BYTES = 8 * HTB, NXCD = 8, WGM = 8;
__host__ __device__ __forceinline__ int lds_byte(int r, int c) { const int st = (r >> 4) * 2 + (c >> 5), rr = r & 15, cc = c & 31, ob = rr * 64 + cc * 2; return st * 1024 + (ob ^ (((ob >> 9) & 1) << 5)); }
__host__ __device__ __forceinline__ void stage_rc(int b, int& R, int& C) { const int st = b / 1024, sb = b % 1024, swz = sb ^ (((sb >> 9) & 1) << 5); R = (st >> 1) * 16 + swz / 64; C = (st & 1) * 32 + (swz % 64) / 2; }
__host__ __device__ __forceinline__ int perm32(int rho) { const int n = rho >> 4, i = rho & 15; return 8 * (i >> 2) + 4 * n + (i & 3); }

struct Unit { const char* A; const char* B; int pm, pn, rows; };

__device__ __forceinline__ bool static_order(int nM, int nN, int G, int c, int i, int& pm, int& pn) {
    const int nwg = nM * nN; const long L = (long)i * G + c; if (L >= nwg) return false;
    int wgid = (int)L; { const int q = nwg / NXCD, r = nwg % NXCD, xcd = wgid % NXCD, off = wgid / NXCD; wgid = (xcd < r ? xcd * (q + 1) : r * (q + 1) + (xcd - r) * q) + off; }
    const int nig = WGM * nN, gid = wgid / nig, fm = gid * WGM, gsz = (nM - fm) < WGM ? (nM - fm) : WGM;
    pm = fm + ((wgid % nig) % gsz); pn = (wgid % nig) / gsz; return true;
}
__device__ __forceinline__ int xcd_remap(int L, int nwg) { const int q = nwg / NXCD, r = nwg % NXCD, xcd = L % NXCD, off = L / NXCD; return (xcd < r ? xcd * (q + 1) : r * (q + 1) + (xcd - r) * q) + off; }

__device__ __forceinline__ bool load_unit(const LAS int* utab, int nU, int i, Unit& u) {
    if (i >= nU) return false;
    const LAS int* p = utab + i * 8;
    const unsigned alo = __builtin_amdgcn_readfirstlane(p[0]), ahi = __builtin_amdgcn_readfirstlane(p[1]), blo = __builtin_amdgcn_readfirstlane(p[2]), bhi = __builtin_amdgcn_readfirstlane(p[3]);
    u.A = (const char*)(((unsigned long long)ahi << 32) | alo); u.B = (const char*)(((unsigned long long)bhi << 32) | blo);
    u.pm = __builtin_amdgcn_readfirstlane(p[4]); u.pn = __builtin_amdgcn_readfirstlane(p[5]); u.rows = __builtin_amdgcn_readfirstlane(p[6]); return true;
}
template <class Sched>
__device__ __forceinline__ int build_units(LAS int* utab, const Sched& S, const int tid) {
    const int i = tid;
    if (i < 16) { Unit u; const bool ok = S.next(i, u); LAS int* p = utab + i * 8;
        if (ok) { const unsigned long long a = (unsigned long long)u.A, b = (unsigned long long)u.B; p[0] = (int)(unsigned)a; p[1] = (int)(unsigned)(a >> 32); p[2] = (int)(unsigned)b; p[3] = (int)(unsigned)(b >> 32); p[4] = u.pm; p[5] = u.pn; p[6] = u.rows; }
        p[7] = ok ? 1 : 0; }
    __syncthreads();
    int n = 0;
#pragma unroll
    for (int k = 0; k < 16; ++k) n += utab[k * 8 + 7];
    return __builtin_amdgcn_readfirstlane(n);
}
template <class Epi, bool GATHER>
__device__ __forceinline__ void gemm_phase(LAS unsigned char* lds, const int tid, const int K, const LAS int* utab, const int nU, const Epi& E, const LAS int* rowtab) {
    const int wid = __builtin_amdgcn_readfirstlane(tid >> 6), lane = tid & 63, wr = wid >> 2, wc = wid & 3, fr = lane & 15, fq = lane >> 4;
    const int nt = K / BK;
    unsigned vA[2][2], vN[2][2], voffB[2]; int Rr[2], Cc[2];
#pragma unroll
    for (int i = 0; i < 2; ++i) { int R, C; stage_rc(tid * 16 + i * 8192, R, C); const int Rb = Epi::PERM ? ((R & ~31) + perm32(R & 31)) : R; Rr[i] = R; Cc[i] = C;
        voffB[i] = (unsigned)(Rb * K + C) * 2u; }
#define PG8_CALCA(u, v) do { _Pragma("unroll") for (int _h = 0; _h < 2; ++_h) _Pragma("unroll") for (int _i = 0; _i < 2; ++_i) { const int _r = _h * HALF + Rr[_i]; \
        const int _row = GATHER ? rowtab[((u).rows >> 2) + _r] : _r; (v)[_h][_i] = (unsigned)(_row * K + Cc[_i]) * 2u; } } while (0)
    const size_t kstep = (size_t)(BK * 2);
    const size_t hstep = (size_t)HALF * K * 2;
    const unsigned ldsw = (unsigned)wid * 1024u;
    const int aoff = lds_byte(wr * 64 + fr, fq * 8), boff = lds_byte(wc * 32 + fr, fq * 8);
#define PG8_SA(b, h) (((b) * 2 + (h)) * HTB)
#define PG8_SB(b, h) ((4 + (b) * 2 + (h)) * HTB)
#define PG8_STAGE(bufoff, gbase, voff) do { _Pragma("unroll") for (int _i = 0; _i < 2; ++_i) \
        __builtin_amdgcn_global_load_lds((const unsigned*)((const char*)(gbase) + (voff)[_i]), (LAS unsigned*)(lds + (bufoff) + ldsw + _i * 8192), 16, 0, 0); } while (0)
#define PG8_LDA(dst, b, h) do { _Pragma("unroll") for (int m = 0; m < 4; ++m) _Pragma("unroll") for (int k = 0; k < 2; ++k) dst[m][k] = *(const LAS bf16x8*)(lds + PG8_SA(b, h) + aoff + m * 2048 + k * 1024); } while (0)
#define PG8_LDB(dst, b, h) do { _Pragma("unroll") for (int n = 0; n < 2; ++n) _Pragma("unroll") for (int k = 0; k < 2; ++k) dst[n][k] = *(const LAS bf16x8*)(lds + PG8_SB(b, h) + boff + n * 2048 + k * 1024); } while (0)
#define PG8_MMA(ai, bj, At, Bt) do { __builtin_amdgcn_s_setprio(1); _Pragma("unroll") for (int m = 0; m < 4; ++m) _Pragma("unroll") for (int n = 0; n < 2; ++n) _Pragma("unroll") for (int k = 0; k < 2; ++k) \
        acc[ai][bj][m][n] = __builtin_amdgcn_mfma_f32_16x16x32_bf16(Bt[n][k], At[m][k], acc[ai][bj][m][n], 0, 0, 0); __builtin_amdgcn_s_setprio(0); } while (0)
#define PG8_WAIT_V(n) asm volatile("s_waitcnt vmcnt(" #n ")" ::: "memory")
#define PG8_WAIT_L(n) asm volatile("s_waitcnt lgkmcnt(" #n ")" ::: "memory")
#define PG8_BAR __builtin_amdgcn_s_barrier()
#define PG8_SCHED __builtin_amdgcn_sched_barrier(0)
    Unit cur, nxt; int ui = 0;
    if (!load_unit(utab, nU, 0, cur)) return;
    f32x4 acc[2][2][4][2];
#pragma unroll
    for (int a = 0; a < 2; ++a)
#pragma unroll
        for (int b = 0; b < 2; ++b)
#pragma unroll
            for (int m = 0; m < 4; ++m)
#pragma unroll
                for (int n = 0; n < 2; ++n) acc[a][b][m][n] = (f32x4){0.f, 0.f, 0.f, 0.f};
    bf16x8 At[4][2], B0[2][2], B1[2][2];
    const char* cA = cur.A; const char* cB = cur.B;
    PG8_CALCA(cur, vA);
    PG8_STAGE(PG8_SB(0, 0), cB, voffB); PG8_STAGE(PG8_SB(0, 1), cB + hstep, voffB); PG8_STAGE(PG8_SA(0, 0), cA, vA[0]); PG8_STAGE(PG8_SA(0, 1), cA, vA[1]);
    if (wr == 1) PG8_BAR;
    PG8_WAIT_V(2); PG8_BAR;
    PG8_STAGE(PG8_SB(1, 0), cB + kstep, voffB); PG8_STAGE(PG8_SA(1, 0), cA + kstep, vA[0]); PG8_STAGE(PG8_SB(1, 1), cB + hstep + kstep, voffB);
    PG8_WAIT_V(6); PG8_BAR;
    for (;;) {
        const bool has_next = load_unit(utab, nU, ui + 1, nxt);
        const char* nA = has_next ? nxt.A : cA; const char* nB = has_next ? nxt.B : cB;
        if (GATHER) {
            if (has_next) { PG8_CALCA(nxt, vN); }
            else {
#pragma unroll
                for (int h = 0; h < 2; ++h) { vN[h][0] = vA[h][0]; vN[h][1] = vA[h][1]; }
            }
        }
        for (int t = 0; t < nt; t += 2) {
            const bool last = (t == nt - 2);
            const char* a1 = cA + (size_t)(t + 1) * kstep;
            const char* a2 = last ? nA : cA + (size_t)(t + 2) * kstep; const char* b2 = last ? nB : cB + (size_t)(t + 2) * kstep;
            const char* a3 = a2 + kstep; const char* b3 = b2 + kstep;
            unsigned w0[2], w1[2];
#pragma unroll
            for (int i = 0; i < 2; ++i) { w0[i] = (GATHER && last) ? vN[0][i] : vA[0][i]; w1[i] = (GATHER && last) ? vN[1][i] : vA[1][i]; }
            PG8_LDB(B0, 0, 0); PG8_LDB(B1, 0, 1); PG8_SCHED; PG8_LDA(At, 0, 0); PG8_STAGE(PG8_SA(1, 1), a1, vA[1]);
            PG8_WAIT_V(8); PG8_WAIT_L(0); PG8_BAR; PG8_MMA(0, 0, At, B0); PG8_MMA(0, 1, At, B1); PG8_BAR; PG8_SCHED;
            PG8_LDA(At, 0, 1); PG8_STAGE(PG8_SB(0, 0), b2, voffB); PG8_STAGE(PG8_SB(0, 1), b2 + hstep, voffB); PG8_STAGE(PG8_SA(0, 0), a2, w0);
            PG8_WAIT_V(8); PG8_WAIT_L(0); PG8_BAR; PG8_MMA(1, 0, At, B0); PG8_MMA(1, 1, At, B1); PG8_BAR; PG8_SCHED;
            PG8_LDB(B0, 1, 0); PG8_LDB(B1, 1, 1); PG8_SCHED; PG8_LDA(At, 1, 0); PG8_STAGE(PG8_SA(0, 1), a2, w1);
            PG8_WAIT_V(8); PG8_WAIT_L(0); PG8_BAR; PG8_MMA(0, 0, At, B0); PG8_MMA(0, 1, At, B1); PG8_BAR; PG8_SCHED;
            PG8_LDA(At, 1, 1); PG8_STAGE(PG8_SB(1, 0), b3, voffB); PG8_STAGE(PG8_SB(1, 1), b3 + hstep, voffB); PG8_STAGE(PG8_SA(1, 0), a3, w0);
            PG8_WAIT_V(8); PG8_WAIT_L(0); PG8_BAR; PG8_MMA(1, 0, At, B0); PG8_MMA(1, 1, At, B1); PG8_BAR; PG8_SCHED;
        }
        if (wr == 0) PG8_BAR;
        E(acc, cur, wr, wc, fr, fq);
        if (!has_next) break;
#pragma unroll
        for (int a = 0; a < 2; ++a)
#pragma unroll
            for (int b = 0; b < 2; ++b)
#pragma unroll
                for (int m = 0; m < 4; ++m)
#pragma unroll
                    for (int n = 0; n < 2; ++n) acc[a][b][m][n] = (f32x4){0.f, 0.f, 0.f, 0.f};
        cur = nxt; cA = nA; cB = nB; ++ui;
        if (GATHER) {
#pragma unroll
            for (int h = 0; h < 2; ++h) { vA[h][0] = vN[h][0]; vA[h][1] = vN[h][1]; }
        }
        if (wr == 1) PG8_BAR;
    }
    PG8_WAIT_V(0);
    PG8_BAR;
#undef PG8_CALCA
#undef PG8_SA
#undef PG8_SB
#undef PG8_STAGE
#undef PG8_LDA
#undef PG8_LDB
#undef PG8_MMA
#undef PG8_WAIT_V
#undef PG8_WAIT_L
#undef PG8_BAR
#undef PG8_SCHED
}
}
namespace pg8 {
typedef f32x4 Acc[2][2][4][2];

struct EpiInProj {
    static constexpr bool PERM = true;
    bf16_t *Q, *Kk, *V, *G; const float *cosT, *sinT;
    __device__ __forceinline__ void operator()(const Acc& acc, const Unit& u, int wr, int wc, int fr, int fq) const {
        const int pn = u.pn, row0 = u.pm * BM + wr * 64 + fr;
        if (pn < 8) {
            const int head = pn & 3; const bool isk = pn >= 4;
            const float lg = __builtin_log2f(1.0f - __builtin_exp2f(-5.0f - (float)head));
            bf16_t* out = isk ? Kk : Q;
            const int j0 = wc * 32 + 8 * fq;
#pragma unroll
            for (int ai = 0; ai < 2; ++ai)
#pragma unroll
                for (int m = 0; m < 4; ++m) {
                    const int row = row0 + ai * HALF + m * 16, pos = row & (SEQ - 1), nn = pos & 63;
                    const float sc = isk ? __builtin_exp2f(-(float)nn * lg) * 0.0625f : __builtin_exp2f((float)nn * lg);
                    u32x4 w1, w2;
#pragma unroll
                    for (int n = 0; n < 2; ++n) {
                        const f32x4 c4 = *(const f32x4*)(cosT + pos * 128 + j0 + 4 * n), s4 = *(const f32x4*)(sinT + pos * 128 + j0 + 4 * n);
                        const f32x4 x1 = acc[ai][0][m][n], x2 = acc[ai][1][m][n];
                        const f32x4 o1 = (x1 * c4 - x2 * s4) * sc, o2 = (x2 * c4 + x1 * s4) * sc;
                        w1[2 * n] = pk2(o1[0], o1[1]); w1[2 * n + 1] = pk2(o1[2], o1[3]); w2[2 * n] = pk2(o2[0], o2[1]); w2[2 * n + 1] = pk2(o2[2], o2[3]);
                    }
                    bf16_t* p = out + (size_t)row * 1024 + head * 256 + j0;
                    *(u32x4*)p = w1; *(u32x4*)(p + 128) = w2;
                }
        } else {
            const bool isg = pn >= 16; bf16_t* out = isg ? G : V; const int col0 = (isg ? pn - 16 : pn - 8) * 256 + wc * 32 + 8 * fq;
#pragma unroll
            for (int ai = 0; ai < 2; ++ai)
#pragma unroll
                for (int m = 0; m < 4; ++m) { bf16_t* rowp = out + (size_t)(row0 + ai * HALF + m * 16) * 2048 + col0;
#pragma unroll
                    for (int bj = 0; bj < 2; ++bj) { f32x4 v0 = acc[ai][bj][m][0], v1 = acc[ai][bj][m][1];
                        if (isg) {
#pragma unroll
                            for (int e = 0; e < 4; ++e) { v0[e] = fast_silu(v0[e]); v1[e] = fast_silu(v1[e]); } }
                        u32x4 w; w.x = pk2(v0[0], v0[1]); w.y = pk2(v0[2], v0[3]); w.z = pk2(v1[0], v1[1]); w.w = pk2(v1[2], v1[3]);
                        *(u32x4*)(rowp + bj * HALF) = w; } }
        }
    }
};
struct EpiMoeUp {
    static constexpr bool PERM = true;
    bf16_t* O;
    __device__ __forceinline__ void operator()(const Acc& acc, const Unit& u, int wr, int wc, int fr, int fq) const {
        const int row0 = u.pm * BM + wr * 64 + fr, col0 = u.pn * 128 + wc * 32 + 8 * fq;
#pragma unroll
        for (int ai = 0; ai < 2; ++ai)
#pragma unroll
            for (int m = 0; m < 4; ++m) {
                f32x4 v0 = acc[ai][0][m][0], v1 = acc[ai][0][m][1]; const f32x4 g0 = acc[ai][1][m][0], g1 = acc[ai][1][m][1];
#pragma unroll
                for (int e = 0; e < 4; ++e) { v0[e] = fast_silu(v0[e]) * g0[e]; v1[e] = fast_silu(v1[e]) * g1[e]; }
                u32x4 w; w.x = pk2(v0[0], v0[1]); w.y = pk2(v0[2], v0[3]); w.z = pk2(v1[0], v1[1]); w.w = pk2(v1[2], v1[3]);
                *(u32x4*)(O + (size_t)(row0 + ai * HALF + m * 16) * 1024 + col0) = w;
            }
    }
};
struct EpiBf16 {
    static constexpr bool PERM = true;
    bf16_t* O; int ldc;
    __device__ __forceinline__ void operator()(const Acc& acc, const Unit& u, int wr, int wc, int fr, int fq) const {
        const int row0 = u.pm * BM + wr * 64 + fr, col0 = u.pn * BM + wc * 32 + 8 * fq;
#pragma unroll
        for (int ai = 0; ai < 2; ++ai)
#pragma unroll
            for (int m = 0; m < 4; ++m) { bf16_t* rowp = O + (size_t)(row0 + ai * HALF + m * 16) * ldc + col0;
#pragma unroll
                for (int bj = 0; bj < 2; ++bj) { const f32x4 v0 = acc[ai][bj][m][0], v1 = acc[ai][bj][m][1];
                    u32x4 w; w.x = pk2(v0[0], v0[1]); w.y = pk2(v0[2], v0[3]); w.z = pk2(v1[0], v1[1]); w.w = pk2(v1[2], v1[3]);
                    *(u32x4*)(rowp + bj * HALF) = w; } }
    }
};
struct EpiResid {
    static constexpr bool PERM = false;
    const float* base; float* out; const float* gate;
    __device__ __forceinline__ void operator()(const Acc& acc, const Unit& u, int wr, int wc, int fr, int fq) const {
        const int row0 = u.pm * BM + wr * 64 + fr, col0 = u.pn * BM + wc * 32 + 4 * fq;
        const float* gp = gate + (size_t)((u.pm * BM) / SEQ) * 6144 + col0;
        f32x4 gv[2][2];
#pragma unroll
        for (int bj = 0; bj < 2; ++bj)
#pragma unroll
            for (int n = 0; n < 2; ++n) gv[bj][n] = *(const f32x4*)(gp + bj * HALF + n * 16);
#pragma unroll
        for (int ai = 0; ai < 2; ++ai)
#pragma unroll
            for (int m = 0; m < 4; ++m) { const size_t off = (size_t)(row0 + ai * HALF + m * 16) * 1024 + col0;
#pragma unroll
                for (int bj = 0; bj < 2; ++bj)
#pragma unroll
                    for (int n = 0; n < 2; ++n) { const f32x4 bs = *(const f32x4*)(base + off + bj * HALF + n * 16);
                        *(f32x4*)(out + off + bj * HALF + n * 16) = bs + gv[bj][n] * acc[ai][bj][m][n]; }
                if (m & 1) asm volatile("" ::: "memory"); }
    }
};
struct EpiQKV {
    static constexpr bool PERM = true;
    bf16_t *Q, *Kk, *V; const float *qn, *kn;
    __device__ __forceinline__ void operator()(const Acc& acc, const Unit& u, int wr, int wc, int fr, int fq) const {
        const int pn = u.pn, row0 = u.pm * BM + wr * 64 + fr;
        if (pn < 8) {
            const bool isk = pn >= 4; bf16_t* out = isk ? Kk : Q; const float* gn = isk ? kn : qn; const float osc = isk ? 1.0f : 0.125f * LOG2E;
            const int col0 = (pn & 3) * 256 + 64 * wc + 8 * fq;
#pragma unroll
            for (int ai = 0; ai < 2; ++ai)
#pragma unroll
                for (int m = 0; m < 4; ++m) {
                    float ss = 0.f;
#pragma unroll
                    for (int bj = 0; bj < 2; ++bj)
#pragma unroll
                        for (int n = 0; n < 2; ++n) { const f32x4 x = acc[ai][bj][m][n]; ss += (x[0] * x[0] + x[1] * x[1]) + (x[2] * x[2] + x[3] * x[3]); }
                    ss += __shfl_xor(ss, 16); ss += __shfl_xor(ss, 32);
                    const float rstd = __builtin_amdgcn_rsqf(ss * (1.0f / 64.0f) + EPS) * osc;
                    bf16_t* rowp = out + (size_t)(row0 + ai * HALF + m * 16) * 1024 + col0;
#pragma unroll
                    for (int bj = 0; bj < 2; ++bj) { const f32x4 g0 = *(const f32x4*)(gn + 32 * bj + 8 * fq), g1 = *(const f32x4*)(gn + 32 * bj + 8 * fq + 4);
                        const f32x4 v0 = acc[ai][bj][m][0] * rstd * g0, v1 = acc[ai][bj][m][1] * rstd * g1;
                        u32x4 w; w.x = pk2(v0[0], v0[1]); w.y = pk2(v0[2], v0[3]); w.z = pk2(v1[0], v1[1]); w.w = pk2(v1[2], v1[3]);
                        *(u32x4*)(rowp + 32 * bj) = w; }
                    asm volatile("" ::: "memory");
                }
        } else {
            const int col0 = (pn - 8) * 256 + wc * 32 + 8 * fq;
#pragma unroll
            for (int ai = 0; ai < 2; ++ai)
#pragma unroll
                for (int m = 0; m < 4; ++m) { bf16_t* rowp = V + (size_t)(row0 + ai * HALF + m * 16) * 1024 + col0;
#pragma unroll
                    for (int bj = 0; bj < 2; ++bj) { const f32x4 v0 = acc[ai][bj][m][0], v1 = acc[ai][bj][m][1];
                        u32x4 w; w.x = pk2(v0[0], v0[1]); w.y = pk2(v0[2], v0[3]); w.z = pk2(v1[0], v1[1]); w.w = pk2(v1[2], v1[3]);
                        *(u32x4*)(rowp + bj * HALF) = w; } }
        }
    }
};

struct SchedPlain {
    const char *A, *B; int nM, nN, K, G, c;
    __device__ __forceinline__ bool next(int i, Unit& u) const { int pm, pn; if (!static_order(nM, nN, G, c, i, pm, pn)) return false;
        u.pm = pm; u.pn = pn; u.rows = 0; u.A = A + (size_t)pm * BM * K * 2; u.B = B + (size_t)pn * BM * K * 2; return true; }
};
struct SchedQKV {
    const char *Aq, *Akv, *Bq, *Bkv; int G, c;
    __device__ __forceinline__ bool next(int i, Unit& u) const { int pm, pn; if (!static_order(NTOK / BM, 12, G, c, i, pm, pn)) return false;
        u.pm = pm; u.pn = pn; u.rows = 0; const size_t ts = (size_t)BM * 1024 * 2;
        u.A = (pn < 4 ? Aq : Akv) + (size_t)pm * ts; u.B = pn < 4 ? Bq + (size_t)pn * ts : Bkv + (size_t)(pn - 4) * ts; return true; }
};
struct SchedMoe {
    const char *A, *B; const LAS int* rbs; int NT, G, c, gather; size_t estride;
    __device__ __forceinline__ bool next(int i, Unit& u) const {
        const int nrb = rbs[16], nwg = nrb * NT; const long L = (long)i * G + c; if (L >= nwg) return false;
        const int wg = xcd_remap((int)L, nwg), rb = wg / NT, pn = wg % NT;
        int e = 0;
#pragma unroll
        for (int k = 1; k < 16; ++k) e += (rb >= rbs[k]) ? 1 : 0;
        u.pm = rb; u.pn = pn; u.rows = i * 1024;
        u.A = gather ? A : A + (size_t)rb * BM * 1024 * 2; u.B = B + (size_t)e * estride + (size_t)pn * BM * 1024 * 2; return true; }
};
}
typedef __attribute__((address_space(4))) const unsigned long long* kargp_t;
struct Frame {
    LAS unsigned char* lds;
    unsigned* ctl;
    int tid, lane, wave, vcu, G;
    unsigned char* ws;
    kargp_t kin;
    __device__ __forceinline__ const float* inp(int i) const { return (const float*)kin[i]; }
    float* out;
};
enum { I_X = 0, I_C, I_ADAW, I_ADAB, I_NMIX, I_NFFN, I_RWIN, I_RGN, I_RWOUT, I_KVADAW, I_KVADAB, I_KVNORM, I_KVW, I_KNORM, I_WQ, I_QNORM, I_LAM, I_SUBLN, I_WOUT,
       I_WG, I_BG, I_WE, I_BE, I_W1, I_W3, I_W2 };

__device__ __forceinline__ int dest_row(int n, int mode) {
    if (mode == 1) { const int c = n & 255; return (n & ~255) + 128 * ((c >> 5) & 1) + 32 * (c >> 6) + (c & 31); }
    if (mode == 2) return (n >> 7) * 256 + (n & 127);
    if (mode == 3) return (n >> 7) * 256 + 128 + (n & 127);
    return n;
}
__device__ __forceinline__ void transpose_item(const float* W, int K, int N, bf16_t* WT, int mode, LAS float* scr, int item, int lane) {
    const int nblk = N / 32, kb = item / nblk, nb = item % nblk, k0 = 64 * kb, n0 = 32 * nb;
#pragma unroll 8
    for (int i = 0; i < 32; ++i) { const int kk = 2 * i + (lane >> 5); scr[kk * 33 + (lane & 31)] = W[(size_t)(k0 + kk) * N + n0 + (lane & 31)]; }
    LDS_WAIT(); asm volatile("" ::: "memory");
    const int c = lane & 7; const int d0 = dest_row(n0, mode);
#pragma unroll
    for (int j = 0; j < 4; ++j) { const int n = (lane >> 3) + 8 * j; const LAS float* s = scr + (8 * c) * 33 + n;
        u32x4 o; o.x = pk2(s[0 * 33], s[1 * 33]); o.y = pk2(s[2 * 33], s[3 * 33]); o.z = pk2(s[4 * 33], s[5 * 33]); o.w = pk2(s[6 * 33], s[7 * 33]);
        *(u32x4*)(WT + (size_t)(d0 + n) * K + k0 + 8 * c) = o; }
    LDS_WAIT(); asm volatile("" ::: "memory");
}
__device__ __forceinline__ void convert_moe_weights(Frame& F, int layer, int gw, int NGW) {
    LAS float* scr = (LAS float*)(F.lds + F.wave * 8448);
    constexpr int IPM = (1024 / 64) * (1024 / 32);
    const int total = 16 * 3 * IPM;
    const float* w1 = F.inp(I_W1) + (size_t)layer * 16 * 1048576; const float* w3 = F.inp(I_W3) + (size_t)layer * 16 * 1048576; const float* w2 = F.inp(I_W2) + (size_t)layer * 16 * 1048576;
    bf16_t* W13 = (bf16_t*)(F.ws + WS_W13); bf16_t* W2 = (bf16_t*)(F.ws + WS_W2);
    for (int it = gw; it < total; it += NGW) {
        const int e = it / (3 * IPM), r = it % (3 * IPM), which = r / IPM, item = r % IPM;
        if (which == 0) transpose_item(w1 + (size_t)e * 1048576, 1024, 1024, W13 + (size_t)e * 2097152, 2, scr, item, F.lane);
        else if (which == 1) transpose_item(w3 + (size_t)e * 1048576, 1024, 1024, W13 + (size_t)e * 2097152, 3, scr, item, F.lane);
        else transpose_item(w2 + (size_t)e * 1048576, 1024, 1024, W2 + (size_t)e * 1048576, 0, scr, item, F.lane);
    }
}
__device__ __forceinline__ void convert_dense_weights(Frame& F, int gw, int NGW) {
    LAS float* scr = (LAS float*)(F.lds + F.wave * 8448);
    constexpr int I_IN = (1024 / 64) * (6144 / 32), I_RO = (2048 / 64) * (1024 / 32), I_KV = (1024 / 64) * (2048 / 32), I_Q = 512, I_AO = 512;
    constexpr int total = I_IN + I_RO + I_KV + I_Q + I_AO;
    for (int it = gw; it < total; it += NGW) {
        int r = it;
        if (r < I_IN) { transpose_item(F.inp(I_RWIN), 1024, 6144, (bf16_t*)(F.ws + WS_WIN), 0, scr, r, F.lane); continue; } r -= I_IN;
        if (r < I_RO) { transpose_item(F.inp(I_RWOUT), 2048, 1024, (bf16_t*)(F.ws + WS_WRO), 0, scr, r, F.lane); continue; } r -= I_RO;
        if (r < I_KV) { const int nb = r % 64; transpose_item(F.inp(I_KVW), 1024, 2048, (bf16_t*)(F.ws + WS_WKV), nb < 32 ? 1 : 0, scr, r, F.lane); continue; } r -= I_KV;
        if (r < I_Q) { transpose_item(F.inp(I_WQ), 1024, 1024, (bf16_t*)(F.ws + WS_WQ), 1, scr, r, F.lane); continue; } r -= I_Q;
        transpose_item(F.inp(I_WOUT), 1024, 1024, (bf16_t*)(F.ws + WS_WAO), 0, scr, r, F.lane);
    }
}
__device__ __forceinline__ void adaln_phase(Frame& F) {
    LAS float* cs = (LAS float*)F.lds;
    LAS float* red = (LAS float*)(F.lds + 65536);
    constexpr int NTASK = (2 * 6144 + 2048) / 64;
    if ((int)blockIdx.x >= NTASK) return;
    for (int i = F.tid; i < 16 * 1024; i += NTHREADS) { const float v = F.inp(I_C)[i]; cs[i] = v / (1.0f + __expf(-v)); }
    __syncthreads();
    for (int task = blockIdx.x; task < NTASK; task += F.G) {
        const int gc = task * 64; const float* W; const float* bias; float* outp; int N, c0, ostride;
        if (gc < 6144) { W = F.inp(I_ADAW); bias = F.inp(I_ADAB); N = 6144; c0 = gc; outp = (float*)(F.ws + WS_MOD); ostride = 6144; }
        else if (gc < 12288) { W = F.inp(I_ADAW) + (size_t)1024 * 6144; bias = F.inp(I_ADAB) + 6144; N = 6144; c0 = gc - 6144; outp = (float*)(F.ws + WS_MOD) + 16 * 6144; ostride = 6144; }
        else { W = F.inp(I_KVADAW); bias = F.inp(I_KVADAB); N = 2048; c0 = gc - 12288; outp = (float*)(F.ws + WS_KVMOD); ostride = 2048; }
        float acc[16];
#pragma unroll
        for (int b = 0; b < 16; ++b) acc[b] = 0.f;
        const int k0 = F.wave * 128;
        for (int k = k0; k < k0 + 128; k += 4) {
            float w[4];
#pragma unroll
            for (int j = 0; j < 4; ++j) w[j] = W[(size_t)(k + j) * N + c0 + F.lane];
#pragma unroll
            for (int b = 0; b < 16; ++b) { const f32x4 c4 = *(const LAS f32x4*)(cs + b * 1024 + k); acc[b] += c4[0] * w[0] + c4[1] * w[1] + c4[2] * w[2] + c4[3] * w[3]; }
        }
#pragma unroll
        for (int b = 0; b < 16; ++b) red[(F.wave * 16 + b) * 64 + F.lane] = acc[b];
        __syncthreads();
        for (int o = F.tid; o < 1024; o += NTHREADS) { const int b = o >> 6, col = o & 63; float s = 0.f;
#pragma unroll
            for (int w = 0; w < 8; ++w) s += red[(w * 16 + b) * 64 + col];
            outp[(size_t)b * ostride + c0 + col] = s + bias[c0 + col]; }
        __syncthreads();
    }
}
__device__ __forceinline__ void rope_table(Frame& F, int gt, int NGT) {
    float* ct = (float*)(F.ws + WS_COS); float* st = (float*)(F.ws + WS_SIN);
    for (int i = gt; i < 2048 * 128; i += NGT) { const int pos = i >> 7, j = i & 127;
        const float inv = 1.0f / powf(10000.0f, (float)j * (1.0f / 128.0f)); const float ang = (float)pos * inv; ct[i] = cosf(ang); st[i] = sinf(ang); }
}

struct Row16 { f32x4 v[4]; };
__device__ __forceinline__ void row_load(Row16& r, const float* p, int lane) {
#pragma unroll
    for (int j = 0; j < 4; ++j) r.v[j] = ((const f32x4*)p)[64 * j + lane];
}
__device__ __forceinline__ float row_sumsq(const Row16& r) { float s = 0.f;
#pragma unroll
    for (int j = 0; j < 4; ++j) s += (r.v[j][0] * r.v[j][0] + r.v[j][1] * r.v[j][1]) + (r.v[j][2] * r.v[j][2] + r.v[j][3] * r.v[j][3]);
    return wave_sum(s); }
__device__ __forceinline__ void row_norm_mod_store(const Row16& r, float rstd, const float* g, const float* shift, const float* scale, bf16_t* outp, int lane) {
#pragma unroll
    for (int j = 0; j < 4; ++j) { const int c = 64 * j + lane; const f32x4 gg = ((const f32x4*)g)[c], sh = ((const f32x4*)shift)[c], sc = ((const f32x4*)scale)[c];
        const f32x4 h = (r.v[j] * rstd * gg) * (sc + 1.0f) + sh; u32x2 w; w.x = pk2(h[0], h[1]); w.y = pk2(h[2], h[3]); ((u32x2*)outp)[c] = w; }
}
__device__ __forceinline__ void phase_h0(Frame& F) {
    const int gw = F.vcu * NWAVES + F.wave, NGW = F.G * NWAVES; const float* mod = (const float*)(F.ws + WS_MOD); bf16_t* H = (bf16_t*)(F.ws + WS_H);
    for (int t = gw; t < NTOK; t += NGW) { Row16 r; row_load(r, F.inp(I_X) + (size_t)t * 1024, F.lane);
        const float rstd = __builtin_amdgcn_rsqf(row_sumsq(r) * (1.0f / 1024.0f) + EPS); const int b = t / SEQ;
        row_norm_mod_store(r, rstd, F.inp(I_NMIX), mod + b * 6144, mod + b * 6144 + 1024, H + (size_t)t * 1024, F.lane); }
}
__device__ __forceinline__ void phase_gate(Frame& F) {
    const int gw = F.vcu * NWAVES + F.wave, NGW = F.G * NWAVES; bf16_t* O = (bf16_t*)(F.ws + WS_VR); const bf16_t* SG = (const bf16_t*)(F.ws + WS_SG); const float* gn = F.inp(I_RGN);
    for (int t = gw; t < NTOK; t += NGW) {
        u32x4 o[4], g[4];
#pragma unroll
        for (int j = 0; j < 4; ++j) { o[j] = ((const u32x4*)(O + (size_t)t * 2048))[64 * j + F.lane]; g[j] = ((const u32x4*)(SG + (size_t)t * 2048))[64 * j + F.lane]; }
#pragma unroll
        for (int j = 0; j < 4; ++j) {
            float ov[8]; float ss = 0.f;
#pragma unroll
            for (int e = 0; e < 4; ++e) { ov[2 * e] = bf_lo(o[j][e]); ov[2 * e + 1] = bf_hi(o[j][e]); ss += ov[2 * e] * ov[2 * e] + ov[2 * e + 1] * ov[2 * e + 1]; }
            const float rstd = __builtin_amdgcn_rsqf(wave_sum(ss) * (1.0f / 512.0f) + EPS);
            const f32x4 g0 = ((const f32x4*)gn)[2 * (64 * j + F.lane)], g1 = ((const f32x4*)gn)[2 * (64 * j + F.lane) + 1];
            u32x4 w;
#pragma unroll
            for (int e = 0; e < 4; ++e) { const float ga = e < 2 ? g0[2 * e] : g1[2 * e - 4], gb = e < 2 ? g0[2 * e + 1] : g1[2 * e - 3];
                w[e] = pk2(bf_lo(g[j][e]) * (ov[2 * e] * rstd * ga), bf_hi(g[j][e]) * (ov[2 * e + 1] * rstd * gb)); }
            ((u32x4*)(O + (size_t)t * 2048))[64 * j + F.lane] = w;
        }
    }
}
__device__ __forceinline__ void phase_route(Frame& F, int layer) {
    const int gw = blockIdx.x * NWAVES + F.wave;
    const float* mod = (const float*)(F.ws + WS_MOD) + (size_t)layer * 16 * 6144; const float* XB = (const float*)(F.ws + WS_XB); bf16_t* H = (bf16_t*)(F.ws + WS_H);
    const float* nf = F.inp(I_NFFN) + layer * 1024; const float* wg = F.inp(I_WG) + (size_t)layer * 4096; const float* we = F.inp(I_WE) + (size_t)layer * 16384;
    const float* bg = F.inp(I_BG) + layer * 4; const float* be = F.inp(I_BE) + layer * 16;
    unsigned* gcnt = F.ctl + (layer ? CW_CNT1 : CW_CNT0);
    int* list = (int*)(F.ws + WS_LIST); int* tokslot = (int*)(F.ws + WS_TOKSLOT); float* tokw = (float*)(F.ws + WS_TOKW);
    LAS int* wcnt = (LAS int*)(F.lds);
    LAS int* wbase = (LAS int*)(F.lds + 1024);
    const int NGW = F.G * NWAVES;
    for (int base = 0; base < NTOK; base += NGW * 16) {
        const int t0 = base + gw * 16; const bool active = t0 < NTOK;
        int my_e0 = 0, my_e1 = 0; float my_w0 = 0.f, my_w1 = 0.f;
        if (active) {
            for (int i = 0; i < 16; ++i) {
                const int t = t0 + i; Row16 r; row_load(r, XB + (size_t)t * 1024, F.lane);
                const float rstd = __builtin_amdgcn_rsqf(row_sumsq(r) * (1.0f / 1024.0f) + EPS); const int b = t / SEQ;
                const float* shift = mod + b * 6144 + 3072; const float* scale = mod + b * 6144 + 4096;
                float lg[20];
#pragma unroll
                for (int q = 0; q < 20; ++q) lg[q] = 0.f;
                bf16_t* outp = H + (size_t)t * 1024;
#pragma unroll
                for (int j = 0; j < 4; ++j) { const int c = 64 * j + F.lane; const f32x4 gg = ((const f32x4*)nf)[c], sh = ((const f32x4*)shift)[c], sc = ((const f32x4*)scale)[c];
                    const f32x4 h = (r.v[j] * rstd * gg) * (sc + 1.0f) + sh; u32x2 w; w.x = pk2(h[0], h[1]); w.y = pk2(h[2], h[3]); ((u32x2*)outp)[c] = w;
#pragma unroll
                    for (int e = 0; e < 4; ++e) { const int col = 4 * c + e; const f32x4 g4 = ((const f32x4*)wg)[col];
                        lg[0] += h[e] * g4[0]; lg[1] += h[e] * g4[1]; lg[2] += h[e] * g4[2]; lg[3] += h[e] * g4[3];
#pragma unroll
                        for (int q = 0; q < 4; ++q) { const f32x4 e4 = ((const f32x4*)we)[col * 4 + q]; lg[4 + 4 * q] += h[e] * e4[0]; lg[5 + 4 * q] += h[e] * e4[1]; lg[6 + 4 * q] += h[e] * e4[2]; lg[7 + 4 * q] += h[e] * e4[3]; } } }
#pragma unroll
                for (int q = 0; q < 20; ++q) lg[q] = wave_sum(lg[q]);
                float gl[4]; int gi = 0;
#pragma unroll
                for (int q = 0; q < 4; ++q) gl[q] = lg[q] + bg[q];
                float gm = gl[0];
#pragma unroll
                for (int q = 1; q < 4; ++q) if (gl[q] > gm) { gm = gl[q]; gi = q; }
                float gs = 0.f;
#pragma unroll
                for (int q = 0; q < 4; ++q) gs += __expf(gl[q] - gm);
                const float ggate = 1.0f / gs;
                float el[4];
#pragma unroll
                for (int q = 0; q < 4; ++q) { float v = lg[4 + q] + be[q];
#pragma unroll
                    for (int g2 = 1; g2 < 4; ++g2) v = (gi == g2) ? lg[4 + 4 * g2 + q] + be[4 * g2 + q] : v;
                    el[q] = v; }
                int i0 = 0; float m0 = el[0];
#pragma unroll
                for (int q = 1; q < 4; ++q) if (el[q] > m0) { m0 = el[q]; i0 = q; }
                int i1 = -1; float m1 = -INFINITY;
#pragma unroll
                for (int q = 0; q < 4; ++q) if (q != i0 && el[q] > m1) { m1 = el[q]; i1 = q; }
                const float p1 = __expf(m1 - m0); const float w0 = ggate / (1.0f + p1), w1 = ggate * p1 / (1.0f + p1);
                if (F.lane == i) { my_e0 = gi * 4 + i0; my_e1 = gi * 4 + i1; my_w0 = w0; my_w1 = w1; }
            }
        }
        const bool have = active && F.lane < 16; int rank0 = 0, rank1 = 0, mycount = 0;
        const unsigned long long lt = (1ull << F.lane) - 1ull;
#pragma unroll
        for (int e = 0; e < 16; ++e) {
            const unsigned long long b0 = __ballot(have && my_e0 == e), b1 = __ballot(have && my_e1 == e);
            if (my_e0 == e) rank0 = __popcll(b0 & lt);
            if (my_e1 == e) rank1 = __popcll(b0) + __popcll(b1 & lt);
            if (F.lane == e) mycount = __popcll(b0) + __popcll(b1);
        }
        if (F.lane < 16) wcnt[F.wave * 16 + F.lane] = mycount;
        __syncthreads();
        if (F.tid < 16) { int tot = 0;
#pragma unroll
            for (int w = 0; w < 8; ++w) { const int c = wcnt[w * 16 + F.tid]; wbase[w * 16 + F.tid] = tot; tot += c; }
            const int gb = tot ? (int)atomicAdd(gcnt + F.tid, (unsigned)tot) : 0;
#pragma unroll
            for (int w = 0; w < 8; ++w) wbase[w * 16 + F.tid] += gb; }
        __syncthreads();
        if (have) { const int t = t0 + F.lane; const int p0 = wbase[F.wave * 16 + my_e0] + rank0, p1 = wbase[F.wave * 16 + my_e1] + rank1;
            list[my_e0 * 32768 + p0] = t; list[my_e1 * 32768 + p1] = t;
            tokslot[2 * t] = (my_e0 << 16) | p0; tokslot[2 * t + 1] = (my_e1 << 16) | p1; tokw[2 * t] = my_w0; tokw[2 * t + 1] = my_w1; }
        __syncthreads();
    }
}
__device__ __forceinline__ void moe_tables(Frame& F, int layer, LAS int* rbs, LAS int* rowtab, int NT, bool gather) {
    const unsigned* gcnt = F.ctl + (layer ? CW_CNT1 : CW_CNT0);
    LAS int* cnts = rbs + 32;
    if (F.tid == 0) { int acc = 0;
        for (int e = 0; e < 16; ++e) { const int c = (int)__hip_atomic_load(gcnt + e, __ATOMIC_RELAXED, __HIP_MEMORY_SCOPE_AGENT); cnts[e] = c; rbs[e] = acc; acc += (c + 255) >> 8; }
        rbs[16] = acc; }
    __syncthreads();
    if (gather) {
        const int* list = (const int*)(F.ws + WS_LIST); const int nrb = rbs[16], nwg = nrb * NT;
        for (int i = 0; i < 16; ++i) { const long L = (long)i * F.G + blockIdx.x; if (L >= nwg) break;
            const int wg = pg8::xcd_remap((int)L, nwg), rb = wg / NT; int e = 0;
            for (int k = 1; k < 16; ++k) e += (rb >= rbs[k]) ? 1 : 0;
            const int lr0 = (rb - rbs[e]) * 256, cnt = cnts[e];
            if (F.tid < 256) { int r = lr0 + F.tid; r = r < cnt ? r : cnt - 1; rowtab[i * 256 + F.tid] = list[e * 32768 + r]; } }
        __syncthreads();
    }
}
__device__ __forceinline__ void moe_combine_row(Frame& F, int layer, int t, const LAS int* rbs, Row16& r) {
    const float* XB = (const float*)(F.ws + WS_XB); const bf16_t* YB = (const bf16_t*)(F.ws + WS_YB);
    const int* tokslot = (const int*)(F.ws + WS_TOKSLOT); const float* tokw = (const float*)(F.ws + WS_TOKW);
    const float* g2 = (const float*)(F.ws + WS_MOD) + (size_t)layer * 16 * 6144 + (size_t)(t / SEQ) * 6144 + 5120;
    row_load(r, XB + (size_t)t * 1024, F.lane);
    const int s0 = tokslot[2 * t], s1 = tokslot[2 * t + 1]; const float w0 = tokw[2 * t], w1 = tokw[2 * t + 1];
    const int r0 = rbs[s0 >> 16] * 256 + (s0 & 0xffff), r1 = rbs[s1 >> 16] * 256 + (s1 & 0xffff);
    const u32x2* y0 = (const u32x2*)(YB + (size_t)r0 * 1024); const u32x2* y1 = (const u32x2*)(YB + (size_t)r1 * 1024);
#pragma unroll
    for (int j = 0; j < 4; ++j) { const int c = 64 * j + F.lane; const u32x2 a = y0[c], b = y1[c]; const f32x4 gg = ((const f32x4*)g2)[c];
        f32x4 m; m[0] = w0 * bf_lo(a.x) + w1 * bf_lo(b.x); m[1] = w0 * bf_hi(a.x) + w1 * bf_hi(b.x); m[2] = w0 * bf_lo(a.y) + w1 * bf_lo(b.y); m[3] = w0 * bf_hi(a.y) + w1 * bf_hi(b.y);
        r.v[j] = r.v[j] + gg * m; }
}
__device__ __forceinline__ void rbs_only(Frame& F, int layer, LAS int* rbs) {
    const unsigned* gcnt = F.ctl + (layer ? CW_CNT1 : CW_CNT0);
    if (F.tid == 0) { int acc = 0;
        for (int e = 0; e < 16; ++e) { const int c = (int)__hip_atomic_load(gcnt + e, __ATOMIC_RELAXED, __HIP_MEMORY_SCOPE_AGENT); rbs[e] = acc; acc += (c + 255) >> 8; }
        rbs[16] = acc; }
    __syncthreads();
}
__device__ __forceinline__ void phase_mid(Frame& F, LAS int* rbs) {
    const int gw = F.vcu * NWAVES + F.wave, NGW = F.G * NWAVES; float* XB = (float*)(F.ws + WS_XB); bf16_t* HQ = (bf16_t*)(F.ws + WS_H); bf16_t* HKV = (bf16_t*)(F.ws + WS_HKV);
    const float* mod1 = (const float*)(F.ws + WS_MOD) + 16 * 6144; const float* kvmod = (const float*)(F.ws + WS_KVMOD);
    rbs_only(F, 0, rbs);
    for (int t = gw; t < NTOK; t += NGW) { Row16 r; moe_combine_row(F, 0, t, rbs, r);
#pragma unroll
        for (int j = 0; j < 4; ++j) ((f32x4*)(XB + (size_t)t * 1024))[64 * j + F.lane] = r.v[j];
        const float rstd = __builtin_amdgcn_rsqf(row_sumsq(r) * (1.0f / 1024.0f) + EPS); const int b = t / SEQ;
        row_norm_mod_store(r, rstd, F.inp(I_NMIX) + 1024, mod1 + b * 6144, mod1 + b * 6144 + 1024, HQ + (size_t)t * 1024, F.lane);
        row_norm_mod_store(r, rstd, F.inp(I_KVNORM), kvmod + b * 2048, kvmod + b * 2048 + 1024, HKV + (size_t)t * 1024, F.lane); }
}
__device__ __forceinline__ void phase_final(Frame& F, LAS int* rbs) {
    const int gw = F.vcu * NWAVES + F.wave, NGW = F.G * NWAVES;
    rbs_only(F, 1, rbs);
    for (int t = gw; t < NTOK; t += NGW) { Row16 r; moe_combine_row(F, 1, t, rbs, r);
#pragma unroll
        for (int j = 0; j < 4; ++j) ((f32x4*)(F.out + (size_t)t * 1024))[64 * j + F.lane] = r.v[j]; }
}
__device__ __forceinline__ s16x4 tr_read(const LAS void* p) {
    typedef short v4s __attribute__((ext_vector_type(4)));
    return __builtin_bit_cast(s16x4, __builtin_amdgcn_ds_read_tr16_b64_v4i16((LAS v4s*)p));
}
__device__ __forceinline__ bf16x8 cat8(s16x4 a, s16x4 b) { return (bf16x8){a[0], a[1], a[2], a[3], b[0], b[1], b[2], b[3]}; }

constexpr int RQ_STRIDE = 528, RV_STRIDE = 272, RS_STRIDE = 144;
constexpr int R_QS = 0, R_KS = 64 * RQ_STRIDE, R_VS = 2 * 64 * RQ_STRIDE, R_SS = R_VS + 64 * RV_STRIDE, R_OS = R_SS + 64 * RS_STRIDE, R_END = R_OS + 64 * RV_STRIDE;
static_assert(R_END <= RING_BYTES, "retention LDS");

__device__ __forceinline__ void phase_retention(Frame& F) {
    LAS unsigned char* lds = F.lds;
    const int tid = F.tid, lane = F.lane, w = F.wave, g = lane >> 4, l15 = lane & 15, tq = (lane >> 2) & 3, tp = lane & 3;
    const bf16_t* QR = (const bf16_t*)(F.ws + WS_QR); const bf16_t* KR = (const bf16_t*)(F.ws + WS_KR); bf16_t* VR = (bf16_t*)(F.ws + WS_VR);
    for (int i = tid; i < 64 * RS_STRIDE / 4; i += NTHREADS) ((LAS unsigned*)(lds + R_SS))[i] = 0u;
    for (int unit = F.vcu; unit < 256; unit += F.G) {
        const int b = unit >> 4, h = (unit >> 2) & 3, s = unit & 3;
        const float lgam = __builtin_log2f(1.0f - __builtin_exp2f(-5.0f - (float)h)); const float cdec = __builtin_exp2f(64.0f * lgam);
        const size_t tok0 = (size_t)b * SEQ;
        const bf16_t* qg = QR + tok0 * 1024 + h * 256; const bf16_t* kg = KR + tok0 * 1024 + h * 256; bf16_t* vg = VR + tok0 * 2048 + h * 512 + s * 128;
        f32x4 St[16];
#pragma unroll
        for (int t = 0; t < 16; ++t) St[t] = (f32x4){0.f, 0.f, 0.f, 0.f};
        u32x4 pq[4], pk[4], pv[2];
#define RET_PREFETCH(ci) do { _Pragma("unroll") for (int i = 0; i < 4; ++i) { const int id = i * 512 + tid, row = id >> 5, c16 = id & 31; \
            pq[i] = *(const u32x4*)(qg + (size_t)((ci) * 64 + row) * 1024 + c16 * 8); pk[i] = *(const u32x4*)(kg + (size_t)((ci) * 64 + row) * 1024 + c16 * 8); } \
            _Pragma("unroll") for (int i = 0; i < 2; ++i) { const int id = i * 512 + tid, row = id >> 4, c16 = id & 15; pv[i] = *(const u32x4*)(vg + (size_t)((ci) * 64 + row) * 2048 + c16 * 8); } } while (0)
        RET_PREFETCH(0);
        for (int ci = 0; ci < 32; ++ci) {
#pragma unroll
            for (int i = 0; i < 4; ++i) { const int id = i * 512 + tid, row = id >> 5, c16 = id & 31;
                *(LAS u32x4*)(lds + R_QS + row * RQ_STRIDE + c16 * 16) = pq[i]; *(LAS u32x4*)(lds + R_KS + row * RQ_STRIDE + c16 * 16) = pk[i]; }
#pragma unroll
            for (int i = 0; i < 2; ++i) { const int id = i * 512 + tid, row = id >> 4, c16 = id & 15; *(LAS u32x4*)(lds + R_VS + row * RV_STRIDE + c16 * 16) = pv[i]; }
            __syncthreads();
            if (ci + 1 < 32) RET_PREFETCH(ci + 1);
#pragma unroll
            for (int rep = 0; rep < 2; ++rep) {
                const int idx = w + 8 * rep;
                if (idx < 10) {
                    const int mt = idx < 4 ? 0 : idx < 7 ? 1 : idx < 9 ? 2 : 3, nt_ = idx < 4 ? idx : idx < 7 ? idx - 3 : idx < 9 ? idx - 5 : 3;
                    f32x4 sacc = (f32x4){0.f, 0.f, 0.f, 0.f};
                    const LAS unsigned char* ka = lds + R_KS + (mt * 16 + l15) * RQ_STRIDE + g * 16; const LAS unsigned char* qb = lds + R_QS + (nt_ * 16 + l15) * RQ_STRIDE + g * 16;
#pragma unroll
                    for (int kk = 0; kk < 8; ++kk) { const bf16x8 a = *(const LAS bf16x8*)(ka + kk * 64), bq = *(const LAS bf16x8*)(qb + kk * 64);
                        sacc = __builtin_amdgcn_mfma_f32_16x16x32_bf16(a, bq, sacc, 0, 0, 0); }
                    const int n = nt_ * 16 + l15, m0 = mt * 16 + 4 * g;
#pragma unroll
                    for (int r = 0; r < 4; ++r) if (n < m0 + r) sacc[r] = 0.f;
                    u32x2 pw; pw.x = pk2(sacc[0], sacc[1]); pw.y = pk2(sacc[2], sacc[3]);
                    *(LAS u32x2*)(lds + R_SS + n * RS_STRIDE + m0 * 2) = pw;
                }
            }
            __syncthreads();
            bf16x8 vf[2];
#pragma unroll
            for (int kk = 0; kk < 2; ++kk) { const LAS unsigned char* vp = lds + R_VS + (32 * kk + 8 * g + tq) * RV_STRIDE + (16 * w + 4 * tp) * 2;
                vf[kk] = cat8(tr_read(vp), tr_read(vp + 4 * RV_STRIDE)); }
            bf16x8 sb[8];
#pragma unroll
            for (int kk = 0; kk < 8; ++kk) { u32x4 x; x.x = pk2(St[2 * kk][0], St[2 * kk][1]); x.y = pk2(St[2 * kk][2], St[2 * kk][3]); x.z = pk2(St[2 * kk + 1][0], St[2 * kk + 1][1]); x.w = pk2(St[2 * kk + 1][2], St[2 * kk + 1][3]);
                sb[kk] = __builtin_bit_cast(bf16x8, x); }
            f32x4 o[4];
#pragma unroll
            for (int nt_ = 0; nt_ < 4; ++nt_) {
                f32x4 oa = (f32x4){0.f, 0.f, 0.f, 0.f};
                const LAS unsigned char* sp = lds + R_SS + (nt_ * 16 + l15) * RS_STRIDE + g * 16;
#pragma unroll
                for (int kk = 0; kk < 2; ++kk) { if (kk * 32 < (nt_ + 1) * 16) { const bf16x8 a = *(const LAS bf16x8*)(sp + kk * 64); oa = __builtin_amdgcn_mfma_f32_16x16x32_bf16(a, vf[kk], oa, 0, 0, 0); } }
                const LAS unsigned char* qp = lds + R_QS + (nt_ * 16 + l15) * RQ_STRIDE + g * 8;
#pragma unroll
                for (int kk = 0; kk < 8; ++kk) { const s16x4 a0 = *(const LAS s16x4*)(qp + kk * 64), a1 = *(const LAS s16x4*)(qp + kk * 64 + 32);
                    oa = __builtin_amdgcn_mfma_f32_16x16x32_bf16(cat8(a0, a1), sb[kk], oa, 0, 0, 0); }
                o[nt_] = oa;
            }
#pragma unroll
            for (int t = 0; t < 16; ++t) {
#pragma unroll
                for (int kk = 0; kk < 2; ++kk) { const LAS unsigned char* kp = lds + R_KS + (32 * kk + 8 * g + tq) * RQ_STRIDE + (16 * t + 4 * tp) * 2;
                    const bf16x8 a = cat8(tr_read(kp), tr_read(kp + 4 * RQ_STRIDE)); St[t] = __builtin_amdgcn_mfma_f32_16x16x32_bf16(a, vf[kk], St[t], 0, 0, 0); }
                St[t] = St[t] * cdec;
            }
#pragma unroll
            for (int nt_ = 0; nt_ < 4; ++nt_)
#pragma unroll
                for (int r = 0; r < 4; ++r) *(LAS bf16_t*)(lds + R_OS + (nt_ * 16 + 4 * g + r) * RV_STRIDE + (16 * w + l15) * 2) = (bf16_t)f2bf(o[nt_][r]);
            __syncthreads();
#pragma unroll
            for (int i = 0; i < 2; ++i) { const int id = i * 512 + tid, row = id >> 4, c16 = id & 15;
                *(u32x4*)(vg + (size_t)(ci * 64 + row) * 2048 + c16 * 8) = *(const LAS u32x4*)(lds + R_OS + row * RV_STRIDE + c16 * 16); }
        }
#undef RET_PREFETCH
        __syncthreads();
    }
}

constexpr int AK_STRIDE = 272, A_K0 = 0, A_V0 = 2 * 64 * AK_STRIDE, A_LS = 4 * 64 * AK_STRIDE, A_X = A_LS + 8 * 64 * 4, A_END = A_X + 4 * 16384;
static_assert(A_END <= ROWTAB_OFF + ROWTAB_BYTES, "attention LDS");
__device__ __forceinline__ int crow(int r, int hi) { return (r & 3) + 8 * (r >> 2) + 4 * hi; }

__device__ __forceinline__ void phase_attention(Frame& F) {
    LAS unsigned char* lds = F.lds;
    const int tid = F.tid, lane = F.lane, w = F.wave, r32 = lane & 31, hi = lane >> 5, tq = (lane >> 2) & 3, tp = lane & 3, ch = (lane >> 4) & 1, t = w >> 2, wq = w & 3;
    const bf16_t* Q1 = (const bf16_t*)(F.ws + WS_Q1); const bf16_t* K1 = (const bf16_t*)(F.ws + WS_K1); const bf16_t* V1 = (const bf16_t*)(F.ws + WS_V1); bf16_t* AO = (bf16_t*)(F.ws + WS_AO);
    const float* lam = F.inp(I_LAM);
    const float l01 = wave_sum(lam[lane] * lam[64 + lane]), l23 = wave_sum(lam[128 + lane] * lam[192 + lane]);
    const float lambda_init = 0.8f - 0.6f * 0.7408182206817179f;
    const float lam_full = __expf(l01) - __expf(l23) + lambda_init;
    const float gq = wave_max(fabsf(F.inp(I_QNORM)[lane])), gk = wave_max(fabsf(F.inp(I_KNORM)[lane]));
    const float M2 = 8.0f * LOG2E * gq * gk * 1.001f + 0.01f;
    const float sub0 = F.inp(I_SUBLN)[r32], sub1 = F.inp(I_SUBLN)[32 + r32], sub2 = F.inp(I_SUBLN)[64 + r32], sub3 = F.inp(I_SUBLN)[96 + r32];
    LAS float* wsf = (LAS float*)(lds + A_LS) + w * 64;
    LAS float* X = (LAS float*)(lds + A_X) + wq * 4096;
    for (int v = F.vcu; v < 256; v += F.G) {
        const int bh = v >> 1, b = bh >> 3, h = bh & 7, half = v & 1;
        for (int ui = 0; ui < 8; ++ui) {
            const int pr = 2 * (ui >> 1) + half, u = (ui & 1) ? 15 - pr : pr;
            const size_t tok0 = (size_t)b * SEQ; const int q0 = u * 128 + wq * 32;
            const int NT = 2 * u + 2, jmax = 2 * u + (wq >> 1);
            const bf16_t* kg = K1 + tok0 * 1024 + h * 128; const bf16_t* vg = V1 + tok0 * 1024 + h * 128;
            bf16x8 qf[4];
#pragma unroll
            for (int ks = 0; ks < 4; ++ks) qf[ks] = *(const bf16x8*)(Q1 + (tok0 + q0 + r32) * 1024 + h * 128 + t * 64 + ks * 16 + hi * 8);
            f32x16 O[4];
#pragma unroll
            for (int d = 0; d < 4; ++d) O[d] = f32x16{};
            float lsum = 0.f;
            u32x4 pk_[2], pv_[2];
#define ATT_PREFETCH(j) do { _Pragma("unroll") for (int i = 0; i < 2; ++i) { const int id = i * 512 + tid, row = id >> 4, c16 = id & 15; \
                pk_[i] = *(const u32x4*)(kg + (size_t)((j) * 64 + row) * 1024 + c16 * 8); pv_[i] = *(const u32x4*)(vg + (size_t)((j) * 64 + row) * 1024 + c16 * 8); } } while (0)
#define ATT_STAGE(buf) do { _Pragma("unroll") for (int i = 0; i < 2; ++i) { const int id = i * 512 + tid, row = id >> 4, c16 = id & 15; \
                *(LAS u32x4*)(lds + A_K0 + (buf) * 64 * AK_STRIDE + row * AK_STRIDE + c16 * 16) = pk_[i]; *(LAS u32x4*)(lds + A_V0 + (buf) * 64 * AK_STRIDE + row * AK_STRIDE + c16 * 16) = pv_[i]; } } while (0)
            ATT_PREFETCH(0); ATT_STAGE(0);
            __syncthreads();
            for (int j = 0; j < NT; ++j) {
                const int buf = j & 1;
                if (j + 1 < NT) ATT_PREFETCH(j + 1);
                if (j <= jmax) {
                    const LAS unsigned char* kb = lds + A_K0 + buf * 64 * AK_STRIDE + r32 * AK_STRIDE + (t * 64 + hi * 8) * 2; const LAS unsigned char* vb = lds + A_V0 + buf * 64 * AK_STRIDE + (4 * hi + tq) * AK_STRIDE + (16 * ch + 4 * tp) * 2;
                    f32x16 p0, p1;
#pragma unroll
                    for (int r = 0; r < 16; ++r) { p0[r] = -M2; p1[r] = -M2; }
#pragma unroll
                    for (int ks = 0; ks < 4; ++ks) { const bf16x8 a0 = *(const LAS bf16x8*)(kb + ks * 32), a1 = *(const LAS bf16x8*)(kb + 32 * AK_STRIDE + ks * 32);
                        p0 = __builtin_amdgcn_mfma_f32_32x32x16_bf16(a0, qf[ks], p0, 0, 0, 0); p1 = __builtin_amdgcn_mfma_f32_32x32x16_bf16(a1, qf[ks], p1, 0, 0, 0); }
                    float sa = 0.f;
#pragma unroll
                    for (int r = 0; r < 16; ++r) { p0[r] = __builtin_amdgcn_exp2f(p0[r]); p1[r] = __builtin_amdgcn_exp2f(p1[r]); sa += p0[r] + p1[r]; }
                    lsum += sa;
                    bf16x8 pf[4];
                    { u32x4 x0, x1, x2, x3;
                      x0.x = pk2(p0[0], p0[1]); x0.y = pk2(p0[2], p0[3]); x0.z = pk2(p0[4], p0[5]); x0.w = pk2(p0[6], p0[7]);
                      x1.x = pk2(p0[8], p0[9]); x1.y = pk2(p0[10], p0[11]); x1.z = pk2(p0[12], p0[13]); x1.w = pk2(p0[14], p0[15]);
                      x2.x = pk2(p1[0], p1[1]); x2.y = pk2(p1[2], p1[3]); x2.z = pk2(p1[4], p1[5]); x2.w = pk2(p1[6], p1[7]);
                      x3.x = pk2(p1[8], p1[9]); x3.y = pk2(p1[10], p1[11]); x3.z = pk2(p1[12], p1[13]); x3.w = pk2(p1[14], p1[15]);
                      pf[0] = __builtin_bit_cast(bf16x8, x0); pf[1] = __builtin_bit_cast(bf16x8, x1); pf[2] = __builtin_bit_cast(bf16x8, x2); pf[3] = __builtin_bit_cast(bf16x8, x3); }
#pragma unroll
                    for (int d = 0; d < 4; ++d)
#pragma unroll
                        for (int s = 0; s < 4; ++s) { const LAS unsigned char* vp = vb + (16 * s) * AK_STRIDE + (32 * d) * 2;
                            const bf16x8 vfr = cat8(tr_read(vp), tr_read(vp + 8 * AK_STRIDE));
                            O[d] = __builtin_amdgcn_mfma_f32_32x32x16_bf16(pf[s], vfr, O[d], 0, 0, 0); }
                }
                if (j + 1 < NT) ATT_STAGE(buf ^ 1);
                __syncthreads();
            }
#undef ATT_PREFETCH
#undef ATT_STAGE
            lsum += __shfl_xor(lsum, 32);
            if (hi == 0) wsf[r32] = (t ? lam_full : 1.0f) / lsum;
            LDS_WAIT(); asm volatile("" ::: "memory");
            float sc[16];
#pragma unroll
            for (int r = 0; r < 16; ++r) sc[r] = wsf[crow(r, hi)];
            if (t == 1) {
#pragma unroll
                for (int d = 0; d < 4; ++d)
#pragma unroll
                    for (int r = 0; r < 16; ++r) X[(d * 16 + r) * 64 + lane] = O[d][r] * sc[r];
            }
            __syncthreads();
            if (t == 0) {
                const float osc = 1.0f - lambda_init;
#pragma unroll
                for (int r = 0; r < 16; ++r) { const int q = crow(r, hi);
                    const float o0 = O[0][r] * sc[r] - X[(0 * 16 + r) * 64 + lane], o1 = O[1][r] * sc[r] - X[(1 * 16 + r) * 64 + lane], o2 = O[2][r] * sc[r] - X[(2 * 16 + r) * 64 + lane], o3 = O[3][r] * sc[r] - X[(3 * 16 + r) * 64 + lane];
                    float ss = o0 * o0 + o1 * o1 + o2 * o2 + o3 * o3;
                    ss += __shfl_xor(ss, 1); ss += __shfl_xor(ss, 2); ss += __shfl_xor(ss, 4); ss += __shfl_xor(ss, 8); ss += __shfl_xor(ss, 16);
                    const float rstd = __builtin_amdgcn_rsqf(ss * (1.0f / 128.0f) + EPS) * osc;
                    bf16_t* op = AO + (tok0 + q0 + q) * 1024 + h * 128 + r32;
                    op[0] = (bf16_t)f2bf(o0 * rstd * sub0); op[32] = (bf16_t)f2bf(o1 * rstd * sub1); op[64] = (bf16_t)f2bf(o2 * rstd * sub2); op[96] = (bf16_t)f2bf(o3 * rstd * sub3); }
            }
            LDS_WAIT(); asm volatile("" ::: "memory");
        }
    }
}
constexpr int N_PHASES = 17;
#ifndef MK_N_LAUNCHES
#define MK_N_LAUNCHES 1
#endif
struct Args { const float* in[26]; float* out; unsigned char* ws; int ph_lo, ph_hi; };

__global__ void __launch_bounds__(NTHREADS, 2) yoco_fwd(Args args) {
    extern __shared__ __attribute__((aligned(16))) unsigned char lds_raw[];
    Frame F;
    F.lds = (LAS unsigned char*)lds_raw;
    F.G = gridDim.x; { const int bx = blockIdx.x; F.vcu = (F.G % 8 == 0) ? (bx % 8) * (F.G / 8) + bx / 8 : bx; }
#define FRESH_IN() do { kargp_t _t = (kargp_t)__builtin_amdgcn_kernarg_segment_ptr(); asm volatile("" : "+s"(_t)); F.kin = _t; \
        F.out = (float*)_t[26]; F.ws = (unsigned char*)_t[27]; F.ctl = (unsigned*)(F.ws + WS_CTL); \
        int _tid = threadIdx.x; asm volatile("" : "+v"(_tid)); F.tid = _tid; F.lane = _tid & 63; F.wave = __builtin_amdgcn_readfirstlane(_tid >> 6); } while (0)
    FRESH_IN();
    volatile LAS unsigned* MISC = (volatile LAS unsigned*)(F.lds + MISC_OFF);
    LAS int* rbs = (LAS int*)(F.lds + MISC_OFF + 256);
    LAS int* rowtab = (LAS int*)(F.lds + ROWTAB_OFF);
    LAS int* utab = (LAS int*)(F.lds + MISC_OFF + 1024);
    for (int u = F.tid; u < 512; u += NTHREADS) MISC[u] = 0u;
    __syncthreads();
    const int lo = args.ph_lo, hi = args.ph_hi;
    const bool multi = (hi - lo) > 1;
    XcdBarrier bar; bar.bar = nullptr; bar.x = 0; bar.st = nullptr;
    if (multi) bar = xcd_barrier_post(F.ctl + CW_BAR, MISC + 8);
#ifdef ONLY_PHASE
#define IN(k) ((k) == ONLY_PHASE && lo <= (k) && (k) < hi)
#else
#define IN(k) (lo <= (k) && (k) < hi)
#endif
#define SEAM(k) do { if (IN(k) && IN((k) + 1)) { bar.bar = F.ctl + CW_BAR; xcd_barrier(bar); } else __syncthreads(); } while (0)
    #define gw (F.vcu * NWAVES + F.wave)
#define NGW (F.G * NWAVES)

    if (IN(0)) { FRESH_IN(); adaln_phase(F); __syncthreads(); rope_table(F, blockIdx.x * NTHREADS + F.tid, F.G * NTHREADS); convert_dense_weights(F, gw, NGW); convert_moe_weights(F, 0, gw, NGW); SEAM(0); }
    if (IN(1)) { FRESH_IN(); phase_h0(F); SEAM(1); }
    if (IN(2)) { FRESH_IN(); pg8::SchedPlain S{(const char*)(F.ws + WS_H), (const char*)(F.ws + WS_WIN), NTOK / 256, 24, 1024, F.G, (int)blockIdx.x};
        pg8::EpiInProj E{(bf16_t*)(F.ws + WS_QR), (bf16_t*)(F.ws + WS_KR), (bf16_t*)(F.ws + WS_VR), (bf16_t*)(F.ws + WS_SG), (const float*)(F.ws + WS_COS), (const float*)(F.ws + WS_SIN)};
        { const int nU = pg8::build_units(utab, S, F.tid); pg8::gemm_phase<pg8::EpiInProj, false>(F.lds, F.tid, 1024, utab, nU, E, rowtab); } SEAM(2); }
    if (IN(3)) { FRESH_IN(); phase_retention(F); SEAM(3); }
    if (IN(4)) { FRESH_IN(); phase_gate(F); SEAM(4); }
    if (IN(5)) { FRESH_IN(); pg8::SchedPlain S{(const char*)(F.ws + WS_VR), (const char*)(F.ws + WS_WRO), NTOK / 256, 4, 2048, F.G, (int)blockIdx.x};
        pg8::EpiResid E{F.inp(I_X), (float*)(F.ws + WS_XB), (const float*)(F.ws + WS_MOD) + 2048};
        { const int nU = pg8::build_units(utab, S, F.tid); pg8::gemm_phase<pg8::EpiResid, false>(F.lds, F.tid, 2048, utab, nU, E, rowtab); } SEAM(5); }
#pragma unroll 1
    for (int layer = 0; layer < 2; ++layer) {
        const int pb = layer ? 13 : 6;
        if (IN(pb)) { FRESH_IN(); phase_route(F, layer); SEAM(pb); }
        if (IN(pb + 1)) { FRESH_IN(); moe_tables(F, layer, rbs, rowtab, 8, true);
            pg8::SchedMoe S{(const char*)(F.ws + WS_H), (const char*)(F.ws + WS_W13), rbs, 8, F.G, (int)blockIdx.x, 1, (size_t)2048 * 1024 * 2};
            pg8::EpiMoeUp E{(bf16_t*)(F.ws + WS_HID)};
            { const int nU = pg8::build_units(utab, S, F.tid); pg8::gemm_phase<pg8::EpiMoeUp, true>(F.lds, F.tid, 1024, utab, nU, E, rowtab); } SEAM(pb + 1); }
        if (IN(pb + 2)) { FRESH_IN(); moe_tables(F, layer, rbs, rowtab, 4, false);
            pg8::SchedMoe S{(const char*)(F.ws + WS_HID), (const char*)(F.ws + WS_W2), rbs, 4, F.G, (int)blockIdx.x, 0, (size_t)1024 * 1024 * 2};
            pg8::EpiBf16 E{(bf16_t*)(F.ws + WS_YB), 1024};
            { const int nU = pg8::build_units(utab, S, F.tid); pg8::gemm_phase<pg8::EpiBf16, false>(F.lds, F.tid, 1024, utab, nU, E, rowtab); } SEAM(pb + 2); }
        if (layer == 0) {
            if (IN(9)) { FRESH_IN(); phase_mid(F, rbs); convert_moe_weights(F, 1, gw, NGW); SEAM(9); }
            if (IN(10)) { FRESH_IN(); pg8::SchedQKV S{(const char*)(F.ws + WS_H), (const char*)(F.ws + WS_HKV), (const char*)(F.ws + WS_WQ), (const char*)(F.ws + WS_WKV), F.G, (int)blockIdx.x};
                pg8::EpiQKV E{(bf16_t*)(F.ws + WS_Q1), (bf16_t*)(F.ws + WS_K1), (bf16_t*)(F.ws + WS_V1), F.inp(I_QNORM), F.inp(I_KNORM)};
                { const int nU = pg8::build_units(utab, S, F.tid); pg8::gemm_phase<pg8::EpiQKV, false>(F.lds, F.tid, 1024, utab, nU, E, rowtab); } SEAM(10); }
            if (IN(11)) { FRESH_IN(); phase_attention(F); SEAM(11); }
            if (IN(12)) { FRESH_IN(); pg8::SchedPlain S{(const char*)(F.ws + WS_AO), (const char*)(F.ws + WS_WAO), NTOK / 256, 4, 1024, F.G, (int)blockIdx.x};
                pg8::EpiResid E{(const float*)(F.ws + WS_XB), (float*)(F.ws + WS_XB), (const float*)(F.ws + WS_MOD) + 16 * 6144 + 2048};
                { const int nU = pg8::build_units(utab, S, F.tid); pg8::gemm_phase<pg8::EpiResid, false>(F.lds, F.tid, 1024, utab, nU, E, rowtab); } SEAM(12); }
        }
    }
    if (IN(16)) { FRESH_IN(); phase_final(F, rbs); }
#undef IN
#undef SEAM
#undef gw
#undef NGW
}

extern "C" void kernel_launch(void* const* d_in, const int* in_sizes, int n_in, void* d_out, int out_size, void* d_ws, size_t ws_size, hipStream_t stream) {
    static int grid = 0;
    if (grid == 0) {
        if (n_in != 26 || in_sizes[0] != NTOK * DM || out_size != NTOK * DM || ws_size < WS_END) {
            fprintf(stderr, "kernel_launch: unexpected shapes (n_in %d, in0 %d, out %d, ws %zu < %zu); nothing launched\n", n_in, n_in > 0 ? in_sizes[0] : -1, out_size, ws_size, (size_t)WS_END); grid = -1; return; }
        int dev = 0, cus = 0, per_cu = 0;
        if (hipGetDevice(&dev) != hipSuccess || hipDeviceGetAttribute(&cus, hipDeviceAttributeMultiprocessorCount, dev) != hipSuccess) { grid = -1; return; }
        if (hipFuncSetAttribute((const void*)yoco_fwd, hipFuncAttributeMaxDynamicSharedMemorySize, LDS_BYTES) != hipSuccess) { fprintf(stderr, "kernel_launch: hipFuncSetAttribute failed\n"); grid = -1; return; }
        if (hipOccupancyMaxActiveBlocksPerMultiprocessor(&per_cu, (const void*)yoco_fwd, NTHREADS, LDS_BYTES) != hipSuccess || per_cu < 1) { fprintf(stderr, "kernel_launch: occupancy query says %d blocks per CU\n", per_cu); (void)hipGetLastError(); grid = -1; return; }
        grid = cus;
    }
    if (grid < 0) return;
    (void)hipMemsetAsync((char*)d_ws + WS_CTL, 0, CTL_ZERO_BYTES, stream);
    Args a{};
    for (int i = 0; i < 26; ++i) a.in[i] = (const float*)d_in[i];
    a.out = (float*)d_out; a.ws = (unsigned char*)d_ws;
    if (MK_N_LAUNCHES == 1) { a.ph_lo = 0; a.ph_hi = N_PHASES; hipLaunchKernelGGL(yoco_fwd, dim3(grid), dim3(NTHREADS), LDS_BYTES, stream, a); }
    else { for (int p = 0; p < N_PHASES; ++p) { a.ph_lo = p; a.ph_hi = p + 1; hipLaunchKernelGGL(yoco_fwd, dim3(grid), dim3(NTHREADS), LDS_BYTES, stream, a); } }
}
```

```cpp
#include <hip/hip_runtime.h>
#include <cstdio>
#include <cstdint>

#define LAS __attribute__((address_space(3)))
#define GAS __attribute__((address_space(1)))
typedef unsigned short bf16_t;
typedef short bf16x8 __attribute__((ext_vector_type(8)));
typedef short s16x4 __attribute__((ext_vector_type(4)));
typedef float f32x2 __attribute__((ext_vector_type(2)));
typedef float f32x4 __attribute__((ext_vector_type(4)));
typedef float f32x16 __attribute__((ext_vector_type(16)));
typedef unsigned u32x2 __attribute__((ext_vector_type(2)));
typedef unsigned u32x4 __attribute__((ext_vector_type(4)));

constexpr int NTOK = 32768, DM = 1024, SEQ = 2048, NBATCH = 16;
constexpr float EPS = 1e-6f;
constexpr float LOG2E = 1.4426950408889634f;
constexpr int NWAVES = 8, NTHREADS = 512;

constexpr size_t MiB = 1u << 20;
constexpr size_t WS_CTL = 0, CTL_ZERO_BYTES = 1 * MiB;
constexpr size_t WS_MOD = 1 * MiB;
constexpr size_t WS_KVMOD = WS_MOD + 786432;
constexpr size_t WS_COS = 2 * MiB, WS_SIN = 3 * MiB;
constexpr size_t WS_LIST = 4 * MiB;
constexpr size_t WS_TOKSLOT = 6 * MiB;
constexpr size_t WS_TOKW = 6 * MiB + 512 * 1024;
constexpr size_t WS_WRT = 7 * MiB;
constexpr size_t WS_WIN = 8 * MiB, WS_WRO = 20 * MiB, WS_WKV = 24 * MiB, WS_WQ = 28 * MiB, WS_WAO = 30 * MiB;
constexpr size_t WS_W13 = 32 * MiB, WS_W2 = 96 * MiB;
constexpr size_t WS_XB = 128 * MiB;
constexpr size_t WS_SG = WS_XB;
constexpr size_t WS_H = 256 * MiB;
constexpr size_t WS_QR = 320 * MiB, WS_KR = 384 * MiB, WS_VR = 448 * MiB;
constexpr size_t WS_HID = 320 * MiB, WS_YB = 456 * MiB;
constexpr size_t WS_HKV = 320 * MiB, WS_Q1 = 384 * MiB, WS_K1 = 448 * MiB, WS_V1 = 512 * MiB, WS_AO = 320 * MiB;
constexpr size_t WS_END = 592 * MiB;
constexpr int MAXROWS = 69632;

constexpr int CW_BAR = 4096, CW_CNT0 = 8192, CW_CNT1 = 8256, CW_ATTQ = 8320, CW_ADALN = 8384;
constexpr int N_CONV = 16;

constexpr int RING_BYTES = 131072, ROWTAB_OFF = 131072, ROWTAB_BYTES = 16384, MISC_OFF = ROWTAB_OFF + ROWTAB_BYTES, LDS_BYTES = MISC_OFF + 2048;

__device__ __forceinline__ unsigned f2bf(float f) { unsigned u = __builtin_bit_cast(unsigned, f); return (u + 0x7fffu + ((u >> 16) & 1u)) >> 16; }
__device__ __forceinline__ unsigned pk2(float lo, float hi) { unsigned r; asm volatile("v_cvt_pk_bf16_f32 %0, %1, %2" : "=v"(r) : "v"(lo), "v"(hi)); return r; }
__device__ __forceinline__ float bf_lo(unsigned u) { return __builtin_bit_cast(float, u << 16); }
__device__ __forceinline__ float bf_hi(unsigned u) { return __builtin_bit_cast(float, u & 0xffff0000u); }
template <int CTRL> __device__ __forceinline__ float dppf(float v) { return __builtin_bit_cast(float, __builtin_amdgcn_update_dpp(0, __builtin_bit_cast(int, v), CTRL, 0xf, 0xf, true)); }
__device__ __forceinline__ float swap16_add(float a, float b) { asm volatile("s_nop 1\n\tv_permlane16_swap_b32 %0, %1" : "+v"(a), "+v"(b)); return a + b; }
__device__ __forceinline__ float swap32_add(float a, float b) { asm volatile("s_nop 1\n\tv_permlane32_swap_b32 %0, %1" : "+v"(a), "+v"(b)); return a + b; }
__device__ __forceinline__ float sum8(float v) { v += dppf<0xB1>(v); v += dppf<0x4E>(v); v += dppf<0x141>(v); return v; }
__device__ __forceinline__ float wave_sum(float v) { v = sum8(v); v += dppf<0x140>(v); v = swap16_add(v, v); return swap32_add(v, v); }
__device__ __forceinline__ float wave_max(float v) {
#pragma unroll
    for (int o = 1; o < 64; o <<= 1) v = fmaxf(v, __shfl_xor(v, o));
    return v;
}
__device__ __forceinline__ float fast_silu(float x) { return x * __builtin_amdgcn_rcpf(1.0f + __builtin_amdgcn_exp2f(-x * LOG2E)); }
#define LDS_WAIT() asm volatile("s_waitcnt lgkmcnt(0)" ::: "memory")
#define VM_WAIT() asm volatile("s_waitcnt vmcnt(0)" ::: "memory")

#define XB_TMO      128
#define XB_XCNT(j)  (256  + 64 * (j))
#define XB_XSUB(j)  (1280 + 64 * (j))
#define XB_XGEN(j)  (2304 + 64 * (j))
#define XB_TOP      3328
#define XB_TOPGEN   3392
#define XCD_BAR_WORDS 3456
#define XB_SPIN_CAP (1u << 22)
__device__ __forceinline__ unsigned xb_ld(unsigned* p)              { return __hip_atomic_load(p, __ATOMIC_RELAXED, __HIP_MEMORY_SCOPE_AGENT); }
__device__ __forceinline__ unsigned xb_add(unsigned* p, unsigned v) { return __hip_atomic_fetch_add(p, v, __ATOMIC_RELAXED, __HIP_MEMORY_SCOPE_AGENT); }
__device__ __forceinline__ unsigned xb_xcc_id() { return (unsigned)__builtin_amdgcn_s_getreg((3 << 11) | 20) & 0xFu; }
#define XB_SPIN(cond, bar) do { unsigned _sp = 0; while (cond) { __builtin_amdgcn_s_sleep(1); \
    if ((++_sp & 255u) == 0u) { if (xb_ld(&(bar)[XB_TMO])) break; if (_sp > XB_SPIN_CAP) { atomicAdd(&(bar)[XB_TMO], 1u); break; } } } } while (0)
struct XcdBarrier { unsigned* bar; unsigned x; volatile LAS unsigned* st; };
__device__ __forceinline__ XcdBarrier xcd_barrier_post(unsigned* bar, volatile LAS unsigned* st) {
    XcdBarrier b; b.bar = bar; b.x = xb_xcc_id(); b.st = st;
    if (threadIdx.x == 0) (void)xb_add(&bar[XB_XCNT(b.x)], 1u);
    return b;
}
__device__ __forceinline__ void xcd_barrier_complete(unsigned* bar, unsigned x, unsigned& nloc, unsigned& nx) {
    const unsigned G = gridDim.x * gridDim.y * gridDim.z;
    unsigned sum, cnt, mine, sp = 0u;
    for (;;) {
        sum = 0u; cnt = 0u; mine = 0u;
#pragma unroll
        for (unsigned j = 0; j < 16; ++j) { const unsigned c = xb_ld(&bar[XB_XCNT(j)]); sum += c; cnt += (c > 0u) ? 1u : 0u; mine = (j == x) ? c : mine; }
        if (sum == G) break;
        __builtin_amdgcn_s_sleep(1);
        if ((++sp & 255u) == 0u) { if (xb_ld(&bar[XB_TMO])) break; if (sp > XB_SPIN_CAP) { atomicAdd(&bar[XB_TMO], 1u); break; } }
    }
    nloc = mine > 0u ? mine : 1u; nx = cnt > 0u ? cnt : 1u;
}
__device__ __forceinline__ void xcd_barrier(const XcdBarrier& b) {
    asm volatile("s_waitcnt vmcnt(0)" ::: "memory");
    __syncthreads();
    if (threadIdx.x == 0) {
        unsigned* bar = b.bar;
        __builtin_amdgcn_s_waitcnt(0);
        unsigned nloc = b.st[0], nx = b.st[1];
        if (nloc == 0u) { xcd_barrier_complete(bar, b.x, nloc, nx); b.st[0] = nloc; b.st[1] = nx; }
        const unsigned old = xb_add(&bar[XB_XSUB(b.x)], 1u);
        const unsigned gen = old / nloc;
        if (old + 1u == (gen + 1u) * nloc) {
            __builtin_amdgcn_fence(__ATOMIC_RELEASE, "agent");
            asm volatile("s_waitcnt vmcnt(0)" ::: "memory");
            const unsigned og = xb_add(&bar[XB_TOP], 1u);
            const unsigned tg = og / nx;
            if (og + 1u == (tg + 1u) * nx) xb_add(&bar[XB_TOPGEN], 1u);
            else XB_SPIN(xb_ld(&bar[XB_TOPGEN]) == tg, bar);
            __builtin_amdgcn_fence(__ATOMIC_ACQUIRE, "agent");
            xb_add(&bar[XB_XGEN(b.x)], 1u);
            asm volatile("s_waitcnt vmcnt(0)" ::: "memory");
        } else {
            XB_SPIN(xb_ld(&bar[XB_XGEN(b.x)]) == gen, bar);
            __builtin_amdgcn_fence(__ATOMIC_ACQUIRE, "agent");
            asm volatile("s_waitcnt vmcnt(0)" ::: "memory");
        }
    }
    __syncthreads();
}
namespace pg8 {
constexpr int BM = 256, BK = 64, HALF = 128, HTB = HALF * BK * 2, STAGE_BYTES = 8 * HTB, NXCD = 8, WGM = 8;
__host__ __device__ __forceinline__ int lds_byte(int r, int c) { const int st = (r >> 4) * 2 + (c >> 5), rr = r & 15, cc = c & 31, ob = rr * 64 + cc * 2; return st * 1024 + (ob ^ (((ob >> 9) & 1) << 5)); }
__host__ __device__ __forceinline__ void stage_rc(int b, int& R, int& C) { const int st = b / 1024, sb = b % 1024, swz = sb ^ (((sb >> 9) & 1) << 5); R = (st >> 1) * 16 + swz / 64; C = (st & 1) * 32 + (swz % 64) / 2; }
__host__ __device__ __forceinline__ int perm32(int rho) { const int n = rho >> 4, i = rho & 15; return 8 * (i >> 2) + 4 * n + (i & 3); }

struct Unit { const char* A; const char* B; int pm, pn, rows; };

__device__ __forceinline__ bool static_order(int nM, int nN, int G, int c, int i, int& pm, int& pn) {
    const int nwg = nM * nN; const long L = (long)i * G + c; if (L >= nwg) return false;
    int wgid = (int)L; { const int q = nwg / NXCD, r = nwg % NXCD, xcd = wgid % NXCD, off = wgid / NXCD; wgid = (xcd < r ? xcd * (q + 1) : r * (q + 1) + (xcd - r) * q) + off; }
    const int nig = WGM * nN, gid = wgid / nig, fm = gid * WGM, gsz = (nM - fm) < WGM ? (nM - fm) : WGM;
    pm = fm + ((wgid % nig) % gsz); pn = (wgid % nig) / gsz; return true;
}
__device__ __forceinline__ int xcd_remap(int L, int nwg) { const int q = nwg / NXCD, r = nwg % NXCD, xcd = L % NXCD, off = L / NXCD; return (xcd < r ? xcd * (q + 1) : r * (q + 1) + (xcd - r) * q) + off; }

__device__ __forceinline__ bool load_unit(const LAS int* utab, int nU, int i, Unit& u) {
    if (i >= nU) return false;
    const LAS int* p = utab + i * 8;
    const unsigned alo = __builtin_amdgcn_readfirstlane(p[0]), ahi = __builtin_amdgcn_readfirstlane(p[1]), blo = __builtin_amdgcn_readfirstlane(p[2]), bhi = __builtin_amdgcn_readfirstlane(p[3]);
    u.A = (const char*)(((unsigned long long)ahi << 32) | alo); u.B = (const char*)(((unsigned long long)bhi << 32) | blo);
    u.pm = __builtin_amdgcn_readfirstlane(p[4]); u.pn = __builtin_amdgcn_readfirstlane(p[5]); u.rows = __builtin_amdgcn_readfirstlane(p[6]); return true;
}
template <class Sched>
__device__ __forceinline__ int build_units(LAS int* utab, const Sched& S, const int tid) {
    const int i = tid;
    if (i < 16) { Unit u; const bool ok = S.next(i, u); LAS int* p = utab + i * 8;
        if (ok) { const unsigned long long a = (unsigned long long)u.A, b = (unsigned long long)u.B; p[0] = (int)(unsigned)a; p[1] = (int)(unsigned)(a >> 32); p[2] = (int)(unsigned)b; p[3] = (int)(unsigned)(b >> 32); p[4] = u.pm; p[5] = u.pn; p[6] = u.rows; }
        p[7] = ok ? 1 : 0; }
    __syncthreads();
    int n = 0;
#pragma unroll
    for (int k = 0; k < 16; ++k) n += utab[k * 8 + 7];
    return __builtin_amdgcn_readfirstlane(n);
}
template <class Epi, bool GATHER>
__device__ __forceinline__ void gemm_phase(LAS unsigned char* lds, const int tid, const int K, const LAS int* utab, const int nU, const Epi& E, const LAS int* rowtab) {
    const int wid = __builtin_amdgcn_readfirstlane(tid >> 6), lane = tid & 63, wr = wid >> 2, wc = wid & 3, fr = lane & 15, fq = lane >> 4;
    const int nt = K / BK;
    unsigned vA[2][2], vN[2][2], voffB[2]; int Rr[2], Cc[2];
#pragma unroll
    for (int i = 0; i < 2; ++i) { int R, C; stage_rc(tid * 16 + i * 8192, R, C); const int Rb = Epi::PERM ? ((R & ~31) + perm32(R & 31)) : R; Rr[i] = R; Cc[i] = C;
        voffB[i] = (unsigned)(Rb * K + C) * 2u; }
#define PG8_CALCA(u, v) do { _Pragma("unroll") for (int _h = 0; _h < 2; ++_h) _Pragma("unroll") for (int _i = 0; _i < 2; ++_i) { const int _r = _h * HALF + Rr[_i]; \
        const int _row = GATHER ? rowtab[((u).rows >> 2) + _r] : _r; (v)[_h][_i] = (unsigned)(_row * K + Cc[_i]) * 2u; } } while (0)
    const size_t kstep = (size_t)(BK * 2);
    const size_t hstep = (size_t)HALF * K * 2;
    const unsigned ldsw = (unsigned)wid * 1024u;
    const int aoff = lds_byte(wr * 64 + fr, fq * 8), boff = lds_byte(wc * 32 + fr, fq * 8);
#define PG8_SA(b, h) (((b) * 2 + (h)) * HTB)
#define PG8_SB(b, h) ((4 + (b) * 2 + (h)) * HTB)
#define PG8_STAGE(bufoff, gbase, voff) do { _Pragma("unroll") for (int _i = 0; _i < 2; ++_i) \
        __builtin_amdgcn_global_load_lds((const unsigned*)((const char*)(gbase) + (voff)[_i]), (LAS unsigned*)(lds + (bufoff) + ldsw + _i * 8192), 16, 0, 0); } while (0)
#define PG8_LDA(dst, b, h) do { _Pragma("unroll") for (int m = 0; m < 4; ++m) _Pragma("unroll") for (int k = 0; k < 2; ++k) dst[m][k] = *(const LAS bf16x8*)(lds + PG8_SA(b, h) + aoff + m * 2048 + k * 1024); } while (0)
#define PG8_LDB(dst, b, h) do { _Pragma("unroll") for (int n = 0; n < 2; ++n) _Pragma("unroll") for (int k = 0; k < 2; ++k) dst[n][k] = *(const LAS bf16x8*)(lds + PG8_SB(b, h) + boff + n * 2048 + k * 1024); } while (0)
#define PG8_MMA(ai, bj, At, Bt) do { __builtin_amdgcn_s_setprio(1); _Pragma("unroll") for (int m = 0; m < 4; ++m) _Pragma("unroll") for (int n = 0; n < 2; ++n) _Pragma("unroll") for (int k = 0; k < 2; ++k) \
        acc[ai][bj][m][n] = __builtin_amdgcn_mfma_f32_16x16x32_bf16(Bt[n][k], At[m][k], acc[ai][bj][m][n], 0, 0, 0); __builtin_amdgcn_s_setprio(0); } while (0)
#define PG8_WAIT_V(n) asm volatile("s_waitcnt vmcnt(" #n ")" ::: "memory")
#define PG8_WAIT_L(n) asm volatile("s_waitcnt lgkmcnt(" #n ")" ::: "memory")
#define PG8_BAR __builtin_amdgcn_s_barrier()
#define PG8_SCHED __builtin_amdgcn_sched_barrier(0)
    Unit cur, nxt; int ui = 0;
    if (!load_unit(utab, nU, 0, cur)) return;
    f32x4 acc[2][2][4][2];
#pragma unroll
    for (int a = 0; a < 2; ++a)
#pragma unroll
        for (int b = 0; b < 2; ++b)
#pragma unroll
            for (int m = 0; m < 4; ++m)
#pragma unroll
                for (int n = 0; n < 2; ++n) acc[a][b][m][n] = (f32x4){0.f, 0.f, 0.f, 0.f};
    bf16x8 At[4][2], B0[2][2], B1[2][2];
    const char* cA = cur.A; const char* cB = cur.B;
    PG8_CALCA(cur, vA);
    PG8_STAGE(PG8_SB(0, 0), cB, voffB); PG8_STAGE(PG8_SB(0, 1), cB + hstep, voffB); PG8_STAGE(PG8_SA(0, 0), cA, vA[0]); PG8_STAGE(PG8_SA(0, 1), cA, vA[1]);
    if (wr == 1) PG8_BAR;
    PG8_WAIT_V(2); PG8_BAR;
    PG8_STAGE(PG8_SB(1, 0), cB + kstep, voffB); PG8_STAGE(PG8_SA(1, 0), cA + kstep, vA[0]); PG8_STAGE(PG8_SB(1, 1), cB + hstep + kstep, voffB);
    PG8_WAIT_V(6); PG8_BAR;
    for (;;) {
        const bool has_next = load_unit(utab, nU, ui + 1, nxt);
        const char* nA = has_next ? nxt.A : cA; const char* nB = has_next ? nxt.B : cB;
        if (GATHER) {
            if (has_next) { PG8_CALCA(nxt, vN); }
            else {
#pragma unroll
                for (int h = 0; h < 2; ++h) { vN[h][0] = vA[h][0]; vN[h][1] = vA[h][1]; }
            }
        }
        for (int t = 0; t < nt; t += 2) {
            const bool last = (t == nt - 2);
            const char* a1 = cA + (size_t)(t + 1) * kstep;
            const char* a2 = last ? nA : cA + (size_t)(t + 2) * kstep; const char* b2 = last ? nB : cB + (size_t)(t + 2) * kstep;
            const char* a3 = a2 + kstep; const char* b3 = b2 + kstep;
            unsigned w0[2], w1[2];
#pragma unroll
            for (int i = 0; i < 2; ++i) { w0[i] = (GATHER && last) ? vN[0][i] : vA[0][i]; w1[i] = (GATHER && last) ? vN[1][i] : vA[1][i]; }
            PG8_LDB(B0, 0, 0); PG8_LDB(B1, 0, 1); PG8_SCHED; PG8_LDA(At, 0, 0); PG8_STAGE(PG8_SA(1, 1), a1, vA[1]);
            PG8_WAIT_V(8); PG8_WAIT_L(0); PG8_BAR; PG8_MMA(0, 0, At, B0); PG8_MMA(0, 1, At, B1); PG8_BAR; PG8_SCHED;
            PG8_LDA(At, 0, 1); PG8_STAGE(PG8_SB(0, 0), b2, voffB); PG8_STAGE(PG8_SB(0, 1), b2 + hstep, voffB); PG8_STAGE(PG8_SA(0, 0), a2, w0);
            PG8_WAIT_V(8); PG8_WAIT_L(0); PG8_BAR; PG8_MMA(1, 0, At, B0); PG8_MMA(1, 1, At, B1); PG8_BAR; PG8_SCHED;
            PG8_LDB(B0, 1, 0); PG8_LDB(B1, 1, 1); PG8_SCHED; PG8_LDA(At, 1, 0); PG8_STAGE(PG8_SA(0, 1), a2, w1);
            PG8_WAIT_V(8); PG8_WAIT_L(0); PG8_BAR; PG8_MMA(0, 0, At, B0); PG8_MMA(0, 1, At, B1); PG8_BAR; PG8_SCHED;
            PG8_LDA(At, 1, 1); PG8_STAGE(PG8_SB(1, 0), b3, voffB); PG8_STAGE(PG8_SB(1, 1), b3 + hstep, voffB); PG8_STAGE(PG8_SA(1, 0), a3, w0);
            PG8_WAIT_V(8); PG8_WAIT_L(0); PG8_BAR; PG8_MMA(1, 0, At, B0); PG8_MMA(1, 1, At, B1); PG8_BAR; PG8_SCHED;
        }
        if (wr == 0) PG8_BAR;
        E(acc, cur, wr, wc, fr, fq);
        if (!has_next) break;
#pragma unroll
        for (int a = 0; a < 2; ++a)
#pragma unroll
            for (int b = 0; b < 2; ++b)
#pragma unroll
                for (int m = 0; m < 4; ++m)
#pragma unroll
                    for (int n = 0; n < 2; ++n) acc[a][b][m][n] = (f32x4){0.f, 0.f, 0.f, 0.f};
        cur = nxt; cA = nA; cB = nB; ++ui;
        if (GATHER) {
#pragma unroll
            for (int h = 0; h < 2; ++h) { vA[h][0] = vN[h][0]; vA[h][1] = vN[h][1]; }
        }
        if (wr == 1) PG8_BAR;
    }
    PG8_WAIT_V(0);
    PG8_BAR;
#undef PG8_CALCA
#undef PG8_SA
#undef PG8_SB
#undef PG8_STAGE
#undef PG8_LDA
#undef PG8_LDB
#undef PG8_MMA
#undef PG8_WAIT_V
#undef PG8_WAIT_L
#undef PG8_BAR
#undef PG8_SCHED
}
}
namespace pg8 {
typedef f32x4 Acc[2][2][4][2];

struct EpiInProj {
    static constexpr bool PERM = true;
    bf16_t *Q, *Kk, *V, *G; const float *cosT, *sinT;
    __device__ __forceinline__ void operator()(const Acc& acc, const Unit& u, int wr, int wc, int fr, int fq) const {
        const int pn = u.pn, row0 = u.pm * BM + wr * 64 + fr;
        if (pn < 8) {
            const int head = pn & 3; const bool isk = pn >= 4;
            const float lg = __builtin_log2f(1.0f - __builtin_exp2f(-5.0f - (float)head));
            bf16_t* out = isk ? Kk : Q;
            const int j0 = wc * 32 + 8 * fq;
#pragma unroll
            for (int ai = 0; ai < 2; ++ai)
#pragma unroll
                for (int m = 0; m < 4; ++m) {
                    const int row = row0 + ai * HALF + m * 16, pos = row & (SEQ - 1), nn = pos & 63;
                    const float sc = isk ? __builtin_exp2f(-(float)nn * lg) * 0.0625f : __builtin_exp2f((float)nn * lg);
                    u32x4 w1, w2;
#pragma unroll
                    for (int n = 0; n < 2; ++n) {
                        const f32x4 c4 = *(const f32x4*)(cosT + pos * 128 + j0 + 4 * n), s4 = *(const f32x4*)(sinT + pos * 128 + j0 + 4 * n);
                        const f32x4 x1 = acc[ai][0][m][n], x2 = acc[ai][1][m][n];
                        const f32x4 o1 = (x1 * c4 - x2 * s4) * sc, o2 = (x2 * c4 + x1 * s4) * sc;
                        w1[2 * n] = pk2(o1[0], o1[1]); w1[2 * n + 1] = pk2(o1[2], o1[3]); w2[2 * n] = pk2(o2[0], o2[1]); w2[2 * n + 1] = pk2(o2[2], o2[3]);
                    }
                    bf16_t* p = out + (size_t)row * 1024 + head * 256 + j0;
                    *(u32x4*)p = w1; *(u32x4*)(p + 128) = w2;
                }
        } else {
            const bool isg = pn >= 16; bf16_t* out = isg ? G : V; const int col0 = (isg ? pn - 16 : pn - 8) * 256 + wc * 32 + 8 * fq;
#pragma unroll
            for (int ai = 0; ai < 2; ++ai)
#pragma unroll
                for (int m = 0; m < 4; ++m) { bf16_t* rowp = out + (size_t)(row0 + ai * HALF + m * 16) * 2048 + col0;
#pragma unroll
                    for (int bj = 0; bj < 2; ++bj) { f32x4 v0 = acc[ai][bj][m][0], v1 = acc[ai][bj][m][1];
                        if (isg) {
#pragma unroll
                            for (int e = 0; e < 4; ++e) { v0[e] = fast_silu(v0[e]); v1[e] = fast_silu(v1[e]); } }
                        u32x4 w; w.x = pk2(v0[0], v0[1]); w.y = pk2(v0[2], v0[3]); w.z = pk2(v1[0], v1[1]); w.w = pk2(v1[2], v1[3]);
                        *(u32x4*)(rowp + bj * HALF) = w; } }
        }
    }
};
struct EpiMoeUp {
    static constexpr bool PERM = true;
    bf16_t* O;
    __device__ __forceinline__ void operator()(const Acc& acc, const Unit& u, int wr, int wc, int fr, int fq) const {
        const int row0 = u.pm * BM + wr * 64 + fr, col0 = u.pn * 128 + wc * 32 + 8 * fq;
#pragma unroll
        for (int ai = 0; ai < 2; ++ai)
#pragma unroll
            for (int m = 0; m < 4; ++m) {
                f32x4 v0 = acc[ai][0][m][0], v1 = acc[ai][0][m][1]; const f32x4 g0 = acc[ai][1][m][0], g1 = acc[ai][1][m][1];
#pragma unroll
                for (int e = 0; e < 4; ++e) { v0[e] = fast_silu(v0[e]) * g0[e]; v1[e] = fast_silu(v1[e]) * g1[e]; }
                u32x4 w; w.x = pk2(v0[0], v0[1]); w.y = pk2(v0[2], v0[3]); w.z = pk2(v1[0], v1[1]); w.w = pk2(v1[2], v1[3]);
                *(u32x4*)(O + (size_t)(row0 + ai * HALF + m * 16) * 1024 + col0) = w;
            }
    }
};
struct EpiBf16 {
    static constexpr bool PERM = true;
    bf16_t* O; int ldc;
    __device__ __forceinline__ void operator()(const Acc& acc, const Unit& u, int wr, int wc, int fr, int fq) const {
        const int row0 = u.pm * BM + wr * 64 + fr, col0 = u.pn * BM + wc * 32 + 8 * fq;
#pragma unroll
        for (int ai = 0; ai < 2; ++ai)
#pragma unroll
            for (int m = 0; m < 4; ++m) { bf16_t* rowp = O + (size_t)(row0 + ai * HALF + m * 16) * ldc + col0;
#pragma unroll
                for (int bj = 0; bj < 2; ++bj) { const f32x4 v0 = acc[ai][bj][m][0], v1 = acc[ai][bj][m][1];
                    u32x4 w; w.x = pk2(v0[0], v0[1]); w.y = pk2(v0[2], v0[3]); w.z = pk2(v1[0], v1[1]); w.w = pk2(v1[2], v1[3]);
                    *(u32x4*)(rowp + bj * HALF) = w; } }
    }
};
template <bool BASE_F32>
struct EpiResid {
    static constexpr bool PERM = true;
    const void* base; bf16_t* out; const float* gate;
    __device__ __forceinline__ void operator()(const Acc& acc, const Unit& u, int wr, int wc, int fr, int fq) const {
        const int row0 = u.pm * BM + wr * 64 + fr, col0 = u.pn * BM + wc * 32 + 8 * fq;
        const float* gp = gate + (size_t)((u.pm * BM) / SEQ) * 6144 + col0;
        f32x4 gv[2][2];
#pragma unroll
        for (int bj = 0; bj < 2; ++bj)
#pragma unroll
            for (int n = 0; n < 2; ++n) gv[bj][n] = *(const f32x4*)(gp + bj * HALF + n * 4);
#pragma unroll
        for (int ai = 0; ai < 2; ++ai)
#pragma unroll
            for (int m = 0; m < 4; ++m) { const size_t off = (size_t)(row0 + ai * HALF + m * 16) * 1024 + col0;
#pragma unroll
                for (int bj = 0; bj < 2; ++bj) {
                    f32x4 b0, b1;
                    if (BASE_F32) { b0 = *(const f32x4*)((const float*)base + off + bj * HALF); b1 = *(const f32x4*)((const float*)base + off + bj * HALF + 4); }
                    else { const u32x4 q = *(const u32x4*)((const bf16_t*)base + off + bj * HALF); b0 = (f32x4){bf_lo(q.x), bf_hi(q.x), bf_lo(q.y), bf_hi(q.y)}; b1 = (f32x4){bf_lo(q.z), bf_hi(q.z), bf_lo(q.w), bf_hi(q.w)}; }
                    const f32x4 v0 = b0 + gv[bj][0] * acc[ai][bj][m][0], v1 = b1 + gv[bj][1] * acc[ai][bj][m][1];
                    u32x4 w; w.x = pk2(v0[0], v0[1]); w.y = pk2(v0[2], v0[3]); w.z = pk2(v1[0], v1[1]); w.w = pk2(v1[2], v1[3]);
                    *(u32x4*)(out + off + bj * HALF) = w; }
                if (m & 1) asm volatile("" ::: "memory"); }
    }
};
struct EpiQKV {
    static constexpr bool PERM = true;
    bf16_t *Q, *Kk, *V; const float *qn, *kn;
    __device__ __forceinline__ void operator()(const Acc& acc, const Unit& u, int wr, int wc, int fr, int fq) const {
        const int pn = u.pn, row0 = u.pm * BM + wr * 64 + fr;
        if (pn < 8) {
            const bool isk = pn >= 4; bf16_t* out = isk ? Kk : Q; const float* gn = isk ? kn : qn; const float osc = isk ? 1.0f : 0.125f * LOG2E;
            const int col0 = (pn & 3) * 256 + 64 * wc + 8 * fq;
#pragma unroll
            for (int ai = 0; ai < 2; ++ai)
#pragma unroll
                for (int m = 0; m < 4; ++m) {
                    float ss = 0.f;
#pragma unroll
                    for (int bj = 0; bj < 2; ++bj)
#pragma unroll
                        for (int n = 0; n < 2; ++n) { const f32x4 x = acc[ai][bj][m][n]; ss += (x[0] * x[0] + x[1] * x[1]) + (x[2] * x[2] + x[3] * x[3]); }
                    ss = swap16_add(ss, ss); ss = swap32_add(ss, ss);
                    const float rstd = __builtin_amdgcn_rsqf(ss * (1.0f / 64.0f) + EPS) * osc;
                    bf16_t* rowp = out + (size_t)(row0 + ai * HALF + m * 16) * 1024 + col0;
#pragma unroll
                    for (int bj = 0; bj < 2; ++bj) { const f32x4 g0 = *(const f32x4*)(gn + 32 * bj + 8 * fq), g1 = *(const f32x4*)(gn + 32 * bj + 8 * fq + 4);
                        const f32x4 v0 = acc[ai][bj][m][0] * rstd * g0, v1 = acc[ai][bj][m][1] * rstd * g1;
                        u32x4 w; w.x = pk2(v0[0], v0[1]); w.y = pk2(v0[2], v0[3]); w.z = pk2(v1[0], v1[1]); w.w = pk2(v1[2], v1[3]);
                        *(u32x4*)(rowp + 32 * bj) = w; }
                    asm volatile("" ::: "memory");
                }
        } else {
            const int col0 = (pn - 8) * 256 + wc * 32 + 8 * fq;
#pragma unroll
            for (int ai = 0; ai < 2; ++ai)
#pragma unroll
                for (int m = 0; m < 4; ++m) { bf16_t* rowp = V + (size_t)(row0 + ai * HALF + m * 16) * 1024 + col0;
#pragma unroll
                    for (int bj = 0; bj < 2; ++bj) { const f32x4 v0 = acc[ai][bj][m][0], v1 = acc[ai][bj][m][1];
                        u32x4 w; w.x = pk2(v0[0], v0[1]); w.y = pk2(v0[2], v0[3]); w.z = pk2(v1[0], v1[1]); w.w = pk2(v1[2], v1[3]);
                        *(u32x4*)(rowp + bj * HALF) = w; } }
        }
    }
};

struct SchedPlain {
    const char *A, *B; int nM, nN, K, G, c;
    __device__ __forceinline__ bool next(int i, Unit& u) const { int pm, pn; if (!static_order(nM, nN, G, c, i, pm, pn)) return false;
        u.pm = pm; u.pn = pn; u.rows = 0; u.A = A + (size_t)pm * BM * K * 2; u.B = B + (size_t)pn * BM * K * 2; return true; }
};
struct SchedQKV {
    const char *Aq, *Akv, *Bq, *Bkv; int G, c;
    __device__ __forceinline__ bool next(int i, Unit& u) const { int pm, pn; if (!static_order(NTOK / BM, 12, G, c, i, pm, pn)) return false;
        u.pm = pm; u.pn = pn; u.rows = 0; const size_t ts = (size_t)BM * 1024 * 2;
        u.A = (pn < 4 ? Aq : Akv) + (size_t)pm * ts; u.B = pn < 4 ? Bq + (size_t)pn * ts : Bkv + (size_t)(pn - 4) * ts; return true; }
};
struct SchedMoe {
    const char *A, *B; const LAS int* rbs; int NT, G, c, gather; size_t estride;
    __device__ __forceinline__ bool next(int i, Unit& u) const {
        const int nrb = rbs[16], nwg = nrb * NT; const long L = (long)i * G + c; if (L >= nwg) return false;
        const int wg = xcd_remap((int)L, nwg), rb = wg / NT, pn = wg % NT;
        int e = 0;
#pragma unroll
        for (int k = 1; k < 16; ++k) e += (rb >= rbs[k]) ? 1 : 0;
        u.pm = rb; u.pn = pn; u.rows = i * 1024;
        u.A = gather ? A : A + (size_t)rb * BM * 1024 * 2; u.B = B + (size_t)e * estride + (size_t)pn * BM * 1024 * 2; return true; }
};
}
typedef __attribute__((address_space(4))) const unsigned long long* kargp_t;
struct Frame {
    LAS unsigned char* lds;
    unsigned* ctl;
    int tid, lane, wave, vcu, G;
    unsigned char* ws;
    kargp_t kin;
    __device__ __forceinline__ const float* inp(int i) const { return (const float*)(const GAS float*)kin[i]; }
    float* out;
};
enum { I_X = 0, I_C, I_ADAW, I_ADAB, I_NMIX, I_NFFN, I_RWIN, I_RGN, I_RWOUT, I_KVADAW, I_KVADAB, I_KVNORM, I_KVW, I_KNORM, I_WQ, I_QNORM, I_LAM, I_SUBLN, I_WOUT,
       I_WG, I_BG, I_WE, I_BE, I_W1, I_W3, I_W2 };

__device__ __forceinline__ int dest_row(int n, int mode) {
    if (mode == 1) { const int c = n & 255; return (n & ~255) + 128 * ((c >> 5) & 1) + 32 * (c >> 6) + (c & 31); }
    if (mode == 2) return (n >> 7) * 256 + (n & 127);
    if (mode == 3) return (n >> 7) * 256 + 128 + (n & 127);
    return n;
}
struct TItem { const float* W; bf16_t* WT; int K, N, mode, item; };
__device__ __forceinline__ void titem_load(const TItem& it, f32x4 (&v)[16], int lane) {
    const int nblk = it.N / 64, kb = it.item / nblk, nb = it.item % nblk, k0 = 64 * kb, n0 = 64 * nb;
    const float* p = it.W + (size_t)(k0 + (lane >> 4)) * it.N + n0 + 4 * (lane & 15);
#pragma unroll
    for (int i = 0; i < 16; ++i) v[i] = *(const f32x4*)(p + (size_t)(4 * i) * it.N);
}
__device__ __forceinline__ void titem_store(const TItem& it, const f32x4 (&v)[16], LAS float* scr, int lane) {
    const int nblk = it.N / 64, kb = it.item / nblk, nb = it.item % nblk, k0 = 64 * kb, n0 = 64 * nb;
#pragma unroll
    for (int i = 0; i < 16; ++i) *(LAS f32x4*)(scr + (4 * i + (lane >> 4)) * 68 + 4 * (lane & 15)) = v[i];
    LDS_WAIT(); asm volatile("" ::: "memory");
    const int d = dest_row(n0 + (lane & 32), it.mode) + (lane & 31);
    bf16_t* op = it.WT + (size_t)d * it.K + k0;
#pragma unroll 2
    for (int c = 0; c < 8; ++c) { const LAS float* s = scr + (8 * c) * 68 + lane;
        u32x4 o; o.x = pk2(s[0 * 68], s[1 * 68]); o.y = pk2(s[2 * 68], s[3 * 68]); o.z = pk2(s[4 * 68], s[5 * 68]); o.w = pk2(s[6 * 68], s[7 * 68]);
        *(u32x4*)(op + 8 * c) = o; }
    LDS_WAIT(); asm volatile("" ::: "memory");
}
__device__ __forceinline__ void thalf_load(const TItem& it, int half, f32x4 (&v)[8], int lane) {
    const int nblk = it.N / 64, kb = it.item / nblk, nb = it.item % nblk, k0 = 64 * kb + 32 * half, n0 = 64 * nb;
    const float* p = it.W + (size_t)(k0 + (lane >> 4)) * it.N + n0 + 4 * (lane & 15);
#pragma unroll
    for (int i = 0; i < 8; ++i) v[i] = *(const f32x4*)(p + (size_t)(4 * i) * it.N);
}
__device__ __forceinline__ void thalf_store(const TItem& it, int half, const f32x4 (&v)[8], LAS float* scr, int lane) {
    const int nblk = it.N / 64, kb = it.item / nblk, nb = it.item % nblk, k0 = 64 * kb + 32 * half, n0 = 64 * nb;
#pragma unroll
    for (int i = 0; i < 8; ++i) *(LAS f32x4*)(scr + (4 * i + (lane >> 4)) * 68 + 4 * (lane & 15)) = v[i];
    LDS_WAIT(); asm volatile("" ::: "memory");
    const int d = dest_row(n0 + (lane & 32), it.mode) + (lane & 31);
    bf16_t* op = it.WT + (size_t)d * it.K + k0;
#pragma unroll 2
    for (int c = 0; c < 4; ++c) { const LAS float* s = scr + (8 * c) * 68 + lane;
        u32x4 o; o.x = pk2(s[0 * 68], s[1 * 68]); o.y = pk2(s[2 * 68], s[3 * 68]); o.z = pk2(s[4 * 68], s[5 * 68]); o.w = pk2(s[6 * 68], s[7 * 68]);
        *(u32x4*)(op + 8 * c) = o; }
    LDS_WAIT(); asm volatile("" ::: "memory");
}
__device__ __forceinline__ TItem moe_item(Frame& F, int layer, int it) {
    constexpr int IPM = 256;
    const int e = it / (3 * IPM), r = it % (3 * IPM), which = r / IPM, item = r % IPM;
    const size_t wo = ((size_t)layer * 16 + e) * 1048576;
    TItem t; t.K = 1024; t.N = 1024; t.item = item;
    if (which == 0) { t.W = F.inp(I_W1) + wo; t.WT = (bf16_t*)(F.ws + WS_W13) + (size_t)e * 2097152; t.mode = 2; }
    else if (which == 1) { t.W = F.inp(I_W3) + wo; t.WT = (bf16_t*)(F.ws + WS_W13) + (size_t)e * 2097152; t.mode = 3; }
    else { t.W = F.inp(I_W2) + wo; t.WT = (bf16_t*)(F.ws + WS_W2) + (size_t)e * 1048576; t.mode = 0; }
    return t;
}
__device__ __forceinline__ TItem dense_item(Frame& F, int it) {
    constexpr int I_IN = 16 * 96, I_RO = 32 * 16, I_KV = 16 * 32, I_Q = 256;
    TItem t; int r = it;
    if (r < I_IN) { t.W = F.inp(I_RWIN); t.WT = (bf16_t*)(F.ws + WS_WIN); t.K = 1024; t.N = 6144; t.mode = 0; t.item = r; return t; } r -= I_IN;
    if (r < I_RO) { t.W = F.inp(I_RWOUT); t.WT = (bf16_t*)(F.ws + WS_WRO); t.K = 2048; t.N = 1024; t.mode = 0; t.item = r; return t; } r -= I_RO;
    if (r < I_KV) { t.W = F.inp(I_KVW); t.WT = (bf16_t*)(F.ws + WS_WKV); t.K = 1024; t.N = 2048; t.mode = (r % 32) < 16 ? 1 : 0; t.item = r; return t; } r -= I_KV;
    if (r < I_Q) { t.W = F.inp(I_WQ); t.WT = (bf16_t*)(F.ws + WS_WQ); t.K = 1024; t.N = 1024; t.mode = 1; t.item = r; return t; } r -= I_Q;
    t.W = F.inp(I_WOUT); t.WT = (bf16_t*)(F.ws + WS_WAO); t.K = 1024; t.N = 1024; t.mode = 0; t.item = r; return t;
}
constexpr int N_DENSE_ITEMS = 16 * 96 + 32 * 16 + 16 * 32 + 256 + 256, N_MOE_ITEMS = 16 * 3 * 256;
__device__ __forceinline__ void convert_weights(Frame& F, int layer, bool with_dense, bool with_moe, int gw, int NGW, int end = 1 << 30) {
    LAS float* scr = (LAS float*)(F.lds + F.wave * 17408);
    const int nd = with_dense ? N_DENSE_ITEMS : 0, total0 = nd + (with_moe ? N_MOE_ITEMS : 0), total = end < total0 ? end : total0;
    int it = gw; if (it >= total) return;
    TItem cur = it < nd ? dense_item(F, it) : moe_item(F, layer, it - nd);
    f32x4 va[16], vb[16];
    titem_load(cur, va, F.lane);
    for (;;) {
        const int itn = it + NGW; const bool more = itn < total;
        TItem nxt = cur;
        if (more) { nxt = itn < nd ? dense_item(F, itn) : moe_item(F, layer, itn - nd); titem_load(nxt, vb, F.lane); }
        titem_store(cur, va, scr, F.lane);
        if (!more) break;
        const int itn2 = itn + NGW; const bool more2 = itn2 < total;
        if (more2) { cur = itn2 < nd ? dense_item(F, itn2) : moe_item(F, layer, itn2 - nd); titem_load(cur, va, F.lane); }
        titem_store(nxt, vb, scr, F.lane);
        if (!more2) break;
        it = itn2;
    }
}
__device__ __forceinline__ void adaln_phase(Frame& F) {
    LAS float* cs = (LAS float*)F.lds;
    LAS float* red = (LAS float*)(F.lds + 65536);
    constexpr int NTASK = (2 * 6144 + 2048) / 64;
    if ((int)blockIdx.x >= NTASK) return;
    { const float* cp = F.inp(I_C) + F.tid; float cvv[32];
#pragma unroll
      for (int i = 0; i < 32; ++i) cvv[i] = cp[i * NTHREADS];
#pragma unroll
      for (int i = 0; i < 32; ++i) cs[i * NTHREADS + F.tid] = cvv[i] / (1.0f + __expf(-cvv[i])); }
    __syncthreads();
    for (int task = blockIdx.x; task < NTASK; task += F.G) {
        const int gc = task * 64; const float* W; const float* bias; float* outp; int N, c0, ostride;
        if (gc < 6144) { W = F.inp(I_ADAW); bias = F.inp(I_ADAB); N = 6144; c0 = gc; outp = (float*)(F.ws + WS_MOD); ostride = 6144; }
        else if (gc < 12288) { W = F.inp(I_ADAW) + (size_t)1024 * 6144; bias = F.inp(I_ADAB) + 6144; N = 6144; c0 = gc - 6144; outp = (float*)(F.ws + WS_MOD) + 16 * 6144; ostride = 6144; }
        else { W = F.inp(I_KVADAW); bias = F.inp(I_KVADAB); N = 2048; c0 = gc - 12288; outp = (float*)(F.ws + WS_KVMOD); ostride = 2048; }
        float acc[16];
#pragma unroll
        for (int b = 0; b < 16; ++b) acc[b] = 0.f;
        const int k0 = F.wave * 128;
        {
            const int k = k0; float w[128];
            const GAS float* wp = (const GAS float*)(W + (size_t)k * N + c0 + F.lane);
#pragma unroll
            for (int j = 0; j < 128; ++j) { w[j] = *wp; wp += N; asm volatile("" : "+v"(wp)); }
#pragma unroll
            for (int j4 = 0; j4 < 32; ++j4) { asm volatile("" ::: "memory");
#pragma unroll
                for (int b = 0; b < 16; ++b) { const f32x4 c4 = *(const LAS f32x4*)(cs + b * 1024 + k + 4 * j4); acc[b] += c4[0] * w[4 * j4] + c4[1] * w[4 * j4 + 1] + c4[2] * w[4 * j4 + 2] + c4[3] * w[4 * j4 + 3]; } }
        }
#pragma unroll
        for (int b = 0; b < 16; ++b) red[(F.wave * 16 + b) * 64 + F.lane] = acc[b];
        __syncthreads();
        for (int o = F.tid; o < 1024; o += NTHREADS) { const int b = o >> 6, col = o & 63; float s = 0.f;
#pragma unroll
            for (int w = 0; w < 8; ++w) s += red[(w * 16 + b) * 64 + col];
            outp[(size_t)b * ostride + c0 + col] = s + bias[c0 + col]; }
        __syncthreads();
    }
}
__device__ __forceinline__ void rope_table(Frame& F, int gt, int NGT) {
    float* ct = (float*)(F.ws + WS_COS); float* st = (float*)(F.ws + WS_SIN);
    for (int i = gt; i < 2048 * 128; i += NGT) { const int pos = i >> 7, j = i & 127;
        const float inv = 1.0f / powf(10000.0f, (float)j * (1.0f / 128.0f)); const float ang = (float)pos * inv;
        const float kq = rintf(ang * 0.15915494309189535f); float rr = fmaf(-kq, 6.28318548202514648f, ang); rr = fmaf(-kq, -1.74845553e-07f, rr);
        const float rev = rr * 0.15915494309189535f; ct[i] = __builtin_amdgcn_cosf(rev); st[i] = __builtin_amdgcn_sinf(rev); }
    float* wrt = (float*)(F.ws + WS_WRT);
    for (int i = gt; i < 2 * 20 * 1024; i += NGT) { const int l = i / 20480, r = i % 20480, q = r >> 10, k = r & 1023;
        wrt[i] = q < 4 ? F.inp(I_WG)[(size_t)l * 4096 + k * 4 + q] : F.inp(I_WE)[(size_t)l * 16384 + k * 16 + (q - 4)]; }
}

struct Row16 { f32x4 v[4]; };
__device__ __forceinline__ void row_load(Row16& r, const float* p, int lane) {
#pragma unroll
    for (int j = 0; j < 4; ++j) r.v[j] = ((const f32x4*)p)[64 * j + lane];
}
__device__ __forceinline__ void row_load_bf16(Row16& r, const bf16_t* p, int lane) {
#pragma unroll
    for (int j = 0; j < 4; ++j) { const u32x2 q = ((const u32x2*)p)[64 * j + lane]; r.v[j] = (f32x4){bf_lo(q.x), bf_hi(q.x), bf_lo(q.y), bf_hi(q.y)}; }
}
__device__ __forceinline__ void row_store_bf16(const Row16& r, bf16_t* p, int lane) {
#pragma unroll
    for (int j = 0; j < 4; ++j) { u32x2 w; w.x = pk2(r.v[j][0], r.v[j][1]); w.y = pk2(r.v[j][2], r.v[j][3]); ((u32x2*)p)[64 * j + lane] = w; }
}
__device__ __forceinline__ float row_sumsq(const Row16& r) { float s = 0.f;
#pragma unroll
    for (int j = 0; j < 4; ++j) s += (r.v[j][0] * r.v[j][0] + r.v[j][1] * r.v[j][1]) + (r.v[j][2] * r.v[j][2] + r.v[j][3] * r.v[j][3]);
    return wave_sum(s); }
__device__ __forceinline__ void row_norm_mod_store(const Row16& r, float rstd, const float* g, const float* shift, const float* scale, bf16_t* outp, int lane) {
#pragma unroll
    for (int j = 0; j < 4; ++j) { const int c = 64 * j + lane; const f32x4 gg = ((const f32x4*)g)[c], sh = ((const f32x4*)shift)[c], sc = ((const f32x4*)scale)[c];
        const f32x4 h = (r.v[j] * rstd * gg) * (sc + 1.0f) + sh; u32x2 w; w.x = pk2(h[0], h[1]); w.y = pk2(h[2], h[3]); ((u32x2*)outp)[c] = w; }
}
struct ModVec { f32x4 A[4], B[4]; };
__device__ __forceinline__ void modvec_load(ModVec& m, const float* g, const float* shift, const float* scale, int lane) {
#pragma unroll
    for (int j = 0; j < 4; ++j) { const int c = 64 * j + lane; m.A[j] = ((const f32x4*)g)[c] * (((const f32x4*)scale)[c] + 1.0f); m.B[j] = ((const f32x4*)shift)[c]; }
}
__device__ __forceinline__ void row_mod_store(const Row16& r, float rstd, const ModVec& m, bf16_t* outp, int lane) {
#pragma unroll
    for (int j = 0; j < 4; ++j) { const f32x4 h = r.v[j] * rstd * m.A[j] + m.B[j]; u32x2 w; w.x = pk2(h[0], h[1]); w.y = pk2(h[2], h[3]); ((u32x2*)outp)[64 * j + lane] = w; }
}
__device__ __forceinline__ void phase_h0(Frame& F) {
    const int gw = F.vcu * NWAVES + F.wave, NGW = F.G * NWAVES; const float* mod = (const float*)(F.ws + WS_MOD); bf16_t* H = (bf16_t*)(F.ws + WS_H);
    for (int t0 = gw * 16; t0 < NTOK; t0 += NGW * 16) { const int b = t0 / SEQ; ModVec m; modvec_load(m, F.inp(I_NMIX), mod + b * 6144, mod + b * 6144 + 1024, F.lane);
#pragma unroll 1
        for (int i = 0; i < 16; i += 4) { Row16 r[4];
#pragma unroll
            for (int u = 0; u < 4; ++u) row_load(r[u], F.inp(I_X) + (size_t)(t0 + i + u) * 1024, F.lane);
#pragma unroll
            for (int u = 0; u < 4; ++u) { const float rstd = __builtin_amdgcn_rsqf(row_sumsq(r[u]) * (1.0f / 1024.0f) + EPS); row_mod_store(r[u], rstd, m, H + (size_t)(t0 + i + u) * 1024, F.lane); } } }
}
__device__ __forceinline__ void phase_gate(Frame& F) {
    const int gw = F.vcu * NWAVES + F.wave, NGW = F.G * NWAVES; bf16_t* O = (bf16_t*)(F.ws + WS_VR); const bf16_t* SG = (const bf16_t*)(F.ws + WS_SG); const float* gn = F.inp(I_RGN);
    for (int t0 = gw; t0 < NTOK; t0 += 2 * NGW) {
        u32x4 o2[2][4], g2[2][4];
#pragma unroll
        for (int u = 0; u < 2; ++u)
#pragma unroll
            for (int j = 0; j < 4; ++j) { const size_t t = t0 + u * NGW; o2[u][j] = ((const u32x4*)(O + t * 2048))[64 * j + F.lane]; g2[u][j] = ((const u32x4*)(SG + t * 2048))[64 * j + F.lane]; }
#pragma unroll
        for (int u = 0; u < 2; ++u) { const size_t t = t0 + u * NGW;
#pragma unroll
        for (int j = 0; j < 4; ++j) {
            float ov[8]; float ss = 0.f;
#pragma unroll
            for (int e = 0; e < 4; ++e) { ov[2 * e] = bf_lo(o2[u][j][e]); ov[2 * e + 1] = bf_hi(o2[u][j][e]); ss += ov[2 * e] * ov[2 * e] + ov[2 * e + 1] * ov[2 * e + 1]; }
            const float rstd = __builtin_amdgcn_rsqf(wave_sum(ss) * (1.0f / 512.0f) + EPS);
            const f32x4 g0 = ((const f32x4*)gn)[2 * (64 * j + F.lane)], g1 = ((const f32x4*)gn)[2 * (64 * j + F.lane) + 1];
            u32x4 w;
#pragma unroll
            for (int e = 0; e < 4; ++e) { const float ga = e < 2 ? g0[2 * e] : g1[2 * e - 4], gb = e < 2 ? g0[2 * e + 1] : g1[2 * e - 3];
                w[e] = pk2(bf_lo(g2[u][j][e]) * (ov[2 * e] * rstd * ga), bf_hi(g2[u][j][e]) * (ov[2 * e + 1] * rstd * gb)); }
            ((u32x4*)(O + t * 2048))[64 * j + F.lane] = w;
        } }
    }
}
__device__ __forceinline__ void phase_route(Frame& F, int layer) {
    const int gwl = blockIdx.x * NWAVES + F.wave;
    const float* mod = (const float*)(F.ws + WS_MOD) + (size_t)layer * 16 * 6144; const bf16_t* XB = (const bf16_t*)(F.ws + WS_XB); bf16_t* H = (bf16_t*)(F.ws + WS_H);
    const float* nf = F.inp(I_NFFN) + layer * 1024;
    const float* bg = F.inp(I_BG) + layer * 4; const float* be = F.inp(I_BE) + layer * 16;
    unsigned* gcnt = F.ctl + (layer ? CW_CNT1 : CW_CNT0);
    int* list = (int*)(F.ws + WS_LIST); int* tokslot = (int*)(F.ws + WS_TOKSLOT); float* tokw = (float*)(F.ws + WS_TOKW);
    LAS float* WrT = (LAS float*)(F.lds);
    LAS float* lgs = (LAS float*)(F.lds + 81920) + F.wave * 96;
    LAS int* wcnt = (LAS int*)(F.lds + 81920 + 4096);
    LAS int* wbase = (LAS int*)(F.lds + 81920 + 4096 + 1024);
    { const f32x4* src = (const f32x4*)((const float*)(F.ws + WS_WRT) + (size_t)layer * 20480);
#pragma unroll
      for (int i = 0; i < 10; ++i) ((LAS f32x4*)WrT)[i * NTHREADS + F.tid] = src[i * NTHREADS + F.tid]; }
    __syncthreads();
    const int lane = F.lane; const bool b5 = lane & 32, b4 = lane & 16, b3 = lane & 8;
    const int NGWL = F.G * NWAVES;
    for (int base = 0; base < NTOK; base += NGWL * 16) {
        const int t0 = base + gwl * 16; const bool active = t0 < NTOK;
        int my_e0 = 0, my_e1 = 0; float my_w0 = 0.f, my_w1 = 0.f;
        if (active) {
            const int b = t0 / SEQ; ModVec mv; modvec_load(mv, nf, mod + b * 6144 + 3072, mod + b * 6144 + 4096, lane);
            u32x2 nx[4][4];
#pragma unroll
            for (int i = 0; i < 4; ++i)
#pragma unroll
                for (int j = 0; j < 4; ++j) nx[i][j] = ((const u32x2*)(XB + (size_t)(t0 + i) * 1024))[64 * j + lane];
#pragma unroll 1
            for (int grp = 0; grp < 4; ++grp) {
                const int tg = t0 + 4 * grp;
                Row16 r[4];
#pragma unroll
                for (int i = 0; i < 4; ++i)
#pragma unroll
                    for (int j = 0; j < 4; ++j) { const u32x2 q = nx[i][j]; r[i].v[j] = (f32x4){bf_lo(q.x), bf_hi(q.x), bf_lo(q.y), bf_hi(q.y)}; }
                if (grp < 3) {
#pragma unroll
                    for (int i = 0; i < 4; ++i)
#pragma unroll
                        for (int j = 0; j < 4; ++j) nx[i][j] = ((const u32x2*)(XB + (size_t)(tg + 4 + i) * 1024))[64 * j + lane];
                }
                float rstd[4];
#pragma unroll
                for (int i = 0; i < 4; ++i) rstd[i] = __builtin_amdgcn_rsqf(row_sumsq(r[i]) * (1.0f / 1024.0f) + EPS);
#pragma unroll
                for (int j = 0; j < 4; ++j) {
#pragma unroll
                    for (int i = 0; i < 4; ++i) { const f32x4 h = r[i].v[j] * rstd[i] * mv.A[j] + mv.B[j]; r[i].v[j] = h; u32x2 w; w.x = pk2(h[0], h[1]); w.y = pk2(h[2], h[3]); ((u32x2*)(H + (size_t)(tg + i) * 1024))[64 * j + lane] = w; } }
#pragma unroll
                for (int hq = 0; hq < 2; ++hq) {
                    float V[40];
#pragma unroll
                    for (int q = 0; q < 10; ++q) {
                        float a0 = 0.f, a1 = 0.f, a2 = 0.f, a3 = 0.f;
#pragma unroll
                        for (int j = 0; j < 4; ++j) { const f32x4 w4 = *(const LAS f32x4*)(WrT + (hq * 10 + q) * 1024 + 4 * (64 * j + lane));
                            a0 += r[0].v[j][0] * w4[0] + r[0].v[j][1] * w4[1] + r[0].v[j][2] * w4[2] + r[0].v[j][3] * w4[3];
                            a1 += r[1].v[j][0] * w4[0] + r[1].v[j][1] * w4[1] + r[1].v[j][2] * w4[2] + r[1].v[j][3] * w4[3];
                            a2 += r[2].v[j][0] * w4[0] + r[2].v[j][1] * w4[1] + r[2].v[j][2] * w4[2] + r[2].v[j][3] * w4[3];
                            a3 += r[3].v[j][0] * w4[0] + r[3].v[j][1] * w4[1] + r[3].v[j][2] * w4[2] + r[3].v[j][3] * w4[3]; }
                        V[q] = a0; V[10 + q] = a1; V[20 + q] = a2; V[30 + q] = a3;
                    }
                    float W20[20], W10[10];
#pragma unroll
                    for (int i = 0; i < 20; ++i) W20[i] = swap32_add(V[i], V[i + 20]);
#pragma unroll
                    for (int i = 0; i < 10; ++i) W10[i] = swap16_add(W20[i], W20[i + 10]);
                    const int vb = (b3 ? 5 : 0) + (b4 ? 10 : 0) + (b5 ? 20 : 0);
#pragma unroll
                    for (int i = 0; i < 5; ++i) { const float keep = b3 ? W10[i + 5] : W10[i], send = b3 ? W10[i] : W10[i + 5]; const float v = sum8(keep + dppf<0x128>(send));
                        const int vi = vb + i;
                        if ((lane & 7) == 0) lgs[(vi / 10) * 20 + hq * 10 + (vi % 10)] = v; }
                    asm volatile("" ::: "memory");
                }
                LDS_WAIT(); asm volatile("" ::: "memory");
                if ((lane >> 2) == grp) {
                    const LAS float* lp = lgs + (lane & 3) * 20;
                    float gl[4]; int gi = 0;
#pragma unroll
                    for (int q = 0; q < 4; ++q) gl[q] = lp[q] + bg[q];
                    float gm = gl[0];
#pragma unroll
                    for (int q = 1; q < 4; ++q) if (gl[q] > gm) { gm = gl[q]; gi = q; }
                    float gs = 0.f;
#pragma unroll
                    for (int q = 0; q < 4; ++q) gs += __expf(gl[q] - gm);
                    const float ggate = 1.0f / gs;
                    float el[4];
#pragma unroll
                    for (int q = 0; q < 4; ++q) el[q] = lp[4 + 4 * gi + q] + be[4 * gi + q];
                    int i0 = 0; float m0 = el[0];
#pragma unroll
                    for (int q = 1; q < 4; ++q) if (el[q] > m0) { m0 = el[q]; i0 = q; }
                    int i1 = 0; float m1 = -INFINITY;
#pragma unroll
                    for (int q = 0; q < 4; ++q) if (q != i0 && el[q] > m1) { m1 = el[q]; i1 = q; }
                    const float p1 = __expf(m1 - m0);
                    my_e0 = gi * 4 + i0; my_e1 = gi * 4 + i1; my_w0 = ggate / (1.0f + p1); my_w1 = ggate * p1 / (1.0f + p1);
                }
                LDS_WAIT(); asm volatile("" ::: "memory");
            }
        }
        const bool have = active && lane < 16; int rank0 = 0, rank1 = 0, mycount = 0;
        const unsigned long long lt = (1ull << lane) - 1ull;
#pragma unroll 1
        for (int e = 0; e < 16; ++e) {
            const unsigned long long b0 = __ballot(have && my_e0 == e), b1 = __ballot(have && my_e1 == e);
            if (my_e0 == e) rank0 = __popcll(b0 & lt);
            if (my_e1 == e) rank1 = __popcll(b0) + __popcll(b1 & lt);
            if (lane == e) mycount = __popcll(b0) + __popcll(b1);
        }
        if (lane < 16) wcnt[F.wave * 16 + lane] = mycount;
        __syncthreads();
        if (F.tid < 16) { int tot = 0;
#pragma unroll
            for (int w = 0; w < 8; ++w) { const int c = wcnt[w * 16 + F.tid]; wbase[w * 16 + F.tid] = tot; tot += c; }
            const int gb = tot ? (int)atomicAdd(gcnt + F.tid, (unsigned)tot) : 0;
#pragma unroll
            for (int w = 0; w < 8; ++w) wbase[w * 16 + F.tid] += gb; }
        __syncthreads();
        if (have) { const int t = t0 + lane; const int p0 = wbase[F.wave * 16 + my_e0] + rank0, p1 = wbase[F.wave * 16 + my_e1] + rank1;
            list[my_e0 * 32768 + p0] = t; list[my_e1 * 32768 + p1] = t;
            tokslot[2 * t] = (my_e0 << 16) | p0; tokslot[2 * t + 1] = (my_e1 << 16) | p1; tokw[2 * t] = my_w0; tokw[2 * t + 1] = my_w1; }
        __syncthreads();
    }
}
__device__ __forceinline__ void load_rbs(Frame& F, const unsigned* gcnt, LAS int* rbs, LAS int* cnts) {
    if (F.tid < 64) {
        const int e = F.tid & 15; const int c = (int)__hip_atomic_load(gcnt + e, __ATOMIC_RELAXED, __HIP_MEMORY_SCOPE_AGENT); const int nb = (c + 255) >> 8;
        int acc = 0, tot = 0;
#pragma unroll
        for (int k = 0; k < 16; ++k) { const int v = __builtin_amdgcn_readlane(nb, k); acc += (k < e) ? v : 0; tot += v; }
        if (F.tid < 16) { rbs[e] = acc; if (cnts) cnts[e] = c; if (e == 0) rbs[16] = tot; }
    }
    __syncthreads();
}
__device__ __forceinline__ void moe_tables(Frame& F, int layer, LAS int* rbs, LAS int* rowtab, int NT, bool gather) {
    const unsigned* gcnt = F.ctl + (layer ? CW_CNT1 : CW_CNT0);
    LAS int* cnts = rbs + 32;
    load_rbs(F, gcnt, rbs, cnts);
    if (gather) {
        const int* list = (const int*)(F.ws + WS_LIST); const int nrb = rbs[16], nwg = nrb * NT;
        int vals[8]; bool ok[8];
#pragma unroll
        for (int p = 0; p < 8; ++p) { const int i = 2 * p + (F.tid >> 8); const long L = (long)i * F.G + blockIdx.x; ok[p] = L < nwg; vals[p] = 0;
            if (ok[p]) { const int wg = pg8::xcd_remap((int)L, nwg), rb = wg / NT; int e = 0;
#pragma unroll
                for (int k = 1; k < 16; ++k) e += (rb >= rbs[k]) ? 1 : 0;
                const int lr0 = (rb - rbs[e]) * 256, cnt = cnts[e]; int r = lr0 + (F.tid & 255); r = r < cnt ? r : cnt - 1; vals[p] = list[e * 32768 + r]; } }
#pragma unroll
        for (int p = 0; p < 8; ++p) if (ok[p]) rowtab[(2 * p + (F.tid >> 8)) * 256 + (F.tid & 255)] = vals[p];
        __syncthreads();
    }
}
struct CombRow { Row16 x; u32x2 y0[4], y1[4]; float w0, w1; };
struct CombSlots { int r0, r1; float w0, w1; };
__device__ __forceinline__ void comb_slots(Frame& F, int t0, const LAS int* rbs, CombSlots& s) {
    const int* tokslot = (const int*)(F.ws + WS_TOKSLOT); const float* tokw = (const float*)(F.ws + WS_TOKW);
    const int i = F.lane & 15; const int s0 = tokslot[2 * (t0 + i)], s1 = tokslot[2 * (t0 + i) + 1]; s.w0 = tokw[2 * (t0 + i)]; s.w1 = tokw[2 * (t0 + i) + 1];
    s.r0 = rbs[s0 >> 16] * 256 + (s0 & 0xffff); s.r1 = rbs[s1 >> 16] * 256 + (s1 & 0xffff);
}
__device__ __forceinline__ void comb_issue(Frame& F, int t, int i, const CombSlots& s, CombRow& c) {
    const bf16_t* XB = (const bf16_t*)(F.ws + WS_XB); const bf16_t* YB = (const bf16_t*)(F.ws + WS_YB);
    row_load_bf16(c.x, XB + (size_t)t * 1024, F.lane);
    const int r0 = __builtin_amdgcn_readlane(s.r0, i), r1 = __builtin_amdgcn_readlane(s.r1, i);
    c.w0 = __builtin_bit_cast(float, __builtin_amdgcn_readlane(__builtin_bit_cast(int, s.w0), i)); c.w1 = __builtin_bit_cast(float, __builtin_amdgcn_readlane(__builtin_bit_cast(int, s.w1), i));
    const u32x2* y0 = (const u32x2*)(YB + (size_t)r0 * 1024); const u32x2* y1 = (const u32x2*)(YB + (size_t)r1 * 1024);
#pragma unroll
    for (int j = 0; j < 4; ++j) { c.y0[j] = y0[64 * j + F.lane]; c.y1[j] = y1[64 * j + F.lane]; }
}
__device__ __forceinline__ void comb_finish(const f32x4 (&g2)[4], CombRow& c) {
#pragma unroll
    for (int j = 0; j < 4; ++j) { const u32x2 a = c.y0[j], b = c.y1[j]; const float w0 = c.w0, w1 = c.w1;
        f32x4 m; m[0] = w0 * bf_lo(a.x) + w1 * bf_lo(b.x); m[1] = w0 * bf_hi(a.x) + w1 * bf_hi(b.x); m[2] = w0 * bf_lo(a.y) + w1 * bf_lo(b.y); m[3] = w0 * bf_hi(a.y) + w1 * bf_hi(b.y);
        c.x.v[j] = c.x.v[j] + g2[j] * m; }
}
__device__ __forceinline__ void rbs_only(Frame& F, int layer, LAS int* rbs) {
    const unsigned* gcnt = F.ctl + (layer ? CW_CNT1 : CW_CNT0);
    load_rbs(F, gcnt, rbs, (LAS int*)nullptr);
}
__device__ __forceinline__ void phase_mid(Frame& F, LAS int* rbs) {
    const int gw = F.vcu * NWAVES + F.wave, NGW = F.G * NWAVES; bf16_t* XB = (bf16_t*)(F.ws + WS_XB); bf16_t* HQ = (bf16_t*)(F.ws + WS_H); bf16_t* HKV = (bf16_t*)(F.ws + WS_HKV);
    const float* mod1 = (const float*)(F.ws + WS_MOD) + 16 * 6144; const float* kvmod = (const float*)(F.ws + WS_KVMOD);
    rbs_only(F, 0, rbs);
    for (int t0 = gw * 16; t0 < NTOK; t0 += NGW * 16) { const int b = t0 / SEQ;
        CombSlots sl; comb_slots(F, t0, rbs, sl);
        ModVec mq, mk; modvec_load(mq, F.inp(I_NMIX) + 1024, mod1 + b * 6144, mod1 + b * 6144 + 1024, F.lane); modvec_load(mk, F.inp(I_KVNORM), kvmod + b * 2048, kvmod + b * 2048 + 1024, F.lane);
        f32x4 g2[4];
#pragma unroll
        for (int j = 0; j < 4; ++j) g2[j] = ((const f32x4*)((const float*)(F.ws + WS_MOD) + (size_t)b * 6144 + 5120))[64 * j + F.lane];
#pragma unroll 1
        for (int i = 0; i < 16; ++i) { CombRow c;
            const int cit = gw + (i >> 1) * NGW; const bool conv = cit < N_MOE_ITEMS; TItem ti; f32x4 tv[8];
            if (conv) { ti = moe_item(F, 1, cit); thalf_load(ti, i & 1, tv, F.lane); }
            comb_issue(F, t0 + i, i, sl, c);
            { const int tt = t0 + i; comb_finish(g2, c); Row16& r = c.x;
                row_store_bf16(r, XB + (size_t)tt * 1024, F.lane);
                const float rstd = __builtin_amdgcn_rsqf(row_sumsq(r) * (1.0f / 1024.0f) + EPS);
                row_mod_store(r, rstd, mq, HQ + (size_t)tt * 1024, F.lane); row_mod_store(r, rstd, mk, HKV + (size_t)tt * 1024, F.lane); }
            if (conv) thalf_store(ti, i & 1, tv, (LAS float*)(F.lds + F.wave * 17408), F.lane);
        } }
}
__device__ __forceinline__ void phase_final(Frame& F, LAS int* rbs) {
    const int gw = F.vcu * NWAVES + F.wave, NGW = F.G * NWAVES;
    rbs_only(F, 1, rbs);
    for (int t0 = gw * 16; t0 < NTOK; t0 += NGW * 16) { const int b = t0 / SEQ;
        CombSlots sl; comb_slots(F, t0, rbs, sl);
        f32x4 g2[4];
#pragma unroll
        for (int j = 0; j < 4; ++j) g2[j] = ((const f32x4*)((const float*)(F.ws + WS_MOD) + (size_t)(16 + b) * 6144 + 5120))[64 * j + F.lane];
#pragma unroll 1
        for (int i = 0; i < 16; i += 4) { CombRow c[4];
#pragma unroll
            for (int u = 0; u < 4; ++u) comb_issue(F, t0 + i + u, i + u, sl, c[u]);
#pragma unroll
            for (int u = 0; u < 4; ++u) { const int tt = t0 + i + u; comb_finish(g2, c[u]);
#pragma unroll
                for (int j = 0; j < 4; ++j) ((f32x4*)(F.out + (size_t)tt * 1024))[64 * j + F.lane] = c[u].x.v[j]; } } }
}
__device__ __forceinline__ s16x4 tr_read(const LAS void* p) {
    typedef short v4s __attribute__((ext_vector_type(4)));
    return __builtin_bit_cast(s16x4, __builtin_amdgcn_ds_read_tr16_b64_v4i16((LAS v4s*)p));
}
__device__ __forceinline__ bf16x8 cat8(s16x4 a, s16x4 b) { return (bf16x8){a[0], a[1], a[2], a[3], b[0], b[1], b[2], b[3]}; }

constexpr int RQ_STRIDE = 528, RV_STRIDE = 272, RS_STRIDE = 144;
constexpr int R_QS = 0, R_KS = 64 * RQ_STRIDE, R_VS = 2 * 64 * RQ_STRIDE, R_SS = R_VS + 64 * RV_STRIDE, R_CV = R_SS + 64 * RS_STRIDE, R_OS = R_CV + 2 * 16384, R_END = R_OS + 64 * RV_STRIDE;
static_assert(R_CV % 16 == 0 && R_OS % 16 == 0 && R_CV + 2 * 16384 <= 131072 && R_END <= ROWTAB_OFF + ROWTAB_BYTES, "retention LDS");

__device__ __forceinline__ void bg_load(Frame& F, int pair, u32x4 (&cv)[4]) {
#pragma unroll
    for (int bsel = 0; bsel < 2; ++bsel) { const TItem it = moe_item(F, 0, (2 * pair + bsel) * F.G + (int)blockIdx.x);
        const int kb = it.item >> 4, nb = it.item & 15, k0 = 64 * kb, n0 = 64 * nb;
#pragma unroll
        for (int i = 0; i < 2; ++i) cv[2 * bsel + i] = *(const u32x4*)((const char*)(it.W + (size_t)(k0 + 32 * i) * 1024 + n0) + (unsigned)((F.tid >> 4) * 4096 + (F.tid & 15) * 16)); }
}
__device__ __forceinline__ void bg_stage(Frame& F, const u32x4 (&cv)[4]) {
#pragma unroll
    for (int bsel = 0; bsel < 2; ++bsel)
#pragma unroll
        for (int i = 0; i < 2; ++i) *(LAS u32x4*)(F.lds + R_CV + bsel * 16384 + (i * 512 + F.tid) * 16) = cv[2 * bsel + i];
}
__device__ __forceinline__ void bg_convert(Frame& F, int pair) {
    if (F.wave < 2) return;
    const int bsel = F.wave >= 5 ? 1 : 0, wi = F.wave - 2 - 3 * bsel, c0 = 3 * wi, cnt = wi < 2 ? 3 : 2;
    const TItem it = moe_item(F, 0, (2 * pair + bsel) * F.G + (int)blockIdx.x);
    const int kb = it.item >> 4, nb = it.item & 15, k0 = 64 * kb, n0 = 64 * nb;
    const int d = dest_row(n0 + (F.lane & 32), it.mode) + (F.lane & 31);
    bf16_t* op = it.WT + (size_t)d * it.K + k0;
    const LAS float* tile = (const LAS float*)(F.lds + R_CV + bsel * 16384) + F.lane;
    float tv[3][8];
#pragma unroll
    for (int i = 0; i < 3; ++i) { if (i < cnt) { const LAS float* s = tile + (8 * (c0 + i)) * 64;
#pragma unroll
        for (int e = 0; e < 8; ++e) tv[i][e] = s[e * 64]; } }
#pragma unroll
    for (int i = 0; i < 3; ++i) { if (i < cnt) { const int c = c0 + i;
        u32x4 o; o.x = pk2(tv[i][0], tv[i][1]); o.y = pk2(tv[i][2], tv[i][3]); o.z = pk2(tv[i][4], tv[i][5]); o.w = pk2(tv[i][6], tv[i][7]);
        *(u32x4*)(op + 8 * c) = o; } }
}

__device__ __forceinline__ void phase_retention(Frame& F) {
    LAS unsigned char* lds = F.lds;
    const int tid = F.tid, lane = F.lane, w = F.wave, g = lane >> 4, l15 = lane & 15, tq = (lane >> 2) & 3, tp = lane & 3;
    const bf16_t* QR = (const bf16_t*)(F.ws + WS_QR); const bf16_t* KR = (const bf16_t*)(F.ws + WS_KR); bf16_t* VR = (bf16_t*)(F.ws + WS_VR);
    const unsigned qaddr = (unsigned)(uintptr_t)(lds + R_QS + l15 * RQ_STRIDE + g * 8), kaddr = (unsigned)(uintptr_t)(lds + R_KS + (8 * g + tq) * RQ_STRIDE + 4 * tp * 2);
    for (int i = tid; i < 64 * RS_STRIDE / 4; i += NTHREADS) ((LAS unsigned*)(lds + R_SS))[i] = 0u;
    for (int unit = F.vcu; unit < 256; unit += F.G) {
        const int b = unit >> 4, h = (unit >> 2) & 3, s = unit & 3;
        const float lgam = __builtin_log2f(1.0f - __builtin_exp2f(-5.0f - (float)h)); const float cdec = __builtin_exp2f(64.0f * lgam);
        const size_t tok0 = (size_t)b * SEQ;
        const bf16_t* qg = QR + tok0 * 1024 + h * 256; const bf16_t* kg = KR + tok0 * 1024 + h * 256; bf16_t* vg = VR + tok0 * 2048 + h * 512 + s * 128;
        f32x4 St[16];
#pragma unroll
        for (int t = 0; t < 16; ++t) St[t] = (f32x4){0.f, 0.f, 0.f, 0.f};
        u32x4 pq[4], pk[4], pv[2], cv[4];
        const unsigned qko = (unsigned)((tid >> 5) * 2048 + (tid & 31) * 16), vo = (unsigned)((tid >> 4) * 4096 + (tid & 15) * 16);
#define RET_PREFETCH(ci) do { const char* _q = (const char*)qg + (size_t)(ci) * 131072; const char* _k = (const char*)kg + (size_t)(ci) * 131072; const char* _v = (const char*)vg + (size_t)(ci) * 262144; \
            _Pragma("unroll") for (int i = 0; i < 4; ++i) { pq[i] = *(const u32x4*)(_q + i * 32768 + qko); pk[i] = *(const u32x4*)(_k + i * 32768 + qko); } \
            _Pragma("unroll") for (int i = 0; i < 2; ++i) pv[i] = *(const u32x4*)(_v + i * 131072 + vo); } while (0)
        RET_PREFETCH(0);
#ifdef RET_PROBE
        unsigned long long rp_acc = 0, rp_prev = __builtin_amdgcn_s_memrealtime();
#define RS(k) do { const unsigned long long _n = __builtin_amdgcn_s_memrealtime(); if (RET_PROBE == (k)) rp_acc += _n - rp_prev; rp_prev = _n; } while (0)
#else
#define RS(k) do {} while (0)
#endif
        for (int ci = 0; ci < 32; ++ci) {
            RS(0);
#pragma unroll
            for (int i = 0; i < 4; ++i) { const int id = i * 512 + tid, row = id >> 5, c16 = id & 31;
                *(LAS u32x4*)(lds + R_QS + row * RQ_STRIDE + c16 * 16) = pq[i]; *(LAS u32x4*)(lds + R_KS + row * RQ_STRIDE + c16 * 16) = pk[i]; }
#pragma unroll
            for (int i = 0; i < 2; ++i) { const int id = i * 512 + tid, row = id >> 4, c16 = id & 15; *(LAS u32x4*)(lds + R_VS + row * RV_STRIDE + c16 * 16) = pv[i]; }
            if (ci >= 1 && ci <= 24) bg_stage(F, cv);
            RS(1); __syncthreads(); RS(2);
            if (ci >= 1) {
#pragma unroll
                for (int i = 0; i < 2; ++i) { const int id = i * 512 + tid, row = id >> 4, c16 = id & 15;
                    *(u32x4*)((char*)vg + (size_t)(ci - 1) * 262144 + i * 131072 + vo) = *(const LAS u32x4*)(lds + R_OS + row * RV_STRIDE + c16 * 16); } }
            if (ci + 1 < 32) RET_PREFETCH(ci + 1);
            if (ci < 24) bg_load(F, ci, cv);
            if (ci >= 1 && ci <= 24) bg_convert(F, ci - 1);
#pragma unroll
            for (int rep = 0; rep < 2; ++rep) {
                const int idx = w + 8 * rep;
                if (idx < 10) {
                    const int mt = idx < 4 ? 0 : idx < 7 ? 1 : idx < 9 ? 2 : 3, nt_ = idx < 4 ? idx : idx < 7 ? idx - 3 : idx < 9 ? idx - 5 : 3;
                    f32x4 sacc = (f32x4){0.f, 0.f, 0.f, 0.f};
                    const LAS unsigned char* ka = lds + R_KS + (mt * 16 + l15) * RQ_STRIDE + g * 16; const LAS unsigned char* qb = lds + R_QS + (nt_ * 16 + l15) * RQ_STRIDE + g * 16;
#pragma unroll
                    for (int hb = 0; hb < 2; ++hb) { bf16x8 fa[4], fb[4];
#pragma unroll
                        for (int kk = 0; kk < 4; ++kk) { fa[kk] = *(const LAS bf16x8*)(ka + (4 * hb + kk) * 64); fb[kk] = *(const LAS bf16x8*)(qb + (4 * hb + kk) * 64); }
                        __builtin_amdgcn_sched_barrier(0);
#pragma unroll
                        for (int kk = 0; kk < 4; ++kk) sacc = __builtin_amdgcn_mfma_f32_16x16x32_bf16(fa[kk], fb[kk], sacc, 0, 0, 0);
                        __builtin_amdgcn_sched_barrier(0); }
                    const int n = nt_ * 16 + l15, m0 = mt * 16 + 4 * g;
#pragma unroll
                    for (int r = 0; r < 4; ++r) if (n < m0 + r) sacc[r] = 0.f;
                    u32x2 pw; pw.x = pk2(sacc[0], sacc[1]); pw.y = pk2(sacc[2], sacc[3]);
                    *(LAS u32x2*)(lds + R_SS + n * RS_STRIDE + m0 * 2) = pw;
                }
            }
            bf16x8 vf[2];
#pragma unroll
            for (int kk = 0; kk < 2; ++kk) { const LAS unsigned char* vp = lds + R_VS + (32 * kk + 8 * g + tq) * RV_STRIDE + (16 * w + 4 * tp) * 2;
                vf[kk] = cat8(tr_read(vp), tr_read(vp + 4 * RV_STRIDE)); }
#define RET_PACKST(kk) ({ u32x4 _x; _x.x = pk2(St[2 * (kk)][0], St[2 * (kk)][1]); _x.y = pk2(St[2 * (kk)][2], St[2 * (kk)][3]); _x.z = pk2(St[2 * (kk) + 1][0], St[2 * (kk) + 1][1]); _x.w = pk2(St[2 * (kk) + 1][2], St[2 * (kk) + 1][3]); __builtin_bit_cast(bf16x8, _x); })
            f32x4 o[4];
#pragma unroll
            for (int nt_ = 0; nt_ < 4; ++nt_) o[nt_] = (f32x4){0.f, 0.f, 0.f, 0.f};
            __builtin_amdgcn_sched_barrier(0);
            {
                s16x4 rlo[4], rhi[4];
#define RET_LD(k, gi) do { if ((gi) < 32) asm volatile("ds_read_b64 %0, %2 offset:%3\n\tds_read_b64 %1, %2 offset:%4" : "=&v"(rlo[k]), "=&v"(rhi[k]) : "v"(qaddr), "i"(((gi) & 3) * 16 * RQ_STRIDE + ((gi) >> 2) * 64), "i"(((gi) & 3) * 16 * RQ_STRIDE + ((gi) >> 2) * 64 + 32) : "memory"); \
                else asm volatile("ds_read_b64_tr_b16 %0, %2 offset:%3\n\tds_read_b64_tr_b16 %1, %2 offset:%4" : "=&v"(rlo[k]), "=&v"(rhi[k]) : "v"(kaddr), "i"(((gi) & 1) * 32 * RQ_STRIDE + (((gi) - 32) >> 1) * 32), "i"(((gi) & 1) * 32 * RQ_STRIDE + (((gi) - 32) >> 1) * 32 + 4 * RQ_STRIDE) : "memory"); } while (0)
#define RET_WAIT(k, n) asm volatile("s_waitcnt lgkmcnt(%2)" : "+v"(rlo[k]), "+v"(rhi[k]) : "n"(n) : "memory")
                RET_LD(0, 0); RET_LD(1, 1); RET_LD(2, 2);
                bf16x8 sbc = RET_PACKST(0), sbn = RET_PACKST(1);
#pragma unroll
                for (int gi = 0; gi < 64; ++gi) {
                    if (gi + 3 < 64) RET_LD((gi + 3) & 3, gi + 3);
                    RET_WAIT(gi & 3, (63 - gi) < 3 ? 2 * (63 - gi) : 6);
                    const bf16x8 af = cat8(rlo[gi & 3], rhi[gi & 3]);
                    if (gi < 32) { o[gi & 3] = __builtin_amdgcn_mfma_f32_16x16x32_bf16(af, sbc, o[gi & 3], 0, 0, 0);
                        if ((gi & 3) == 3) { sbc = sbn; if ((gi >> 2) + 2 < 8) sbn = RET_PACKST((gi >> 2) + 2); } }
                    else { const int t = (gi - 32) >> 1; St[t] = __builtin_amdgcn_mfma_f32_16x16x32_bf16(af, vf[gi & 1], St[t], 0, 0, 0);
                        if ((gi & 1) && t >= 1) St[t - 1] = St[t - 1] * cdec; }
                    __builtin_amdgcn_sched_barrier(0);
                }
                St[15] = St[15] * cdec;
#undef RET_LD
#undef RET_WAIT
            }
            RS(3); __syncthreads(); RS(4);
            {
#pragma unroll
                for (int nt_ = 0; nt_ < 4; ++nt_) {
                    const LAS unsigned char* sp = lds + R_SS + (nt_ * 16 + l15) * RS_STRIDE + g * 16;
#pragma unroll
                    for (int kk = 0; kk < 2; ++kk) { if (kk * 32 < (nt_ + 1) * 16) { const bf16x8 a = *(const LAS bf16x8*)(sp + kk * 64); o[nt_] = __builtin_amdgcn_mfma_f32_16x16x32_bf16(a, vf[kk], o[nt_], 0, 0, 0); } }
                }
#undef RET_PACKST
            }
#pragma unroll
            for (int nt_ = 0; nt_ < 4; ++nt_)
#pragma unroll
                for (int r = 0; r < 4; ++r) *(LAS bf16_t*)(lds + R_OS + (nt_ * 16 + 4 * g + r) * RV_STRIDE + (16 * w + l15) * 2) = (bf16_t)f2bf(o[nt_][r]);
            RS(5); __syncthreads(); RS(6);
        }
#ifdef RET_PROBE
        if (blockIdx.x == 0 && tid == RET_PROBE_WAVE * 64) __hip_atomic_store((unsigned long long*)(F.ctl + 8400), rp_acc, __ATOMIC_RELAXED, __HIP_MEMORY_SCOPE_AGENT);
#endif
#undef RET_PREFETCH
#pragma unroll
        for (int i = 0; i < 2; ++i) { const int id = i * 512 + tid, row = id >> 4, c16 = id & 15;
            *(u32x4*)((char*)vg + (size_t)31 * 262144 + i * 131072 + vo) = *(const LAS u32x4*)(lds + R_OS + row * RV_STRIDE + c16 * 16); }
        __syncthreads();
    }
}

constexpr int A_SLOT = 16384, A_K0 = 0, A_V0 = 3 * A_SLOT, A_LS = 6 * A_SLOT, A_X = 0, A_OST = A_LS + 8 * 64 * 4, A_OSTRIDE = 272, A_END = A_OST + 4 * 32 * A_OSTRIDE;
static_assert(A_END <= ROWTAB_OFF + ROWTAB_BYTES && 4 * 16384 <= A_LS, "attention LDS");
__device__ __forceinline__ int crow(int r, int hi) { return (r & 3) + 8 * (r >> 2) + 4 * hi; }
#define ATT_SB() __builtin_amdgcn_sched_barrier(0)

template <bool SHIFT, int t>
__device__ __forceinline__ void phase_attention_impl(Frame& F, const float M2) {
    LAS unsigned char* lds = F.lds;
    const int tid = F.tid, lane = F.lane, w = F.wave, r32 = lane & 31, hi = lane >> 5, tq = (lane >> 2) & 3, tp = lane & 3, ch = (lane >> 4) & 1, wq = w & 3;
    const bf16_t* Q1 = (const bf16_t*)(F.ws + WS_Q1); const bf16_t* K1 = (const bf16_t*)(F.ws + WS_K1); const bf16_t* V1 = (const bf16_t*)(F.ws + WS_V1); bf16_t* AO = (bf16_t*)(F.ws + WS_AO);
    const float* lam = F.inp(I_LAM);
    const float l01 = wave_sum(lam[lane] * lam[64 + lane]), l23 = wave_sum(lam[128 + lane] * lam[192 + lane]);
    const float lambda_init = 0.8f - 0.6f * 0.7408182206817179f;
    const float lam_full = __expf(l01) - __expf(l23) + lambda_init;
    LAS float* wsf = (LAS float*)(lds + A_LS) + w * 64;
    unsigned dsrc[2];
#pragma unroll
    for (int i = 0; i < 2; ++i) { const int row = 4 * (2 * w + i) + (lane >> 4), fr = ((row & 3) << 2) | ((row >> 2) & 3); dsrc[i] = (unsigned)(row * 2048 + (((lane & 15) ^ fr) << 4)); }
    const unsigned ddst = (unsigned)(w * 2048);
    const int frk = ((r32 & 3) << 2) | ((r32 >> 2) & 3);
    int koff[4];
#pragma unroll
    for (int ks = 0; ks < 4; ++ks) koff[ks] = r32 * 256 + (((8 * t + 2 * ks + hi) ^ frk) << 4);
    unsigned vofA[4], vofB[4];
#pragma unroll
    for (int d = 0; d < 4; ++d) { const int c = 4 * d + 2 * ch + (tp >> 1);
        vofA[d] = (unsigned)((4 * hi + tq) * 256 + ((c ^ ((tq << 2) | (hi & 3))) << 4) + 8 * (tp & 1));
        vofB[d] = (unsigned)((4 * hi + tq + 8) * 256 + ((c ^ ((tq << 2) | ((hi + 2) & 3))) << 4) + 8 * (tp & 1)); }
    const unsigned ldsb = (unsigned)(uintptr_t)lds;
#ifdef ATT_PROBE
    unsigned long long att_tw = 0;
#endif
#define ATT_UNIT(n, b_, h_, u_) const int _v##b_ = F.vcu + ((n) >> 3) * F.G, _bh##b_ = _v##b_ >> 1, b_ = _bh##b_ >> 3, h_ = _bh##b_ & 7, _pr##b_ = 2 * (((n) & 7) >> 1) + (_v##b_ & 1), u_ = ((n) & 1) ? 15 - _pr##b_ : _pr##b_
#define ATT_DMA(gbase, tile, NTu, slotbase) do { const int _tl = (tile) < (NTu) ? (tile) : (NTu) - 1; const char* _g = (gbase) + (size_t)_tl * 131072; const unsigned _s = (slotbase) + (unsigned)(((tile) % 3) * A_SLOT) + ddst; \
            __builtin_amdgcn_global_load_lds((const GAS unsigned*)(_g + dsrc[0]), (LAS unsigned*)(lds + _s), 16, 0, 0); \
            __builtin_amdgcn_global_load_lds((const GAS unsigned*)(_g + dsrc[1]), (LAS unsigned*)(lds + _s + 1024), 16, 0, 0); } while (0)
#define ATT_PROLOGUE_DMA(kgx, vgx, NTx) do { ATT_DMA(kgx, 0, NTx, A_K0); ATT_DMA(vgx, 0, NTx, A_V0); ATT_DMA(kgx, 1, NTx, A_K0); ATT_DMA(kgx, 2, NTx, A_K0); ATT_DMA(vgx, 1, NTx, A_V0); } while (0)
#define ATT_WAITBAR(n) asm volatile("s_waitcnt vmcnt(" #n ") lgkmcnt(0)\n\ts_barrier" ::: "memory")
    const int NU = 8 * ((256 - F.vcu + F.G - 1) / F.G);
    if (NU > 0) { ATT_UNIT(0, b0_, h0_, u0_); ATT_PROLOGUE_DMA((const char*)(K1 + (size_t)b0_ * SEQ * 1024 + h0_ * 128), (const char*)(V1 + (size_t)b0_ * SEQ * 1024 + h0_ * 128), 2 * u0_ + 2); }
    {
        for (int n = 0; n < NU; ++n) {
            ATT_UNIT(n, b, h, u);
            const size_t tok0 = (size_t)b * SEQ; const int q0 = u * 128 + wq * 32;
            const int NT = 2 * u + 2, jmax = 2 * u + (wq >> 1);
            const char* kg = (const char*)(K1 + tok0 * 1024 + h * 128); const char* vg = (const char*)(V1 + tok0 * 1024 + h * 128);
            bf16x8 qf[4];
#pragma unroll
            for (int ks = 0; ks < 4; ++ks) qf[ks] = *(const bf16x8*)((const char*)(Q1 + (tok0 + q0) * 1024 + h * 128 + t * 64) + (unsigned)(r32 * 2048 + hi * 16 + ks * 32));
            f32x16 O[4];
#pragma unroll
            for (int d = 0; d < 4; ++d) O[d] = f32x16{};
            float lsum = 0.f;
#define ATT_QK(S0, S1, kslot) do { const f32x16 _z = f32x16{}; bf16x8 _a0[2], _a1[2]; const LAS unsigned char* _kb = lds + A_K0 + (kslot) * A_SLOT; \
            _Pragma("unroll") for (int ks = 0; ks < 2; ++ks) { _a0[ks] = *(const LAS bf16x8*)(_kb + koff[ks]); _a1[ks] = *(const LAS bf16x8*)(_kb + koff[ks] + 32 * 256); } \
            S0 = __builtin_amdgcn_mfma_f32_32x32x16_bf16(_a0[0], qf[0], _z, 0, 0, 0); S1 = __builtin_amdgcn_mfma_f32_32x32x16_bf16(_a1[0], qf[0], _z, 0, 0, 0); \
            S0 = __builtin_amdgcn_mfma_f32_32x32x16_bf16(_a0[1], qf[1], S0, 0, 0, 0); S1 = __builtin_amdgcn_mfma_f32_32x32x16_bf16(_a1[1], qf[1], S1, 0, 0, 0); ATT_SB(); \
            _Pragma("unroll") for (int ks = 0; ks < 2; ++ks) { _a0[ks] = *(const LAS bf16x8*)(_kb + koff[ks + 2]); _a1[ks] = *(const LAS bf16x8*)(_kb + koff[ks + 2] + 32 * 256); } \
            S0 = __builtin_amdgcn_mfma_f32_32x32x16_bf16(_a0[0], qf[2], S0, 0, 0, 0); S1 = __builtin_amdgcn_mfma_f32_32x32x16_bf16(_a1[0], qf[2], S1, 0, 0, 0); \
            S0 = __builtin_amdgcn_mfma_f32_32x32x16_bf16(_a0[1], qf[3], S0, 0, 0, 0); S1 = __builtin_amdgcn_mfma_f32_32x32x16_bf16(_a1[1], qf[3], S1, 0, 0, 0); } while (0)
#define ATT_EXP4(S0, S1, PFN, e) do { float x0, x1, x2, x3; \
            if ((e) < 4) { x0 = S0[4 * (e)]; x1 = S0[4 * (e) + 1]; x2 = S0[4 * (e) + 2]; x3 = S0[4 * (e) + 3]; } else { x0 = S1[4 * ((e) - 4)]; x1 = S1[4 * ((e) - 4) + 1]; x2 = S1[4 * ((e) - 4) + 2]; x3 = S1[4 * ((e) - 4) + 3]; } \
            if (SHIFT) { x0 -= M2; x1 -= M2; x2 -= M2; x3 -= M2; } \
            x0 = __builtin_amdgcn_exp2f(x0); x1 = __builtin_amdgcn_exp2f(x1); x2 = __builtin_amdgcn_exp2f(x2); x3 = __builtin_amdgcn_exp2f(x3); lsum += (x0 + x1) + (x2 + x3); \
            PFN[(e) >> 1][((e) & 1) * 2] = pk2(x0, x1); PFN[(e) >> 1][((e) & 1) * 2 + 1] = pk2(x2, x3); } while (0)
#define ATT_VLD(k, i) asm volatile("ds_read_b64_tr_b16 %0, %2 offset:%4\n\tds_read_b64_tr_b16 %1, %3 offset:%4" : "=&v"(vlo[k]), "=&v"(vhi[k]) : "v"(va[(i) & 3]), "v"(vb[(i) & 3]), "i"(((i) >> 2) * 4096) : "memory")
#define ATT_VWAIT(k, n) asm volatile("s_waitcnt lgkmcnt(" #n ")" : "+v"(vlo[k]), "+v"(vhi[k]) :: "memory")
#define ATT_MM(PF, k, i) do { O[(i) & 3] = __builtin_amdgcn_mfma_f32_32x32x16_bf16(__builtin_bit_cast(bf16x8, PF[(i) >> 2]), cat8(vlo[k], vhi[k]), O[(i) & 3], 0, 0, 0); } while (0)
#define ATT_SLOT(PF, i) do { if ((i) + 3 < 16) ATT_VLD(((i) + 3) & 3, (i) + 3); \
            if ((i) < 13) ATT_VWAIT((i) & 3, 6); else if ((i) == 13) ATT_VWAIT((i) & 3, 4); else if ((i) == 14) ATT_VWAIT((i) & 3, 2); else ATT_VWAIT((i) & 3, 0); \
            ATT_MM(PF, (i) & 3, i); } while (0)
            ATT_WAITBAR(4);
            u32x4 pf[4];
            { f32x16 s0, s1; ATT_QK(s0, s1, 0);
#pragma unroll
              for (int e = 0; e < 8; ++e) ATT_EXP4(s0, s1, pf, e); }
            ATT_WAITBAR(4);
            f32x16 sA0, sA1;
            int ks1 = 1, vs0 = 0;
#if defined(ATT_PROBE) && defined(ATT_PROBE_LOOP)
            const unsigned long long _tl0 = __builtin_amdgcn_s_memrealtime();
#endif
            for (int j = 0; j < NT; ++j) {
                ATT_DMA(kg, j + 3, NT, A_K0); ATT_DMA(vg, j + 2, NT, A_V0);
                unsigned va[4], vb[4];
#pragma unroll
                for (int d = 0; d < 4; ++d) { va[d] = ldsb + (unsigned)(A_V0 + vs0 * A_SLOT) + vofA[d]; vb[d] = ldsb + (unsigned)(A_V0 + vs0 * A_SLOT) + vofB[d]; }
                if (t == 0) {
                    if (j + 1 <= jmax) {
                        u32x4 pfn[4];
                        s16x4 vlo[4], vhi[4];
                        ATT_VLD(0, 0); ATT_VLD(1, 1); ATT_VLD(2, 2);
                        ATT_QK(sA0, sA1, ks1); ATT_SB();
#pragma unroll
                        for (int i = 0; i < 8; ++i) { ATT_SLOT(pf, i); ATT_SB(); }
#pragma unroll
                        for (int i = 8; i < 16; ++i) { ATT_SLOT(pf, i); ATT_EXP4(sA0, sA1, pfn, i - 8); ATT_SB(); }
#pragma unroll
                        for (int s = 0; s < 4; ++s) pf[s] = pfn[s];
                    } else if (j <= jmax) {
                        s16x4 vlo[4], vhi[4];
                        ATT_VLD(0, 0); ATT_VLD(1, 1); ATT_VLD(2, 2);
#pragma unroll
                        for (int i = 0; i < 16; ++i) { ATT_SLOT(pf, i); ATT_SB(); }
                    }
                } else {
                    if (j + 1 <= jmax) {
                        u32x4 pfn[4];
                        s16x4 vlo[4], vhi[4];
                        ATT_VLD(0, 0); ATT_VLD(1, 1); ATT_VLD(2, 2);
                        ATT_QK(sA0, sA1, ks1); ATT_SB();
#pragma unroll
                        for (int i = 0; i < 8; ++i) { ATT_SLOT(pf, i); ATT_EXP4(sA0, sA1, pfn, i); ATT_SB(); }
#pragma unroll
                        for (int i = 8; i < 16; ++i) { ATT_SLOT(pf, i); ATT_SB(); }
#pragma unroll
                        for (int s = 0; s < 4; ++s) pf[s] = pfn[s];
                    } else if (j <= jmax) {
                        s16x4 vlo[4], vhi[4];
                        ATT_VLD(0, 0); ATT_VLD(1, 1); ATT_VLD(2, 2);
#pragma unroll
                        for (int i = 0; i < 16; ++i) { ATT_SLOT(pf, i); ATT_SB(); }
                    }
                }
                ks1 = ks1 == 2 ? 0 : ks1 + 1; vs0 = vs0 == 2 ? 0 : vs0 + 1;
#if defined(ATT_PROBE) && !defined(ATT_PROBE_LOOP)
                { const unsigned long long _t0 = __builtin_amdgcn_s_memrealtime(); ATT_WAITBAR(4); att_tw += __builtin_amdgcn_s_memrealtime() - _t0; }
#else
                ATT_WAITBAR(4);
#endif
            }
#if defined(ATT_PROBE) && defined(ATT_PROBE_LOOP)
            att_tw += __builtin_amdgcn_s_memrealtime() - _tl0;
#endif
            asm volatile("s_waitcnt vmcnt(0)" ::: "memory");
            if (n + 1 < NU) { const int n1 = n + 1; ATT_UNIT(n1, bn_, hn_, un_);
                ATT_PROLOGUE_DMA((const char*)(K1 + (size_t)bn_ * SEQ * 1024 + hn_ * 128), (const char*)(V1 + (size_t)bn_ * SEQ * 1024 + hn_ * 128), 2 * un_ + 2); }
#undef ATT_QK
#undef ATT_EXP4
#undef ATT_VLD
#undef ATT_VWAIT
#undef ATT_MM
#undef ATT_SLOT
            lsum = swap32_add(lsum, lsum);
            if (hi == 0) wsf[r32] = (t ? lam_full : 1.0f) / lsum;
            LDS_WAIT(); asm volatile("" ::: "memory");
            float sc[16];
#pragma unroll
            for (int r = 0; r < 16; ++r) sc[r] = wsf[crow(r, hi)];
            LAS unsigned* XR = (LAS unsigned*)(lds + A_OST + wq * 32 * A_OSTRIDE);
            if (t == 1) {
#pragma unroll
                for (int d = 0; d < 4; ++d)
#pragma unroll
                    for (int rr = 0; rr < 8; ++rr) XR[(d * 8 + rr) * 64 + lane] = pk2(O[d][2 * rr] * sc[2 * rr], O[d][2 * rr + 1] * sc[2 * rr + 1]);
            }
            __syncthreads();
            if (t == 0) {
                const float osc = 1.0f - lambda_init;
                const float* subp = F.inp(I_SUBLN); const float sub0 = subp[r32], sub1 = subp[32 + r32], sub2 = subp[64 + r32], sub3 = subp[96 + r32];
                unsigned xr[32];
#pragma unroll
                for (int i = 0; i < 32; ++i) xr[i] = XR[i * 64 + lane];
                LDS_WAIT(); asm volatile("" ::: "memory");
#pragma unroll
                for (int r = 0; r < 16; ++r) { const int q = crow(r, hi);
#define ATT_X(d) ((r & 1) ? bf_hi(xr[(d) * 8 + (r >> 1)]) : bf_lo(xr[(d) * 8 + (r >> 1)]))
                    const float o0 = O[0][r] * sc[r] - ATT_X(0), o1 = O[1][r] * sc[r] - ATT_X(1), o2 = O[2][r] * sc[r] - ATT_X(2), o3 = O[3][r] * sc[r] - ATT_X(3);
#undef ATT_X
                    float ss = o0 * o0 + o1 * o1 + o2 * o2 + o3 * o3;
                    ss = sum8(ss); ss += dppf<0x140>(ss); ss = swap16_add(ss, ss);
                    const float rstd = __builtin_amdgcn_rsqf(ss * (1.0f / 128.0f) + EPS) * osc;
                    LAS bf16_t* sp = (LAS bf16_t*)(lds + A_OST + wq * 32 * A_OSTRIDE + q * A_OSTRIDE) + r32;
                    sp[0] = (bf16_t)f2bf(o0 * rstd * sub0); sp[32] = (bf16_t)f2bf(o1 * rstd * sub1); sp[64] = (bf16_t)f2bf(o2 * rstd * sub2); sp[96] = (bf16_t)f2bf(o3 * rstd * sub3); }
                LDS_WAIT(); asm volatile("" ::: "memory");
                char* ob = (char*)(AO + (tok0 + q0) * 1024 + h * 128);
#pragma unroll
                for (int i = 0; i < 8; ++i) { const int id = i * 64 + lane, row = id >> 4, c16 = id & 15;
                    *(u32x4*)(ob + (unsigned)(row * 2048 + c16 * 16)) = *(const LAS u32x4*)(lds + A_OST + wq * 32 * A_OSTRIDE + row * A_OSTRIDE + c16 * 16); }
            }
        }
    }
#undef ATT_DMA
#undef ATT_UNIT
#undef ATT_PROLOGUE_DMA
#undef ATT_WAITBAR
#ifdef ATT_PROBE
    if (blockIdx.x == 0 && tid == ATT_PROBE * 64) __hip_atomic_store((unsigned long long*)(F.ctl + 8400), att_tw, __ATOMIC_RELAXED, __HIP_MEMORY_SCOPE_AGENT);
#endif
}

__device__ __forceinline__ void phase_attention(Frame& F) {
    const float gq = wave_max(fabsf(F.inp(I_QNORM)[F.lane])), gk = wave_max(fabsf(F.inp(I_KNORM)[F.lane]));
    const float bound = 8.0f * LOG2E * gq * gk * 1.001f + 0.01f;
    if (bound > 96.0f) { if (F.wave < 4) phase_attention_impl<true, 0>(F, bound - 96.0f); else phase_attention_impl<true, 1>(F, bound - 96.0f); }
    else { if (F.wave < 4) phase_attention_impl<false, 0>(F, 0.0f); else phase_attention_impl<false, 1>(F, 0.0f); }
}
constexpr int N_PHASES = 17;
#ifndef MK_N_LAUNCHES
#define MK_N_LAUNCHES 1
#endif
struct Args { const float* in[26]; float* out; unsigned char* ws; int ph_lo, ph_hi; };

__global__ void __launch_bounds__(NTHREADS, 2) yoco_fwd(Args args) {
    extern __shared__ __attribute__((aligned(16))) unsigned char lds_raw[];
    Frame F;
    F.lds = (LAS unsigned char*)lds_raw;
    const int wave0 = __builtin_amdgcn_readfirstlane((int)threadIdx.x >> 6);
    F.G = gridDim.x; { const int bx = blockIdx.x; F.vcu = (F.G % 8 == 0) ? (bx % 8) * (F.G / 8) + bx / 8 : bx; }
#define FRESH_IN() do { kargp_t _t = (kargp_t)__builtin_amdgcn_kernarg_segment_ptr(); asm volatile("" : "+s"(_t)); F.kin = _t; \
        F.out = (float*)(GAS float*)_t[26]; F.ws = (unsigned char*)(GAS unsigned char*)_t[27]; F.ctl = (unsigned*)(F.ws + WS_CTL); \
        int _tid; asm volatile("v_mbcnt_lo_u32_b32 %0, -1, 0\n\tv_mbcnt_hi_u32_b32 %0, -1, %0" : "=v"(_tid)); _tid += wave0 * 64; asm volatile("" : "+v"(_tid)); F.tid = _tid;     \
        F.lane = _tid & 63; F.wave = __builtin_amdgcn_readfirstlane(_tid >> 6); } while (0)
    FRESH_IN();
    volatile LAS unsigned* MISC = (volatile LAS unsigned*)(F.lds + MISC_OFF);
    LAS int* rbs = (LAS int*)(F.lds + MISC_OFF + 256);
    LAS int* rowtab = (LAS int*)(F.lds + ROWTAB_OFF);
    LAS int* utab = (LAS int*)(F.lds + MISC_OFF + 1024);
    for (int u = F.tid; u < 512; u += NTHREADS) MISC[u] = 0u;
    __syncthreads();
    const int lo = args.ph_lo, hi = args.ph_hi;
    const bool multi = (hi - lo) > 1;
    XcdBarrier bar; bar.bar = nullptr; bar.x = 0; bar.st = nullptr;
    if (multi) bar = xcd_barrier_post(F.ctl + CW_BAR, MISC + 8);
#ifdef ONLY_PHASE
#define IN(k) ((k) == ONLY_PHASE && lo <= (k) && (k) < hi)
#else
#define IN(k) (lo <= (k) && (k) < hi)
#endif
#if defined(PROBE_A) || defined(PROBE_B)
#ifndef PROBE_A
#define PROBE_A 0
#endif
#ifndef PROBE_B
#define PROBE_B 0
#endif
#ifndef PROBE_CONST
#define PROBE_CONST 0ull
#endif
#ifndef PROBE_MUL
#define PROBE_MUL 0ull
#endif
    unsigned long long pr_prev = __builtin_amdgcn_s_memrealtime(), pr_a = 0, pr_b = 0;
#define PROBE_STAMP(k) do { const unsigned long long _n = __builtin_amdgcn_s_memrealtime(); if ((PROBE_A >> (k)) & 1) pr_a += _n - pr_prev; if ((PROBE_B >> (k)) & 1) pr_b += _n - pr_prev; pr_prev = _n; } while (0)
#else
#define PROBE_STAMP(k) do {} while (0)
#endif
#define SEAM(k) do { if (IN(k) && IN((k) + 1)) { bar.bar = F.ctl + CW_BAR; xcd_barrier(bar); } else __syncthreads(); PROBE_STAMP(k); } while (0)
    #define gw (F.vcu * NWAVES + F.wave)
#define NGW (F.G * NWAVES)

#if defined(P0_PROBE)
#define P0S(k) do { if (P0_PROBE == (k)) pr_a = __builtin_amdgcn_s_memrealtime() - pr_prev; } while (0)
#else
#define P0S(k) do {} while (0)
#endif
    if (IN(0)) { FRESH_IN(); P0S(0); adaln_phase(F); __syncthreads(); P0S(1); rope_table(F, blockIdx.x * NTHREADS + F.tid, F.G * NTHREADS); P0S(2); {
          const int blk = (int)blockIdx.x; if (blk < 224) convert_weights(F, 0, true, false, blk * 8 + F.wave, 1 << 20, 1792); else { const int s0 = 1792 + (blk - 224) * 40 + F.wave * 5; convert_weights(F, 0, true, false, s0, 1, s0 + 5); } }
        SEAM(0); }
    if (IN(1)) { FRESH_IN(); phase_h0(F); SEAM(1); }
    if (IN(2)) { FRESH_IN();
      {
        pg8::SchedPlain S{(const char*)(F.ws + WS_H), (const char*)(F.ws + WS_WIN), NTOK / 256, 24, 1024, F.G, (int)blockIdx.x};
        pg8::EpiInProj E{(bf16_t*)(F.ws + WS_QR), (bf16_t*)(F.ws + WS_KR), (bf16_t*)(F.ws + WS_VR), (bf16_t*)(F.ws + WS_SG), (const float*)(F.ws + WS_COS), (const float*)(F.ws + WS_SIN)};
        { const int nU = pg8::build_units(utab, S, F.tid); pg8::gemm_phase<pg8::EpiInProj, false>(F.lds, F.tid, 1024, utab, nU, E, rowtab); } }
      SEAM(2); }
    if (IN(3)) { FRESH_IN(); if (F.wave >= 4) __builtin_amdgcn_s_setprio(1);
        phase_retention(F); __builtin_amdgcn_s_setprio(0); SEAM(3); }
    if (IN(4)) { FRESH_IN(); phase_gate(F); SEAM(4); }
    if (IN(5)) { FRESH_IN(); pg8::SchedPlain S{(const char*)(F.ws + WS_VR), (const char*)(F.ws + WS_WRO), NTOK / 256, 4, 2048, F.G, (int)blockIdx.x};
        pg8::EpiResid<true> E{F.inp(I_X), (bf16_t*)(F.ws + WS_XB), (const float*)(F.ws + WS_MOD) + 2048};
        { const int nU = pg8::build_units(utab, S, F.tid); pg8::gemm_phase<pg8::EpiResid<true>, false>(F.lds, F.tid, 2048, utab, nU, E, rowtab); } SEAM(5); }
#pragma unroll 1
    for (int layer = 0; layer < 2; ++layer) {
        const int pb = layer ? 13 : 6;
        if (IN(pb)) { FRESH_IN(); phase_route(F, layer); SEAM(pb); }
        if (IN(pb + 1)) { FRESH_IN(); moe_tables(F, layer, rbs, rowtab, 8, true);
            pg8::SchedMoe S{(const char*)(F.ws + WS_H), (const char*)(F.ws + WS_W13), rbs, 8, F.G, (int)blockIdx.x, 1, (size_t)2048 * 1024 * 2};
            pg8::EpiMoeUp E{(bf16_t*)(F.ws + WS_HID)};
            { const int nU = pg8::build_units(utab, S, F.tid); pg8::gemm_phase<pg8::EpiMoeUp, true>(F.lds, F.tid, 1024, utab, nU, E, rowtab); } SEAM(pb + 1); }
        if (IN(pb + 2)) { FRESH_IN(); moe_tables(F, layer, rbs, rowtab, 4, false);
            pg8::SchedMoe S{(const char*)(F.ws + WS_HID), (const char*)(F.ws + WS_W2), rbs, 4, F.G, (int)blockIdx.x, 0, (size_t)1024 * 1024 * 2};
            pg8::EpiBf16 E{(bf16_t*)(F.ws + WS_YB), 1024};
            { const int nU = pg8::build_units(utab, S, F.tid); pg8::gemm_phase<pg8::EpiBf16, false>(F.lds, F.tid, 1024, utab, nU, E, rowtab); } SEAM(pb + 2); }
        if (layer == 0) {
            if (IN(9)) { FRESH_IN(); phase_mid(F, rbs); SEAM(9); }
            if (IN(10)) { FRESH_IN(); pg8::SchedQKV S{(const char*)(F.ws + WS_H), (const char*)(F.ws + WS_HKV), (const char*)(F.ws + WS_WQ), (const char*)(F.ws + WS_WKV), F.G, (int)blockIdx.x};
                pg8::EpiQKV E{(bf16_t*)(F.ws + WS_Q1), (bf16_t*)(F.ws + WS_K1), (bf16_t*)(F.ws + WS_V1), F.inp(I_QNORM), F.inp(I_KNORM)};
                { const int nU = pg8::build_units(utab, S, F.tid); pg8::gemm_phase<pg8::EpiQKV, false>(F.lds, F.tid, 1024, utab, nU, E, rowtab); } SEAM(10); }
            if (IN(11)) { FRESH_IN();
                if (F.wave >= 4) __builtin_amdgcn_s_setprio(1);
                phase_attention(F); __builtin_amdgcn_s_setprio(0);
                SEAM(11); }
            if (IN(12)) { FRESH_IN(); pg8::SchedPlain S{(const char*)(F.ws + WS_AO), (const char*)(F.ws + WS_WAO), NTOK / 256, 4, 1024, F.G, (int)blockIdx.x};
                pg8::EpiResid<false> E{(const void*)(F.ws + WS_XB), (bf16_t*)(F.ws + WS_XB), (const float*)(F.ws + WS_MOD) + 16 * 6144 + 2048};
                { const int nU = pg8::build_units(utab, S, F.tid); pg8::gemm_phase<pg8::EpiResid<false>, false>(F.lds, F.tid, 1024, utab, nU, E, rowtab); } SEAM(12); }
        }
    }
    if (IN(16)) { FRESH_IN(); phase_final(F, rbs); }
#if defined(PROBE_A) || defined(PROBE_B)
    __syncthreads(); PROBE_STAMP(16);
#if defined(ATT_PROBE) || defined(RET_PROBE)
    if (blockIdx.x == 0) pr_a = __hip_atomic_load((unsigned long long*)(F.ctl + 8400), __ATOMIC_RELAXED, __HIP_MEMORY_SCOPE_AGENT);
#endif
    if (blockIdx.x == 0) { const unsigned long long qa = (pr_a + 500ull) / 1000ull, spin = (PROBE_MUL ? pr_a * PROBE_MUL : qa * 100000ull) + pr_b + PROBE_CONST, t0 = __builtin_amdgcn_s_memrealtime();
        while (__builtin_amdgcn_s_memrealtime() - t0 < spin) __builtin_amdgcn_s_sleep(8); }
#endif
#undef IN
#undef SEAM
#undef gw
#undef NGW
}

extern "C" void kernel_launch(void* const* d_in, const int* in_sizes, int n_in, void* d_out, int out_size, void* d_ws, size_t ws_size, hipStream_t stream) {
    static int grid = 0;
    if (grid == 0) {
        if (n_in != 26 || in_sizes[0] != NTOK * DM || out_size != NTOK * DM || ws_size < WS_END) {
            fprintf(stderr, "kernel_launch: unexpected shapes (n_in %d, in0 %d, out %d, ws %zu < %zu); nothing launched\n", n_in, n_in > 0 ? in_sizes[0] : -1, out_size, ws_size, (size_t)WS_END); grid = -1; return; }
        int dev = 0, cus = 0, per_cu = 0;
        if (hipGetDevice(&dev) != hipSuccess || hipDeviceGetAttribute(&cus, hipDeviceAttributeMultiprocessorCount, dev) != hipSuccess) { grid = -1; return; }
        if (hipFuncSetAttribute((const void*)yoco_fwd, hipFuncAttributeMaxDynamicSharedMemorySize, LDS_BYTES) != hipSuccess) { fprintf(stderr, "kernel_launch: hipFuncSetAttribute failed\n"); grid = -1; return; }
        if (hipOccupancyMaxActiveBlocksPerMultiprocessor(&per_cu, (const void*)yoco_fwd, NTHREADS, LDS_BYTES) != hipSuccess || per_cu < 1) { fprintf(stderr, "kernel_launch: occupancy query says %d blocks per CU\n", per_cu); (void)hipGetLastError(); grid = -1; return; }
        if (cus != 256) { fprintf(stderr, "kernel_launch: built for a 256-CU device (got %d)\n", cus); grid = -1; return; }
        grid = cus;
    }
    if (grid < 0) return;
    (void)hipMemsetAsync((char*)d_ws + WS_CTL, 0, CTL_ZERO_BYTES, stream);
    Args a{};
    for (int i = 0; i < 26; ++i) a.in[i] = (const float*)d_in[i];
    a.out = (float*)d_out; a.ws = (unsigned char*)d_ws;
    if (MK_N_LAUNCHES == 1) { a.ph_lo = 0; a.ph_hi = N_PHASES; hipLaunchKernelGGL(yoco_fwd, dim3(grid), dim3(NTHREADS), LDS_BYTES, stream, a); }
    else { for (int p = 0; p < N_PHASES; ++p) { a.ph_lo = p; a.ph_hi = p + 1; hipLaunchKernelGGL(yoco_fwd, dim3(grid), dim3(NTHREADS), LDS_BYTES, stream, a); } }
}
```

```cpp
#include <hip/hip_runtime.h>
#include <cstdio>
#include <cstdint>

#define LAS __attribute__((address_space(3)))
#define GAS __attribute__((address_space(1)))
typedef unsigned short bf16_t;
typedef short bf16x8 __attribute__((ext_vector_type(8)));
typedef short s16x4 __attribute__((ext_vector_type(4)));
typedef float f32x2 __attribute__((ext_vector_type(2)));
typedef float f32x4 __attribute__((ext_vector_type(4)));
typedef float f32x16 __attribute__((ext_vector_type(16)));
typedef unsigned u32x2 __attribute__((ext_vector_type(2)));
typedef unsigned u32x4 __attribute__((ext_vector_type(4)));

constexpr int NTOK = 32768, DM = 1024, SEQ = 2048, NBATCH = 16;
constexpr float EPS = 1e-6f;
constexpr float LOG2E = 1.4426950408889634f;
constexpr int NWAVES = 8, NTHREADS = 512;

constexpr size_t MiB = 1u << 20;
constexpr size_t WS_CTL = 0, CTL_ZERO_BYTES = 1 * MiB;
constexpr size_t WS_MOD = 1 * MiB;
constexpr size_t WS_KVMOD = WS_MOD + 786432;
constexpr size_t WS_COS = 2 * MiB, WS_SIN = 3 * MiB;
constexpr size_t WS_LIST = 4 * MiB;
constexpr size_t WS_TOKSLOT = 6 * MiB;
constexpr size_t WS_TOKW = 6 * MiB + 512 * 1024;
constexpr size_t WS_WRT = 7 * MiB;
constexpr size_t WS_WIN = 8 * MiB, WS_WRO = 20 * MiB, WS_WKV = 24 * MiB, WS_WQ = 28 * MiB, WS_WAO = 30 * MiB;
constexpr size_t WS_W13 = 32 * MiB, WS_W2 = 96 * MiB;
constexpr size_t WS_W13_L1 = 192 * MiB, WS_W2_L1 = 32 * MiB;
constexpr size_t WS_XB = 128 * MiB;
constexpr size_t WS_SG = WS_XB;
constexpr size_t WS_H = 256 * MiB;
constexpr size_t WS_QR = 320 * MiB, WS_KR = 384 * MiB, WS_VR = 448 * MiB;
constexpr size_t WS_HID = 320 * MiB, WS_YB = 456 * MiB;
constexpr size_t WS_HKV = 320 * MiB, WS_Q1 = 384 * MiB, WS_K1 = 448 * MiB, WS_V1 = 512 * MiB, WS_AO = 320 * MiB;
constexpr size_t WS_END = 592 * MiB;
constexpr int MAXROWS = 69632;

constexpr int CW_BAR = 4096, CW_CNT0 = 8192, CW_CNT1 = 8256, CW_ATTQ = 8320, CW_ADALN = 8384;
constexpr int N_CONV = 16;

constexpr int RING_BYTES = 131072, ROWTAB_OFF = 131072, ROWTAB_BYTES = 16384, MISC_OFF = ROWTAB_OFF + ROWTAB_BYTES, LDS_BYTES = MISC_OFF + 2048;

__device__ __forceinline__ unsigned f2bf(float f) { unsigned u = __builtin_bit_cast(unsigned, f); return (u + 0x7fffu + ((u >> 16) & 1u)) >> 16; }
__device__ __forceinline__ unsigned pk2(float lo, float hi) { unsigned r; asm volatile("v_cvt_pk_bf16_f32 %0, %1, %2" : "=v"(r) : "v"(lo), "v"(hi)); return r; }
__device__ __forceinline__ float bf_lo(unsigned u) { return __builtin_bit_cast(float, u << 16); }
__device__ __forceinline__ float bf_hi(unsigned u) { return __builtin_bit_cast(float, u & 0xffff0000u); }
template <int CTRL> __device__ __forceinline__ float dppf(float v) { return __builtin_bit_cast(float, __builtin_amdgcn_update_dpp(0, __builtin_bit_cast(int, v), CTRL, 0xf, 0xf, true)); }
__device__ __forceinline__ float swap16_add(float a, float b) { asm volatile("s_nop 1\n\tv_permlane16_swap_b32 %0, %1" : "+v"(a), "+v"(b)); return a + b; }
__device__ __forceinline__ float swap32_add(float a, float b) { asm volatile("s_nop 1\n\tv_permlane32_swap_b32 %0, %1" : "+v"(a), "+v"(b)); return a + b; }
__device__ __forceinline__ float sum8(float v) { v += dppf<0xB1>(v); v += dppf<0x4E>(v); v += dppf<0x141>(v); return v; }
__device__ __forceinline__ float wave_sum(float v) { v = sum8(v); v += dppf<0x140>(v); v = swap16_add(v, v); return swap32_add(v, v); }
__device__ __forceinline__ float wave_max(float v) {
#pragma unroll
    for (int o = 1; o < 64; o <<= 1) v = fmaxf(v, __shfl_xor(v, o));
    return v;
}
__device__ __forceinline__ float fast_silu(float x) { return x * __builtin_amdgcn_rcpf(1.0f + __builtin_amdgcn_exp2f(-x * LOG2E)); }
#define LDS_WAIT() asm volatile("s_waitcnt lgkmcnt(0)" ::: "memory")
#define VM_WAIT() asm volatile("s_waitcnt vmcnt(0)" ::: "memory")

#define XB_TMO      128
#define XB_XCNT(j)  (256  + 64 * (j))
#define XB_XSUB(j)  (1280 + 64 * (j))
#define XB_XGEN(j)  (2304 + 64 * (j))
#define XB_TOP      3328
#define XB_TOPGEN   3392
#define XCD_BAR_WORDS 3456
#define XB_SPIN_CAP (1u << 22)
__device__ __forceinline__ unsigned xb_ld(unsigned* p)              { return __hip_atomic_load(p, __ATOMIC_RELAXED, __HIP_MEMORY_SCOPE_AGENT); }
__device__ __forceinline__ unsigned xb_add(unsigned* p, unsigned v) { return __hip_atomic_fetch_add(p, v, __ATOMIC_RELAXED, __HIP_MEMORY_SCOPE_AGENT); }
__device__ __forceinline__ unsigned xb_xcc_id() { return (unsigned)__builtin_amdgcn_s_getreg((3 << 11) | 20) & 0xFu; }
#define XB_SPIN(cond, bar) do { unsigned _sp = 0; while (cond) { __builtin_amdgcn_s_sleep(1); \
    if ((++_sp & 255u) == 0u) { if (xb_ld(&(bar)[XB_TMO])) break; if (_sp > XB_SPIN_CAP) { atomicAdd(&(bar)[XB_TMO], 1u); break; } } } } while (0)
struct XcdBarrier { unsigned* bar; unsigned x; volatile LAS unsigned* st; };
__device__ __forceinline__ XcdBarrier xcd_barrier_post(unsigned* bar, volatile LAS unsigned* st) {
    XcdBarrier b; b.bar = bar; b.x = xb_xcc_id(); b.st = st;
    if (threadIdx.x == 0) (void)xb_add(&bar[XB_XCNT(b.x)], 1u);
    return b;
}
__device__ __forceinline__ void xcd_barrier_complete(unsigned* bar, unsigned x, unsigned& nloc, unsigned& nx) {
    const unsigned G = gridDim.x * gridDim.y * gridDim.z;
    unsigned sum, cnt, mine, sp = 0u;
    for (;;) {
        sum = 0u; cnt = 0u; mine = 0u;
#pragma unroll
        for (unsigned j = 0; j < 16; ++j) { const unsigned c = xb_ld(&bar[XB_XCNT(j)]); sum += c; cnt += (c > 0u) ? 1u : 0u; mine = (j == x) ? c : mine; }
        if (sum == G) break;
        __builtin_amdgcn_s_sleep(1);
        if ((++sp & 255u) == 0u) { if (xb_ld(&bar[XB_TMO])) break; if (sp > XB_SPIN_CAP) { atomicAdd(&bar[XB_TMO], 1u); break; } }
    }
    nloc = mine > 0u ? mine : 1u; nx = cnt > 0u ? cnt : 1u;
}
__device__ __forceinline__ void xcd_barrier(const XcdBarrier& b) {
    asm volatile("s_waitcnt vmcnt(0)" ::: "memory");
    __syncthreads();
    if (threadIdx.x == 0) {
        unsigned* bar = b.bar;
        __builtin_amdgcn_s_waitcnt(0);
        unsigned nloc = b.st[0], nx = b.st[1];
        if (nloc == 0u) { xcd_barrier_complete(bar, b.x, nloc, nx); b.st[0] = nloc; b.st[1] = nx; }
        const unsigned old = xb_add(&bar[XB_XSUB(b.x)], 1u);
        const unsigned gen = old / nloc;
        if (old + 1u == (gen + 1u) * nloc) {
            __builtin_amdgcn_fence(__ATOMIC_RELEASE, "agent");
            asm volatile("s_waitcnt vmcnt(0)" ::: "memory");
            const unsigned og = xb_add(&bar[XB_TOP], 1u);
            const unsigned tg = og / nx;
            if (og + 1u == (tg + 1u) * nx) xb_add(&bar[XB_TOPGEN], 1u);
            else XB_SPIN(xb_ld(&bar[XB_TOPGEN]) == tg, bar);
            __builtin_amdgcn_fence(__ATOMIC_ACQUIRE, "agent");
            xb_add(&bar[XB_XGEN(b.x)], 1u);
            asm volatile("s_waitcnt vmcnt(0)" ::: "memory");
        } else {
            XB_SPIN(xb_ld(&bar[XB_XGEN(b.x)]) == gen, bar);
            __builtin_amdgcn_fence(__ATOMIC_ACQUIRE, "agent");
            asm volatile("s_waitcnt vmcnt(0)" ::: "memory");
        }
    }
    __syncthreads();
}
namespace pg8 {
constexpr int BM = 256, BK = 64, HALF = 128, HTB = HALF * BK * 2, STAGE_BYTES = 8 * HTB, NXCD = 8, WGM = 8;
__host__ __device__ __forceinline__ int lds_byte(int r, int c) { const int st = (r >> 4) * 2 + (c >> 5), rr = r & 15, cc = c & 31, ob = rr * 64 + cc * 2; return st * 1024 + (ob ^ (((ob >> 9) & 1) << 5)); }
__host__ __device__ __forceinline__ void stage_rc(int b, int& R, int& C) { const int st = b / 1024, sb = b % 1024, swz = sb ^ (((sb >> 9) & 1) << 5); R = (st >> 1) * 16 + swz / 64; C = (st & 1) * 32 + (swz % 64) / 2; }
__host__ __device__ __forceinline__ int perm32(int rho) { const int n = rho >> 4, i = rho & 15; return 8 * (i >> 2) + 4 * n + (i & 3); }

struct Unit { const char* A; const char* B; int pm, pn, rows; };

__device__ __forceinline__ bool static_order(int nM, int nN, int G, int c, int i, int& pm, int& pn) {
    const int nwg = nM * nN; const long L = (long)i * G + c; if (L >= nwg) return false;
    int wgid = (int)L; { const int q = nwg / NXCD, r = nwg % NXCD, xcd = wgid % NXCD, off = wgid / NXCD; wgid = (xcd < r ? xcd * (q + 1) : r * (q + 1) + (xcd - r) * q) + off; }
    const int nig = WGM * nN, gid = wgid / nig, fm = gid * WGM, gsz = (nM - fm) < WGM ? (nM - fm) : WGM;
    pm = fm + ((wgid % nig) % gsz); pn = (wgid % nig) / gsz; return true;
}
__device__ __forceinline__ int xcd_remap(int L, int nwg) { const int q = nwg / NXCD, r = nwg % NXCD, xcd = L % NXCD, off = L / NXCD; return (xcd < r ? xcd * (q + 1) : r * (q + 1) + (xcd - r) * q) + off; }

__device__ __forceinline__ bool load_unit(const LAS int* utab, int nU, int i, Unit& u) {
    if (i >= nU) return false;
    const LAS int* p = utab + i * 8;
    const unsigned alo = __builtin_amdgcn_readfirstlane(p[0]), ahi = __builtin_amdgcn_readfirstlane(p[1]), blo = __builtin_amdgcn_readfirstlane(p[2]), bhi = __builtin_amdgcn_readfirstlane(p[3]);
    u.A = (const char*)(((unsigned long long)ahi << 32) | alo); u.B = (const char*)(((unsigned long long)bhi << 32) | blo);
    u.pm = __builtin_amdgcn_readfirstlane(p[4]); u.pn = __builtin_amdgcn_readfirstlane(p[5]); u.rows = __builtin_amdgcn_readfirstlane(p[6]); return true;
}
template <class Sched>
__device__ __forceinline__ int build_units(LAS int* utab, const Sched& S, const int tid) {
    const int i = tid;
    if (i < 16) { Unit u; const bool ok = S.next(i, u); LAS int* p = utab + i * 8;
        if (ok) { const unsigned long long a = (unsigned long long)u.A, b = (unsigned long long)u.B; p[0] = (int)(unsigned)a; p[1] = (int)(unsigned)(a >> 32); p[2] = (int)(unsigned)b; p[3] = (int)(unsigned)(b >> 32); p[4] = u.pm; p[5] = u.pn; p[6] = u.rows; }
        p[7] = ok ? 1 : 0; }
    __syncthreads();
    int n = 0;
#pragma unroll
    for (int k = 0; k < 16; ++k) n += utab[k * 8 + 7];
    return __builtin_amdgcn_readfirstlane(n);
}
template <class Epi, bool GATHER>
__device__ __forceinline__ void gemm_phase(LAS unsigned char* lds, const int tid, const int K, const LAS int* utab, const int nU, const Epi& E, const LAS int* rowtab) {
    const int wid = __builtin_amdgcn_readfirstlane(tid >> 6), lane = tid & 63, wr = wid >> 2, wc = wid & 3, fr = lane & 15, fq = lane >> 4;
    const int nt = K / BK;
    unsigned vA[2][2], vN[2][2], voffB[2]; int Rr[2], Cc[2];
#pragma unroll
    for (int i = 0; i < 2; ++i) { int R, C; stage_rc(tid * 16 + i * 8192, R, C); const int Rb = Epi::PERM ? ((R & ~31) + perm32(R & 31)) : R; Rr[i] = R; Cc[i] = C;
        voffB[i] = (unsigned)(Rb * K + C) * 2u; }
#define PG8_CALCA(u, v) do { _Pragma("unroll") for (int _h = 0; _h < 2; ++_h) _Pragma("unroll") for (int _i = 0; _i < 2; ++_i) { const int _r = _h * HALF + Rr[_i]; \
        const int _row = GATHER ? rowtab[((u).rows >> 2) + _r] : _r; (v)[_h][_i] = (unsigned)(_row * K + Cc[_i]) * 2u; } } while (0)
    const size_t kstep = (size_t)(BK * 2);
    const size_t hstep = (size_t)HALF * K * 2;
    const unsigned ldsw = (unsigned)wid * 1024u;
    const int aoff = lds_byte(wr * 64 + fr, fq * 8), boff = lds_byte(wc * 32 + fr, fq * 8);
#define PG8_SA(b, h) (((b) * 2 + (h)) * HTB)
#define PG8_SB(b, h) ((4 + (b) * 2 + (h)) * HTB)
#define PG8_STAGE(bufoff, gbase, voff) do { _Pragma("unroll") for (int _i = 0; _i < 2; ++_i) \
        __builtin_amdgcn_global_load_lds((const unsigned*)((const char*)(gbase) + (voff)[_i]), (LAS unsigned*)(lds + (bufoff) + ldsw + _i * 8192), 16, 0, 0); } while (0)
#define PG8_LDA(dst, b, h) do { _Pragma("unroll") for (int m = 0; m < 4; ++m) _Pragma("unroll") for (int k = 0; k < 2; ++k) dst[m][k] = *(const LAS bf16x8*)(lds + PG8_SA(b, h) + aoff + m * 2048 + k * 1024); } while (0)
#define PG8_LDB(dst, b, h) do { _Pragma("unroll") for (int n = 0; n < 2; ++n) _Pragma("unroll") for (int k = 0; k < 2; ++k) dst[n][k] = *(const LAS bf16x8*)(lds + PG8_SB(b, h) + boff + n * 2048 + k * 1024); } while (0)
#define PG8_MMA(ai, bj, At, Bt) do { __builtin_amdgcn_s_setprio(1); _Pragma("unroll") for (int m = 0; m < 4; ++m) _Pragma("unroll") for (int n = 0; n < 2; ++n) _Pragma("unroll") for (int k = 0; k < 2; ++k) \
        acc[ai][bj][m][n] = __builtin_amdgcn_mfma_f32_16x16x32_bf16(Bt[n][k], At[m][k], acc[ai][bj][m][n], 0, 0, 0); __builtin_amdgcn_s_setprio(0); } while (0)
#define PG8_WAIT_V(n) asm volatile("s_waitcnt vmcnt(" #n ")" ::: "memory")
#define PG8_WAIT_L(n) asm volatile("s_waitcnt lgkmcnt(" #n ")" ::: "memory")
#define PG8_BAR __builtin_amdgcn_s_barrier()
#define PG8_SCHED __builtin_amdgcn_sched_barrier(0)
    Unit cur, nxt; int ui = 0;
    if (!load_unit(utab, nU, 0, cur)) return;
    f32x4 acc[2][2][4][2];
#pragma unroll
    for (int a = 0; a < 2; ++a)
#pragma unroll
        for (int b = 0; b < 2; ++b)
#pragma unroll
            for (int m = 0; m < 4; ++m)
#pragma unroll
                for (int n = 0; n < 2; ++n) acc[a][b][m][n] = (f32x4){0.f, 0.f, 0.f, 0.f};
    bf16x8 At[4][2], B0[2][2], B1[2][2];
    const char* cA = cur.A; const char* cB = cur.B;
    PG8_CALCA(cur, vA);
    PG8_STAGE(PG8_SB(0, 0), cB, voffB); PG8_STAGE(PG8_SB(0, 1), cB + hstep, voffB); PG8_STAGE(PG8_SA(0, 0), cA, vA[0]); PG8_STAGE(PG8_SA(0, 1), cA, vA[1]);
    if (wr == 1) PG8_BAR;
    PG8_WAIT_V(2); PG8_BAR;
    PG8_STAGE(PG8_SB(1, 0), cB + kstep, voffB); PG8_STAGE(PG8_SA(1, 0), cA + kstep, vA[0]); PG8_STAGE(PG8_SB(1, 1), cB + hstep + kstep, voffB);
    PG8_WAIT_V(6); PG8_BAR;
    for (;;) {
        const bool has_next = load_unit(utab, nU, ui + 1, nxt);
        const char* nA = has_next ? nxt.A : cA; const char* nB = has_next ? nxt.B : cB;
        if (GATHER) {
            if (has_next) { PG8_CALCA(nxt, vN); }
            else {
#pragma unroll
                for (int h = 0; h < 2; ++h) { vN[h][0] = vA[h][0]; vN[h][1] = vA[h][1]; }
            }
        }
        for (int t = 0; t < nt; t += 2) {
            const bool last = (t == nt - 2);
            const char* a1 = cA + (size_t)(t + 1) * kstep;
            const char* a2 = last ? nA : cA + (size_t)(t + 2) * kstep; const char* b2 = last ? nB : cB + (size_t)(t + 2) * kstep;
            const char* a3 = a2 + kstep; const char* b3 = b2 + kstep;
            unsigned w0[2], w1[2];
#pragma unroll
            for (int i = 0; i < 2; ++i) { w0[i] = (GATHER && last) ? vN[0][i] : vA[0][i]; w1[i] = (GATHER && last) ? vN[1][i] : vA[1][i]; }
            PG8_LDB(B0, 0, 0); PG8_LDB(B1, 0, 1); PG8_SCHED; PG8_LDA(At, 0, 0); PG8_STAGE(PG8_SA(1, 1), a1, vA[1]);
            PG8_WAIT_V(8); PG8_WAIT_L(0); PG8_BAR; PG8_MMA(0, 0, At, B0); PG8_MMA(0, 1, At, B1); PG8_BAR; PG8_SCHED;
            PG8_LDA(At, 0, 1); PG8_STAGE(PG8_SB(0, 0), b2, voffB); PG8_STAGE(PG8_SB(0, 1), b2 + hstep, voffB); PG8_STAGE(PG8_SA(0, 0), a2, w0);
            PG8_WAIT_V(8); PG8_WAIT_L(0); PG8_BAR; PG8_MMA(1, 0, At, B0); PG8_MMA(1, 1, At, B1); PG8_BAR; PG8_SCHED;
            PG8_LDB(B0, 1, 0); PG8_LDB(B1, 1, 1); PG8_SCHED; PG8_LDA(At, 1, 0); PG8_STAGE(PG8_SA(0, 1), a2, w1);
            PG8_WAIT_V(8); PG8_WAIT_L(0); PG8_BAR; PG8_MMA(0, 0, At, B0); PG8_MMA(0, 1, At, B1); PG8_BAR; PG8_SCHED;
            PG8_LDA(At, 1, 1); PG8_STAGE(PG8_SB(1, 0), b3, voffB); PG8_STAGE(PG8_SB(1, 1), b3 + hstep, voffB); PG8_STAGE(PG8_SA(1, 0), a3, w0);
            PG8_WAIT_V(8); PG8_WAIT_L(0); PG8_BAR; PG8_MMA(1, 0, At, B0); PG8_MMA(1, 1, At, B1); PG8_BAR; PG8_SCHED;
        }
        if (wr == 0) PG8_BAR;
        E(acc, cur, wr, wc, fr, fq);
        if (!has_next) break;
#pragma unroll
        for (int a = 0; a < 2; ++a)
#pragma unroll
            for (int b = 0; b < 2; ++b)
#pragma unroll
                for (int m = 0; m < 4; ++m)
#pragma unroll
                    for (int n = 0; n < 2; ++n) acc[a][b][m][n] = (f32x4){0.f, 0.f, 0.f, 0.f};
        cur = nxt; cA = nA; cB = nB; ++ui;
        if (GATHER) {
#pragma unroll
            for (int h = 0; h < 2; ++h) { vA[h][0] = vN[h][0]; vA[h][1] = vN[h][1]; }
        }
        if (wr == 1) PG8_BAR;
    }
    PG8_WAIT_V(0);
    PG8_BAR;
#undef PG8_CALCA
#undef PG8_SA
#undef PG8_SB
#undef PG8_STAGE
#undef PG8_LDA
#undef PG8_LDB
#undef PG8_MMA
#undef PG8_WAIT_V
#undef PG8_WAIT_L
#undef PG8_BAR
#undef PG8_SCHED
}
}
namespace pg8 {
typedef f32x4 Acc[2][2][4][2];

struct EpiInProj {
    static constexpr bool PERM = true;
    bf16_t *Q, *Kk, *V, *G; const float *cosT, *sinT;
    __device__ __forceinline__ void operator()(const Acc& acc, const Unit& u, int wr, int wc, int fr, int fq) const {
        const int pn = u.pn, row0 = u.pm * BM + wr * 64 + fr;
        if (pn < 8) {
            const int head = pn & 3; const bool isk = pn >= 4;
            const float lg = __builtin_log2f(1.0f - __builtin_exp2f(-5.0f - (float)head));
            bf16_t* out = isk ? Kk : Q;
            const int j0 = wc * 32 + 8 * fq;
#pragma unroll
            for (int ai = 0; ai < 2; ++ai)
#pragma unroll
                for (int m = 0; m < 4; ++m) {
                    const int row = row0 + ai * HALF + m * 16, pos = row & (SEQ - 1), nn = pos & 63;
                    const float sc = isk ? __builtin_exp2f(-(float)nn * lg) * 0.0625f : __builtin_exp2f((float)nn * lg);
                    u32x4 w1, w2;
#pragma unroll
                    for (int n = 0; n < 2; ++n) {
                        const f32x4 c4 = *(const f32x4*)(cosT + pos * 128 + j0 + 4 * n), s4 = *(const f32x4*)(sinT + pos * 128 + j0 + 4 * n);
                        const f32x4 x1 = acc[ai][0][m][n], x2 = acc[ai][1][m][n];
                        const f32x4 o1 = (x1 * c4 - x2 * s4) * sc, o2 = (x2 * c4 + x1 * s4) * sc;
                        w1[2 * n] = pk2(o1[0], o1[1]); w1[2 * n + 1] = pk2(o1[2], o1[3]); w2[2 * n] = pk2(o2[0], o2[1]); w2[2 * n + 1] = pk2(o2[2], o2[3]);
                    }
                    bf16_t* p = out + (size_t)row * 1024 + head * 256 + j0;
                    *(u32x4*)p = w1; *(u32x4*)(p + 128) = w2;
                }
        } else {
            const bool isg = pn >= 16; bf16_t* out = isg ? G : V; const int col0 = (isg ? pn - 16 : pn - 8) * 256 + wc * 32 + 8 * fq;
#pragma unroll
            for (int ai = 0; ai < 2; ++ai)
#pragma unroll
                for (int m = 0; m < 4; ++m) { bf16_t* rowp = out + (size_t)(row0 + ai * HALF + m * 16) * 2048 + col0;
#pragma unroll
                    for (int bj = 0; bj < 2; ++bj) { f32x4 v0 = acc[ai][bj][m][0], v1 = acc[ai][bj][m][1];
                        if (isg) {
#pragma unroll
                            for (int e = 0; e < 4; ++e) { v0[e] = fast_silu(v0[e]); v1[e] = fast_silu(v1[e]); } }
                        u32x4 w; w.x = pk2(v0[0], v0[1]); w.y = pk2(v0[2], v0[3]); w.z = pk2(v1[0], v1[1]); w.w = pk2(v1[2], v1[3]);
                        *(u32x4*)(rowp + bj * HALF) = w; } }
        }
    }
};
struct EpiMoeUp {
    static constexpr bool PERM = true;
    bf16_t* O;
    __device__ __forceinline__ void operator()(const Acc& acc, const Unit& u, int wr, int wc, int fr, int fq) const {
        const int row0 = u.pm * BM + wr * 64 + fr, col0 = u.pn * 128 + wc * 32 + 8 * fq;
#pragma unroll
        for (int ai = 0; ai < 2; ++ai)
#pragma unroll
            for (int m = 0; m < 4; ++m) {
                f32x4 v0 = acc[ai][0][m][0], v1 = acc[ai][0][m][1]; const f32x4 g0 = acc[ai][1][m][0], g1 = acc[ai][1][m][1];
#pragma unroll
                for (int e = 0; e < 4; ++e) { v0[e] = fast_silu(v0[e]) * g0[e]; v1[e] = fast_silu(v1[e]) * g1[e]; }
                u32x4 w; w.x = pk2(v0[0], v0[1]); w.y = pk2(v0[2], v0[3]); w.z = pk2(v1[0], v1[1]); w.w = pk2(v1[2], v1[3]);
                *(u32x4*)(O + (size_t)(row0 + ai * HALF + m * 16) * 1024 + col0) = w;
            }
    }
};
struct EpiBf16 {
    static constexpr bool PERM = true;
    bf16_t* O; int ldc;
    __device__ __forceinline__ void operator()(const Acc& acc, const Unit& u, int wr, int wc, int fr, int fq) const {
        const int row0 = u.pm * BM + wr * 64 + fr, col0 = u.pn * BM + wc * 32 + 8 * fq;
#pragma unroll
        for (int ai = 0; ai < 2; ++ai)
#pragma unroll
            for (int m = 0; m < 4; ++m) { bf16_t* rowp = O + (size_t)(row0 + ai * HALF + m * 16) * ldc + col0;
#pragma unroll
                for (int bj = 0; bj < 2; ++bj) { const f32x4 v0 = acc[ai][bj][m][0], v1 = acc[ai][bj][m][1];
                    u32x4 w; w.x = pk2(v0[0], v0[1]); w.y = pk2(v0[2], v0[3]); w.z = pk2(v1[0], v1[1]); w.w = pk2(v1[2], v1[3]);
                    *(u32x4*)(rowp + bj * HALF) = w; } }
    }
};
template <bool BASE_F32>
struct EpiResid {
    static constexpr bool PERM = true;
    const void* base; bf16_t* out; const float* gate;
    __device__ __forceinline__ void operator()(const Acc& acc, const Unit& u, int wr, int wc, int fr, int fq) const {
        const int row0 = u.pm * BM + wr * 64 + fr, col0 = u.pn * BM + wc * 32 + 8 * fq;
        const float* gp = gate + (size_t)((u.pm * BM) / SEQ) * 6144 + col0;
        f32x4 gv[2][2];
#pragma unroll
        for (int bj = 0; bj < 2; ++bj)
#pragma unroll
            for (int n = 0; n < 2; ++n) gv[bj][n] = *(const f32x4*)(gp + bj * HALF + n * 4);
#pragma unroll
        for (int ai = 0; ai < 2; ++ai)
#pragma unroll
            for (int m = 0; m < 4; ++m) { const size_t off = (size_t)(row0 + ai * HALF + m * 16) * 1024 + col0;
#pragma unroll
                for (int bj = 0; bj < 2; ++bj) {
                    f32x4 b0, b1;
                    if (BASE_F32) { b0 = *(const f32x4*)((const float*)base + off + bj * HALF); b1 = *(const f32x4*)((const float*)base + off + bj * HALF + 4); }
                    else { const u32x4 q = *(const u32x4*)((const bf16_t*)base + off + bj * HALF); b0 = (f32x4){bf_lo(q.x), bf_hi(q.x), bf_lo(q.y), bf_hi(q.y)}; b1 = (f32x4){bf_lo(q.z), bf_hi(q.z), bf_lo(q.w), bf_hi(q.w)}; }
                    const f32x4 v0 = b0 + gv[bj][0] * acc[ai][bj][m][0], v1 = b1 + gv[bj][1] * acc[ai][bj][m][1];
                    u32x4 w; w.x = pk2(v0[0], v0[1]); w.y = pk2(v0[2], v0[3]); w.z = pk2(v1[0], v1[1]); w.w = pk2(v1[2], v1[3]);
                    *(u32x4*)(out + off + bj * HALF) = w; }
                if (m & 1) asm volatile("" ::: "memory"); }
    }
};
struct EpiQKV {
    static constexpr bool PERM = true;
    bf16_t *Q, *Kk, *V; const float *qn, *kn;
    __device__ __forceinline__ void operator()(const Acc& acc, const Unit& u, int wr, int wc, int fr, int fq) const {
        const int pn = u.pn, row0 = u.pm * BM + wr * 64 + fr;
        if (pn < 8) {
            const bool isk = pn >= 4; bf16_t* out = isk ? Kk : Q; const float* gn = isk ? kn : qn; const float osc = isk ? 1.0f : 0.125f * LOG2E;
            const int col0 = (pn & 3) * 256 + 64 * wc + 8 * fq;
#pragma unroll
            for (int ai = 0; ai < 2; ++ai)
#pragma unroll
                for (int m = 0; m < 4; ++m) {
                    float ss = 0.f;
#pragma unroll
                    for (int bj = 0; bj < 2; ++bj)
#pragma unroll
                        for (int n = 0; n < 2; ++n) { const f32x4 x = acc[ai][bj][m][n]; ss += (x[0] * x[0] + x[1] * x[1]) + (x[2] * x[2] + x[3] * x[3]); }
                    ss = swap16_add(ss, ss); ss = swap32_add(ss, ss);
                    const float rstd = __builtin_amdgcn_rsqf(ss * (1.0f / 64.0f) + EPS) * osc;
                    bf16_t* rowp = out + (size_t)(row0 + ai * HALF + m * 16) * 1024 + col0;
#pragma unroll
                    for (int bj = 0; bj < 2; ++bj) { const f32x4 g0 = *(const f32x4*)(gn + 32 * bj + 8 * fq), g1 = *(const f32x4*)(gn + 32 * bj + 8 * fq + 4);
                        const f32x4 v0 = acc[ai][bj][m][0] * rstd * g0, v1 = acc[ai][bj][m][1] * rstd * g1;
                        u32x4 w; w.x = pk2(v0[0], v0[1]); w.y = pk2(v0[2], v0[3]); w.z = pk2(v1[0], v1[1]); w.w = pk2(v1[2], v1[3]);
                        *(u32x4*)(rowp + 32 * bj) = w; }
                    asm volatile("" ::: "memory");
                }
        } else {
            const int col0 = (pn - 8) * 256 + wc * 32 + 8 * fq;
#pragma unroll
            for (int ai = 0; ai < 2; ++ai)
#pragma unroll
                for (int m = 0; m < 4; ++m) { bf16_t* rowp = V + (size_t)(row0 + ai * HALF + m * 16) * 1024 + col0;
#pragma unroll
                    for (int bj = 0; bj < 2; ++bj) { const f32x4 v0 = acc[ai][bj][m][0], v1 = acc[ai][bj][m][1];
                        u32x4 w; w.x = pk2(v0[0], v0[1]); w.y = pk2(v0[2], v0[3]); w.z = pk2(v1[0], v1[1]); w.w = pk2(v1[2], v1[3]);
                        *(u32x4*)(rowp + bj * HALF) = w; } }
        }
    }
};

struct SchedPlain {
    const char *A, *B; int nM, nN, K, G, c;
    __device__ __forceinline__ bool next(int i, Unit& u) const { int pm, pn; if (!static_order(nM, nN, G, c, i, pm, pn)) return false;
        u.pm = pm; u.pn = pn; u.rows = 0; u.A = A + (size_t)pm * BM * K * 2; u.B = B + (size_t)pn * BM * K * 2; return true; }
};
struct SchedQKV {
    const char *Aq, *Akv, *Bq, *Bkv; int G, c;
    __device__ __forceinline__ bool next(int i, Unit& u) const { int pm, pn; if (!static_order(NTOK / BM, 12, G, c, i, pm, pn)) return false;
        u.pm = pm; u.pn = pn; u.rows = 0; const size_t ts = (size_t)BM * 1024 * 2;
        u.A = (pn < 4 ? Aq : Akv) + (size_t)pm * ts; u.B = pn < 4 ? Bq + (size_t)pn * ts : Bkv + (size_t)(pn - 4) * ts; return true; }
};
struct SchedMoe {
    const char *A, *B; const LAS int* rbs; int NT, G, c, gather; size_t estride;
    __device__ __forceinline__ bool next(int i, Unit& u) const {
        const int nrb = rbs[16], nwg = nrb * NT; const long L = (long)i * G + c; if (L >= nwg) return false;
        const int wg = xcd_remap((int)L, nwg), rb = wg / NT, pn = wg % NT;
        int e = 0;
#pragma unroll
        for (int k = 1; k < 16; ++k) e += (rb >= rbs[k]) ? 1 : 0;
        u.pm = rb; u.pn = pn; u.rows = i * 1024;
        u.A = gather ? A : A + (size_t)rb * BM * 1024 * 2; u.B = B + (size_t)e * estride + (size_t)pn * BM * 1024 * 2; return true; }
};
}
typedef __attribute__((address_space(4))) const unsigned long long* kargp_t;
struct Frame {
    LAS unsigned char* lds;
    unsigned* ctl;
    int tid, lane, wave, vcu, G;
    unsigned char* ws;
    kargp_t kin;
    __device__ __forceinline__ const float* inp(int i) const { return (const float*)(const GAS float*)kin[i]; }
    float* out;
};
enum { I_X = 0, I_C, I_ADAW, I_ADAB, I_NMIX, I_NFFN, I_RWIN, I_RGN, I_RWOUT, I_KVADAW, I_KVADAB, I_KVNORM, I_KVW, I_KNORM, I_WQ, I_QNORM, I_LAM, I_SUBLN, I_WOUT,
       I_WG, I_BG, I_WE, I_BE, I_W1, I_W3, I_W2 };

__device__ __forceinline__ int dest_row(int n, int mode) {
    if (mode == 1) { const int c = n & 255; return (n & ~255) + 128 * ((c >> 5) & 1) + 32 * (c >> 6) + (c & 31); }
    if (mode == 2) return (n >> 7) * 256 + (n & 127);
    if (mode == 3) return (n >> 7) * 256 + 128 + (n & 127);
    return n;
}
struct TItem { const float* W; bf16_t* WT; int K, N, mode, item; };
__device__ __forceinline__ void titem_load(const TItem& it, f32x4 (&v)[16], int lane) {
    const int nblk = it.N / 64, kb = it.item / nblk, nb = it.item % nblk, k0 = 64 * kb, n0 = 64 * nb;
    const float* p = it.W + (size_t)(k0 + (lane >> 4)) * it.N + n0 + 4 * (lane & 15);
#pragma unroll
    for (int i = 0; i < 16; ++i) v[i] = *(const f32x4*)(p + (size_t)(4 * i) * it.N);
}
__device__ __forceinline__ void titem_store(const TItem& it, const f32x4 (&v)[16], LAS float* scr, int lane) {
    const int nblk = it.N / 64, kb = it.item / nblk, nb = it.item % nblk, k0 = 64 * kb, n0 = 64 * nb;
#pragma unroll
    for (int i = 0; i < 16; ++i) *(LAS f32x4*)(scr + (4 * i + (lane >> 4)) * 68 + 4 * (lane & 15)) = v[i];
    LDS_WAIT(); asm volatile("" ::: "memory");
    const int d = dest_row(n0 + (lane & 32), it.mode) + (lane & 31);
    bf16_t* op = it.WT + (size_t)d * it.K + k0;
#pragma unroll 2
    for (int c = 0; c < 8; ++c) { const LAS float* s = scr + (8 * c) * 68 + lane;
        u32x4 o; o.x = pk2(s[0 * 68], s[1 * 68]); o.y = pk2(s[2 * 68], s[3 * 68]); o.z = pk2(s[4 * 68], s[5 * 68]); o.w = pk2(s[6 * 68], s[7 * 68]);
        *(u32x4*)(op + 8 * c) = o; }
    LDS_WAIT(); asm volatile("" ::: "memory");
}
__device__ __forceinline__ void thalf_load(const TItem& it, int half, f32x4 (&v)[8], int lane) {
    const int nblk = it.N / 64, kb = it.item / nblk, nb = it.item % nblk, k0 = 64 * kb + 32 * half, n0 = 64 * nb;
    const float* p = it.W + (size_t)(k0 + (lane >> 4)) * it.N + n0 + 4 * (lane & 15);
#pragma unroll
    for (int i = 0; i < 8; ++i) v[i] = *(const f32x4*)(p + (size_t)(4 * i) * it.N);
}
__device__ __forceinline__ void thalf_store(const TItem& it, int half, const f32x4 (&v)[8], LAS float* scr, int lane) {
    const int nblk = it.N / 64, kb = it.item / nblk, nb = it.item % nblk, k0 = 64 * kb + 32 * half, n0 = 64 * nb;
#pragma unroll
    for (int i = 0; i < 8; ++i) *(LAS f32x4*)(scr + (4 * i + (lane >> 4)) * 68 + 4 * (lane & 15)) = v[i];
    LDS_WAIT(); asm volatile("" ::: "memory");
    const int d = dest_row(n0 + (lane & 32), it.mode) + (lane & 31);
    bf16_t* op = it.WT + (size_t)d * it.K + k0;
#pragma unroll 2
    for (int c = 0; c < 4; ++c) { const LAS float* s = scr + (8 * c) * 68 + lane;
        u32x4 o; o.x = pk2(s[0 * 68], s[1 * 68]); o.y = pk2(s[2 * 68], s[3 * 68]); o.z = pk2(s[4 * 68], s[5 * 68]); o.w = pk2(s[6 * 68], s[7 * 68]);
        *(u32x4*)(op + 8 * c) = o; }
    LDS_WAIT(); asm volatile("" ::: "memory");
}
__device__ __forceinline__ TItem moe_item(Frame& F, int layer, int it) {
    constexpr int IPM = 256;
    int e, which, item;
    if (layer == 0) { e = it / (3 * IPM); const int r = it % (3 * IPM); which = r / IPM; item = r % IPM; }
    else if (it < 32 * IPM) { e = it / (2 * IPM); const int r = it % (2 * IPM); which = r / IPM; item = r % IPM; }
    else { const int j = it - 32 * IPM; e = j / IPM; which = 2; item = j % IPM; }
    const size_t wo = ((size_t)layer * 16 + e) * 1048576;
    bf16_t* w13 = (bf16_t*)(F.ws + (layer ? WS_W13_L1 : WS_W13)); bf16_t* w2 = (bf16_t*)(F.ws + (layer ? WS_W2_L1 : WS_W2));
    TItem t; t.K = 1024; t.N = 1024; t.item = item;
    if (which == 0) { t.W = F.inp(I_W1) + wo; t.WT = w13 + (size_t)e * 2097152; t.mode = 2; }
    else if (which == 1) { t.W = F.inp(I_W3) + wo; t.WT = w13 + (size_t)e * 2097152; t.mode = 3; }
    else { t.W = F.inp(I_W2) + wo; t.WT = w2 + (size_t)e * 1048576; t.mode = 0; }
    return t;
}
__device__ __forceinline__ TItem dense_item(Frame& F, int it) {
    constexpr int I_IN = 16 * 96, I_RO = 32 * 16, I_KV = 16 * 32, I_Q = 256;
    TItem t; int r = it;
    if (r < I_IN) { t.W = F.inp(I_RWIN); t.WT = (bf16_t*)(F.ws + WS_WIN); t.K = 1024; t.N = 6144; t.mode = 0; t.item = r; return t; } r -= I_IN;
    if (r < I_RO) { t.W = F.inp(I_RWOUT); t.WT = (bf16_t*)(F.ws + WS_WRO); t.K = 2048; t.N = 1024; t.mode = 0; t.item = r; return t; } r -= I_RO;
    if (r < I_KV) { t.W = F.inp(I_KVW); t.WT = (bf16_t*)(F.ws + WS_WKV); t.K = 1024; t.N = 2048; t.mode = (r % 32) < 16 ? 1 : 0; t.item = r; return t; } r -= I_KV;
    if (r < I_Q) { t.W = F.inp(I_WQ); t.WT = (bf16_t*)(F.ws + WS_WQ); t.K = 1024; t.N = 1024; t.mode = 1; t.item = r; return t; } r -= I_Q;
    t.W = F.inp(I_WOUT); t.WT = (bf16_t*)(F.ws + WS_WAO); t.K = 1024; t.N = 1024; t.mode = 0; t.item = r; return t;
}
constexpr int N_DENSE_ITEMS = 16 * 96 + 32 * 16 + 16 * 32 + 256 + 256, N_MOE_ITEMS = 16 * 3 * 256;
__device__ __forceinline__ void convert_weights(Frame& F, int layer, bool with_dense, bool with_moe, int gw, int NGW, int end = 1 << 30) {
    LAS float* scr = (LAS float*)(F.lds + F.wave * 17408);
    const int nd = with_dense ? N_DENSE_ITEMS : 0, total0 = nd + (with_moe ? N_MOE_ITEMS : 0), total = end < total0 ? end : total0;
    int it = gw; if (it >= total) return;
    TItem cur = it < nd ? dense_item(F, it) : moe_item(F, layer, it - nd);
    f32x4 va[16], vb[16];
    titem_load(cur, va, F.lane);
    for (;;) {
        const int itn = it + NGW; const bool more = itn < total;
        TItem nxt = cur;
        if (more) { nxt = itn < nd ? dense_item(F, itn) : moe_item(F, layer, itn - nd); titem_load(nxt, vb, F.lane); }
        titem_store(cur, va, scr, F.lane);
        if (!more) break;
        const int itn2 = itn + NGW; const bool more2 = itn2 < total;
        if (more2) { cur = itn2 < nd ? dense_item(F, itn2) : moe_item(F, layer, itn2 - nd); titem_load(cur, va, F.lane); }
        titem_store(nxt, vb, scr, F.lane);
        if (!more2) break;
        it = itn2;
    }
}
constexpr int TAILQ7 = 3, TAILQ8 = 3;
static_assert(TAILQ7 * NWAVES * 255 <= 8192, "the MoE-up tail may only convert w1 / w3 items");
__device__ __forceinline__ int tail_idle(int nrb, int NT) { const int rem = (nrb * NT) & 255; return rem ? 256 - rem : 0; }
__device__ __forceinline__ int tail_base(int nrb, int which) {
    int n = 0; if (which >= 1) n += tail_idle(nrb, 8) * NWAVES * TAILQ7; if (which >= 2) n += tail_idle(nrb, 4) * NWAVES * TAILQ8; return n < N_MOE_ITEMS ? n : N_MOE_ITEMS; }
__device__ __forceinline__ void tail_convert(Frame& F, const LAS int* rbs, int NT, int which) {
    const int nrb = rbs[16], rem = (nrb * NT) & 255; if (rem == 0 || (int)blockIdx.x < rem) return;
    const int Q = which ? TAILQ8 : TAILQ7, s0 = tail_base(nrb, which) + (((int)blockIdx.x - rem) * NWAVES + F.wave) * Q;
    convert_weights(F, 1, false, true, s0, 1, s0 + Q);
}
__device__ __forceinline__ void adaln_phase(Frame& F) {
    LAS float* cs = (LAS float*)F.lds;
    LAS float* red = (LAS float*)(F.lds + 65536);
    constexpr int NTASK = (2 * 6144 + 2048) / 64;
    if ((int)blockIdx.x >= NTASK) return;
    { const float* cp = F.inp(I_C) + F.tid; float cvv[32];
#pragma unroll
      for (int i = 0; i < 32; ++i) cvv[i] = cp[i * NTHREADS];
#pragma unroll
      for (int i = 0; i < 32; ++i) cs[i * NTHREADS + F.tid] = cvv[i] / (1.0f + __expf(-cvv[i])); }
    __syncthreads();
    for (int task = blockIdx.x; task < NTASK; task += F.G) {
        const int gc = task * 64; const float* W; const float* bias; float* outp; int N, c0, ostride;
        if (gc < 6144) { W = F.inp(I_ADAW); bias = F.inp(I_ADAB); N = 6144; c0 = gc; outp = (float*)(F.ws + WS_MOD); ostride = 6144; }
        else if (gc < 12288) { W = F.inp(I_ADAW) + (size_t)1024 * 6144; bias = F.inp(I_ADAB) + 6144; N = 6144; c0 = gc - 6144; outp = (float*)(F.ws + WS_MOD) + 16 * 6144; ostride = 6144; }
        else { W = F.inp(I_KVADAW); bias = F.inp(I_KVADAB); N = 2048; c0 = gc - 12288; outp = (float*)(F.ws + WS_KVMOD); ostride = 2048; }
        float acc[16];
#pragma unroll
        for (int b = 0; b < 16; ++b) acc[b] = 0.f;
        const int k0 = F.wave * 128;
        {
            const int k = k0; float w[128];
            const GAS float* wp = (const GAS float*)(W + (size_t)k * N + c0 + F.lane);
#pragma unroll
            for (int j = 0; j < 128; ++j) { w[j] = *wp; wp += N; asm volatile("" : "+v"(wp)); }
#pragma unroll
            for (int j4 = 0; j4 < 32; ++j4) { asm volatile("" ::: "memory");
#pragma unroll
                for (int b = 0; b < 16; ++b) { const f32x4 c4 = *(const LAS f32x4*)(cs + b * 1024 + k + 4 * j4); acc[b] += c4[0] * w[4 * j4] + c4[1] * w[4 * j4 + 1] + c4[2] * w[4 * j4 + 2] + c4[3] * w[4 * j4 + 3]; } }
        }
#pragma unroll
        for (int b = 0; b < 16; ++b) red[(F.wave * 16 + b) * 64 + F.lane] = acc[b];
        __syncthreads();
        for (int o = F.tid; o < 1024; o += NTHREADS) { const int b = o >> 6, col = o & 63; float s = 0.f;
#pragma unroll
            for (int w = 0; w < 8; ++w) s += red[(w * 16 + b) * 64 + col];
            outp[(size_t)b * ostride + c0 + col] = s + bias[c0 + col]; }
        __syncthreads();
    }
}
__device__ __forceinline__ void rope_table(Frame& F, int gt, int NGT) {
    float* ct = (float*)(F.ws + WS_COS); float* st = (float*)(F.ws + WS_SIN);
    for (int i = gt; i < 2048 * 128; i += NGT) { const int pos = i >> 7, j = i & 127;
        const float inv = 1.0f / powf(10000.0f, (float)j * (1.0f / 128.0f)); const float ang = (float)pos * inv;
        const float kq = rintf(ang * 0.15915494309189535f); float rr = fmaf(-kq, 6.28318548202514648f, ang); rr = fmaf(-kq, -1.74845553e-07f, rr);
        const float rev = rr * 0.15915494309189535f; ct[i] = __builtin_amdgcn_cosf(rev); st[i] = __builtin_amdgcn_sinf(rev); }
    float* wrt = (float*)(F.ws + WS_WRT);
    for (int i = gt; i < 2 * 20 * 1024; i += NGT) { const int l = i / 20480, r = i % 20480, q = r >> 10, k = r & 1023;
        wrt[i] = q < 4 ? F.inp(I_WG)[(size_t)l * 4096 + k * 4 + q] : F.inp(I_WE)[(size_t)l * 16384 + k * 16 + (q - 4)]; }
}

struct Row16 { f32x4 v[4]; };
__device__ __forceinline__ void row_load(Row16& r, const float* p, int lane) {
#pragma unroll
    for (int j = 0; j < 4; ++j) r.v[j] = ((const f32x4*)p)[64 * j + lane];
}
__device__ __forceinline__ void row_load_bf16(Row16& r, const bf16_t* p, int lane) {
#pragma unroll
    for (int j = 0; j < 4; ++j) { const u32x2 q = ((const u32x2*)p)[64 * j + lane]; r.v[j] = (f32x4){bf_lo(q.x), bf_hi(q.x), bf_lo(q.y), bf_hi(q.y)}; }
}
__device__ __forceinline__ void row_store_bf16(const Row16& r, bf16_t* p, int lane) {
#pragma unroll
    for (int j = 0; j < 4; ++j) { u32x2 w; w.x = pk2(r.v[j][0], r.v[j][1]); w.y = pk2(r.v[j][2], r.v[j][3]); ((u32x2*)p)[64 * j + lane] = w; }
}
__device__ __forceinline__ float row_sumsq(const Row16& r) { float s = 0.f;
#pragma unroll
    for (int j = 0; j < 4; ++j) s += (r.v[j][0] * r.v[j][0] + r.v[j][1] * r.v[j][1]) + (r.v[j][2] * r.v[j][2] + r.v[j][3] * r.v[j][3]);
    return wave_sum(s); }
__device__ __forceinline__ void row_norm_mod_store(const Row16& r, float rstd, const float* g, const float* shift, const float* scale, bf16_t* outp, int lane) {
#pragma unroll
    for (int j = 0; j < 4; ++j) { const int c = 64 * j + lane; const f32x4 gg = ((const f32x4*)g)[c], sh = ((const f32x4*)shift)[c], sc = ((const f32x4*)scale)[c];
        const f32x4 h = (r.v[j] * rstd * gg) * (sc + 1.0f) + sh; u32x2 w; w.x = pk2(h[0], h[1]); w.y = pk2(h[2], h[3]); ((u32x2*)outp)[c] = w; }
}
struct ModVec { f32x4 A[4], B[4]; };
__device__ __forceinline__ void modvec_load(ModVec& m, const float* g, const float* shift, const float* scale, int lane) {
#pragma unroll
    for (int j = 0; j < 4; ++j) { const int c = 64 * j + lane; m.A[j] = ((const f32x4*)g)[c] * (((const f32x4*)scale)[c] + 1.0f); m.B[j] = ((const f32x4*)shift)[c]; }
}
__device__ __forceinline__ void row_mod_store(const Row16& r, float rstd, const ModVec& m, bf16_t* outp, int lane) {
#pragma unroll
    for (int j = 0; j < 4; ++j) { const f32x4 h = r.v[j] * rstd * m.A[j] + m.B[j]; u32x2 w; w.x = pk2(h[0], h[1]); w.y = pk2(h[2], h[3]); ((u32x2*)outp)[64 * j + lane] = w; }
}
__device__ __forceinline__ void phase_h0(Frame& F) {
    const int gw = F.vcu * NWAVES + F.wave, NGW = F.G * NWAVES; const float* mod = (const float*)(F.ws + WS_MOD); bf16_t* H = (bf16_t*)(F.ws + WS_H);
    for (int t0 = gw * 16; t0 < NTOK; t0 += NGW * 16) { const int b = t0 / SEQ; ModVec m; modvec_load(m, F.inp(I_NMIX), mod + b * 6144, mod + b * 6144 + 1024, F.lane);
#pragma unroll 1
        for (int i = 0; i < 16; i += 4) { Row16 r[4];
#pragma unroll
            for (int u = 0; u < 4; ++u) row_load(r[u], F.inp(I_X) + (size_t)(t0 + i + u) * 1024, F.lane);
#pragma unroll
            for (int u = 0; u < 4; ++u) { const float rstd = __builtin_amdgcn_rsqf(row_sumsq(r[u]) * (1.0f / 1024.0f) + EPS); row_mod_store(r[u], rstd, m, H + (size_t)(t0 + i + u) * 1024, F.lane); } } }
}
__device__ __forceinline__ void phase_gate(Frame& F) {
    const int gw = F.vcu * NWAVES + F.wave, NGW = F.G * NWAVES; bf16_t* O = (bf16_t*)(F.ws + WS_VR); const bf16_t* SG = (const bf16_t*)(F.ws + WS_SG); const float* gn = F.inp(I_RGN);
    for (int t0 = gw; t0 < NTOK; t0 += 2 * NGW) {
        u32x4 o2[2][4], g2[2][4];
#pragma unroll
        for (int u = 0; u < 2; ++u)
#pragma unroll
            for (int j = 0; j < 4; ++j) { const size_t t = t0 + u * NGW; o2[u][j] = ((const u32x4*)(O + t * 2048))[64 * j + F.lane]; g2[u][j] = ((const u32x4*)(SG + t * 2048))[64 * j + F.lane]; }
#pragma unroll
        for (int u = 0; u < 2; ++u) { const size_t t = t0 + u * NGW;
#pragma unroll
        for (int j = 0; j < 4; ++j) {
            float ov[8]; float ss = 0.f;
#pragma unroll
            for (int e = 0; e < 4; ++e) { ov[2 * e] = bf_lo(o2[u][j][e]); ov[2 * e + 1] = bf_hi(o2[u][j][e]); ss += ov[2 * e] * ov[2 * e] + ov[2 * e + 1] * ov[2 * e + 1]; }
            const float rstd = __builtin_amdgcn_rsqf(wave_sum(ss) * (1.0f / 512.0f) + EPS);
            const f32x4 g0 = ((const f32x4*)gn)[2 * (64 * j + F.lane)], g1 = ((const f32x4*)gn)[2 * (64 * j + F.lane) + 1];
            u32x4 w;
#pragma unroll
            for (int e = 0; e < 4; ++e) { const float ga = e < 2 ? g0[2 * e] : g1[2 * e - 4], gb = e < 2 ? g0[2 * e + 1] : g1[2 * e - 3];
                w[e] = pk2(bf_lo(g2[u][j][e]) * (ov[2 * e] * rstd * ga), bf_hi(g2[u][j][e]) * (ov[2 * e + 1] * rstd * gb)); }
            ((u32x4*)(O + t * 2048))[64 * j + F.lane] = w;
        } }
    }
}
__device__ __forceinline__ void phase_route(Frame& F, int layer) {
    const int gwl = blockIdx.x * NWAVES + F.wave;
    const float* mod = (const float*)(F.ws + WS_MOD) + (size_t)layer * 16 * 6144; const bf16_t* XB = (const bf16_t*)(F.ws + WS_XB); bf16_t* H = (bf16_t*)(F.ws + WS_H);
    const float* nf = F.inp(I_NFFN) + layer * 1024;
    const float* bg = F.inp(I_BG) + layer * 4; const float* be = F.inp(I_BE) + layer * 16;
    unsigned* gcnt = F.ctl + (layer ? CW_CNT1 : CW_CNT0);
    int* list = (int*)(F.ws + WS_LIST); int* tokslot = (int*)(F.ws + WS_TOKSLOT); float* tokw = (float*)(F.ws + WS_TOKW);
    LAS float* WrT = (LAS float*)(F.lds);
    LAS float* lgs = (LAS float*)(F.lds + 81920) + F.wave * 96;
    LAS int* wcnt = (LAS int*)(F.lds + 81920 + 4096);
    LAS int* wbase = (LAS int*)(F.lds + 81920 + 4096 + 1024);
    { const f32x4* src = (const f32x4*)((const float*)(F.ws + WS_WRT) + (size_t)layer * 20480);
#pragma unroll
      for (int i = 0; i < 10; ++i) ((LAS f32x4*)WrT)[i * NTHREADS + F.tid] = src[i * NTHREADS + F.tid]; }
    __syncthreads();
    const int lane = F.lane; const bool b5 = lane & 32, b4 = lane & 16, b3 = lane & 8;
    const int NGWL = F.G * NWAVES;
    for (int base = 0; base < NTOK; base += NGWL * 16) {
        const int t0 = base + gwl * 16; const bool active = t0 < NTOK;
        int my_e0 = 0, my_e1 = 0; float my_w0 = 0.f, my_w1 = 0.f;
        if (active) {
            const int b = t0 / SEQ; ModVec mv; modvec_load(mv, nf, mod + b * 6144 + 3072, mod + b * 6144 + 4096, lane);
            u32x2 nx[4][4];
#pragma unroll
            for (int i = 0; i < 4; ++i)
#pragma unroll
                for (int j = 0; j < 4; ++j) nx[i][j] = ((const u32x2*)(XB + (size_t)(t0 + i) * 1024))[64 * j + lane];
#pragma unroll 1
            for (int grp = 0; grp < 4; ++grp) {
                const int tg = t0 + 4 * grp;
                Row16 r[4];
#pragma unroll
                for (int i = 0; i < 4; ++i)
#pragma unroll
                    for (int j = 0; j < 4; ++j) { const u32x2 q = nx[i][j]; r[i].v[j] = (f32x4){bf_lo(q.x), bf_hi(q.x), bf_lo(q.y), bf_hi(q.y)}; }
                if (grp < 3) {
#pragma unroll
                    for (int i = 0; i < 4; ++i)
#pragma unroll
                        for (int j = 0; j < 4; ++j) nx[i][j] = ((const u32x2*)(XB + (size_t)(tg + 4 + i) * 1024))[64 * j + lane];
                }
                float rstd[4];
#pragma unroll
                for (int i = 0; i < 4; ++i) rstd[i] = __builtin_amdgcn_rsqf(row_sumsq(r[i]) * (1.0f / 1024.0f) + EPS);
#pragma unroll
                for (int j = 0; j < 4; ++j) {
#pragma unroll
                    for (int i = 0; i < 4; ++i) { const f32x4 h = r[i].v[j] * rstd[i] * mv.A[j] + mv.B[j]; r[i].v[j] = h; u32x2 w; w.x = pk2(h[0], h[1]); w.y = pk2(h[2], h[3]); ((u32x2*)(H + (size_t)(tg + i) * 1024))[64 * j + lane] = w; } }
#pragma unroll
                for (int hq = 0; hq < 2; ++hq) {
                    float V[40];
#pragma unroll
                    for (int q = 0; q < 10; ++q) {
                        float a0 = 0.f, a1 = 0.f, a2 = 0.f, a3 = 0.f;
#pragma unroll
                        for (int j = 0; j < 4; ++j) { const f32x4 w4 = *(const LAS f32x4*)(WrT + (hq * 10 + q) * 1024 + 4 * (64 * j + lane));
                            a0 += r[0].v[j][0] * w4[0] + r[0].v[j][1] * w4[1] + r[0].v[j][2] * w4[2] + r[0].v[j][3] * w4[3];
                            a1 += r[1].v[j][0] * w4[0] + r[1].v[j][1] * w4[1] + r[1].v[j][2] * w4[2] + r[1].v[j][3] * w4[3];
                            a2 += r[2].v[j][0] * w4[0] + r[2].v[j][1] * w4[1] + r[2].v[j][2] * w4[2] + r[2].v[j][3] * w4[3];
                            a3 += r[3].v[j][0] * w4[0] + r[3].v[j][1] * w4[1] + r[3].v[j][2] * w4[2] + r[3].v[j][3] * w4[3]; }
                        V[q] = a0; V[10 + q] = a1; V[20 + q] = a2; V[30 + q] = a3;
                    }
                    float W20[20], W10[10];
#pragma unroll
                    for (int i = 0; i < 20; ++i) W20[i] = swap32_add(V[i], V[i + 20]);
#pragma unroll
                    for (int i = 0; i < 10; ++i) W10[i] = swap16_add(W20[i], W20[i + 10]);
                    const int vb = (b3 ? 5 : 0) + (b4 ? 10 : 0) + (b5 ? 20 : 0);
#pragma unroll
                    for (int i = 0; i < 5; ++i) { const float keep = b3 ? W10[i + 5] : W10[i], send = b3 ? W10[i] : W10[i + 5]; const float v = sum8(keep + dppf<0x128>(send));
                        const int vi = vb + i;
                        if ((lane & 7) == 0) lgs[(vi / 10) * 20 + hq * 10 + (vi % 10)] = v; }
                    asm volatile("" ::: "memory");
                }
                LDS_WAIT(); asm volatile("" ::: "memory");
                if ((lane >> 2) == grp) {
                    const LAS float* lp = lgs + (lane & 3) * 20;
                    float gl[4]; int gi = 0;
#pragma unroll
                    for (int q = 0; q < 4; ++q) gl[q] = lp[q] + bg[q];
                    float gm = gl[0];
#pragma unroll
                    for (int q = 1; q < 4; ++q) if (gl[q] > gm) { gm = gl[q]; gi = q; }
                    float gs = 0.f;
#pragma unroll
                    for (int q = 0; q < 4; ++q) gs += __expf(gl[q] - gm);
                    const float ggate = 1.0f / gs;
                    float el[4];
#pragma unroll
                    for (int q = 0; q < 4; ++q) el[q] = lp[4 + 4 * gi + q] + be[4 * gi + q];
                    int i0 = 0; float m0 = el[0];
#pragma unroll
                    for (int q = 1; q < 4; ++q) if (el[q] > m0) { m0 = el[q]; i0 = q; }
                    int i1 = 0; float m1 = -INFINITY;
#pragma unroll
                    for (int q = 0; q < 4; ++q) if (q != i0 && el[q] > m1) { m1 = el[q]; i1 = q; }
                    const float p1 = __expf(m1 - m0);
                    my_e0 = gi * 4 + i0; my_e1 = gi * 4 + i1; my_w0 = ggate / (1.0f + p1); my_w1 = ggate * p1 / (1.0f + p1);
                }
                LDS_WAIT(); asm volatile("" ::: "memory");
            }
        }
        const bool have = active && lane < 16; int rank0 = 0, rank1 = 0, mycount = 0;
        const unsigned long long lt = (1ull << lane) - 1ull;
#pragma unroll 1
        for (int e = 0; e < 16; ++e) {
            const unsigned long long b0 = __ballot(have && my_e0 == e), b1 = __ballot(have && my_e1 == e);
            if (my_e0 == e) rank0 = __popcll(b0 & lt);
            if (my_e1 == e) rank1 = __popcll(b0) + __popcll(b1 & lt);
            if (lane == e) mycount = __popcll(b0) + __popcll(b1);
        }
        if (lane < 16) wcnt[F.wave * 16 + lane] = mycount;
        __syncthreads();
        if (F.tid < 16) { int tot = 0;
#pragma unroll
            for (int w = 0; w < 8; ++w) { const int c = wcnt[w * 16 + F.tid]; wbase[w * 16 + F.tid] = tot; tot += c; }
            const int gb = tot ? (int)atomicAdd(gcnt + F.tid, (unsigned)tot) : 0;
#pragma unroll
            for (int w = 0; w < 8; ++w) wbase[w * 16 + F.tid] += gb; }
        __syncthreads();
        if (have) { const int t = t0 + lane; const int p0 = wbase[F.wave * 16 + my_e0] + rank0, p1 = wbase[F.wave * 16 + my_e1] + rank1;
            list[my_e0 * 32768 + p0] = t; list[my_e1 * 32768 + p1] = t;
            tokslot[2 * t] = (my_e0 << 16) | p0; tokslot[2 * t + 1] = (my_e1 << 16) | p1; tokw[2 * t] = my_w0; tokw[2 * t + 1] = my_w1; }
        __syncthreads();
    }
}
__device__ __forceinline__ void load_rbs(Frame& F, const unsigned* gcnt, LAS int* rbs, LAS int* cnts) {
    if (F.tid < 64) {
        const int e = F.tid & 15; const int c = (int)__hip_atomic_load(gcnt + e, __ATOMIC_RELAXED, __HIP_MEMORY_SCOPE_AGENT); const int nb = (c + 255) >> 8;
        int acc = 0, tot = 0;
#pragma unroll
        for (int k = 0; k < 16; ++k) { const int v = __builtin_amdgcn_readlane(nb, k); acc += (k < e) ? v : 0; tot += v; }
        if (F.tid < 16) { rbs[e] = acc; if (cnts) cnts[e] = c; if (e == 0) rbs[16] = tot; }
    }
    __syncthreads();
}
__device__ __forceinline__ void moe_tables(Frame& F, int layer, LAS int* rbs, LAS int* rowtab, int NT, bool gather) {
    const unsigned* gcnt = F.ctl + (layer ? CW_CNT1 : CW_CNT0);
    LAS int* cnts = rbs + 32;
    load_rbs(F, gcnt, rbs, cnts);
    if (gather) {
        const int* list = (const int*)(F.ws + WS_LIST); const int nrb = rbs[16], nwg = nrb * NT;
        int vals[8]; bool ok[8];
#pragma unroll
        for (int p = 0; p < 8; ++p) { const int i = 2 * p + (F.tid >> 8); const long L = (long)i * F.G + blockIdx.x; ok[p] = L < nwg; vals[p] = 0;
            if (ok[p]) { const int wg = pg8::xcd_remap((int)L, nwg), rb = wg / NT; int e = 0;
#pragma unroll
                for (int k = 1; k < 16; ++k) e += (rb >= rbs[k]) ? 1 : 0;
                const int lr0 = (rb - rbs[e]) * 256, cnt = cnts[e]; int r = lr0 + (F.tid & 255); r = r < cnt ? r : cnt - 1; vals[p] = list[e * 32768 + r]; } }
#pragma unroll
        for (int p = 0; p < 8; ++p) if (ok[p]) rowtab[(2 * p + (F.tid >> 8)) * 256 + (F.tid & 255)] = vals[p];
        __syncthreads();
    }
}
struct CombRow { Row16 x; u32x2 y0[4], y1[4]; float w0, w1; };
struct CombSlots { int r0, r1; float w0, w1; };
__device__ __forceinline__ void comb_slots(Frame& F, int t0, const LAS int* rbs, CombSlots& s) {
    const int* tokslot = (const int*)(F.ws + WS_TOKSLOT); const float* tokw = (const float*)(F.ws + WS_TOKW);
    const int i = F.lane & 15; const int s0 = tokslot[2 * (t0 + i)], s1 = tokslot[2 * (t0 + i) + 1]; s.w0 = tokw[2 * (t0 + i)]; s.w1 = tokw[2 * (t0 + i) + 1];
    s.r0 = rbs[s0 >> 16] * 256 + (s0 & 0xffff); s.r1 = rbs[s1 >> 16] * 256 + (s1 & 0xffff);
}
__device__ __forceinline__ void comb_issue(Frame& F, int t, int i, const CombSlots& s, CombRow& c) {
    const bf16_t* XB = (const bf16_t*)(F.ws + WS_XB); const bf16_t* YB = (const bf16_t*)(F.ws + WS_YB);
    row_load_bf16(c.x, XB + (size_t)t * 1024, F.lane);
    const int r0 = __builtin_amdgcn_readlane(s.r0, i), r1 = __builtin_amdgcn_readlane(s.r1, i);
    c.w0 = __builtin_bit_cast(float, __builtin_amdgcn_readlane(__builtin_bit_cast(int, s.w0), i)); c.w1 = __builtin_bit_cast(float, __builtin_amdgcn_readlane(__builtin_bit_cast(int, s.w1), i));
    const u32x2* y0 = (const u32x2*)(YB + (size_t)r0 * 1024); const u32x2* y1 = (const u32x2*)(YB + (size_t)r1 * 1024);
#pragma unroll
    for (int j = 0; j < 4; ++j) { c.y0[j] = y0[64 * j + F.lane]; c.y1[j] = y1[64 * j + F.lane]; }
}
__device__ __forceinline__ void comb_finish(const f32x4 (&g2)[4], CombRow& c) {
#pragma unroll
    for (int j = 0; j < 4; ++j) { const u32x2 a = c.y0[j], b = c.y1[j]; const float w0 = c.w0, w1 = c.w1;
        f32x4 m; m[0] = w0 * bf_lo(a.x) + w1 * bf_lo(b.x); m[1] = w0 * bf_hi(a.x) + w1 * bf_hi(b.x); m[2] = w0 * bf_lo(a.y) + w1 * bf_lo(b.y); m[3] = w0 * bf_hi(a.y) + w1 * bf_hi(b.y);
        c.x.v[j] = c.x.v[j] + g2[j] * m; }
}
__device__ __forceinline__ void rbs_only(Frame& F, int layer, LAS int* rbs) {
    const unsigned* gcnt = F.ctl + (layer ? CW_CNT1 : CW_CNT0);
    load_rbs(F, gcnt, rbs, (LAS int*)nullptr);
}
__device__ __forceinline__ void phase_mid(Frame& F, LAS int* rbs) {
    const int gw = F.vcu * NWAVES + F.wave, NGW = F.G * NWAVES; bf16_t* XB = (bf16_t*)(F.ws + WS_XB); bf16_t* HQ = (bf16_t*)(F.ws + WS_H); bf16_t* HKV = (bf16_t*)(F.ws + WS_HKV);
    const float* mod1 = (const float*)(F.ws + WS_MOD) + 16 * 6144; const float* kvmod = (const float*)(F.ws + WS_KVMOD);
    rbs_only(F, 0, rbs);
    const int cbase = tail_base(rbs[16], 2);
    for (int t0 = gw * 16; t0 < NTOK; t0 += NGW * 16) { const int b = t0 / SEQ;
        CombSlots sl; comb_slots(F, t0, rbs, sl);
        ModVec mq, mk; modvec_load(mq, F.inp(I_NMIX) + 1024, mod1 + b * 6144, mod1 + b * 6144 + 1024, F.lane); modvec_load(mk, F.inp(I_KVNORM), kvmod + b * 2048, kvmod + b * 2048 + 1024, F.lane);
        f32x4 g2[4];
#pragma unroll
        for (int j = 0; j < 4; ++j) g2[j] = ((const f32x4*)((const float*)(F.ws + WS_MOD) + (size_t)b * 6144 + 5120))[64 * j + F.lane];
#pragma unroll 1
        for (int i = 0; i < 16; ++i) { CombRow c;
            const int cit = cbase + gw + (i >> 1) * NGW; const bool conv = cit < N_MOE_ITEMS; TItem ti; f32x4 tv[8];
            if (conv) { ti = moe_item(F, 1, cit); thalf_load(ti, i & 1, tv, F.lane); }
            comb_issue(F, t0 + i, i, sl, c);
            { const int tt = t0 + i; comb_finish(g2, c); Row16& r = c.x;
                row_store_bf16(r, XB + (size_t)tt * 1024, F.lane);
                const float rstd = __builtin_amdgcn_rsqf(row_sumsq(r) * (1.0f / 1024.0f) + EPS);
                row_mod_store(r, rstd, mq, HQ + (size_t)tt * 1024, F.lane); row_mod_store(r, rstd, mk, HKV + (size_t)tt * 1024, F.lane); }
            if (conv) thalf_store(ti, i & 1, tv, (LAS float*)(F.lds + F.wave * 17408), F.lane);
        } }
}
__device__ __forceinline__ void phase_final(Frame& F, LAS int* rbs) {
    const int gw = F.vcu * NWAVES + F.wave, NGW = F.G * NWAVES;
    rbs_only(F, 1, rbs);
    for (int t0 = gw * 16; t0 < NTOK; t0 += NGW * 16) { const int b = t0 / SEQ;
        CombSlots sl; comb_slots(F, t0, rbs, sl);
        f32x4 g2[4];
#pragma unroll
        for (int j = 0; j < 4; ++j) g2[j] = ((const f32x4*)((const float*)(F.ws + WS_MOD) + (size_t)(16 + b) * 6144 + 5120))[64 * j + F.lane];
#pragma unroll 1
        for (int i = 0; i < 16; i += 4) { CombRow c[4];
#pragma unroll
            for (int u = 0; u < 4; ++u) comb_issue(F, t0 + i + u, i + u, sl, c[u]);
#pragma unroll
            for (int u = 0; u < 4; ++u) { const int tt = t0 + i + u; comb_finish(g2, c[u]);
#pragma unroll
                for (int j = 0; j < 4; ++j) ((f32x4*)(F.out + (size_t)tt * 1024))[64 * j + F.lane] = c[u].x.v[j]; } } }
}
__device__ __forceinline__ s16x4 tr_read(const LAS void* p) {
    typedef short v4s __attribute__((ext_vector_type(4)));
    return __builtin_bit_cast(s16x4, __builtin_amdgcn_ds_read_tr16_b64_v4i16((LAS v4s*)p));
}
__device__ __forceinline__ bf16x8 cat8(s16x4 a, s16x4 b) { return (bf16x8){a[0], a[1], a[2], a[3], b[0], b[1], b[2], b[3]}; }

constexpr int RQ_STRIDE = 528, RV_STRIDE = 272, RS_STRIDE = 144;
constexpr int R_QS = 0, R_KS = 64 * RQ_STRIDE, R_VS = 2 * 64 * RQ_STRIDE, R_SS = R_VS + 64 * RV_STRIDE, R_CV = R_SS + 64 * RS_STRIDE, R_OS = R_CV + 2 * 16384, R_END = R_OS + 64 * RV_STRIDE;
static_assert(R_CV % 16 == 0 && R_OS % 16 == 0 && R_CV + 2 * 16384 <= 131072 && R_END <= ROWTAB_OFF + ROWTAB_BYTES, "retention LDS");

__device__ __forceinline__ void bg_load(Frame& F, int pair, u32x4 (&cv)[4]) {
#pragma unroll
    for (int bsel = 0; bsel < 2; ++bsel) { const TItem it = moe_item(F, 0, (2 * pair + bsel) * F.G + (int)blockIdx.x);
        const int kb = it.item >> 4, nb = it.item & 15, k0 = 64 * kb, n0 = 64 * nb;
#pragma unroll
        for (int i = 0; i < 2; ++i) cv[2 * bsel + i] = *(const u32x4*)((const char*)(it.W + (size_t)(k0 + 32 * i) * 1024 + n0) + (unsigned)((F.tid >> 4) * 4096 + (F.tid & 15) * 16)); }
}
__device__ __forceinline__ void bg_stage(Frame& F, const u32x4 (&cv)[4]) {
#pragma unroll
    for (int bsel = 0; bsel < 2; ++bsel)
#pragma unroll
        for (int i = 0; i < 2; ++i) *(LAS u32x4*)(F.lds + R_CV + bsel * 16384 + (i * 512 + F.tid) * 16) = cv[2 * bsel + i];
}
__device__ __forceinline__ void bg_convert(Frame& F, int pair) {
    if (F.wave < 2) return;
    const int bsel = F.wave >= 5 ? 1 : 0, wi = F.wave - 2 - 3 * bsel, c0 = 3 * wi, cnt = wi < 2 ? 3 : 2;
    const TItem it = moe_item(F, 0, (2 * pair + bsel) * F.G + (int)blockIdx.x);
    const int kb = it.item >> 4, nb = it.item & 15, k0 = 64 * kb, n0 = 64 * nb;
    const int d = dest_row(n0 + (F.lane & 32), it.mode) + (F.lane & 31);
    bf16_t* op = it.WT + (size_t)d * it.K + k0;
    const LAS float* tile = (const LAS float*)(F.lds + R_CV + bsel * 16384) + F.lane;
    float tv[3][8];
#pragma unroll
    for (int i = 0; i < 3; ++i) { if (i < cnt) { const LAS float* s = tile + (8 * (c0 + i)) * 64;
#pragma unroll
        for (int e = 0; e < 8; ++e) tv[i][e] = s[e * 64]; } }
#pragma unroll
    for (int i = 0; i < 3; ++i) { if (i < cnt) { const int c = c0 + i;
        u32x4 o; o.x = pk2(tv[i][0], tv[i][1]); o.y = pk2(tv[i][2], tv[i][3]); o.z = pk2(tv[i][4], tv[i][5]); o.w = pk2(tv[i][6], tv[i][7]);
        *(u32x4*)(op + 8 * c) = o; } }
}

__device__ __forceinline__ void phase_retention(Frame& F) {
    LAS unsigned char* lds = F.lds;
    const int tid = F.tid, lane = F.lane, w = F.wave, g = lane >> 4, l15 = lane & 15, tq = (lane >> 2) & 3, tp = lane & 3;
    const bf16_t* QR = (const bf16_t*)(F.ws + WS_QR); const bf16_t* KR = (const bf16_t*)(F.ws + WS_KR); bf16_t* VR = (bf16_t*)(F.ws + WS_VR);
    const unsigned qaddr = (unsigned)(uintptr_t)(lds + R_QS + l15 * RQ_STRIDE + g * 8), kaddr = (unsigned)(uintptr_t)(lds + R_KS + (8 * g + tq) * RQ_STRIDE + 4 * tp * 2);
    for (int i = tid; i < 64 * RS_STRIDE / 4; i += NTHREADS) ((LAS unsigned*)(lds + R_SS))[i] = 0u;
    for (int unit = F.vcu; unit < 256; unit += F.G) {
        const int b = unit >> 4, h = (unit >> 2) & 3, s = unit & 3;
        const float lgam = __builtin_log2f(1.0f - __builtin_exp2f(-5.0f - (float)h)); const float cdec = __builtin_exp2f(64.0f * lgam);
        const size_t tok0 = (size_t)b * SEQ;
        const bf16_t* qg = QR + tok0 * 1024 + h * 256; const bf16_t* kg = KR + tok0 * 1024 + h * 256; bf16_t* vg = VR + tok0 * 2048 + h * 512 + s * 128;
        f32x4 St[16];
#pragma unroll
        for (int t = 0; t < 16; ++t) St[t] = (f32x4){0.f, 0.f, 0.f, 0.f};
        u32x4 pq[4], pk[4], pv[2], cv[4];
        const unsigned qko = (unsigned)((tid >> 5) * 2048 + (tid & 31) * 16), vo = (unsigned)((tid >> 4) * 4096 + (tid & 15) * 16);
#define RET_PREFETCH(ci) do { const char* _q = (const char*)qg + (size_t)(ci) * 131072; const char* _k = (const char*)kg + (size_t)(ci) * 131072; const char* _v = (const char*)vg + (size_t)(ci) * 262144; \
            _Pragma("unroll") for (int i = 0; i < 4; ++i) { pq[i] = *(const u32x4*)(_q + i * 32768 + qko); pk[i] = *(const u32x4*)(_k + i * 32768 + qko); } \
            _Pragma("unroll") for (int i = 0; i < 2; ++i) pv[i] = *(const u32x4*)(_v + i * 131072 + vo); } while (0)
        RET_PREFETCH(0);
#ifdef RET_PROBE
        unsigned long long rp_acc = 0, rp_prev = __builtin_amdgcn_s_memrealtime();
#define RS(k) do { const unsigned long long _n = __builtin_amdgcn_s_memrealtime(); if (RET_PROBE == (k)) rp_acc += _n - rp_prev; rp_prev = _n; } while (0)
#else
#define RS(k) do {} while (0)
#endif
        for (int ci = 0; ci < 32; ++ci) {
            RS(0);
#pragma unroll
            for (int i = 0; i < 4; ++i) { const int id = i * 512 + tid, row = id >> 5, c16 = id & 31;
                *(LAS u32x4*)(lds + R_QS + row * RQ_STRIDE + c16 * 16) = pq[i]; *(LAS u32x4*)(lds + R_KS + row * RQ_STRIDE + c16 * 16) = pk[i]; }
#pragma unroll
            for (int i = 0; i < 2; ++i) { const int id = i * 512 + tid, row = id >> 4, c16 = id & 15; *(LAS u32x4*)(lds + R_VS + row * RV_STRIDE + c16 * 16) = pv[i]; }
            if (ci >= 1 && ci <= 24) bg_stage(F, cv);
            RS(1); __syncthreads(); RS(2);
            if (ci >= 1) {
#pragma unroll
                for (int i = 0; i < 2; ++i) { const int id = i * 512 + tid, row = id >> 4, c16 = id & 15;
                    *(u32x4*)((char*)vg + (size_t)(ci - 1) * 262144 + i * 131072 + vo) = *(const LAS u32x4*)(lds + R_OS + row * RV_STRIDE + c16 * 16); } }
            if (ci + 1 < 32) RET_PREFETCH(ci + 1);
            if (ci < 24) bg_load(F, ci, cv);
            if (ci >= 1 && ci <= 24) bg_convert(F, ci - 1);
#pragma unroll
            for (int rep = 0; rep < 2; ++rep) {
                const int idx = w + 8 * rep;
                if (idx < 10) {
                    const int mt = idx < 4 ? 0 : idx < 7 ? 1 : idx < 9 ? 2 : 3, nt_ = idx < 4 ? idx : idx < 7 ? idx - 3 : idx < 9 ? idx - 5 : 3;
                    f32x4 sacc = (f32x4){0.f, 0.f, 0.f, 0.f};
                    const LAS unsigned char* ka = lds + R_KS + (mt * 16 + l15) * RQ_STRIDE + g * 16; const LAS unsigned char* qb = lds + R_QS + (nt_ * 16 + l15) * RQ_STRIDE + g * 16;
#pragma unroll
                    for (int hb = 0; hb < 2; ++hb) { bf16x8 fa[4], fb[4];
#pragma unroll
                        for (int kk = 0; kk < 4; ++kk) { fa[kk] = *(const LAS bf16x8*)(ka + (4 * hb + kk) * 64); fb[kk] = *(const LAS bf16x8*)(qb + (4 * hb + kk) * 64); }
                        __builtin_amdgcn_sched_barrier(0);
#pragma unroll
                        for (int kk = 0; kk < 4; ++kk) sacc = __builtin_amdgcn_mfma_f32_16x16x32_bf16(fa[kk], fb[kk], sacc, 0, 0, 0);
                        __builtin_amdgcn_sched_barrier(0); }
                    const int n = nt_ * 16 + l15, m0 = mt * 16 + 4 * g;
#pragma unroll
                    for (int r = 0; r < 4; ++r) if (n < m0 + r) sacc[r] = 0.f;
                    u32x2 pw; pw.x = pk2(sacc[0], sacc[1]); pw.y = pk2(sacc[2], sacc[3]);
                    *(LAS u32x2*)(lds + R_SS + n * RS_STRIDE + m0 * 2) = pw;
                }
            }
            bf16x8 vf[2];
#pragma unroll
            for (int kk = 0; kk < 2; ++kk) { const LAS unsigned char* vp = lds + R_VS + (32 * kk + 8 * g + tq) * RV_STRIDE + (16 * w + 4 * tp) * 2;
                vf[kk] = cat8(tr_read(vp), tr_read(vp + 4 * RV_STRIDE)); }
#define RET_PACKST(kk) ({ u32x4 _x; _x.x = pk2(St[2 * (kk)][0], St[2 * (kk)][1]); _x.y = pk2(St[2 * (kk)][2], St[2 * (kk)][3]); _x.z = pk2(St[2 * (kk) + 1][0], St[2 * (kk) + 1][1]); _x.w = pk2(St[2 * (kk) + 1][2], St[2 * (kk) + 1][3]); __builtin_bit_cast(bf16x8, _x); })
            f32x4 o[4];
#pragma unroll
            for (int nt_ = 0; nt_ < 4; ++nt_) o[nt_] = (f32x4){0.f, 0.f, 0.f, 0.f};
            __builtin_amdgcn_sched_barrier(0);
            {
                s16x4 rlo[4], rhi[4];
#define RET_LD(k, gi) do { if ((gi) < 32) asm volatile("ds_read_b64 %0, %2 offset:%3\n\tds_read_b64 %1, %2 offset:%4" : "=&v"(rlo[k]), "=&v"(rhi[k]) : "v"(qaddr), "i"(((gi) & 3) * 16 * RQ_STRIDE + ((gi) >> 2) * 64), "i"(((gi) & 3) * 16 * RQ_STRIDE + ((gi) >> 2) * 64 + 32) : "memory"); \
                else asm volatile("ds_read_b64_tr_b16 %0, %2 offset:%3\n\tds_read_b64_tr_b16 %1, %2 offset:%4" : "=&v"(rlo[k]), "=&v"(rhi[k]) : "v"(kaddr), "i"(((gi) & 1) * 32 * RQ_STRIDE + (((gi) - 32) >> 1) * 32), "i"(((gi) & 1) * 32 * RQ_STRIDE + (((gi) - 32) >> 1) * 32 + 4 * RQ_STRIDE) : "memory"); } while (0)
#define RET_WAIT(k, n) asm volatile("s_waitcnt lgkmcnt(%2)" : "+v"(rlo[k]), "+v"(rhi[k]) : "n"(n) : "memory")
                RET_LD(0, 0); RET_LD(1, 1); RET_LD(2, 2);
                bf16x8 sbc = RET_PACKST(0), sbn = RET_PACKST(1);
#pragma unroll
                for (int gi = 0; gi < 64; ++gi) {
                    if (gi + 3 < 64) RET_LD((gi + 3) & 3, gi + 3);
                    RET_WAIT(gi & 3, (63 - gi) < 3 ? 2 * (63 - gi) : 6);
                    const bf16x8 af = cat8(rlo[gi & 3], rhi[gi & 3]);
                    if (gi < 32) { o[gi & 3] = __builtin_amdgcn_mfma_f32_16x16x32_bf16(af, sbc, o[gi & 3], 0, 0, 0);
                        if ((gi & 3) == 3) { sbc = sbn; if ((gi >> 2) + 2 < 8) sbn = RET_PACKST((gi >> 2) + 2); } }
                    else { const int t = (gi - 32) >> 1; St[t] = __builtin_amdgcn_mfma_f32_16x16x32_bf16(af, vf[gi & 1], St[t], 0, 0, 0);
                        if ((gi & 1) && t >= 1) St[t - 1] = St[t - 1] * cdec; }
                    __builtin_amdgcn_sched_barrier(0);
                }
                St[15] = St[15] * cdec;
#undef RET_LD
#undef RET_WAIT
            }
            RS(3); __syncthreads(); RS(4);
            {
#pragma unroll
                for (int nt_ = 0; nt_ < 4; ++nt_) {
                    const LAS unsigned char* sp = lds + R_SS + (nt_ * 16 + l15) * RS_STRIDE + g * 16;
#pragma unroll
                    for (int kk = 0; kk < 2; ++kk) { if (kk * 32 < (nt_ + 1) * 16) { const bf16x8 a = *(const LAS bf16x8*)(sp + kk * 64); o[nt_] = __builtin_amdgcn_mfma_f32_16x16x32_bf16(a, vf[kk], o[nt_], 0, 0, 0); } }
                }
#undef RET_PACKST
            }
#pragma unroll
            for (int nt_ = 0; nt_ < 4; ++nt_)
#pragma unroll
                for (int r = 0; r < 4; ++r) *(LAS bf16_t*)(lds + R_OS + (nt_ * 16 + 4 * g + r) * RV_STRIDE + (16 * w + l15) * 2) = (bf16_t)f2bf(o[nt_][r]);
            RS(5); __syncthreads(); RS(6);
        }
#ifdef RET_PROBE
        if (blockIdx.x == 0 && tid == RET_PROBE_WAVE * 64) __hip_atomic_store((unsigned long long*)(F.ctl + 8400), rp_acc, __ATOMIC_RELAXED, __HIP_MEMORY_SCOPE_AGENT);
#endif
#undef RET_PREFETCH
#pragma unroll
        for (int i = 0; i < 2; ++i) { const int id = i * 512 + tid, row = id >> 4, c16 = id & 15;
            *(u32x4*)((char*)vg + (size_t)31 * 262144 + i * 131072 + vo) = *(const LAS u32x4*)(lds + R_OS + row * RV_STRIDE + c16 * 16); }
        __syncthreads();
    }
}

constexpr int A_SLOT = 16384, A_K0 = 0, A_V0 = 3 * A_SLOT, A_LS = 6 * A_SLOT, A_X = 0, A_OST = A_LS + 8 * 64 * 4, A_OSTRIDE = 272, A_END = A_OST + 4 * 32 * A_OSTRIDE;
static_assert(A_END <= ROWTAB_OFF + ROWTAB_BYTES && 4 * 16384 <= A_LS, "attention LDS");
__device__ __forceinline__ int crow(int r, int hi) { return (r & 3) + 8 * (r >> 2) + 4 * hi; }
#define ATT_SB() __builtin_amdgcn_sched_barrier(0)

template <bool SHIFT>
__device__ __forceinline__ void phase_attention_impl(Frame& F, const float M2) {
    LAS unsigned char* lds = F.lds;
    const int tid = F.tid, lane = F.lane, w = F.wave, r32 = lane & 31, hi = lane >> 5, tq = (lane >> 2) & 3, tp = lane & 3, ch = (lane >> 4) & 1, t = w >> 2, wq = w & 3;
    const bf16_t* Q1 = (const bf16_t*)(F.ws + WS_Q1); const bf16_t* K1 = (const bf16_t*)(F.ws + WS_K1); const bf16_t* V1 = (const bf16_t*)(F.ws + WS_V1); bf16_t* AO = (bf16_t*)(F.ws + WS_AO);
    const float* lam = F.inp(I_LAM);
    const float l01 = wave_sum(lam[lane] * lam[64 + lane]), l23 = wave_sum(lam[128 + lane] * lam[192 + lane]);
    const float lambda_init = 0.8f - 0.6f * 0.7408182206817179f;
    const float lam_full = __expf(l01) - __expf(l23) + lambda_init;
    LAS float* wsf = (LAS float*)(lds + A_LS) + w * 64;
    unsigned dsrc[2];
#pragma unroll
    for (int i = 0; i < 2; ++i) { const int row = 4 * (2 * w + i) + (lane >> 4), fr = ((row & 3) << 2) | ((row >> 2) & 3); dsrc[i] = (unsigned)(row * 2048 + (((lane & 15) ^ fr) << 4)); }
    const unsigned ddst = (unsigned)(w * 2048);
    const int frk = ((r32 & 3) << 2) | ((r32 >> 2) & 3);
    int koff[4];
#pragma unroll
    for (int ks = 0; ks < 4; ++ks) koff[ks] = r32 * 256 + (((8 * t + 2 * ks + hi) ^ frk) << 4);
    unsigned vofA[4], vofB[4];
#pragma unroll
    for (int d = 0; d < 4; ++d) { const int c = 4 * d + 2 * ch + (tp >> 1);
        vofA[d] = (unsigned)((4 * hi + tq) * 256 + ((c ^ ((tq << 2) | (hi & 3))) << 4) + 8 * (tp & 1));
        vofB[d] = (unsigned)((4 * hi + tq + 8) * 256 + ((c ^ ((tq << 2) | ((hi + 2) & 3))) << 4) + 8 * (tp & 1)); }
    const unsigned ldsb = (unsigned)(uintptr_t)lds;
#ifdef ATT_PROBE
    unsigned long long att_tw = 0;
#endif
#define ATT_UNIT(n, b_, h_, u_) const int _v##b_ = F.vcu + ((n) >> 3) * F.G, _bh##b_ = _v##b_ >> 1, b_ = _bh##b_ >> 3, h_ = _bh##b_ & 7, _pr##b_ = 2 * (((n) & 7) >> 1) + (_v##b_ & 1), u_ = ((n) & 1) ? 15 - _pr##b_ : _pr##b_
#define ATT_DMA(gbase, tile, NTu, slotbase) do { const int _tl = (tile) < (NTu) ? (tile) : (NTu) - 1; const char* _g = (gbase) + (size_t)_tl * 131072; const unsigned _s = (slotbase) + (unsigned)(((tile) % 3) * A_SLOT) + ddst; \
            __builtin_amdgcn_global_load_lds((const GAS unsigned*)(_g + dsrc[0]), (LAS unsigned*)(lds + _s), 16, 0, 0); \
            __builtin_amdgcn_global_load_lds((const GAS unsigned*)(_g + dsrc[1]), (LAS unsigned*)(lds + _s + 1024), 16, 0, 0); } while (0)
#define ATT_PROLOGUE_DMA(kgx, vgx, NTx) do { ATT_DMA(kgx, 0, NTx, A_K0); ATT_DMA(vgx, 0, NTx, A_V0); ATT_DMA(kgx, 1, NTx, A_K0); ATT_DMA(kgx, 2, NTx, A_K0); ATT_DMA(vgx, 1, NTx, A_V0); } while (0)
#define ATT_WAITBAR(n) asm volatile("s_waitcnt vmcnt(" #n ") lgkmcnt(0)\n\ts_barrier" ::: "memory")
    const int NU = 8 * ((256 - F.vcu + F.G - 1) / F.G);
    if (NU > 0) { ATT_UNIT(0, b0_, h0_, u0_); ATT_PROLOGUE_DMA((const char*)(K1 + (size_t)b0_ * SEQ * 1024 + h0_ * 128), (const char*)(V1 + (size_t)b0_ * SEQ * 1024 + h0_ * 128), 2 * u0_ + 2); }
    {
        for (int n = 0; n < NU; ++n) {
            ATT_UNIT(n, b, h, u);
            const size_t tok0 = (size_t)b * SEQ; const int q0 = u * 128 + wq * 32;
            const int NT = 2 * u + 2, jmax = 2 * u + (wq >> 1);
            const char* kg = (const char*)(K1 + tok0 * 1024 + h * 128); const char* vg = (const char*)(V1 + tok0 * 1024 + h * 128);
            bf16x8 qf[4];
#pragma unroll
            for (int ks = 0; ks < 4; ++ks) qf[ks] = *(const bf16x8*)((const char*)(Q1 + (tok0 + q0) * 1024 + h * 128 + t * 64) + (unsigned)(r32 * 2048 + hi * 16 + ks * 32));
            f32x16 O[4];
#pragma unroll
            for (int d = 0; d < 4; ++d) O[d] = f32x16{};
            float lsum = 0.f;
#define ATT_QK(S0, S1, kslot) do { const f32x16 _z = f32x16{}; bf16x8 _a0[2], _a1[2]; const LAS unsigned char* _kb = lds + A_K0 + (kslot) * A_SLOT; \
            _Pragma("unroll") for (int ks = 0; ks < 2; ++ks) { _a0[ks] = *(const LAS bf16x8*)(_kb + koff[ks]); _a1[ks] = *(const LAS bf16x8*)(_kb + koff[ks] + 32 * 256); } \
            S0 = __builtin_amdgcn_mfma_f32_32x32x16_bf16(_a0[0], qf[0], _z, 0, 0, 0); S1 = __builtin_amdgcn_mfma_f32_32x32x16_bf16(_a1[0], qf[0], _z, 0, 0, 0); \
            S0 = __builtin_amdgcn_mfma_f32_32x32x16_bf16(_a0[1], qf[1], S0, 0, 0, 0); S1 = __builtin_amdgcn_mfma_f32_32x32x16_bf16(_a1[1], qf[1], S1, 0, 0, 0); ATT_SB(); \
            _Pragma("unroll") for (int ks = 0; ks < 2; ++ks) { _a0[ks] = *(const LAS bf16x8*)(_kb + koff[ks + 2]); _a1[ks] = *(const LAS bf16x8*)(_kb + koff[ks + 2] + 32 * 256); } \
            S0 = __builtin_amdgcn_mfma_f32_32x32x16_bf16(_a0[0], qf[2], S0, 0, 0, 0); S1 = __builtin_amdgcn_mfma_f32_32x32x16_bf16(_a1[0], qf[2], S1, 0, 0, 0); \
            S0 = __builtin_amdgcn_mfma_f32_32x32x16_bf16(_a0[1], qf[3], S0, 0, 0, 0); S1 = __builtin_amdgcn_mfma_f32_32x32x16_bf16(_a1[1], qf[3], S1, 0, 0, 0); } while (0)
#define ATT_EXP4(S0, S1, PFN, e) do { float x0, x1, x2, x3; \
            if ((e) < 4) { x0 = S0[4 * (e)]; x1 = S0[4 * (e) + 1]; x2 = S0[4 * (e) + 2]; x3 = S0[4 * (e) + 3]; } else { x0 = S1[4 * ((e) - 4)]; x1 = S1[4 * ((e) - 4) + 1]; x2 = S1[4 * ((e) - 4) + 2]; x3 = S1[4 * ((e) - 4) + 3]; } \
            if (SHIFT) { x0 -= M2; x1 -= M2; x2 -= M2; x3 -= M2; } \
            x0 = __builtin_amdgcn_exp2f(x0); x1 = __builtin_amdgcn_exp2f(x1); x2 = __builtin_amdgcn_exp2f(x2); x3 = __builtin_amdgcn_exp2f(x3); lsum += (x0 + x1) + (x2 + x3); \
            PFN[(e) >> 1][((e) & 1) * 2] = pk2(x0, x1); PFN[(e) >> 1][((e) & 1) * 2 + 1] = pk2(x2, x3); } while (0)
#define ATT_VLD(k, i) asm volatile("ds_read_b64_tr_b16 %0, %2 offset:%4\n\tds_read_b64_tr_b16 %1, %3 offset:%4" : "=&v"(vlo[k]), "=&v"(vhi[k]) : "v"(va[(i) & 3]), "v"(vb[(i) & 3]), "i"(((i) >> 2) * 4096) : "memory")
#define ATT_VWAIT(k, n) asm volatile("s_waitcnt lgkmcnt(" #n ")" : "+v"(vlo[k]), "+v"(vhi[k]) :: "memory")
#define ATT_MM(PF, k, i) do { O[(i) & 3] = __builtin_amdgcn_mfma_f32_32x32x16_bf16(__builtin_bit_cast(bf16x8, PF[(i) >> 2]), cat8(vlo[k], vhi[k]), O[(i) & 3], 0, 0, 0); } while (0)
#define ATT_SLOT(PF, i) do { if ((i) + 3 < 16) ATT_VLD(((i) + 3) & 3, (i) + 3); \
            if ((i) < 13) ATT_VWAIT((i) & 3, 6); else if ((i) == 13) ATT_VWAIT((i) & 3, 4); else if ((i) == 14) ATT_VWAIT((i) & 3, 2); else ATT_VWAIT((i) & 3, 0); \
            ATT_MM(PF, (i) & 3, i); } while (0)
            ATT_WAITBAR(4);
            u32x4 pf[4];
            { f32x16 s0, s1; ATT_QK(s0, s1, 0);
#pragma unroll
              for (int e = 0; e < 8; ++e) ATT_EXP4(s0, s1, pf, e); }
            ATT_WAITBAR(4);
            int ks1 = 1, vs0 = 0;
#if defined(ATT_PROBE) && defined(ATT_PROBE_LOOP)
            const unsigned long long _tl0 = __builtin_amdgcn_s_memrealtime();
#endif
            for (int j = 0; j < NT; ++j) {
                ATT_DMA(kg, j + 3, NT, A_K0); ATT_DMA(vg, j + 2, NT, A_V0);
                unsigned va[4], vb[4];
#pragma unroll
                for (int d = 0; d < 4; ++d) { va[d] = ldsb + (unsigned)(A_V0 + vs0 * A_SLOT) + vofA[d]; vb[d] = ldsb + (unsigned)(A_V0 + vs0 * A_SLOT) + vofB[d]; }
                if (j + 1 <= jmax) {
                    f32x16 s0, s1; u32x4 pfn[4];
                    s16x4 vlo[4], vhi[4];
                    ATT_VLD(0, 0); ATT_VLD(1, 1); ATT_VLD(2, 2);
                    ATT_QK(s0, s1, ks1); ATT_SB();
#pragma unroll
                    for (int i = 0; i < 8; ++i) { ATT_SLOT(pf, i); ATT_SB(); }
#pragma unroll
                    for (int i = 8; i < 16; ++i) { ATT_SLOT(pf, i); ATT_EXP4(s0, s1, pfn, i - 8); ATT_SB(); }
#pragma unroll
                    for (int s = 0; s < 4; ++s) pf[s] = pfn[s];
                } else if (j <= jmax) {
                    s16x4 vlo[4], vhi[4];
                    ATT_VLD(0, 0); ATT_VLD(1, 1); ATT_VLD(2, 2);
#pragma unroll
                    for (int i = 0; i < 16; ++i) { ATT_SLOT(pf, i); ATT_SB(); }
                }
                ks1 = ks1 == 2 ? 0 : ks1 + 1; vs0 = vs0 == 2 ? 0 : vs0 + 1;
#if defined(ATT_PROBE) && !defined(ATT_PROBE_LOOP)
                { const unsigned long long _t0 = __builtin_amdgcn_s_memrealtime(); ATT_WAITBAR(4); att_tw += __builtin_amdgcn_s_memrealtime() - _t0; }
#else
                ATT_WAITBAR(4);
#endif
            }
#if defined(ATT_PROBE) && defined(ATT_PROBE_LOOP)
            att_tw += __builtin_amdgcn_s_memrealtime() - _tl0;
#endif
            asm volatile("s_waitcnt vmcnt(0)" ::: "memory");
            if (n + 1 < NU) { const int n1 = n + 1; ATT_UNIT(n1, bn_, hn_, un_);
                ATT_PROLOGUE_DMA((const char*)(K1 + (size_t)bn_ * SEQ * 1024 + hn_ * 128), (const char*)(V1 + (size_t)bn_ * SEQ * 1024 + hn_ * 128), 2 * un_ + 2); }
#undef ATT_QK
#undef ATT_EXP4
#undef ATT_VLD
#undef ATT_VWAIT
#undef ATT_MM
#undef ATT_SLOT
            lsum = swap32_add(lsum, lsum);
            if (hi == 0) wsf[r32] = (t ? lam_full : 1.0f) / lsum;
            LDS_WAIT(); asm volatile("" ::: "memory");
            float sc[16];
#pragma unroll
            for (int r = 0; r < 16; ++r) sc[r] = wsf[crow(r, hi)];
            LAS unsigned* XR = (LAS unsigned*)(lds + A_OST + wq * 32 * A_OSTRIDE);
            if (t == 1) {
#pragma unroll
                for (int d = 0; d < 4; ++d)
#pragma unroll
                    for (int rr = 0; rr < 8; ++rr) XR[(d * 8 + rr) * 64 + lane] = pk2(O[d][2 * rr] * sc[2 * rr], O[d][2 * rr + 1] * sc[2 * rr + 1]);
            }
            __syncthreads();
            if (t == 0) {
                const float osc = 1.0f - lambda_init;
                const float* subp = F.inp(I_SUBLN); const float sub0 = subp[r32], sub1 = subp[32 + r32], sub2 = subp[64 + r32], sub3 = subp[96 + r32];
                unsigned xr[32];
#pragma unroll
                for (int i = 0; i < 32; ++i) xr[i] = XR[i * 64 + lane];
                LDS_WAIT(); asm volatile("" ::: "memory");
#pragma unroll
                for (int r = 0; r < 16; ++r) { const int q = crow(r, hi);
#define ATT_X(d) ((r & 1) ? bf_hi(xr[(d) * 8 + (r >> 1)]) : bf_lo(xr[(d) * 8 + (r >> 1)]))
                    const float o0 = O[0][r] * sc[r] - ATT_X(0), o1 = O[1][r] * sc[r] - ATT_X(1), o2 = O[2][r] * sc[r] - ATT_X(2), o3 = O[3][r] * sc[r] - ATT_X(3);
#undef ATT_X
                    float ss = o0 * o0 + o1 * o1 + o2 * o2 + o3 * o3;
                    ss = sum8(ss); ss += dppf<0x140>(ss); ss = swap16_add(ss, ss);
                    const float rstd = __builtin_amdgcn_rsqf(ss * (1.0f / 128.0f) + EPS) * osc;
                    LAS bf16_t* sp = (LAS bf16_t*)(lds + A_OST + wq * 32 * A_OSTRIDE + q * A_OSTRIDE) + r32;
                    sp[0] = (bf16_t)f2bf(o0 * rstd * sub0); sp[32] = (bf16_t)f2bf(o1 * rstd * sub1); sp[64] = (bf16_t)f2bf(o2 * rstd * sub2); sp[96] = (bf16_t)f2bf(o3 * rstd * sub3); }
                LDS_WAIT(); asm volatile("" ::: "memory");
                char* ob = (char*)(AO + (tok0 + q0) * 1024 + h * 128);
#pragma unroll
                for (int i = 0; i < 8; ++i) { const int id = i * 64 + lane, row = id >> 4, c16 = id & 15;
                    *(u32x4*)(ob + (unsigned)(row * 2048 + c16 * 16)) = *(const LAS u32x4*)(lds + A_OST + wq * 32 * A_OSTRIDE + row * A_OSTRIDE + c16 * 16); }
            }
        }
    }
#undef ATT_DMA
#undef ATT_UNIT
#undef ATT_PROLOGUE_DMA
#undef ATT_WAITBAR
#ifdef ATT_PROBE
    if (blockIdx.x == 0 && tid == ATT_PROBE * 64) __hip_atomic_store((unsigned long long*)(F.ctl + 8400), att_tw, __ATOMIC_RELAXED, __HIP_MEMORY_SCOPE_AGENT);
#endif
}

__device__ __forceinline__ void phase_attention(Frame& F) {
    const float gq = wave_max(fabsf(F.inp(I_QNORM)[F.lane])), gk = wave_max(fabsf(F.inp(I_KNORM)[F.lane]));
    const float bound = 8.0f * LOG2E * gq * gk * 1.001f + 0.01f;
    if (bound > 96.0f) phase_attention_impl<true>(F, bound - 96.0f); else phase_attention_impl<false>(F, 0.0f);
}
constexpr int N_PHASES = 17;
#ifndef MK_N_LAUNCHES
#define MK_N_LAUNCHES 1
#endif
struct Args { const float* in[26]; float* out; unsigned char* ws; int ph_lo, ph_hi; };

__global__ void __launch_bounds__(NTHREADS, 2) yoco_fwd(Args args) {
    extern __shared__ __attribute__((aligned(16))) unsigned char lds_raw[];
    Frame F;
    F.lds = (LAS unsigned char*)lds_raw;
    const int wave0 = __builtin_amdgcn_readfirstlane((int)threadIdx.x >> 6);
    F.G = gridDim.x; { const int bx = blockIdx.x; F.vcu = (F.G % 8 == 0) ? (bx % 8) * (F.G / 8) + bx / 8 : bx; }
#define FRESH_IN() do { kargp_t _t = (kargp_t)__builtin_amdgcn_kernarg_segment_ptr(); asm volatile("" : "+s"(_t)); F.kin = _t; \
        F.out = (float*)(GAS float*)_t[26]; F.ws = (unsigned char*)(GAS unsigned char*)_t[27]; F.ctl = (unsigned*)(F.ws + WS_CTL); \
        int _tid; asm volatile("v_mbcnt_lo_u32_b32 %0, -1, 0\n\tv_mbcnt_hi_u32_b32 %0, -1, %0" : "=v"(_tid)); _tid += wave0 * 64; asm volatile("" : "+v"(_tid)); F.tid = _tid;     \
        F.lane = _tid & 63; F.wave = __builtin_amdgcn_readfirstlane(_tid >> 6); } while (0)
    FRESH_IN();
    volatile LAS unsigned* MISC = (volatile LAS unsigned*)(F.lds + MISC_OFF);
    LAS int* rbs = (LAS int*)(F.lds + MISC_OFF + 256);
    LAS int* rowtab = (LAS int*)(F.lds + ROWTAB_OFF);
    LAS int* utab = (LAS int*)(F.lds + MISC_OFF + 1024);
    for (int u = F.tid; u < 512; u += NTHREADS) MISC[u] = 0u;
    __syncthreads();
    const int lo = args.ph_lo, hi = args.ph_hi;
    const bool multi = (hi - lo) > 1;
    XcdBarrier bar; bar.bar = nullptr; bar.x = 0; bar.st = nullptr;
    if (multi) bar = xcd_barrier_post(F.ctl + CW_BAR, MISC + 8);
#ifdef ONLY_PHASE
#define IN(k) ((k) == ONLY_PHASE && lo <= (k) && (k) < hi)
#else
#define IN(k) (lo <= (k) && (k) < hi)
#endif
#if defined(PROBE_A) || defined(PROBE_B)
#ifndef PROBE_A
#define PROBE_A 0
#endif
#ifndef PROBE_B
#define PROBE_B 0
#endif
#ifndef PROBE_CONST
#define PROBE_CONST 0ull
#endif
#ifndef PROBE_MUL
#define PROBE_MUL 0ull
#endif
    unsigned long long pr_prev = __builtin_amdgcn_s_memrealtime(), pr_a = 0, pr_b = 0;
#define PROBE_STAMP(k) do { const unsigned long long _n = __builtin_amdgcn_s_memrealtime(); if ((PROBE_A >> (k)) & 1) pr_a += _n - pr_prev; if ((PROBE_B >> (k)) & 1) pr_b += _n - pr_prev; pr_prev = _n; } while (0)
#else
#define PROBE_STAMP(k) do {} while (0)
#endif
#ifdef BAR_PROBE
#define SEAM(k) do { if (IN(k) && IN((k) + 1)) { bar.bar = F.ctl + CW_BAR; const unsigned long long _b0 = __builtin_amdgcn_s_memrealtime(); xcd_barrier(bar); pr_a += __builtin_amdgcn_s_memrealtime() - _b0; } else __syncthreads(); } while (0)
#else
#define SEAM(k) do { if (IN(k) && IN((k) + 1)) { bar.bar = F.ctl + CW_BAR; xcd_barrier(bar); } else __syncthreads(); PROBE_STAMP(k); } while (0)
#endif
    #define gw (F.vcu * NWAVES + F.wave)
#define NGW (F.G * NWAVES)

#if defined(P0_PROBE)
#define P0S(k) do { if (P0_PROBE == (k)) pr_a = __builtin_amdgcn_s_memrealtime() - pr_prev; } while (0)
#else
#define P0S(k) do {} while (0)
#endif
    if (IN(0)) { FRESH_IN(); P0S(0); adaln_phase(F); __syncthreads(); P0S(1); rope_table(F, blockIdx.x * NTHREADS + F.tid, F.G * NTHREADS); P0S(2); {
          const int blk = (int)blockIdx.x; if (blk < 224) convert_weights(F, 0, true, false, blk * 8 + F.wave, 1 << 20, 1792); else { const int s0 = 1792 + (blk - 224) * 40 + F.wave * 5; convert_weights(F, 0, true, false, s0, 1, s0 + 5); } }
        SEAM(0); }
    if (IN(1)) { FRESH_IN(); phase_h0(F); SEAM(1); }
    if (IN(2)) { FRESH_IN();
      {
        pg8::SchedPlain S{(const char*)(F.ws + WS_H), (const char*)(F.ws + WS_WIN), NTOK / 256, 24, 1024, F.G, (int)blockIdx.x};
        pg8::EpiInProj E{(bf16_t*)(F.ws + WS_QR), (bf16_t*)(F.ws + WS_KR), (bf16_t*)(F.ws + WS_VR), (bf16_t*)(F.ws + WS_SG), (const float*)(F.ws + WS_COS), (const float*)(F.ws + WS_SIN)};
        { const int nU = pg8::build_units(utab, S, F.tid); pg8::gemm_phase<pg8::EpiInProj, false>(F.lds, F.tid, 1024, utab, nU, E, rowtab); } }
      SEAM(2); }
    if (IN(3)) { FRESH_IN(); if (F.wave >= 4) __builtin_amdgcn_s_setprio(1);
        phase_retention(F); __builtin_amdgcn_s_setprio(0); SEAM(3); }
    if (IN(4)) { FRESH_IN(); phase_gate(F); SEAM(4); }
    if (IN(5)) { FRESH_IN(); pg8::SchedPlain S{(const char*)(F.ws + WS_VR), (const char*)(F.ws + WS_WRO), NTOK / 256, 4, 2048, F.G, (int)blockIdx.x};
        pg8::EpiResid<true> E{F.inp(I_X), (bf16_t*)(F.ws + WS_XB), (const float*)(F.ws + WS_MOD) + 2048};
        { const int nU = pg8::build_units(utab, S, F.tid); pg8::gemm_phase<pg8::EpiResid<true>, false>(F.lds, F.tid, 2048, utab, nU, E, rowtab); } SEAM(5); }
#pragma unroll 1
    for (int layer = 0; layer < 2; ++layer) {
        const int pb = layer ? 13 : 6;
        if (IN(pb)) { FRESH_IN(); phase_route(F, layer); SEAM(pb); }
        if (IN(pb + 1)) { FRESH_IN(); moe_tables(F, layer, rbs, rowtab, 8, true);
            pg8::SchedMoe S{(const char*)(F.ws + WS_H), (const char*)(F.ws + (layer ? WS_W13_L1 : WS_W13)), rbs, 8, F.G, (int)blockIdx.x, 1, (size_t)2048 * 1024 * 2};
            pg8::EpiMoeUp E{(bf16_t*)(F.ws + WS_HID)};
            { const int nU = pg8::build_units(utab, S, F.tid); pg8::gemm_phase<pg8::EpiMoeUp, true>(F.lds, F.tid, 1024, utab, nU, E, rowtab); } if (layer == 0) tail_convert(F, rbs, 8, 0); SEAM(pb + 1); }
        if (IN(pb + 2)) { FRESH_IN(); moe_tables(F, layer, rbs, rowtab, 4, false);
            pg8::SchedMoe S{(const char*)(F.ws + WS_HID), (const char*)(F.ws + (layer ? WS_W2_L1 : WS_W2)), rbs, 4, F.G, (int)blockIdx.x, 0, (size_t)1024 * 1024 * 2};
            pg8::EpiBf16 E{(bf16_t*)(F.ws + WS_YB), 1024};
            { const int nU = pg8::build_units(utab, S, F.tid); pg8::gemm_phase<pg8::EpiBf16, false>(F.lds, F.tid, 1024, utab, nU, E, rowtab); } if (layer == 0) tail_convert(F, rbs, 4, 1); SEAM(pb + 2); }
        if (layer == 0) {
            if (IN(9)) { FRESH_IN(); phase_mid(F, rbs); SEAM(9); }
            if (IN(10)) { FRESH_IN(); pg8::SchedQKV S{(const char*)(F.ws + WS_H), (const char*)(F.ws + WS_HKV), (const char*)(F.ws + WS_WQ), (const char*)(F.ws + WS_WKV), F.G, (int)blockIdx.x};
                pg8::EpiQKV E{(bf16_t*)(F.ws + WS_Q1), (bf16_t*)(F.ws + WS_K1), (bf16_t*)(F.ws + WS_V1), F.inp(I_QNORM), F.inp(I_KNORM)};
                { const int nU = pg8::build_units(utab, S, F.tid); pg8::gemm_phase<pg8::EpiQKV, false>(F.lds, F.tid, 1024, utab, nU, E, rowtab); } SEAM(10); }
            if (IN(11)) { FRESH_IN();
                if (F.wave >= 4) __builtin_amdgcn_s_setprio(1);
                phase_attention(F); __builtin_amdgcn_s_setprio(0);
                SEAM(11); }
            if (IN(12)) { FRESH_IN(); pg8::SchedPlain S{(const char*)(F.ws + WS_AO), (const char*)(F.ws + WS_WAO), NTOK / 256, 4, 1024, F.G, (int)blockIdx.x};
                pg8::EpiResid<false> E{(const void*)(F.ws + WS_XB), (bf16_t*)(F.ws + WS_XB), (const float*)(F.ws + WS_MOD) + 16 * 6144 + 2048};
                { const int nU = pg8::build_units(utab, S, F.tid); pg8::gemm_phase<pg8::EpiResid<false>, false>(F.lds, F.tid, 1024, utab, nU, E, rowtab); } SEAM(12); }
        }
    }
    if (IN(16)) { FRESH_IN(); phase_final(F, rbs); }
#if defined(PROBE_A) || defined(PROBE_B)
    __syncthreads(); PROBE_STAMP(16);
#if defined(ATT_PROBE) || defined(RET_PROBE)
    if (blockIdx.x == 0) pr_a = __hip_atomic_load((unsigned long long*)(F.ctl + 8400), __ATOMIC_RELAXED, __HIP_MEMORY_SCOPE_AGENT);
#endif
    if (blockIdx.x == 0) { const unsigned long long qa = (pr_a + 500ull) / 1000ull, spin = (PROBE_MUL ? pr_a * PROBE_MUL : qa * 100000ull) + pr_b + PROBE_CONST, t0 = __builtin_amdgcn_s_memrealtime();
        while (__builtin_amdgcn_s_memrealtime() - t0 < spin) __builtin_amdgcn_s_sleep(8); }
#endif
#undef IN
#undef SEAM
#undef gw
#undef NGW
}

extern "C" void kernel_launch(void* const* d_in, const int* in_sizes, int n_in, void* d_out, int out_size, void* d_ws, size_t ws_size, hipStream_t stream) {
    static int grid = 0;
    if (grid == 0) {
        if (n_in != 26 || in_sizes[0] != NTOK * DM || out_size != NTOK * DM || ws_size < WS_END) {
            fprintf(stderr, "kernel_launch: unexpected shapes (n_in %d, in0 %d, out %d, ws %zu < %zu); nothing launched\n", n_in, n_in > 0 ? in_sizes[0] : -1, out_size, ws_size, (size_t)WS_END); grid = -1; return; }
        int dev = 0, cus = 0, per_cu = 0;
        if (hipGetDevice(&dev) != hipSuccess || hipDeviceGetAttribute(&cus, hipDeviceAttributeMultiprocessorCount, dev) != hipSuccess) { grid = -1; return; }
        if (hipFuncSetAttribute((const void*)yoco_fwd, hipFuncAttributeMaxDynamicSharedMemorySize, LDS_BYTES) != hipSuccess) { fprintf(stderr, "kernel_launch: hipFuncSetAttribute failed\n"); grid = -1; return; }
        if (hipOccupancyMaxActiveBlocksPerMultiprocessor(&per_cu, (const void*)yoco_fwd, NTHREADS, LDS_BYTES) != hipSuccess || per_cu < 1) { fprintf(stderr, "kernel_launch: occupancy query says %d blocks per CU\n", per_cu); (void)hipGetLastError(); grid = -1; return; }
        if (cus != 256) { fprintf(stderr, "kernel_launch: built for a 256-CU device (got %d)\n", cus); grid = -1; return; }
        grid = cus;
    }
    if (grid < 0) return;
    (void)hipMemsetAsync((char*)d_ws + WS_CTL, 0, CTL_ZERO_BYTES, stream);
    Args a{};
    for (int i = 0; i < 26; ++i) a.in[i] = (const float*)d_in[i];
    a.out = (float*)d_out; a.ws = (unsigned char*)d_ws;
    if (MK_N_LAUNCHES == 1) { a.ph_lo = 0; a.ph_hi = N_PHASES; hipLaunchKernelGGL(yoco_fwd, dim3(grid), dim3(NTHREADS), LDS_BYTES, stream, a); }
    else { for (int p = 0; p < N_PHASES; ++p) { a.ph_lo = p; a.ph_hi = p + 1; hipLaunchKernelGGL(yoco_fwd, dim3(grid), dim3(NTHREADS), LDS_BYTES, stream, a); } }
}
```

```cpp
#include <hip/hip_runtime.h>
#include <cstdio>
#include <cstdint>

#define LAS __attribute__((address_space(3)))
#define GAS __attribute__((address_space(1)))
typedef unsigned short bf16_t;
typedef short bf16x8 __attribute__((ext_vector_type(8)));
typedef short s16x4 __attribute__((ext_vector_type(4)));
typedef float f32x2 __attribute__((ext_vector_type(2)));
typedef float f32x4 __attribute__((ext_vector_type(4)));
typedef float f32x16 __attribute__((ext_vector_type(16)));
typedef unsigned u32x2 __attribute__((ext_vector_type(2)));
typedef unsigned u32x4 __attribute__((ext_vector_type(4)));

constexpr int NTOK = 32768, DM = 1024, SEQ = 2048, NBATCH = 16;
constexpr float EPS = 1e-6f;
constexpr float LOG2E = 1.4426950408889634f;
constexpr int NWAVES = 8, NTHREADS = 512;

constexpr size_t MiB = 1u << 20;
constexpr size_t WS_CTL = 0, CTL_ZERO_BYTES = 1 * MiB;
constexpr size_t WS_MOD = 1 * MiB;
constexpr size_t WS_KVMOD = WS_MOD + 786432;
constexpr size_t WS_COS = 2 * MiB, WS_SIN = 3 * MiB;
constexpr size_t WS_LIST = 4 * MiB;
constexpr size_t WS_TOKSLOT = 6 * MiB;
constexpr size_t WS_TOKW = 6 * MiB + 512 * 1024;
constexpr size_t WS_WRT = 7 * MiB;
constexpr size_t WS_WIN = 8 * MiB, WS_WRO = 20 * MiB, WS_WKV = 24 * MiB, WS_WQ = 28 * MiB, WS_WAO = 30 * MiB;
constexpr size_t WS_W13 = 32 * MiB, WS_W2 = 96 * MiB;
constexpr size_t WS_W13_L1 = 192 * MiB, WS_W2_L1 = 32 * MiB;
constexpr size_t WS_XB = 128 * MiB;
constexpr size_t WS_SG = WS_XB;
constexpr size_t WS_H = 256 * MiB;
constexpr size_t WS_QR = 320 * MiB, WS_KR = 384 * MiB, WS_VR = 448 * MiB;
constexpr size_t WS_HID = 320 * MiB, WS_YB = 456 * MiB;
constexpr size_t WS_HKV = 320 * MiB, WS_Q1 = 384 * MiB, WS_K1 = 448 * MiB, WS_V1 = 512 * MiB, WS_AO = 320 * MiB;
constexpr size_t WS_END = 592 * MiB;
constexpr int MAXROWS = 69632;

constexpr int CW_BAR = 4096, CW_CNT0 = 8192, CW_CNT1 = 8256, CW_ATTQ = 8320, CW_ADALN = 8384;
constexpr int N_CONV = 16;

constexpr int RING_BYTES = 131072, ROWTAB_OFF = 131072, ROWTAB_BYTES = 16384, MISC_OFF = ROWTAB_OFF + ROWTAB_BYTES, LDS_BYTES = MISC_OFF + 2048;

__device__ __forceinline__ unsigned f2bf(float f) { unsigned u = __builtin_bit_cast(unsigned, f); return (u + 0x7fffu + ((u >> 16) & 1u)) >> 16; }
__device__ __forceinline__ unsigned pk2(float lo, float hi) { unsigned r; asm volatile("v_cvt_pk_bf16_f32 %0, %1, %2" : "=v"(r) : "v"(lo), "v"(hi)); return r; }
__device__ __forceinline__ float bf_lo(unsigned u) { return __builtin_bit_cast(float, u << 16); }
__device__ __forceinline__ float bf_hi(unsigned u) { return __builtin_bit_cast(float, u & 0xffff0000u); }
template <int CTRL> __device__ __forceinline__ float dppf(float v) { return __builtin_bit_cast(float, __builtin_amdgcn_update_dpp(0, __builtin_bit_cast(int, v), CTRL, 0xf, 0xf, true)); }
__device__ __forceinline__ float swap16_add(float a, float b) { asm volatile("s_nop 1\n\tv_permlane16_swap_b32 %0, %1" : "+v"(a), "+v"(b)); return a + b; }
__device__ __forceinline__ float swap32_add(float a, float b) { asm volatile("s_nop 1\n\tv_permlane32_swap_b32 %0, %1" : "+v"(a), "+v"(b)); return a + b; }
__device__ __forceinline__ float sum8(float v) { v += dppf<0xB1>(v); v += dppf<0x4E>(v); v += dppf<0x141>(v); return v; }
__device__ __forceinline__ float wave_sum(float v) { v = sum8(v); v += dppf<0x140>(v); v = swap16_add(v, v); return swap32_add(v, v); }
__device__ __forceinline__ float wave_max(float v) {
#pragma unroll
    for (int o = 1; o < 64; o <<= 1) v = fmaxf(v, __shfl_xor(v, o));
    return v;
}
__device__ __forceinline__ float fast_silu(float x) { return x * __builtin_amdgcn_rcpf(1.0f + __builtin_amdgcn_exp2f(-x * LOG2E)); }
#define LDS_WAIT() asm volatile("s_waitcnt lgkmcnt(0)" ::: "memory")
#define VM_WAIT() asm volatile("s_waitcnt vmcnt(0)" ::: "memory")

#define XB_TMO      128
#define XB_XCNT(j)  (256  + 64 * (j))
#define XB_XSUB(j)  (1280 + 64 * (j))
#define XB_XGEN(j)  (2304 + 64 * (j))
#define XB_TOP      3328
#define XB_TOPGEN   3392
#define XCD_BAR_WORDS 3456
#define XB_SPIN_CAP (1u << 22)
__device__ __forceinline__ unsigned xb_ld(unsigned* p)              { return __hip_atomic_load(p, __ATOMIC_RELAXED, __HIP_MEMORY_SCOPE_AGENT); }
__device__ __forceinline__ unsigned xb_add(unsigned* p, unsigned v) { return __hip_atomic_fetch_add(p, v, __ATOMIC_RELAXED, __HIP_MEMORY_SCOPE_AGENT); }
__device__ __forceinline__ unsigned xb_xcc_id() { return (unsigned)__builtin_amdgcn_s_getreg((3 << 11) | 20) & 0xFu; }
#define XB_SPIN(cond, bar) do { unsigned _sp = 0; while (cond) { __builtin_amdgcn_s_sleep(1); \
    if ((++_sp & 255u) == 0u) { if (xb_ld(&(bar)[XB_TMO])) break; if (_sp > XB_SPIN_CAP) { atomicAdd(&(bar)[XB_TMO], 1u); break; } } } } while (0)
struct XcdBarrier { unsigned* bar; unsigned x; volatile LAS unsigned* st; };
__device__ __forceinline__ XcdBarrier xcd_barrier_post(unsigned* bar, volatile LAS unsigned* st) {
    XcdBarrier b; b.bar = bar; b.x = xb_xcc_id(); b.st = st;
    if (threadIdx.x == 0) (void)xb_add(&bar[XB_XCNT(b.x)], 1u);
    return b;
}
__device__ __forceinline__ void xcd_barrier_complete(unsigned* bar, unsigned x, unsigned& nloc, unsigned& nx) {
    const unsigned G = gridDim.x * gridDim.y * gridDim.z;
    unsigned sum, cnt, mine, sp = 0u;
    for (;;) {
        sum = 0u; cnt = 0u; mine = 0u;
#pragma unroll
        for (unsigned j = 0; j < 16; ++j) { const unsigned c = xb_ld(&bar[XB_XCNT(j)]); sum += c; cnt += (c > 0u) ? 1u : 0u; mine = (j == x) ? c : mine; }
        if (sum == G) break;
        __builtin_amdgcn_s_sleep(1);
        if ((++sp & 255u) == 0u) { if (xb_ld(&bar[XB_TMO])) break; if (sp > XB_SPIN_CAP) { atomicAdd(&bar[XB_TMO], 1u); break; } }
    }
    nloc = mine > 0u ? mine : 1u; nx = cnt > 0u ? cnt : 1u;
}
__device__ __forceinline__ void xcd_barrier(const XcdBarrier& b) {
    asm volatile("s_waitcnt vmcnt(0)" ::: "memory");
    __syncthreads();
    if (threadIdx.x == 0) {
        unsigned* bar = b.bar;
        __builtin_amdgcn_s_waitcnt(0);
        unsigned nloc = b.st[0], nx = b.st[1];
        if (nloc == 0u) { xcd_barrier_complete(bar, b.x, nloc, nx); b.st[0] = nloc; b.st[1] = nx; }
        const unsigned old = xb_add(&bar[XB_XSUB(b.x)], 1u);
        const unsigned gen = old / nloc;
        if (old + 1u == (gen + 1u) * nloc) {
            __builtin_amdgcn_fence(__ATOMIC_RELEASE, "agent");
            asm volatile("s_waitcnt vmcnt(0)" ::: "memory");
            const unsigned og = xb_add(&bar[XB_TOP], 1u);
            const unsigned tg = og / nx;
            if (og + 1u == (tg + 1u) * nx) xb_add(&bar[XB_TOPGEN], 1u);
            else XB_SPIN(xb_ld(&bar[XB_TOPGEN]) == tg, bar);
            __builtin_amdgcn_fence(__ATOMIC_ACQUIRE, "agent");
            xb_add(&bar[XB_XGEN(b.x)], 1u);
            asm volatile("s_waitcnt vmcnt(0)" ::: "memory");
        } else {
            XB_SPIN(xb_ld(&bar[XB_XGEN(b.x)]) == gen, bar);
            __builtin_amdgcn_fence(__ATOMIC_ACQUIRE, "agent");
            asm volatile("s_waitcnt vmcnt(0)" ::: "memory");
        }
    }
    __syncthreads();
}
#ifdef GEMM_PROBE
#ifndef GEMM_PROBE_SEL
#define GEMM_PROBE_SEL 31
#endif
__device__ unsigned long long g_pr;
#endif
namespace pg8 {
constexpr int BM = 256, BK = 64, HALF = 128, HTB = HALF * BK * 2, STAGE_BYTES = 8 * HTB, NXCD = 8, WGM = 8;
__host__ __device__ __forceinline__ int lds_byte(int r, int c) { const int st = (r >> 4) * 2 + (c >> 5), rr = r & 15, cc = c & 31, ob = rr * 64 + cc * 2; return st * 1024 + (ob ^ (((ob >> 9) & 1) << 5)); }
__host__ __device__ __forceinline__ void stage_rc(int b, int& R, int& C) { const int st = b / 1024, sb = b % 1024, swz = sb ^ (((sb >> 9) & 1) << 5); R = (st >> 1) * 16 + swz / 64; C = (st & 1) * 32 + (swz % 64) / 2; }
__host__ __device__ __forceinline__ int perm32(int rho) { const int n = rho >> 4, i = rho & 15; return 8 * (i >> 2) + 4 * n + (i & 3); }

struct Unit { const char* A; const char* B; int pm, pn, rows; };

__device__ __forceinline__ bool static_order(int nM, int nN, int G, int c, int i, int& pm, int& pn) {
    const int nwg = nM * nN; const long L = (long)i * G + c; if (L >= nwg) return false;
    int wgid = (int)L; { const int q = nwg / NXCD, r = nwg % NXCD, xcd = wgid % NXCD, off = wgid / NXCD; wgid = (xcd < r ? xcd * (q + 1) : r * (q + 1) + (xcd - r) * q) + off; }
    const int nig = WGM * nN, gid = wgid / nig, fm = gid * WGM, gsz = (nM - fm) < WGM ? (nM - fm) : WGM;
    pm = fm + ((wgid % nig) % gsz); pn = (wgid % nig) / gsz; return true;
}
__device__ __forceinline__ int xcd_remap(int L, int nwg) { const int q = nwg / NXCD, r = nwg % NXCD, xcd = L % NXCD, off = L / NXCD; return (xcd < r ? xcd * (q + 1) : r * (q + 1) + (xcd - r) * q) + off; }

__device__ __forceinline__ bool load_unit(const LAS int* utab, int nU, int i, Unit& u) {
    if (i >= nU) return false;
    const LAS int* p = utab + i * 8;
    const unsigned alo = __builtin_amdgcn_readfirstlane(p[0]), ahi = __builtin_amdgcn_readfirstlane(p[1]), blo = __builtin_amdgcn_readfirstlane(p[2]), bhi = __builtin_amdgcn_readfirstlane(p[3]);
    u.A = (const char*)(((unsigned long long)ahi << 32) | alo); u.B = (const char*)(((unsigned long long)bhi << 32) | blo);
    u.pm = __builtin_amdgcn_readfirstlane(p[4]); u.pn = __builtin_amdgcn_readfirstlane(p[5]); u.rows = __builtin_amdgcn_readfirstlane(p[6]); return true;
}
template <class Sched>
__device__ __forceinline__ int build_units(LAS int* utab, const Sched& S, const int tid) {
    const int i = tid;
    if (i < 16) { Unit u; const bool ok = S.next(i, u); LAS int* p = utab + i * 8;
        if (ok) { const unsigned long long a = (unsigned long long)u.A, b = (unsigned long long)u.B; p[0] = (int)(unsigned)a; p[1] = (int)(unsigned)(a >> 32); p[2] = (int)(unsigned)b; p[3] = (int)(unsigned)(b >> 32); p[4] = u.pm; p[5] = u.pn; p[6] = u.rows; }
        p[7] = ok ? 1 : 0; }
    __syncthreads();
    int n = 0;
#pragma unroll
    for (int k = 0; k < 16; ++k) n += utab[k * 8 + 7];
    return __builtin_amdgcn_readfirstlane(n);
}
template <class Epi, bool GATHER>
__device__ __forceinline__ void gemm_phase(LAS unsigned char* lds, const int tid, const int K, const LAS int* utab, const int nU, const Epi& E, const LAS int* rowtab) {
    const int wid = __builtin_amdgcn_readfirstlane(tid >> 6), lane = tid & 63, wr = wid >> 2, wc = wid & 3, fr = lane & 15, fq = lane >> 4;
    const int nt = K / BK;
    unsigned vA[2][2], vN[2][2], voffB[2]; int Rr[2], Cc[2];
#pragma unroll
    for (int i = 0; i < 2; ++i) { int R, C; stage_rc(tid * 16 + i * 8192, R, C); const int Rb = Epi::PERM ? ((R & ~31) + perm32(R & 31)) : R; Rr[i] = R; Cc[i] = C;
        voffB[i] = (unsigned)(Rb * K + C) * 2u; }
#define PG8_CALCA(u, v) do { _Pragma("unroll") for (int _h = 0; _h < 2; ++_h) _Pragma("unroll") for (int _i = 0; _i < 2; ++_i) { const int _r = _h * HALF + Rr[_i]; \
        const int _row = GATHER ? rowtab[((u).rows >> 2) + _r] : _r; (v)[_h][_i] = (unsigned)(_row * K + Cc[_i]) * 2u; } } while (0)
    const size_t kstep = (size_t)(BK * 2);
    const size_t hstep = (size_t)HALF * K * 2;
    const unsigned ldsw = (unsigned)wid * 1024u;
    const int aoff = lds_byte(wr * 64 + fr, fq * 8), boff = lds_byte(wc * 32 + fr, fq * 8);
#define PG8_SA(b, h) (((b) * 2 + (h)) * HTB)
#define PG8_SB(b, h) ((4 + (b) * 2 + (h)) * HTB)
#define PG8_STAGE(bufoff, gbase, voff) do { _Pragma("unroll") for (int _i = 0; _i < 2; ++_i) \
        __builtin_amdgcn_global_load_lds((const unsigned*)((const char*)(gbase) + (voff)[_i]), (LAS unsigned*)(lds + (bufoff) + ldsw + _i * 8192), 16, 0, 0); } while (0)
#define PG8_LDA(dst, b, h) do { _Pragma("unroll") for (int m = 0; m < 4; ++m) _Pragma("unroll") for (int k = 0; k < 2; ++k) dst[m][k] = *(const LAS bf16x8*)(lds + PG8_SA(b, h) + aoff + m * 2048 + k * 1024); } while (0)
#define PG8_LDB(dst, b, h) do { _Pragma("unroll") for (int n = 0; n < 2; ++n) _Pragma("unroll") for (int k = 0; k < 2; ++k) dst[n][k] = *(const LAS bf16x8*)(lds + PG8_SB(b, h) + boff + n * 2048 + k * 1024); } while (0)
#define PG8_MMA(ai, bj, At, Bt) do { __builtin_amdgcn_s_setprio(1); _Pragma("unroll") for (int m = 0; m < 4; ++m) _Pragma("unroll") for (int n = 0; n < 2; ++n) _Pragma("unroll") for (int k = 0; k < 2; ++k) \
        acc[ai][bj][m][n] = __builtin_amdgcn_mfma_f32_16x16x32_bf16(Bt[n][k], At[m][k], acc[ai][bj][m][n], 0, 0, 0); __builtin_amdgcn_s_setprio(0); } while (0)
#define PG8_WAIT_V(n) asm volatile("s_waitcnt vmcnt(" #n ")" ::: "memory")
#define PG8_WAIT_L(n) asm volatile("s_waitcnt lgkmcnt(" #n ")" ::: "memory")
#define PG8_BAR __builtin_amdgcn_s_barrier()
#define PG8_SCHED __builtin_amdgcn_sched_barrier(0)
    Unit cur, nxt; int ui = 0;
    if (!load_unit(utab, nU, 0, cur)) return;
    f32x4 acc[2][2][4][2];
#pragma unroll
    for (int a = 0; a < 2; ++a)
#pragma unroll
        for (int b = 0; b < 2; ++b)
#pragma unroll
            for (int m = 0; m < 4; ++m)
#pragma unroll
                for (int n = 0; n < 2; ++n) acc[a][b][m][n] = (f32x4){0.f, 0.f, 0.f, 0.f};
    bf16x8 At[4][2], B0[2][2], B1[2][2];
    const char* cA = cur.A; const char* cB = cur.B;
    PG8_CALCA(cur, vA);
    PG8_STAGE(PG8_SB(0, 0), cB, voffB); PG8_STAGE(PG8_SB(0, 1), cB + hstep, voffB); PG8_STAGE(PG8_SA(0, 0), cA, vA[0]); PG8_STAGE(PG8_SA(0, 1), cA, vA[1]);
    if (wr == 1) PG8_BAR;
    PG8_WAIT_V(2); PG8_BAR;
    PG8_STAGE(PG8_SB(1, 0), cB + kstep, voffB); PG8_STAGE(PG8_SA(1, 0), cA + kstep, vA[0]); PG8_STAGE(PG8_SB(1, 1), cB + hstep + kstep, voffB);
    PG8_WAIT_V(6); PG8_BAR;
    for (;;) {
        const bool has_next = load_unit(utab, nU, ui + 1, nxt);
        const char* nA = has_next ? nxt.A : cA; const char* nB = has_next ? nxt.B : cB;
        if (GATHER) {
            if (has_next) { PG8_CALCA(nxt, vN); }
            else {
#pragma unroll
                for (int h = 0; h < 2; ++h) { vN[h][0] = vA[h][0]; vN[h][1] = vA[h][1]; }
            }
        }
        for (int t = 0; t < nt; t += 2) {
            const bool last = (t == nt - 2);
            const char* a1 = cA + (size_t)(t + 1) * kstep;
            const char* a2 = last ? nA : cA + (size_t)(t + 2) * kstep; const char* b2 = last ? nB : cB + (size_t)(t + 2) * kstep;
            const char* a3 = a2 + kstep; const char* b3 = b2 + kstep;
            unsigned w0[2], w1[2];
#pragma unroll
            for (int i = 0; i < 2; ++i) { w0[i] = (GATHER && last) ? vN[0][i] : vA[0][i]; w1[i] = (GATHER && last) ? vN[1][i] : vA[1][i]; }
            PG8_LDB(B0, 0, 0); PG8_LDB(B1, 0, 1); PG8_SCHED; PG8_LDA(At, 0, 0); PG8_STAGE(PG8_SA(1, 1), a1, vA[1]);
            PG8_WAIT_V(8); PG8_WAIT_L(0); PG8_BAR; PG8_MMA(0, 0, At, B0); PG8_MMA(0, 1, At, B1); PG8_BAR; PG8_SCHED;
            PG8_LDA(At, 0, 1); PG8_STAGE(PG8_SB(0, 0), b2, voffB); PG8_STAGE(PG8_SB(0, 1), b2 + hstep, voffB); PG8_STAGE(PG8_SA(0, 0), a2, w0);
            PG8_WAIT_V(8); PG8_WAIT_L(0); PG8_BAR; PG8_MMA(1, 0, At, B0); PG8_MMA(1, 1, At, B1); PG8_BAR; PG8_SCHED;
            PG8_LDB(B0, 1, 0); PG8_LDB(B1, 1, 1); PG8_SCHED; PG8_LDA(At, 1, 0); PG8_STAGE(PG8_SA(0, 1), a2, w1);
            PG8_WAIT_V(8); PG8_WAIT_L(0); PG8_BAR; PG8_MMA(0, 0, At, B0); PG8_MMA(0, 1, At, B1); PG8_BAR; PG8_SCHED;
            PG8_LDA(At, 1, 1); PG8_STAGE(PG8_SB(1, 0), b3, voffB); PG8_STAGE(PG8_SB(1, 1), b3 + hstep, voffB); PG8_STAGE(PG8_SA(1, 0), a3, w0);
            PG8_WAIT_V(8); PG8_WAIT_L(0); PG8_BAR; PG8_MMA(1, 0, At, B0); PG8_MMA(1, 1, At, B1); PG8_BAR; PG8_SCHED;
        }
#ifdef GEMM_PROBE
        const unsigned long long _g0 = __builtin_amdgcn_s_memrealtime();
#endif
        if (wr == 0) PG8_BAR;
        E(acc, cur, wr, wc, fr, fq);
#ifdef GEMM_PROBE
#if GEMM_PROBE == 2
        asm volatile("s_waitcnt vmcnt(0)" ::: "memory");
#endif
        if (blockIdx.x == 0 && tid == 0 && ((GEMM_PROBE_SEL >> Epi::PID) & 1)) g_pr += __builtin_amdgcn_s_memrealtime() - _g0;
#endif
        if (!has_next) break;
#pragma unroll
        for (int a = 0; a < 2; ++a)
#pragma unroll
            for (int b = 0; b < 2; ++b)
#pragma unroll
                for (int m = 0; m < 4; ++m)
#pragma unroll
                    for (int n = 0; n < 2; ++n) acc[a][b][m][n] = (f32x4){0.f, 0.f, 0.f, 0.f};
        cur = nxt; cA = nA; cB = nB; ++ui;
        if (GATHER) {
#pragma unroll
            for (int h = 0; h < 2; ++h) { vA[h][0] = vN[h][0]; vA[h][1] = vN[h][1]; }
        }
        if (wr == 1) PG8_BAR;
    }
    PG8_WAIT_V(0);
    PG8_BAR;
#undef PG8_CALCA
#undef PG8_SA
#undef PG8_SB
#undef PG8_STAGE
#undef PG8_LDA
#undef PG8_LDB
#undef PG8_MMA
#undef PG8_WAIT_V
#undef PG8_WAIT_L
#undef PG8_BAR
#undef PG8_SCHED
}
}
namespace pg8 {
typedef f32x4 Acc[2][2][4][2];

struct EpiInProj {
    static constexpr bool PERM = true; static constexpr int PID = 0;
    bf16_t *Q, *Kk, *V, *G; const float *cosT, *sinT;
    __device__ __forceinline__ void operator()(const Acc& acc, const Unit& u, int wr, int wc, int fr, int fq) const {
        const int pn = u.pn, row0 = u.pm * BM + wr * 64 + fr;
        if (pn < 8) {
            const int head = pn & 3; const bool isk = pn >= 4;
            const float lg = __builtin_log2f(1.0f - __builtin_exp2f(-5.0f - (float)head));
            bf16_t* out = isk ? Kk : Q;
            const int j0 = wc * 32 + 8 * fq;
            const int pos0 = row0 & (SEQ - 1);
            f32x4 cb[2][2], sb[2][2], cst[2], sst[2];
#pragma unroll
            for (int n = 0; n < 2; ++n) {
#pragma unroll
                for (int ai = 0; ai < 2; ++ai) { cb[ai][n] = *(const f32x4*)(cosT + (pos0 + ai * HALF) * 128 + j0 + 4 * n); sb[ai][n] = *(const f32x4*)(sinT + (pos0 + ai * HALF) * 128 + j0 + 4 * n); }
                cst[n] = *(const f32x4*)(cosT + 16 * 128 + j0 + 4 * n); sst[n] = *(const f32x4*)(sinT + 16 * 128 + j0 + 4 * n); }
#pragma unroll
            for (int ai = 0; ai < 2; ++ai) {
                f32x4 c4[2] = {cb[ai][0], cb[ai][1]}, s4[2] = {sb[ai][0], sb[ai][1]};
#pragma unroll
                for (int m = 0; m < 4; ++m) {
                    const int row = row0 + ai * HALF + m * 16, pos = row & (SEQ - 1), nn = pos & 63;
                    const float sc = isk ? __builtin_exp2f(-(float)nn * lg) * 0.0625f : __builtin_exp2f((float)nn * lg);
                    u32x4 w1, w2;
#pragma unroll
                    for (int n = 0; n < 2; ++n) {
                        const f32x4 x1 = acc[ai][0][m][n], x2 = acc[ai][1][m][n];
                        const f32x4 o1 = (x1 * c4[n] - x2 * s4[n]) * sc, o2 = (x2 * c4[n] + x1 * s4[n]) * sc;
                        w1[2 * n] = pk2(o1[0], o1[1]); w1[2 * n + 1] = pk2(o1[2], o1[3]); w2[2 * n] = pk2(o2[0], o2[1]); w2[2 * n + 1] = pk2(o2[2], o2[3]);
                        if (m < 3) { const f32x4 cn = c4[n] * cst[n] - s4[n] * sst[n], sn = s4[n] * cst[n] + c4[n] * sst[n]; c4[n] = cn; s4[n] = sn; }
                    }
                    bf16_t* p = out + (size_t)row * 1024 + head * 256 + j0;
                    *(u32x4*)p = w1; *(u32x4*)(p + 128) = w2;
                }
            }
        } else {
            const bool isg = pn >= 16; bf16_t* out = isg ? G : V; const int col0 = (isg ? pn - 16 : pn - 8) * 256 + wc * 32 + 8 * fq;
#pragma unroll
            for (int ai = 0; ai < 2; ++ai)
#pragma unroll
                for (int m = 0; m < 4; ++m) { bf16_t* rowp = out + (size_t)(row0 + ai * HALF + m * 16) * 2048 + col0;
#pragma unroll
                    for (int bj = 0; bj < 2; ++bj) { f32x4 v0 = acc[ai][bj][m][0], v1 = acc[ai][bj][m][1];
                        if (isg) {
#pragma unroll
                            for (int e = 0; e < 4; ++e) { v0[e] = fast_silu(v0[e]); v1[e] = fast_silu(v1[e]); } }
                        u32x4 w; w.x = pk2(v0[0], v0[1]); w.y = pk2(v0[2], v0[3]); w.z = pk2(v1[0], v1[1]); w.w = pk2(v1[2], v1[3]);
                        *(u32x4*)(rowp + bj * HALF) = w; } }
        }
    }
};
struct EpiMoeUp {
    static constexpr bool PERM = true; static constexpr int PID = 1;
    bf16_t* O;
    __device__ __forceinline__ void operator()(const Acc& acc, const Unit& u, int wr, int wc, int fr, int fq) const {
        const int row0 = u.pm * BM + wr * 64 + fr, col0 = u.pn * 128 + wc * 32 + 8 * fq;
#pragma unroll
        for (int ai = 0; ai < 2; ++ai)
#pragma unroll
            for (int m = 0; m < 4; ++m) {
                f32x4 v0 = acc[ai][0][m][0], v1 = acc[ai][0][m][1]; const f32x4 g0 = acc[ai][1][m][0], g1 = acc[ai][1][m][1];
#pragma unroll
                for (int e = 0; e < 4; ++e) { v0[e] = fast_silu(v0[e]) * g0[e]; v1[e] = fast_silu(v1[e]) * g1[e]; }
                u32x4 w; w.x = pk2(v0[0], v0[1]); w.y = pk2(v0[2], v0[3]); w.z = pk2(v1[0], v1[1]); w.w = pk2(v1[2], v1[3]);
                *(u32x4*)(O + (size_t)(row0 + ai * HALF + m * 16) * 1024 + col0) = w;
            }
    }
};
struct EpiBf16 {
    static constexpr bool PERM = true; static constexpr int PID = 2;
    bf16_t* O; int ldc;
    __device__ __forceinline__ void operator()(const Acc& acc, const Unit& u, int wr, int wc, int fr, int fq) const {
        const int row0 = u.pm * BM + wr * 64 + fr, col0 = u.pn * BM + wc * 32 + 8 * fq;
#pragma unroll
        for (int ai = 0; ai < 2; ++ai)
#pragma unroll
            for (int m = 0; m < 4; ++m) { bf16_t* rowp = O + (size_t)(row0 + ai * HALF + m * 16) * ldc + col0;
#pragma unroll
                for (int bj = 0; bj < 2; ++bj) { const f32x4 v0 = acc[ai][bj][m][0], v1 = acc[ai][bj][m][1];
                    u32x4 w; w.x = pk2(v0[0], v0[1]); w.y = pk2(v0[2], v0[3]); w.z = pk2(v1[0], v1[1]); w.w = pk2(v1[2], v1[3]);
                    *(u32x4*)(rowp + bj * HALF) = w; } }
    }
};
template <bool BASE_F32>
struct EpiResid {
    static constexpr bool PERM = true; static constexpr int PID = 3;
    const void* base; bf16_t* out; const float* gate;
    __device__ __forceinline__ void operator()(const Acc& acc, const Unit& u, int wr, int wc, int fr, int fq) const {
        const int row0 = u.pm * BM + wr * 64 + fr, col0 = u.pn * BM + wc * 32 + 8 * fq;
        const float* gp = gate + (size_t)((u.pm * BM) / SEQ) * 6144 + col0;
        f32x4 gv[2][2];
#pragma unroll
        for (int bj = 0; bj < 2; ++bj)
#pragma unroll
            for (int n = 0; n < 2; ++n) gv[bj][n] = *(const f32x4*)(gp + bj * HALF + n * 4);
        if (BASE_F32) {
#pragma unroll
            for (int ai = 0; ai < 2; ++ai) { f32x4 b[4][2][2];
#pragma unroll
                for (int m = 0; m < 4; ++m)
#pragma unroll
                    for (int bj = 0; bj < 2; ++bj) { const float* bp = (const float*)base + (size_t)(row0 + ai * HALF + m * 16) * 1024 + col0 + bj * HALF; b[m][bj][0] = *(const f32x4*)bp; b[m][bj][1] = *(const f32x4*)(bp + 4); }
                asm volatile("" ::: "memory");
#pragma unroll
                for (int m = 0; m < 4; ++m)
#pragma unroll
                    for (int bj = 0; bj < 2; ++bj) { const size_t off = (size_t)(row0 + ai * HALF + m * 16) * 1024 + col0 + bj * HALF;
                        const f32x4 v0 = b[m][bj][0] + gv[bj][0] * acc[ai][bj][m][0], v1 = b[m][bj][1] + gv[bj][1] * acc[ai][bj][m][1];
                        u32x4 w; w.x = pk2(v0[0], v0[1]); w.y = pk2(v0[2], v0[3]); w.z = pk2(v1[0], v1[1]); w.w = pk2(v1[2], v1[3]);
                        *(u32x4*)(out + off) = w; }
                asm volatile("" ::: "memory"); }
        } else {
            u32x4 q[2][4][2];
#pragma unroll
            for (int ai = 0; ai < 2; ++ai)
#pragma unroll
                for (int m = 0; m < 4; ++m)
#pragma unroll
                    for (int bj = 0; bj < 2; ++bj) q[ai][m][bj] = *(const u32x4*)((const bf16_t*)base + (size_t)(row0 + ai * HALF + m * 16) * 1024 + col0 + bj * HALF);
            asm volatile("" ::: "memory");
#pragma unroll
            for (int ai = 0; ai < 2; ++ai)
#pragma unroll
                for (int m = 0; m < 4; ++m)
#pragma unroll
                    for (int bj = 0; bj < 2; ++bj) { const size_t off = (size_t)(row0 + ai * HALF + m * 16) * 1024 + col0 + bj * HALF; const u32x4 qq = q[ai][m][bj];
                        const f32x4 b0 = (f32x4){bf_lo(qq.x), bf_hi(qq.x), bf_lo(qq.y), bf_hi(qq.y)}, b1 = (f32x4){bf_lo(qq.z), bf_hi(qq.z), bf_lo(qq.w), bf_hi(qq.w)};
                        const f32x4 v0 = b0 + gv[bj][0] * acc[ai][bj][m][0], v1 = b1 + gv[bj][1] * acc[ai][bj][m][1];
                        u32x4 w; w.x = pk2(v0[0], v0[1]); w.y = pk2(v0[2], v0[3]); w.z = pk2(v1[0], v1[1]); w.w = pk2(v1[2], v1[3]);
                        *(u32x4*)(out + off) = w; }
        }
    }
};
struct EpiQKV {
    static constexpr bool PERM = true; static constexpr int PID = 4;
    bf16_t *Q, *Kk, *V; const float *qn, *kn;
    __device__ __forceinline__ void operator()(const Acc& acc, const Unit& u, int wr, int wc, int fr, int fq) const {
        const int pn = u.pn, row0 = u.pm * BM + wr * 64 + fr;
        if (pn < 8) {
            const bool isk = pn >= 4; bf16_t* out = isk ? Kk : Q; const float* gn = isk ? kn : qn; const float osc = isk ? 1.0f : 0.125f * LOG2E;
            const int col0 = (pn & 3) * 256 + 64 * wc + 8 * fq;
            f32x4 gq[2][2];
#pragma unroll
            for (int bj = 0; bj < 2; ++bj) { gq[bj][0] = *(const f32x4*)(gn + 32 * bj + 8 * fq); gq[bj][1] = *(const f32x4*)(gn + 32 * bj + 8 * fq + 4); }
#pragma unroll
            for (int ai = 0; ai < 2; ++ai)
#pragma unroll
                for (int m = 0; m < 4; ++m) {
                    float ss = 0.f;
#pragma unroll
                    for (int bj = 0; bj < 2; ++bj)
#pragma unroll
                        for (int n = 0; n < 2; ++n) { const f32x4 x = acc[ai][bj][m][n]; ss += (x[0] * x[0] + x[1] * x[1]) + (x[2] * x[2] + x[3] * x[3]); }
                    ss = swap16_add(ss, ss); ss = swap32_add(ss, ss);
                    const float rstd = __builtin_amdgcn_rsqf(ss * (1.0f / 64.0f) + EPS) * osc;
                    bf16_t* rowp = out + (size_t)(row0 + ai * HALF + m * 16) * 1024 + col0;
#pragma unroll
                    for (int bj = 0; bj < 2; ++bj) { const f32x4 g0 = gq[bj][0], g1 = gq[bj][1];
                        const f32x4 v0 = acc[ai][bj][m][0] * rstd * g0, v1 = acc[ai][bj][m][1] * rstd * g1;
                        u32x4 w; w.x = pk2(v0[0], v0[1]); w.y = pk2(v0[2], v0[3]); w.z = pk2(v1[0], v1[1]); w.w = pk2(v1[2], v1[3]);
                        *(u32x4*)(rowp + 32 * bj) = w; }
                    asm volatile("" ::: "memory");
                }
        } else {
            const int col0 = (pn - 8) * 256 + wc * 32 + 8 * fq;
#pragma unroll
            for (int ai = 0; ai < 2; ++ai)
#pragma unroll
                for (int m = 0; m < 4; ++m) { bf16_t* rowp = V + (size_t)(row0 + ai * HALF + m * 16) * 1024 + col0;
#pragma unroll
                    for (int bj = 0; bj < 2; ++bj) { const f32x4 v0 = acc[ai][bj][m][0], v1 = acc[ai][bj][m][1];
                        u32x4 w; w.x = pk2(v0[0], v0[1]); w.y = pk2(v0[2], v0[3]); w.z = pk2(v1[0], v1[1]); w.w = pk2(v1[2], v1[3]);
                        *(u32x4*)(rowp + bj * HALF) = w; } }
        }
    }
};

struct SchedPlain {
    const char *A, *B; int nM, nN, K, G, c;
    __device__ __forceinline__ bool next(int i, Unit& u) const { int pm, pn; if (!static_order(nM, nN, G, c, i, pm, pn)) return false;
        u.pm = pm; u.pn = pn; u.rows = 0; u.A = A + (size_t)pm * BM * K * 2; u.B = B + (size_t)pn * BM * K * 2; return true; }
};
struct SchedQKV {
    const char *Aq, *Akv, *Bq, *Bkv; int G, c;
    __device__ __forceinline__ bool next(int i, Unit& u) const { int pm, pn; if (!static_order(NTOK / BM, 12, G, c, i, pm, pn)) return false;
        u.pm = pm; u.pn = pn; u.rows = 0; const size_t ts = (size_t)BM * 1024 * 2;
        u.A = (pn < 4 ? Aq : Akv) + (size_t)pm * ts; u.B = pn < 4 ? Bq + (size_t)pn * ts : Bkv + (size_t)(pn - 4) * ts; return true; }
};
struct SchedMoe {
    const char *A, *B; const LAS int* rbs; int NT, G, c, gather; size_t estride;
    __device__ __forceinline__ bool next(int i, Unit& u) const {
        const int nrb = rbs[16], nwg = nrb * NT; const long L = (long)i * G + c; if (L >= nwg) return false;
        const int wg = xcd_remap((int)L, nwg), rb = wg / NT, pn = wg % NT;
        int e = 0;
#pragma unroll
        for (int k = 1; k < 16; ++k) e += (rb >= rbs[k]) ? 1 : 0;
        u.pm = rb; u.pn = pn; u.rows = i * 1024;
        u.A = gather ? A : A + (size_t)rb * BM * 1024 * 2; u.B = B + (size_t)e * estride + (size_t)pn * BM * 1024 * 2; return true; }
};
}
typedef __attribute__((address_space(4))) const unsigned long long* kargp_t;
struct Frame {
    LAS unsigned char* lds;
    unsigned* ctl;
    int tid, lane, wave, vcu, G;
    unsigned char* ws;
    kargp_t kin;
    __device__ __forceinline__ const float* inp(int i) const { return (const float*)(const GAS float*)kin[i]; }
    float* out;
};
enum { I_X = 0, I_C, I_ADAW, I_ADAB, I_NMIX, I_NFFN, I_RWIN, I_RGN, I_RWOUT, I_KVADAW, I_KVADAB, I_KVNORM, I_KVW, I_KNORM, I_WQ, I_QNORM, I_LAM, I_SUBLN, I_WOUT,
       I_WG, I_BG, I_WE, I_BE, I_W1, I_W3, I_W2 };

__device__ __forceinline__ int dest_row(int n, int mode) {
    if (mode == 1) { const int c = n & 255; return (n & ~255) + 128 * ((c >> 5) & 1) + 32 * (c >> 6) + (c & 31); }
    if (mode == 2) return (n >> 7) * 256 + (n & 127);
    if (mode == 3) return (n >> 7) * 256 + 128 + (n & 127);
    return n;
}
struct TItem { const float* W; bf16_t* WT; int K, N, mode, item; };
__device__ __forceinline__ void titem_load(const TItem& it, f32x4 (&v)[16], int lane) {
    const int nblk = it.N / 64, kb = it.item / nblk, nb = it.item % nblk, k0 = 64 * kb, n0 = 64 * nb;
    const float* p = it.W + (size_t)(k0 + (lane >> 4)) * it.N + n0 + 4 * (lane & 15);
#pragma unroll
    for (int i = 0; i < 16; ++i) v[i] = *(const f32x4*)(p + (size_t)(4 * i) * it.N);
}
__device__ __forceinline__ void titem_store(const TItem& it, const f32x4 (&v)[16], LAS float* scr, int lane) {
    const int nblk = it.N / 64, kb = it.item / nblk, nb = it.item % nblk, k0 = 64 * kb, n0 = 64 * nb;
#pragma unroll
    for (int i = 0; i < 16; ++i) *(LAS f32x4*)(scr + (4 * i + (lane >> 4)) * 68 + 4 * (lane & 15)) = v[i];
    LDS_WAIT(); asm volatile("" ::: "memory");
    const int d = dest_row(n0 + (lane & 32), it.mode) + (lane & 31);
    bf16_t* op = it.WT + (size_t)d * it.K + k0;
#pragma unroll 2
    for (int c = 0; c < 8; ++c) { const LAS float* s = scr + (8 * c) * 68 + lane;
        u32x4 o; o.x = pk2(s[0 * 68], s[1 * 68]); o.y = pk2(s[2 * 68], s[3 * 68]); o.z = pk2(s[4 * 68], s[5 * 68]); o.w = pk2(s[6 * 68], s[7 * 68]);
        *(u32x4*)(op + 8 * c) = o; }
    LDS_WAIT(); asm volatile("" ::: "memory");
}
__device__ __forceinline__ void thalf_load(const TItem& it, int half, f32x4 (&v)[8], int lane) {
    const int nblk = it.N / 64, kb = it.item / nblk, nb = it.item % nblk, k0 = 64 * kb + 32 * half, n0 = 64 * nb;
    const float* p = it.W + (size_t)(k0 + (lane >> 4)) * it.N + n0 + 4 * (lane & 15);
#pragma unroll
    for (int i = 0; i < 8; ++i) v[i] = *(const f32x4*)(p + (size_t)(4 * i) * it.N);
}
__device__ __forceinline__ void thalf_store(const TItem& it, int half, const f32x4 (&v)[8], LAS float* scr, int lane) {
    const int nblk = it.N / 64, kb = it.item / nblk, nb = it.item % nblk, k0 = 64 * kb + 32 * half, n0 = 64 * nb;
#pragma unroll
    for (int i = 0; i < 8; ++i) *(LAS f32x4*)(scr + (4 * i + (lane >> 4)) * 68 + 4 * (lane & 15)) = v[i];
    LDS_WAIT(); asm volatile("" ::: "memory");
    const int d = dest_row(n0 + (lane & 32), it.mode) + (lane & 31);
    bf16_t* op = it.WT + (size_t)d * it.K + k0;
#pragma unroll 2
    for (int c = 0; c < 4; ++c) { const LAS float* s = scr + (8 * c) * 68 + lane;
        u32x4 o; o.x = pk2(s[0 * 68], s[1 * 68]); o.y = pk2(s[2 * 68], s[3 * 68]); o.z = pk2(s[4 * 68], s[5 * 68]); o.w = pk2(s[6 * 68], s[7 * 68]);
        *(u32x4*)(op + 8 * c) = o; }
    LDS_WAIT(); asm volatile("" ::: "memory");
}
__device__ __forceinline__ TItem moe_item(Frame& F, int layer, int it) {
    constexpr int IPM = 256;
    int e, which, item;
    if (layer == 0) { e = it / (3 * IPM); const int r = it % (3 * IPM); which = r / IPM; item = r % IPM; }
    else if (it < 32 * IPM) { e = it / (2 * IPM); const int r = it % (2 * IPM); which = r / IPM; item = r % IPM; }
    else { const int j = it - 32 * IPM; e = j / IPM; which = 2; item = j % IPM; }
    const size_t wo = ((size_t)layer * 16 + e) * 1048576;
    bf16_t* w13 = (bf16_t*)(F.ws + (layer ? WS_W13_L1 : WS_W13)); bf16_t* w2 = (bf16_t*)(F.ws + (layer ? WS_W2_L1 : WS_W2));
    TItem t; t.K = 1024; t.N = 1024; t.item = item;
    if (which == 0) { t.W = F.inp(I_W1) + wo; t.WT = w13 + (size_t)e * 2097152; t.mode = 2; }
    else if (which == 1) { t.W = F.inp(I_W3) + wo; t.WT = w13 + (size_t)e * 2097152; t.mode = 3; }
    else { t.W = F.inp(I_W2) + wo; t.WT = w2 + (size_t)e * 1048576; t.mode = 0; }
    return t;
}
__device__ __forceinline__ TItem dense_item(Frame& F, int it) {
    constexpr int I_IN = 16 * 96, I_RO = 32 * 16, I_KV = 16 * 32, I_Q = 256;
    TItem t; int r = it;
    if (r < I_IN) { t.W = F.inp(I_RWIN); t.WT = (bf16_t*)(F.ws + WS_WIN); t.K = 1024; t.N = 6144; t.mode = 0; t.item = r; return t; } r -= I_IN;
    if (r < I_RO) { t.W = F.inp(I_RWOUT); t.WT = (bf16_t*)(F.ws + WS_WRO); t.K = 2048; t.N = 1024; t.mode = 0; t.item = r; return t; } r -= I_RO;
    if (r < I_KV) { t.W = F.inp(I_KVW); t.WT = (bf16_t*)(F.ws + WS_WKV); t.K = 1024; t.N = 2048; t.mode = (r % 32) < 16 ? 1 : 0; t.item = r; return t; } r -= I_KV;
    if (r < I_Q) { t.W = F.inp(I_WQ); t.WT = (bf16_t*)(F.ws + WS_WQ); t.K = 1024; t.N = 1024; t.mode = 1; t.item = r; return t; } r -= I_Q;
    t.W = F.inp(I_WOUT); t.WT = (bf16_t*)(F.ws + WS_WAO); t.K = 1024; t.N = 1024; t.mode = 0; t.item = r; return t;
}
constexpr int N_DENSE_ITEMS = 16 * 96 + 32 * 16 + 16 * 32 + 256 + 256, N_MOE_ITEMS = 16 * 3 * 256;
__device__ __forceinline__ void convert_weights(Frame& F, int layer, bool with_dense, bool with_moe, int gw, int NGW, int end = 1 << 30) {
    LAS float* scr = (LAS float*)(F.lds + F.wave * 17408);
    const int nd = with_dense ? N_DENSE_ITEMS : 0, total0 = nd + (with_moe ? N_MOE_ITEMS : 0), total = end < total0 ? end : total0;
    int it = gw; if (it >= total) return;
    TItem cur = it < nd ? dense_item(F, it) : moe_item(F, layer, it - nd);
    f32x4 va[16], vb[16];
    titem_load(cur, va, F.lane);
    for (;;) {
        const int itn = it + NGW; const bool more = itn < total;
        TItem nxt = cur;
        if (more) { nxt = itn < nd ? dense_item(F, itn) : moe_item(F, layer, itn - nd); titem_load(nxt, vb, F.lane); }
        titem_store(cur, va, scr, F.lane);
        if (!more) break;
        const int itn2 = itn + NGW; const bool more2 = itn2 < total;
        if (more2) { cur = itn2 < nd ? dense_item(F, itn2) : moe_item(F, layer, itn2 - nd); titem_load(cur, va, F.lane); }
        titem_store(nxt, vb, scr, F.lane);
        if (!more2) break;
        it = itn2;
    }
}
#ifndef TQ7
#define TQ7 3
#endif
#ifndef TQ8
#define TQ8 3
#endif
constexpr int TAILQ7 = TQ7, TAILQ8 = TQ8;
static_assert(TAILQ7 * NWAVES * 255 <= 8192, "the MoE-up tail may only convert w1 / w3 items");
__device__ __forceinline__ int tail_idle(int nrb, int NT) { const int rem = (nrb * NT) & 255; return rem ? 256 - rem : 0; }
__device__ __forceinline__ int tail_base(int nrb, int which) {
    int n = 0; if (which >= 1) n += tail_idle(nrb, 8) * NWAVES * TAILQ7; if (which >= 2) n += tail_idle(nrb, 4) * NWAVES * TAILQ8; return n < N_MOE_ITEMS ? n : N_MOE_ITEMS; }
__device__ __forceinline__ void tail_convert(Frame& F, const LAS int* rbs, int NT, int which) {
    const int nrb = rbs[16], rem = (nrb * NT) & 255; if (rem == 0 || (int)blockIdx.x < rem) return;
    const int Q = which ? TAILQ8 : TAILQ7, s0 = tail_base(nrb, which) + (((int)blockIdx.x - rem) * NWAVES + F.wave) * Q;
    convert_weights(F, 1, false, true, s0, 1, s0 + Q);
}
__device__ __forceinline__ void adaln_phase(Frame& F) {
    LAS float* cs = (LAS float*)F.lds;
    LAS float* red = (LAS float*)(F.lds + 65536);
    constexpr int NTASK = (2 * 6144 + 2048) / 64;
    if ((int)blockIdx.x >= NTASK) return;
    { const float* cp = F.inp(I_C) + F.tid; float cvv[32];
#pragma unroll
      for (int i = 0; i < 32; ++i) cvv[i] = cp[i * NTHREADS];
#pragma unroll
      for (int i = 0; i < 32; ++i) cs[i * NTHREADS + F.tid] = cvv[i] / (1.0f + __expf(-cvv[i])); }
    __syncthreads();
    for (int task = blockIdx.x; task < NTASK; task += F.G) {
        const int gc = task * 64; const float* W; const float* bias; float* outp; int N, c0, ostride;
        if (gc < 6144) { W = F.inp(I_ADAW); bias = F.inp(I_ADAB); N = 6144; c0 = gc; outp = (float*)(F.ws + WS_MOD); ostride = 6144; }
        else if (gc < 12288) { W = F.inp(I_ADAW) + (size_t)1024 * 6144; bias = F.inp(I_ADAB) + 6144; N = 6144; c0 = gc - 6144; outp = (float*)(F.ws + WS_MOD) + 16 * 6144; ostride = 6144; }
        else { W = F.inp(I_KVADAW); bias = F.inp(I_KVADAB); N = 2048; c0 = gc - 12288; outp = (float*)(F.ws + WS_KVMOD); ostride = 2048; }
        float acc[16];
#pragma unroll
        for (int b = 0; b < 16; ++b) acc[b] = 0.f;
        const int k0 = F.wave * 128;
        {
            const int k = k0; float w[128];
            const GAS float* wp = (const GAS float*)(W + (size_t)k * N + c0 + F.lane);
#pragma unroll
            for (int j = 0; j < 128; ++j) { w[j] = *wp; wp += N; asm volatile("" : "+v"(wp)); }
#pragma unroll
            for (int j4 = 0; j4 < 32; ++j4) { asm volatile("" ::: "memory");
#pragma unroll
                for (int b = 0; b < 16; ++b) { const f32x4 c4 = *(const LAS f32x4*)(cs + b * 1024 + k + 4 * j4); acc[b] += c4[0] * w[4 * j4] + c4[1] * w[4 * j4 + 1] + c4[2] * w[4 * j4 + 2] + c4[3] * w[4 * j4 + 3]; } }
        }
#pragma unroll
        for (int b = 0; b < 16; ++b) red[(F.wave * 16 + b) * 64 + F.lane] = acc[b];
        __syncthreads();
        for (int o = F.tid; o < 1024; o += NTHREADS) { const int b = o >> 6, col = o & 63; float s = 0.f;
#pragma unroll
            for (int w = 0; w < 8; ++w) s += red[(w * 16 + b) * 64 + col];
            outp[(size_t)b * ostride + c0 + col] = s + bias[c0 + col]; }
        __syncthreads();
    }
}
__device__ __forceinline__ void rope_table(Frame& F, int gt, int NGT) {
    float* ct = (float*)(F.ws + WS_COS); float* st = (float*)(F.ws + WS_SIN);
    for (int i = gt; i < 2048 * 128; i += NGT) { const int pos = i >> 7, j = i & 127;
        const float inv = 1.0f / powf(10000.0f, (float)j * (1.0f / 128.0f)); const float ang = (float)pos * inv;
        const float kq = rintf(ang * 0.15915494309189535f); float rr = fmaf(-kq, 6.28318548202514648f, ang); rr = fmaf(-kq, -1.74845553e-07f, rr);
        const float rev = rr * 0.15915494309189535f; ct[i] = __builtin_amdgcn_cosf(rev); st[i] = __builtin_amdgcn_sinf(rev); }
    float* wrt = (float*)(F.ws + WS_WRT);
    for (int i = gt; i < 2 * 20 * 1024; i += NGT) { const int l = i / 20480, r = i % 20480, q = r >> 10, k = r & 1023;
        wrt[i] = q < 4 ? F.inp(I_WG)[(size_t)l * 4096 + k * 4 + q] : F.inp(I_WE)[(size_t)l * 16384 + k * 16 + (q - 4)]; }
}

struct Row16 { f32x4 v[4]; };
__device__ __forceinline__ void row_load(Row16& r, const float* p, int lane) {
#pragma unroll
    for (int j = 0; j < 4; ++j) r.v[j] = ((const f32x4*)p)[64 * j + lane];
}
__device__ __forceinline__ void row_load_bf16(Row16& r, const bf16_t* p, int lane) {
#pragma unroll
    for (int j = 0; j < 4; ++j) { const u32x2 q = ((const u32x2*)p)[64 * j + lane]; r.v[j] = (f32x4){bf_lo(q.x), bf_hi(q.x), bf_lo(q.y), bf_hi(q.y)}; }
}
__device__ __forceinline__ void row_store_bf16(const Row16& r, bf16_t* p, int lane) {
#pragma unroll
    for (int j = 0; j < 4; ++j) { u32x2 w; w.x = pk2(r.v[j][0], r.v[j][1]); w.y = pk2(r.v[j][2], r.v[j][3]); ((u32x2*)p)[64 * j + lane] = w; }
}
__device__ __forceinline__ float row_sumsq(const Row16& r) { float s = 0.f;
#pragma unroll
    for (int j = 0; j < 4; ++j) s += (r.v[j][0] * r.v[j][0] + r.v[j][1] * r.v[j][1]) + (r.v[j][2] * r.v[j][2] + r.v[j][3] * r.v[j][3]);
    return wave_sum(s); }
__device__ __forceinline__ void row_norm_mod_store(const Row16& r, float rstd, const float* g, const float* shift, const float* scale, bf16_t* outp, int lane) {
#pragma unroll
    for (int j = 0; j < 4; ++j) { const int c = 64 * j + lane; const f32x4 gg = ((const f32x4*)g)[c], sh = ((const f32x4*)shift)[c], sc = ((const f32x4*)scale)[c];
        const f32x4 h = (r.v[j] * rstd * gg) * (sc + 1.0f) + sh; u32x2 w; w.x = pk2(h[0], h[1]); w.y = pk2(h[2], h[3]); ((u32x2*)outp)[c] = w; }
}
struct ModVec { f32x4 A[4], B[4]; };
__device__ __forceinline__ void modvec_load(ModVec& m, const float* g, const float* shift, const float* scale, int lane) {
#pragma unroll
    for (int j = 0; j < 4; ++j) { const int c = 64 * j + lane; m.A[j] = ((const f32x4*)g)[c] * (((const f32x4*)scale)[c] + 1.0f); m.B[j] = ((const f32x4*)shift)[c]; }
}
__device__ __forceinline__ void row_mod_store(const Row16& r, float rstd, const ModVec& m, bf16_t* outp, int lane) {
#pragma unroll
    for (int j = 0; j < 4; ++j) { const f32x4 h = r.v[j] * rstd * m.A[j] + m.B[j]; u32x2 w; w.x = pk2(h[0], h[1]); w.y = pk2(h[2], h[3]); ((u32x2*)outp)[64 * j + lane] = w; }
}
__device__ __forceinline__ void phase_h0(Frame& F) {
    const int gw = F.vcu * NWAVES + F.wave, NGW = F.G * NWAVES; const float* mod = (const float*)(F.ws + WS_MOD); bf16_t* H = (bf16_t*)(F.ws + WS_H);
    for (int t0 = gw * 16; t0 < NTOK; t0 += NGW * 16) { const int b = t0 / SEQ; ModVec m; modvec_load(m, F.inp(I_NMIX), mod + b * 6144, mod + b * 6144 + 1024, F.lane);
#pragma unroll 1
        for (int i = 0; i < 16; i += 4) { Row16 r[4];
#pragma unroll
            for (int u = 0; u < 4; ++u) row_load(r[u], F.inp(I_X) + (size_t)(t0 + i + u) * 1024, F.lane);
#pragma unroll
            for (int u = 0; u < 4; ++u) { const float rstd = __builtin_amdgcn_rsqf(row_sumsq(r[u]) * (1.0f / 1024.0f) + EPS); row_mod_store(r[u], rstd, m, H + (size_t)(t0 + i + u) * 1024, F.lane); } } }
}
__device__ __forceinline__ void phase_gate(Frame& F) {
    const int gw = F.vcu * NWAVES + F.wave, NGW = F.G * NWAVES; bf16_t* O = (bf16_t*)(F.ws + WS_VR); const bf16_t* SG = (const bf16_t*)(F.ws + WS_SG); const float* gn = F.inp(I_RGN);
    for (int t0 = gw; t0 < NTOK; t0 += 2 * NGW) {
        u32x4 o2[2][4], g2[2][4];
#pragma unroll
        for (int u = 0; u < 2; ++u)
#pragma unroll
            for (int j = 0; j < 4; ++j) { const size_t t = t0 + u * NGW; o2[u][j] = ((const u32x4*)(O + t * 2048))[64 * j + F.lane]; g2[u][j] = ((const u32x4*)(SG + t * 2048))[64 * j + F.lane]; }
#pragma unroll
        for (int u = 0; u < 2; ++u) { const size_t t = t0 + u * NGW;
#pragma unroll
        for (int j = 0; j < 4; ++j) {
            float ov[8]; float ss = 0.f;
#pragma unroll
            for (int e = 0; e < 4; ++e) { ov[2 * e] = bf_lo(o2[u][j][e]); ov[2 * e + 1] = bf_hi(o2[u][j][e]); ss += ov[2 * e] * ov[2 * e] + ov[2 * e + 1] * ov[2 * e + 1]; }
            const float rstd = __builtin_amdgcn_rsqf(wave_sum(ss) * (1.0f / 512.0f) + EPS);
            const f32x4 g0 = ((const f32x4*)gn)[2 * (64 * j + F.lane)], g1 = ((const f32x4*)gn)[2 * (64 * j + F.lane) + 1];
            u32x4 w;
#pragma unroll
            for (int e = 0; e < 4; ++e) { const float ga = e < 2 ? g0[2 * e] : g1[2 * e - 4], gb = e < 2 ? g0[2 * e + 1] : g1[2 * e - 3];
                w[e] = pk2(bf_lo(g2[u][j][e]) * (ov[2 * e] * rstd * ga), bf_hi(g2[u][j][e]) * (ov[2 * e + 1] * rstd * gb)); }
            ((u32x4*)(O + t * 2048))[64 * j + F.lane] = w;
        } }
    }
}
__device__ __forceinline__ void phase_route(Frame& F, int layer) {
    const int gwl = blockIdx.x * NWAVES + F.wave;
    const float* mod = (const float*)(F.ws + WS_MOD) + (size_t)layer * 16 * 6144; const bf16_t* XB = (const bf16_t*)(F.ws + WS_XB); bf16_t* H = (bf16_t*)(F.ws + WS_H);
    const float* nf = F.inp(I_NFFN) + layer * 1024;
    const float* bg = F.inp(I_BG) + layer * 4; const float* be = F.inp(I_BE) + layer * 16;
    unsigned* gcnt = F.ctl + (layer ? CW_CNT1 : CW_CNT0);
    int* list = (int*)(F.ws + WS_LIST); int* tokslot = (int*)(F.ws + WS_TOKSLOT); float* tokw = (float*)(F.ws + WS_TOKW);
    LAS float* WrT = (LAS float*)(F.lds);
    LAS float* lgs = (LAS float*)(F.lds + 81920) + F.wave * 96;
    LAS int* wcnt = (LAS int*)(F.lds + 81920 + 4096);
    LAS int* wbase = (LAS int*)(F.lds + 81920 + 4096 + 1024);
    { const f32x4* src = (const f32x4*)((const float*)(F.ws + WS_WRT) + (size_t)layer * 20480);
#pragma unroll
      for (int i = 0; i < 10; ++i) ((LAS f32x4*)WrT)[i * NTHREADS + F.tid] = src[i * NTHREADS + F.tid]; }
    __syncthreads();
    const int lane = F.lane; const bool b5 = lane & 32, b4 = lane & 16, b3 = lane & 8;
    const int NGWL = F.G * NWAVES;
    for (int base = 0; base < NTOK; base += NGWL * 16) {
        const int t0 = base + gwl * 16; const bool active = t0 < NTOK;
        int my_e0 = 0, my_e1 = 0; float my_w0 = 0.f, my_w1 = 0.f;
        if (active) {
            const int b = t0 / SEQ; ModVec mv; modvec_load(mv, nf, mod + b * 6144 + 3072, mod + b * 6144 + 4096, lane);
            u32x2 nx[4][4];
#pragma unroll
            for (int i = 0; i < 4; ++i)
#pragma unroll
                for (int j = 0; j < 4; ++j) nx[i][j] = ((const u32x2*)(XB + (size_t)(t0 + i) * 1024))[64 * j + lane];
#pragma unroll 1
            for (int grp = 0; grp < 4; ++grp) {
                const int tg = t0 + 4 * grp;
                Row16 r[4];
#pragma unroll
                for (int i = 0; i < 4; ++i)
#pragma unroll
                    for (int j = 0; j < 4; ++j) { const u32x2 q = nx[i][j]; r[i].v[j] = (f32x4){bf_lo(q.x), bf_hi(q.x), bf_lo(q.y), bf_hi(q.y)}; }
                if (grp < 3) {
#pragma unroll
                    for (int i = 0; i < 4; ++i)
#pragma unroll
                        for (int j = 0; j < 4; ++j) nx[i][j] = ((const u32x2*)(XB + (size_t)(tg + 4 + i) * 1024))[64 * j + lane];
                }
                float rstd[4];
#pragma unroll
                for (int i = 0; i < 4; ++i) rstd[i] = __builtin_amdgcn_rsqf(row_sumsq(r[i]) * (1.0f / 1024.0f) + EPS);
#pragma unroll
                for (int j = 0; j < 4; ++j) {
#pragma unroll
                    for (int i = 0; i < 4; ++i) { const f32x4 h = r[i].v[j] * rstd[i] * mv.A[j] + mv.B[j]; r[i].v[j] = h; u32x2 w; w.x = pk2(h[0], h[1]); w.y = pk2(h[2], h[3]); ((u32x2*)(H + (size_t)(tg + i) * 1024))[64 * j + lane] = w; } }
#pragma unroll
                for (int hq = 0; hq < 2; ++hq) {
                    float V[40];
#pragma unroll
                    for (int q = 0; q < 10; ++q) {
                        float a0 = 0.f, a1 = 0.f, a2 = 0.f, a3 = 0.f;
#pragma unroll
                        for (int j = 0; j < 4; ++j) { const f32x4 w4 = *(const LAS f32x4*)(WrT + (hq * 10 + q) * 1024 + 4 * (64 * j + lane));
                            a0 += r[0].v[j][0] * w4[0] + r[0].v[j][1] * w4[1] + r[0].v[j][2] * w4[2] + r[0].v[j][3] * w4[3];
                            a1 += r[1].v[j][0] * w4[0] + r[1].v[j][1] * w4[1] + r[1].v[j][2] * w4[2] + r[1].v[j][3] * w4[3];
                            a2 += r[2].v[j][0] * w4[0] + r[2].v[j][1] * w4[1] + r[2].v[j][2] * w4[2] + r[2].v[j][3] * w4[3];
                            a3 += r[3].v[j][0] * w4[0] + r[3].v[j][1] * w4[1] + r[3].v[j][2] * w4[2] + r[3].v[j][3] * w4[3]; }
                        V[q] = a0; V[10 + q] = a1; V[20 + q] = a2; V[30 + q] = a3;
                    }
                    float W20[20], W10[10];
#pragma unroll
                    for (int i = 0; i < 20; ++i) W20[i] = swap32_add(V[i], V[i + 20]);
#pragma unroll
                    for (int i = 0; i < 10; ++i) W10[i] = swap16_add(W20[i], W20[i + 10]);
                    const int vb = (b3 ? 5 : 0) + (b4 ? 10 : 0) + (b5 ? 20 : 0);
#pragma unroll
                    for (int i = 0; i < 5; ++i) { const float keep = b3 ? W10[i + 5] : W10[i], send = b3 ? W10[i] : W10[i + 5]; const float v = sum8(keep + dppf<0x128>(send));
                        const int vi = vb + i;
                        if ((lane & 7) == 0) lgs[(vi / 10) * 20 + hq * 10 + (vi % 10)] = v; }
                    asm volatile("" ::: "memory");
                }
                LDS_WAIT(); asm volatile("" ::: "memory");
                if ((lane >> 2) == grp) {
                    const LAS float* lp = lgs + (lane & 3) * 20;
                    float gl[4]; int gi = 0;
#pragma unroll
                    for (int q = 0; q < 4; ++q) gl[q] = lp[q] + bg[q];
                    float gm = gl[0];
#pragma unroll
                    for (int q = 1; q < 4; ++q) if (gl[q] > gm) { gm = gl[q]; gi = q; }
                    float gs = 0.f;
#pragma unroll
                    for (int q = 0; q < 4; ++q) gs += __expf(gl[q] - gm);
                    const float ggate = 1.0f / gs;
                    float el[4];
#pragma unroll
                    for (int q = 0; q < 4; ++q) el[q] = lp[4 + 4 * gi + q] + be[4 * gi + q];
                    int i0 = 0; float m0 = el[0];
#pragma unroll
                    for (int q = 1; q < 4; ++q) if (el[q] > m0) { m0 = el[q]; i0 = q; }
                    int i1 = 0; float m1 = -INFINITY;
#pragma unroll
                    for (int q = 0; q < 4; ++q) if (q != i0 && el[q] > m1) { m1 = el[q]; i1 = q; }
                    const float p1 = __expf(m1 - m0);
                    my_e0 = gi * 4 + i0; my_e1 = gi * 4 + i1; my_w0 = ggate / (1.0f + p1); my_w1 = ggate * p1 / (1.0f + p1);
                }
                LDS_WAIT(); asm volatile("" ::: "memory");
            }
        }
        const bool have = active && lane < 16; int rank0 = 0, rank1 = 0, mycount = 0;
        const unsigned long long lt = (1ull << lane) - 1ull;
#pragma unroll 1
        for (int e = 0; e < 16; ++e) {
            const unsigned long long b0 = __ballot(have && my_e0 == e), b1 = __ballot(have && my_e1 == e);
            if (my_e0 == e) rank0 = __popcll(b0 & lt);
            if (my_e1 == e) rank1 = __popcll(b0) + __popcll(b1 & lt);
            if (lane == e) mycount = __popcll(b0) + __popcll(b1);
        }
        if (lane < 16) wcnt[F.wave * 16 + lane] = mycount;
        __syncthreads();
        if (F.tid < 16) { int tot = 0;
#pragma unroll
            for (int w = 0; w < 8; ++w) { const int c = wcnt[w * 16 + F.tid]; wbase[w * 16 + F.tid] = tot; tot += c; }
            const int gb = tot ? (int)atomicAdd(gcnt + F.tid, (unsigned)tot) : 0;
#pragma unroll
            for (int w = 0; w < 8; ++w) wbase[w * 16 + F.tid] += gb; }
        __syncthreads();
        if (have) { const int t = t0 + lane; const int p0 = wbase[F.wave * 16 + my_e0] + rank0, p1 = wbase[F.wave * 16 + my_e1] + rank1;
            list[my_e0 * 32768 + p0] = t; list[my_e1 * 32768 + p1] = t;
            tokslot[2 * t] = (my_e0 << 16) | p0; tokslot[2 * t + 1] = (my_e1 << 16) | p1; tokw[2 * t] = my_w0; tokw[2 * t + 1] = my_w1; }
        __syncthreads();
    }
}
__device__ __forceinline__ void load_rbs(Frame& F, const unsigned* gcnt, LAS int* rbs, LAS int* cnts) {
    if (F.tid < 64) {
        const int e = F.tid & 15; const int c = (int)__hip_atomic_load(gcnt + e, __ATOMIC_RELAXED, __HIP_MEMORY_SCOPE_AGENT); const int nb = (c + 255) >> 8;
        int acc = 0, tot = 0;
#pragma unroll
        for (int k = 0; k < 16; ++k) { const int v = __builtin_amdgcn_readlane(nb, k); acc += (k < e) ? v : 0; tot += v; }
        if (F.tid < 16) { rbs[e] = acc; if (cnts) cnts[e] = c; if (e == 0) rbs[16] = tot; }
    }
    __syncthreads();
}
__device__ __forceinline__ void moe_tables(Frame& F, int layer, LAS int* rbs, LAS int* rowtab, int NT, bool gather) {
    const unsigned* gcnt = F.ctl + (layer ? CW_CNT1 : CW_CNT0);
    LAS int* cnts = rbs + 32;
    load_rbs(F, gcnt, rbs, cnts);
    if (gather) {
        const int* list = (const int*)(F.ws + WS_LIST); const int nrb = rbs[16], nwg = nrb * NT;
        int vals[8]; bool ok[8];
#pragma unroll
        for (int p = 0; p < 8; ++p) { const int i = 2 * p + (F.tid >> 8); const long L = (long)i * F.G + blockIdx.x; ok[p] = L < nwg; vals[p] = 0;
            if (ok[p]) { const int wg = pg8::xcd_remap((int)L, nwg), rb = wg / NT; int e = 0;
#pragma unroll
                for (int k = 1; k < 16; ++k) e += (rb >= rbs[k]) ? 1 : 0;
                const int lr0 = (rb - rbs[e]) * 256, cnt = cnts[e]; int r = lr0 + (F.tid & 255); r = r < cnt ? r : cnt - 1; vals[p] = list[e * 32768 + r]; } }
#pragma unroll
        for (int p = 0; p < 8; ++p) if (ok[p]) rowtab[(2 * p + (F.tid >> 8)) * 256 + (F.tid & 255)] = vals[p];
        __syncthreads();
    }
}
struct CombRow { Row16 x; u32x2 y0[4], y1[4]; float w0, w1; };
struct CombSlots { int r0, r1; float w0, w1; };
__device__ __forceinline__ void comb_slots(Frame& F, int t0, const LAS int* rbs, CombSlots& s) {
    const int* tokslot = (const int*)(F.ws + WS_TOKSLOT); const float* tokw = (const float*)(F.ws + WS_TOKW);
    const int i = F.lane & 15; const int s0 = tokslot[2 * (t0 + i)], s1 = tokslot[2 * (t0 + i) + 1]; s.w0 = tokw[2 * (t0 + i)]; s.w1 = tokw[2 * (t0 + i) + 1];
    s.r0 = rbs[s0 >> 16] * 256 + (s0 & 0xffff); s.r1 = rbs[s1 >> 16] * 256 + (s1 & 0xffff);
}
__device__ __forceinline__ void comb_issue(Frame& F, int t, int i, const CombSlots& s, CombRow& c) {
    const bf16_t* XB = (const bf16_t*)(F.ws + WS_XB); const bf16_t* YB = (const bf16_t*)(F.ws + WS_YB);
    row_load_bf16(c.x, XB + (size_t)t * 1024, F.lane);
    const int r0 = __builtin_amdgcn_readlane(s.r0, i), r1 = __builtin_amdgcn_readlane(s.r1, i);
    c.w0 = __builtin_bit_cast(float, __builtin_amdgcn_readlane(__builtin_bit_cast(int, s.w0), i)); c.w1 = __builtin_bit_cast(float, __builtin_amdgcn_readlane(__builtin_bit_cast(int, s.w1), i));
    const u32x2* y0 = (const u32x2*)(YB + (size_t)r0 * 1024); const u32x2* y1 = (const u32x2*)(YB + (size_t)r1 * 1024);
#pragma unroll
    for (int j = 0; j < 4; ++j) { c.y0[j] = y0[64 * j + F.lane]; c.y1[j] = y1[64 * j + F.lane]; }
}
__device__ __forceinline__ void comb_finish(const f32x4 (&g2)[4], CombRow& c) {
#pragma unroll
    for (int j = 0; j < 4; ++j) { const u32x2 a = c.y0[j], b = c.y1[j]; const float w0 = c.w0, w1 = c.w1;
        f32x4 m; m[0] = w0 * bf_lo(a.x) + w1 * bf_lo(b.x); m[1] = w0 * bf_hi(a.x) + w1 * bf_hi(b.x); m[2] = w0 * bf_lo(a.y) + w1 * bf_lo(b.y); m[3] = w0 * bf_hi(a.y) + w1 * bf_hi(b.y);
        c.x.v[j] = c.x.v[j] + g2[j] * m; }
}
__device__ __forceinline__ void rbs_only(Frame& F, int layer, LAS int* rbs) {
    const unsigned* gcnt = F.ctl + (layer ? CW_CNT1 : CW_CNT0);
    load_rbs(F, gcnt, rbs, (LAS int*)nullptr);
}
__device__ __forceinline__ void phase_mid(Frame& F, LAS int* rbs) {
    const int gw = F.vcu * NWAVES + F.wave, NGW = F.G * NWAVES; bf16_t* XB = (bf16_t*)(F.ws + WS_XB); bf16_t* HQ = (bf16_t*)(F.ws + WS_H); bf16_t* HKV = (bf16_t*)(F.ws + WS_HKV);
    const float* mod1 = (const float*)(F.ws + WS_MOD) + 16 * 6144; const float* kvmod = (const float*)(F.ws + WS_KVMOD);
    rbs_only(F, 0, rbs);
    const int cbase = tail_base(rbs[16], 2);
    for (int t0 = gw * 16; t0 < NTOK; t0 += NGW * 16) { const int b = t0 / SEQ;
        CombSlots sl; comb_slots(F, t0, rbs, sl);
        ModVec mq, mk; modvec_load(mq, F.inp(I_NMIX) + 1024, mod1 + b * 6144, mod1 + b * 6144 + 1024, F.lane); modvec_load(mk, F.inp(I_KVNORM), kvmod + b * 2048, kvmod + b * 2048 + 1024, F.lane);
        f32x4 g2[4];
#pragma unroll
        for (int j = 0; j < 4; ++j) g2[j] = ((const f32x4*)((const float*)(F.ws + WS_MOD) + (size_t)b * 6144 + 5120))[64 * j + F.lane];
#pragma unroll 1
        for (int i = 0; i < 16; ++i) { CombRow c;
            const int cit = cbase + gw + (i >> 1) * NGW; const bool conv = cit < N_MOE_ITEMS; TItem ti; f32x4 tv[8];
            if (conv) { ti = moe_item(F, 1, cit); thalf_load(ti, i & 1, tv, F.lane); }
            comb_issue(F, t0 + i, i, sl, c);
            { const int tt = t0 + i; comb_finish(g2, c); Row16& r = c.x;
                row_store_bf16(r, XB + (size_t)tt * 1024, F.lane);
                const float rstd = __builtin_amdgcn_rsqf(row_sumsq(r) * (1.0f / 1024.0f) + EPS);
                row_mod_store(r, rstd, mq, HQ + (size_t)tt * 1024, F.lane); row_mod_store(r, rstd, mk, HKV + (size_t)tt * 1024, F.lane); }
            if (conv) thalf_store(ti, i & 1, tv, (LAS float*)(F.lds + F.wave * 17408), F.lane);
        } }
}
__device__ __forceinline__ void phase_final(Frame& F, LAS int* rbs) {
    const int gw = F.vcu * NWAVES + F.wave, NGW = F.G * NWAVES;
    rbs_only(F, 1, rbs);
    for (int t0 = gw * 16; t0 < NTOK; t0 += NGW * 16) { const int b = t0 / SEQ;
        CombSlots sl; comb_slots(F, t0, rbs, sl);
        f32x4 g2[4];
#pragma unroll
        for (int j = 0; j < 4; ++j) g2[j] = ((const f32x4*)((const float*)(F.ws + WS_MOD) + (size_t)(16 + b) * 6144 + 5120))[64 * j + F.lane];
#pragma unroll 1
        for (int i = 0; i < 16; i += 4) { CombRow c[4];
#pragma unroll
            for (int u = 0; u < 4; ++u) comb_issue(F, t0 + i + u, i + u, sl, c[u]);
#pragma unroll
            for (int u = 0; u < 4; ++u) { const int tt = t0 + i + u; comb_finish(g2, c[u]);
#pragma unroll
                for (int j = 0; j < 4; ++j) ((f32x4*)(F.out + (size_t)tt * 1024))[64 * j + F.lane] = c[u].x.v[j]; } } }
}
__device__ __forceinline__ s16x4 tr_read(const LAS void* p) {
    typedef short v4s __attribute__((ext_vector_type(4)));
    return __builtin_bit_cast(s16x4, __builtin_amdgcn_ds_read_tr16_b64_v4i16((LAS v4s*)p));
}
__device__ __forceinline__ bf16x8 cat8(s16x4 a, s16x4 b) { return (bf16x8){a[0], a[1], a[2], a[3], b[0], b[1], b[2], b[3]}; }

constexpr int RQ_STRIDE = 528, RV_STRIDE = 272, RS_STRIDE = 144;
constexpr int R_QS = 0, R_KS = 64 * RQ_STRIDE, R_VS = 2 * 64 * RQ_STRIDE, R_SS = R_VS + 64 * RV_STRIDE, R_CV = R_SS + 64 * RS_STRIDE, R_OS = R_CV + 2 * 16384, R_END = R_OS + 64 * RV_STRIDE;
static_assert(R_CV % 16 == 0 && R_OS % 16 == 0 && R_CV + 2 * 16384 <= 131072 && R_END <= ROWTAB_OFF + ROWTAB_BYTES, "retention LDS");

__device__ __forceinline__ void bg_load(Frame& F, int pair, u32x4 (&cv)[4]) {
#pragma unroll
    for (int bsel = 0; bsel < 2; ++bsel) { const TItem it = moe_item(F, 0, (2 * pair + bsel) * F.G + (int)blockIdx.x);
        const int kb = it.item >> 4, nb = it.item & 15, k0 = 64 * kb, n0 = 64 * nb;
#pragma unroll
        for (int i = 0; i < 2; ++i) cv[2 * bsel + i] = *(const u32x4*)((const char*)(it.W + (size_t)(k0 + 32 * i) * 1024 + n0) + (unsigned)((F.tid >> 4) * 4096 + (F.tid & 15) * 16)); }
}
__device__ __forceinline__ void bg_stage(Frame& F, const u32x4 (&cv)[4]) {
#pragma unroll
    for (int bsel = 0; bsel < 2; ++bsel)
#pragma unroll
        for (int i = 0; i < 2; ++i) *(LAS u32x4*)(F.lds + R_CV + bsel * 16384 + (i * 512 + F.tid) * 16) = cv[2 * bsel + i];
}
__device__ __forceinline__ void bg_convert(Frame& F, int pair) {
    if (F.wave < 2) return;
    const int bsel = F.wave >= 5 ? 1 : 0, wi = F.wave - 2 - 3 * bsel, c0 = 3 * wi, cnt = wi < 2 ? 3 : 2;
    const TItem it = moe_item(F, 0, (2 * pair + bsel) * F.G + (int)blockIdx.x);
    const int kb = it.item >> 4, nb = it.item & 15, k0 = 64 * kb, n0 = 64 * nb;
    const int d = dest_row(n0 + (F.lane & 32), it.mode) + (F.lane & 31);
    bf16_t* op = it.WT + (size_t)d * it.K + k0;
    const LAS float* tile = (const LAS float*)(F.lds + R_CV + bsel * 16384) + F.lane;
    float tv[3][8];
#pragma unroll
    for (int i = 0; i < 3; ++i) { if (i < cnt) { const LAS float* s = tile + (8 * (c0 + i)) * 64;
#pragma unroll
        for (int e = 0; e < 8; ++e) tv[i][e] = s[e * 64]; } }
#pragma unroll
    for (int i = 0; i < 3; ++i) { if (i < cnt) { const int c = c0 + i;
        u32x4 o; o.x = pk2(tv[i][0], tv[i][1]); o.y = pk2(tv[i][2], tv[i][3]); o.z = pk2(tv[i][4], tv[i][5]); o.w = pk2(tv[i][6], tv[i][7]);
        *(u32x4*)(op + 8 * c) = o; } }
}

__device__ __forceinline__ void phase_retention(Frame& F) {
    LAS unsigned char* lds = F.lds;
    const int tid = F.tid, lane = F.lane, w = F.wave, g = lane >> 4, l15 = lane & 15, tq = (lane >> 2) & 3, tp = lane & 3;
    const bf16_t* QR = (const bf16_t*)(F.ws + WS_QR); const bf16_t* KR = (const bf16_t*)(F.ws + WS_KR); bf16_t* VR = (bf16_t*)(F.ws + WS_VR);
    const unsigned qaddr = (unsigned)(uintptr_t)(lds + R_QS + l15 * RQ_STRIDE + g * 8), kaddr = (unsigned)(uintptr_t)(lds + R_KS + (8 * g + tq) * RQ_STRIDE + 4 * tp * 2);
    for (int i = tid; i < 64 * RS_STRIDE / 4; i += NTHREADS) ((LAS unsigned*)(lds + R_SS))[i] = 0u;
    for (int unit = F.vcu; unit < 256; unit += F.G) {
        const int b = unit >> 4, h = (unit >> 2) & 3, s = unit & 3;
        const float lgam = __builtin_log2f(1.0f - __builtin_exp2f(-5.0f - (float)h)); const float cdec = __builtin_exp2f(64.0f * lgam);
        const size_t tok0 = (size_t)b * SEQ;
        const bf16_t* qg = QR + tok0 * 1024 + h * 256; const bf16_t* kg = KR + tok0 * 1024 + h * 256; bf16_t* vg = VR + tok0 * 2048 + h * 512 + s * 128;
        f32x4 St[16];
#pragma unroll
        for (int t = 0; t < 16; ++t) St[t] = (f32x4){0.f, 0.f, 0.f, 0.f};
        u32x4 pq[4], pk[4], pv[2], cv[4];
        const unsigned qko = (unsigned)((tid >> 5) * 2048 + (tid & 31) * 16), vo = (unsigned)((tid >> 4) * 4096 + (tid & 15) * 16);
#define RET_PREFETCH(ci) do { const char* _q = (const char*)qg + (size_t)(ci) * 131072; const char* _k = (const char*)kg + (size_t)(ci) * 131072; const char* _v = (const char*)vg + (size_t)(ci) * 262144; \
            _Pragma("unroll") for (int i = 0; i < 4; ++i) { pq[i] = *(const u32x4*)(_q + i * 32768 + qko); pk[i] = *(const u32x4*)(_k + i * 32768 + qko); } \
            _Pragma("unroll") for (int i = 0; i < 2; ++i) pv[i] = *(const u32x4*)(_v + i * 131072 + vo); } while (0)
        RET_PREFETCH(0);
#ifdef RET_PROBE
        unsigned long long rp_acc = 0, rp_prev = __builtin_amdgcn_s_memrealtime();
#define RS(k) do { const unsigned long long _n = __builtin_amdgcn_s_memrealtime(); if (RET_PROBE == (k)) rp_acc += _n - rp_prev; rp_prev = _n; } while (0)
#else
#define RS(k) do {} while (0)
#endif
        for (int ci = 0; ci < 32; ++ci) {
            RS(0);
#pragma unroll
            for (int i = 0; i < 4; ++i) { const int id = i * 512 + tid, row = id >> 5, c16 = id & 31;
                *(LAS u32x4*)(lds + R_QS + row * RQ_STRIDE + c16 * 16) = pq[i]; *(LAS u32x4*)(lds + R_KS + row * RQ_STRIDE + c16 * 16) = pk[i]; }
#pragma unroll
            for (int i = 0; i < 2; ++i) { const int id = i * 512 + tid, row = id >> 4, c16 = id & 15; *(LAS u32x4*)(lds + R_VS + row * RV_STRIDE + c16 * 16) = pv[i]; }
            if (ci >= 1 && ci <= 24) bg_stage(F, cv);
            RS(1); __syncthreads(); RS(2);
            if (ci >= 1) {
#pragma unroll
                for (int i = 0; i < 2; ++i) { const int id = i * 512 + tid, row = id >> 4, c16 = id & 15;
                    *(u32x4*)((char*)vg + (size_t)(ci - 1) * 262144 + i * 131072 + vo) = *(const LAS u32x4*)(lds + R_OS + row * RV_STRIDE + c16 * 16); } }
            if (ci + 1 < 32) RET_PREFETCH(ci + 1);
            if (ci < 24) bg_load(F, ci, cv);
            if (ci >= 1 && ci <= 24) bg_convert(F, ci - 1);
#pragma unroll
            for (int rep = 0; rep < 2; ++rep) {
                const int idx = w + 8 * rep;
                if (idx < 10) {
                    const int mt = idx < 4 ? 0 : idx < 7 ? 1 : idx < 9 ? 2 : 3, nt_ = idx < 4 ? idx : idx < 7 ? idx - 3 : idx < 9 ? idx - 5 : 3;
                    f32x4 sacc = (f32x4){0.f, 0.f, 0.f, 0.f};
                    const LAS unsigned char* ka = lds + R_KS + (mt * 16 + l15) * RQ_STRIDE + g * 16; const LAS unsigned char* qb = lds + R_QS + (nt_ * 16 + l15) * RQ_STRIDE + g * 16;
#pragma unroll
                    for (int hb = 0; hb < 2; ++hb) { bf16x8 fa[4], fb[4];
#pragma unroll
                        for (int kk = 0; kk < 4; ++kk) { fa[kk] = *(const LAS bf16x8*)(ka + (4 * hb + kk) * 64); fb[kk] = *(const LAS bf16x8*)(qb + (4 * hb + kk) * 64); }
                        __builtin_amdgcn_sched_barrier(0);
#pragma unroll
                        for (int kk = 0; kk < 4; ++kk) sacc = __builtin_amdgcn_mfma_f32_16x16x32_bf16(fa[kk], fb[kk], sacc, 0, 0, 0);
                        __builtin_amdgcn_sched_barrier(0); }
                    const int n = nt_ * 16 + l15, m0 = mt * 16 + 4 * g;
#pragma unroll
                    for (int r = 0; r < 4; ++r) if (n < m0 + r) sacc[r] = 0.f;
                    u32x2 pw; pw.x = pk2(sacc[0], sacc[1]); pw.y = pk2(sacc[2], sacc[3]);
                    *(LAS u32x2*)(lds + R_SS + n * RS_STRIDE + m0 * 2) = pw;
                }
            }
            bf16x8 vf[2];
#pragma unroll
            for (int kk = 0; kk < 2; ++kk) { const LAS unsigned char* vp = lds + R_VS + (32 * kk + 8 * g + tq) * RV_STRIDE + (16 * w + 4 * tp) * 2;
                vf[kk] = cat8(tr_read(vp), tr_read(vp + 4 * RV_STRIDE)); }
#define RET_PACKST(kk) ({ u32x4 _x; _x.x = pk2(St[2 * (kk)][0], St[2 * (kk)][1]); _x.y = pk2(St[2 * (kk)][2], St[2 * (kk)][3]); _x.z = pk2(St[2 * (kk) + 1][0], St[2 * (kk) + 1][1]); _x.w = pk2(St[2 * (kk) + 1][2], St[2 * (kk) + 1][3]); __builtin_bit_cast(bf16x8, _x); })
            f32x4 o[4];
#pragma unroll
            for (int nt_ = 0; nt_ < 4; ++nt_) o[nt_] = (f32x4){0.f, 0.f, 0.f, 0.f};
            __builtin_amdgcn_sched_barrier(0);
            {
                s16x4 rlo[4], rhi[4];
#define RET_LD(k, gi) do { if ((gi) < 32) asm volatile("ds_read_b64 %0, %2 offset:%3\n\tds_read_b64 %1, %2 offset:%4" : "=&v"(rlo[k]), "=&v"(rhi[k]) : "v"(qaddr), "i"(((gi) & 3) * 16 * RQ_STRIDE + ((gi) >> 2) * 64), "i"(((gi) & 3) * 16 * RQ_STRIDE + ((gi) >> 2) * 64 + 32) : "memory"); \
                else asm volatile("ds_read_b64_tr_b16 %0, %2 offset:%3\n\tds_read_b64_tr_b16 %1, %2 offset:%4" : "=&v"(rlo[k]), "=&v"(rhi[k]) : "v"(kaddr), "i"(((gi) & 1) * 32 * RQ_STRIDE + (((gi) - 32) >> 1) * 32), "i"(((gi) & 1) * 32 * RQ_STRIDE + (((gi) - 32) >> 1) * 32 + 4 * RQ_STRIDE) : "memory"); } while (0)
#define RET_WAIT(k, n) asm volatile("s_waitcnt lgkmcnt(%2)" : "+v"(rlo[k]), "+v"(rhi[k]) : "n"(n) : "memory")
                RET_LD(0, 0); RET_LD(1, 1); RET_LD(2, 2);
                bf16x8 sbc = RET_PACKST(0), sbn = RET_PACKST(1);
#pragma unroll
                for (int gi = 0; gi < 64; ++gi) {
                    if (gi + 3 < 64) RET_LD((gi + 3) & 3, gi + 3);
                    RET_WAIT(gi & 3, (63 - gi) < 3 ? 2 * (63 - gi) : 6);
                    const bf16x8 af = cat8(rlo[gi & 3], rhi[gi & 3]);
                    if (gi < 32) { o[gi & 3] = __builtin_amdgcn_mfma_f32_16x16x32_bf16(af, sbc, o[gi & 3], 0, 0, 0);
                        if ((gi & 3) == 3) { sbc = sbn; if ((gi >> 2) + 2 < 8) sbn = RET_PACKST((gi >> 2) + 2); } }
                    else { const int t = (gi - 32) >> 1; St[t] = __builtin_amdgcn_mfma_f32_16x16x32_bf16(af, vf[gi & 1], St[t], 0, 0, 0);
                        if ((gi & 1) && t >= 1) St[t - 1] = St[t - 1] * cdec; }
                    __builtin_amdgcn_sched_barrier(0);
                }
                St[15] = St[15] * cdec;
#undef RET_LD
#undef RET_WAIT
            }
            RS(3); __syncthreads(); RS(4);
            {
#pragma unroll
                for (int nt_ = 0; nt_ < 4; ++nt_) {
                    const LAS unsigned char* sp = lds + R_SS + (nt_ * 16 + l15) * RS_STRIDE + g * 16;
#pragma unroll
                    for (int kk = 0; kk < 2; ++kk) { if (kk * 32 < (nt_ + 1) * 16) { const bf16x8 a = *(const LAS bf16x8*)(sp + kk * 64); o[nt_] = __builtin_amdgcn_mfma_f32_16x16x32_bf16(a, vf[kk], o[nt_], 0, 0, 0); } }
                }
#undef RET_PACKST
            }
#pragma unroll
            for (int nt_ = 0; nt_ < 4; ++nt_)
#pragma unroll
                for (int r = 0; r < 4; ++r) *(LAS bf16_t*)(lds + R_OS + (nt_ * 16 + 4 * g + r) * RV_STRIDE + (16 * w + l15) * 2) = (bf16_t)f2bf(o[nt_][r]);
            RS(5); __syncthreads(); RS(6);
        }
#ifdef RET_PROBE
        if (blockIdx.x == 0 && tid == RET_PROBE_WAVE * 64) __hip_atomic_store((unsigned long long*)(F.ctl + 8400), rp_acc, __ATOMIC_RELAXED, __HIP_MEMORY_SCOPE_AGENT);
#endif
#undef RET_PREFETCH
#pragma unroll
        for (int i = 0; i < 2; ++i) { const int id = i * 512 + tid, row = id >> 4, c16 = id & 15;
            *(u32x4*)((char*)vg + (size_t)31 * 262144 + i * 131072 + vo) = *(const LAS u32x4*)(lds + R_OS + row * RV_STRIDE + c16 * 16); }
        __syncthreads();
    }
}

constexpr int A_SLOT = 16384, A_K0 = 0, A_V0 = 3 * A_SLOT, A_LS = 6 * A_SLOT, A_X = 0, A_OST = A_LS + 8 * 64 * 4, A_OSTRIDE = 272, A_END = A_OST + 4 * 32 * A_OSTRIDE;
static_assert(A_END <= ROWTAB_OFF + ROWTAB_BYTES && 4 * 16384 <= A_LS, "attention LDS");
__device__ __forceinline__ int crow(int r, int hi) { return (r & 3) + 8 * (r >> 2) + 4 * hi; }
#define ATT_SB() __builtin_amdgcn_sched_barrier(0)

template <bool SHIFT>
__device__ __forceinline__ void phase_attention_impl(Frame& F, const float M2) {
    LAS unsigned char* lds = F.lds;
    const int tid = F.tid, lane = F.lane, w = F.wave, r32 = lane & 31, hi = lane >> 5, tq = (lane >> 2) & 3, tp = lane & 3, ch = (lane >> 4) & 1, t = w >> 2, wq = w & 3;
    const bf16_t* Q1 = (const bf16_t*)(F.ws + WS_Q1); const bf16_t* K1 = (const bf16_t*)(F.ws + WS_K1); const bf16_t* V1 = (const bf16_t*)(F.ws + WS_V1); bf16_t* AO = (bf16_t*)(F.ws + WS_AO);
    const float* lam = F.inp(I_LAM);
    const float l01 = wave_sum(lam[lane] * lam[64 + lane]), l23 = wave_sum(lam[128 + lane] * lam[192 + lane]);
    const float lambda_init = 0.8f - 0.6f * 0.7408182206817179f;
    const float lam_full = __expf(l01) - __expf(l23) + lambda_init;
    LAS float* wsf = (LAS float*)(lds + A_LS) + w * 64;
    unsigned dsrc[2];
#pragma unroll
    for (int i = 0; i < 2; ++i) { const int row = 4 * (2 * w + i) + (lane >> 4), fr = ((row & 3) << 2) | ((row >> 2) & 3); dsrc[i] = (unsigned)(row * 2048 + (((lane & 15) ^ fr) << 4)); }
    const unsigned ddst = (unsigned)(w * 2048);
    const int frk = ((r32 & 3) << 2) | ((r32 >> 2) & 3);
    int koff[4];
#pragma unroll
    for (int ks = 0; ks < 4; ++ks) koff[ks] = r32 * 256 + (((8 * t + 2 * ks + hi) ^ frk) << 4);
    unsigned vofA[4], vofB[4];
#pragma unroll
    for (int d = 0; d < 4; ++d) { const int c = 4 * d + 2 * ch + (tp >> 1);
        vofA[d] = (unsigned)((4 * hi + tq) * 256 + ((c ^ ((tq << 2) | (hi & 3))) << 4) + 8 * (tp & 1));
        vofB[d] = (unsigned)((4 * hi + tq + 8) * 256 + ((c ^ ((tq << 2) | ((hi + 2) & 3))) << 4) + 8 * (tp & 1)); }
    const unsigned ldsb = (unsigned)(uintptr_t)lds;
#ifdef ATT_PROBE
    unsigned long long att_tw = 0;
#endif
#define ATT_UNIT(n, b_, h_, u_) const int _v##b_ = F.vcu + ((n) >> 3) * F.G, _bh##b_ = _v##b_ >> 1, b_ = _bh##b_ >> 3, h_ = _bh##b_ & 7, _pr##b_ = 2 * (((n) & 7) >> 1) + (_v##b_ & 1), u_ = ((n) & 1) ? 15 - _pr##b_ : _pr##b_
#define ATT_DMA(gbase, tile, NTu, slotbase) do { const int _tl = (tile) < (NTu) ? (tile) : (NTu) - 1; const char* _g = (gbase) + (size_t)_tl * 131072; const unsigned _s = (slotbase) + (unsigned)(((tile) % 3) * A_SLOT) + ddst; \
            __builtin_amdgcn_global_load_lds((const GAS unsigned*)(_g + dsrc[0]), (LAS unsigned*)(lds + _s), 16, 0, 0); \
            __builtin_amdgcn_global_load_lds((const GAS unsigned*)(_g + dsrc[1]), (LAS unsigned*)(lds + _s + 1024), 16, 0, 0); } while (0)
#define ATT_PROLOGUE_DMA(kgx, vgx, NTx) do { ATT_DMA(kgx, 0, NTx, A_K0); ATT_DMA(vgx, 0, NTx, A_V0); ATT_DMA(kgx, 1, NTx, A_K0); ATT_DMA(kgx, 2, NTx, A_K0); ATT_DMA(vgx, 1, NTx, A_V0); } while (0)
#define ATT_WAITBAR(n) asm volatile("s_waitcnt vmcnt(" #n ") lgkmcnt(0)\n\ts_barrier" ::: "memory")
    const int NU = 8 * ((256 - F.vcu + F.G - 1) / F.G);
    if (NU > 0) { ATT_UNIT(0, b0_, h0_, u0_); ATT_PROLOGUE_DMA((const char*)(K1 + (size_t)b0_ * SEQ * 1024 + h0_ * 128), (const char*)(V1 + (size_t)b0_ * SEQ * 1024 + h0_ * 128), 2 * u0_ + 2); }
    {
        for (int n = 0; n < NU; ++n) {
            ATT_UNIT(n, b, h, u);
            const size_t tok0 = (size_t)b * SEQ; const int q0 = u * 128 + wq * 32;
            const int NT = 2 * u + 2, jmax = 2 * u + (wq >> 1);
            const char* kg = (const char*)(K1 + tok0 * 1024 + h * 128); const char* vg = (const char*)(V1 + tok0 * 1024 + h * 128);
            bf16x8 qf[4];
#pragma unroll
            for (int ks = 0; ks < 4; ++ks) qf[ks] = *(const bf16x8*)((const char*)(Q1 + (tok0 + q0) * 1024 + h * 128 + t * 64) + (unsigned)(r32 * 2048 + hi * 16 + ks * 32));
            f32x16 O[4];
#pragma unroll
            for (int d = 0; d < 4; ++d) O[d] = f32x16{};
            float lsum = 0.f;
#define ATT_QK(S0, S1, kslot) do { const f32x16 _z = f32x16{}; bf16x8 _a0[2], _a1[2]; const LAS unsigned char* _kb = lds + A_K0 + (kslot) * A_SLOT; \
            _Pragma("unroll") for (int ks = 0; ks < 2; ++ks) { _a0[ks] = *(const LAS bf16x8*)(_kb + koff[ks]); _a1[ks] = *(const LAS bf16x8*)(_kb + koff[ks] + 32 * 256); } \
            S0 = __builtin_amdgcn_mfma_f32_32x32x16_bf16(_a0[0], qf[0], _z, 0, 0, 0); S1 = __builtin_amdgcn_mfma_f32_32x32x16_bf16(_a1[0], qf[0], _z, 0, 0, 0); \
            S0 = __builtin_amdgcn_mfma_f32_32x32x16_bf16(_a0[1], qf[1], S0, 0, 0, 0); S1 = __builtin_amdgcn_mfma_f32_32x32x16_bf16(_a1[1], qf[1], S1, 0, 0, 0); ATT_SB(); \
            _Pragma("unroll") for (int ks = 0; ks < 2; ++ks) { _a0[ks] = *(const LAS bf16x8*)(_kb + koff[ks + 2]); _a1[ks] = *(const LAS bf16x8*)(_kb + koff[ks + 2] + 32 * 256); } \
            S0 = __builtin_amdgcn_mfma_f32_32x32x16_bf16(_a0[0], qf[2], S0, 0, 0, 0); S1 = __builtin_amdgcn_mfma_f32_32x32x16_bf16(_a1[0], qf[2], S1, 0, 0, 0); \
            S0 = __builtin_amdgcn_mfma_f32_32x32x16_bf16(_a0[1], qf[3], S0, 0, 0, 0); S1 = __builtin_amdgcn_mfma_f32_32x32x16_bf16(_a1[1], qf[3], S1, 0, 0, 0); } while (0)
#define ATT_EXP4(S0, S1, PFN, e) do { float x0, x1, x2, x3; \
            if ((e) < 4) { x0 = S0[4 * (e)]; x1 = S0[4 * (e) + 1]; x2 = S0[4 * (e) + 2]; x3 = S0[4 * (e) + 3]; } else { x0 = S1[4 * ((e) - 4)]; x1 = S1[4 * ((e) - 4) + 1]; x2 = S1[4 * ((e) - 4) + 2]; x3 = S1[4 * ((e) - 4) + 3]; } \
            if (SHIFT) { x0 -= M2; x1 -= M2; x2 -= M2; x3 -= M2; } \
            x0 = __builtin_amdgcn_exp2f(x0); x1 = __builtin_amdgcn_exp2f(x1); x2 = __builtin_amdgcn_exp2f(x2); x3 = __builtin_amdgcn_exp2f(x3); lsum += (x0 + x1) + (x2 + x3); \
            PFN[(e) >> 1][((e) & 1) * 2] = pk2(x0, x1); PFN[(e) >> 1][((e) & 1) * 2 + 1] = pk2(x2, x3); } while (0)
#define ATT_VLD(k, i) asm volatile("ds_read_b64_tr_b16 %0, %2 offset:%4\n\tds_read_b64_tr_b16 %1, %3 offset:%4" : "=&v"(vlo[k]), "=&v"(vhi[k]) : "v"(va[(i) & 3]), "v"(vb[(i) & 3]), "i"(((i) >> 2) * 4096) : "memory")
#define ATT_VWAIT(k, n) asm volatile("s_waitcnt lgkmcnt(" #n ")" : "+v"(vlo[k]), "+v"(vhi[k]) :: "memory")
#define ATT_MM(PF, k, i) do { O[(i) & 3] = __builtin_amdgcn_mfma_f32_32x32x16_bf16(__builtin_bit_cast(bf16x8, PF[(i) >> 2]), cat8(vlo[k], vhi[k]), O[(i) & 3], 0, 0, 0); } while (0)
#define ATT_SLOT(PF, i) do { if ((i) + 3 < 16) ATT_VLD(((i) + 3) & 3, (i) + 3); \
            if ((i) < 13) ATT_VWAIT((i) & 3, 6); else if ((i) == 13) ATT_VWAIT((i) & 3, 4); else if ((i) == 14) ATT_VWAIT((i) & 3, 2); else ATT_VWAIT((i) & 3, 0); \
            ATT_MM(PF, (i) & 3, i); } while (0)
            ATT_WAITBAR(4);
            u32x4 pf[4];
            { f32x16 s0, s1; ATT_QK(s0, s1, 0);
#pragma unroll
              for (int e = 0; e < 8; ++e) ATT_EXP4(s0, s1, pf, e); }
            ATT_WAITBAR(4);
            int ks1 = 1, vs0 = 0;
#if defined(ATT_PROBE) && defined(ATT_PROBE_LOOP)
            const unsigned long long _tl0 = __builtin_amdgcn_s_memrealtime();
#endif
            for (int j = 0; j < NT; ++j) {
                ATT_DMA(kg, j + 3, NT, A_K0); ATT_DMA(vg, j + 2, NT, A_V0);
                unsigned va[4], vb[4];
#pragma unroll
                for (int d = 0; d < 4; ++d) { va[d] = ldsb + (unsigned)(A_V0 + vs0 * A_SLOT) + vofA[d]; vb[d] = ldsb + (unsigned)(A_V0 + vs0 * A_SLOT) + vofB[d]; }
                if (j + 1 <= jmax) {
                    f32x16 s0, s1; u32x4 pfn[4];
                    s16x4 vlo[4], vhi[4];
                    ATT_VLD(0, 0); ATT_VLD(1, 1); ATT_VLD(2, 2);
                    ATT_QK(s0, s1, ks1); ATT_SB();
#pragma unroll
                    for (int i = 0; i < 8; ++i) { ATT_SLOT(pf, i); ATT_SB(); }
#pragma unroll
                    for (int i = 8; i < 16; ++i) { ATT_SLOT(pf, i); ATT_EXP4(s0, s1, pfn, i - 8); ATT_SB(); }
#pragma unroll
                    for (int s = 0; s < 4; ++s) pf[s] = pfn[s];
                } else if (j <= jmax) {
                    s16x4 vlo[4], vhi[4];
                    ATT_VLD(0, 0); ATT_VLD(1, 1); ATT_VLD(2, 2);
#pragma unroll
                    for (int i = 0; i < 16; ++i) { ATT_SLOT(pf, i); ATT_SB(); }
                }
                ks1 = ks1 == 2 ? 0 : ks1 + 1; vs0 = vs0 == 2 ? 0 : vs0 + 1;
#if defined(ATT_PROBE) && !defined(ATT_PROBE_LOOP)
                { const unsigned long long _t0 = __builtin_amdgcn_s_memrealtime(); ATT_WAITBAR(4); att_tw += __builtin_amdgcn_s_memrealtime() - _t0; }
#else
                ATT_WAITBAR(4);
#endif
            }
#if defined(ATT_PROBE) && defined(ATT_PROBE_LOOP)
            att_tw += __builtin_amdgcn_s_memrealtime() - _tl0;
#endif
            asm volatile("s_waitcnt vmcnt(0)" ::: "memory");
            if (n + 1 < NU) { const int n1 = n + 1; ATT_UNIT(n1, bn_, hn_, un_);
                ATT_PROLOGUE_DMA((const char*)(K1 + (size_t)bn_ * SEQ * 1024 + hn_ * 128), (const char*)(V1 + (size_t)bn_ * SEQ * 1024 + hn_ * 128), 2 * un_ + 2); }
#undef ATT_QK
#undef ATT_EXP4
#undef ATT_VLD
#undef ATT_VWAIT
#undef ATT_MM
#undef ATT_SLOT
            lsum = swap32_add(lsum, lsum);
            if (hi == 0) wsf[r32] = (t ? lam_full : 1.0f) / lsum;
            LDS_WAIT(); asm volatile("" ::: "memory");
            float sc[16];
#pragma unroll
            for (int r = 0; r < 16; ++r) sc[r] = wsf[crow(r, hi)];
            LAS unsigned* XR = (LAS unsigned*)(lds + A_OST + wq * 32 * A_OSTRIDE);
            if (t == 1) {
#pragma unroll
                for (int d = 0; d < 4; ++d)
#pragma unroll
                    for (int rr = 0; rr < 8; ++rr) XR[(d * 8 + rr) * 64 + lane] = pk2(O[d][2 * rr] * sc[2 * rr], O[d][2 * rr + 1] * sc[2 * rr + 1]);
            }
            __syncthreads();
            if (t == 0) {
                const float osc = 1.0f - lambda_init;
                const float* subp = F.inp(I_SUBLN); const float sub0 = subp[r32], sub1 = subp[32 + r32], sub2 = subp[64 + r32], sub3 = subp[96 + r32];
                unsigned xr[32];
#pragma unroll
                for (int i = 0; i < 32; ++i) xr[i] = XR[i * 64 + lane];
                LDS_WAIT(); asm volatile("" ::: "memory");
#pragma unroll
                for (int r = 0; r < 16; ++r) { const int q = crow(r, hi);
#define ATT_X(d) ((r & 1) ? bf_hi(xr[(d) * 8 + (r >> 1)]) : bf_lo(xr[(d) * 8 + (r >> 1)]))
                    const float o0 = O[0][r] * sc[r] - ATT_X(0), o1 = O[1][r] * sc[r] - ATT_X(1), o2 = O[2][r] * sc[r] - ATT_X(2), o3 = O[3][r] * sc[r] - ATT_X(3);
#undef ATT_X
                    float ss = o0 * o0 + o1 * o1 + o2 * o2 + o3 * o3;
                    ss = sum8(ss); ss += dppf<0x140>(ss); ss = swap16_add(ss, ss);
                    const float rstd = __builtin_amdgcn_rsqf(ss * (1.0f / 128.0f) + EPS) * osc;
                    LAS bf16_t* sp = (LAS bf16_t*)(lds + A_OST + wq * 32 * A_OSTRIDE + q * A_OSTRIDE) + r32;
                    sp[0] = (bf16_t)f2bf(o0 * rstd * sub0); sp[32] = (bf16_t)f2bf(o1 * rstd * sub1); sp[64] = (bf16_t)f2bf(o2 * rstd * sub2); sp[96] = (bf16_t)f2bf(o3 * rstd * sub3); }
                LDS_WAIT(); asm volatile("" ::: "memory");
                char* ob = (char*)(AO + (tok0 + q0) * 1024 + h * 128);
#pragma unroll
                for (int i = 0; i < 8; ++i) { const int id = i * 64 + lane, row = id >> 4, c16 = id & 15;
                    *(u32x4*)(ob + (unsigned)(row * 2048 + c16 * 16)) = *(const LAS u32x4*)(lds + A_OST + wq * 32 * A_OSTRIDE + row * A_OSTRIDE + c16 * 16); }
            }
        }
    }
#undef ATT_DMA
#undef ATT_UNIT
#undef ATT_PROLOGUE_DMA
#undef ATT_WAITBAR
#ifdef ATT_PROBE
    if (blockIdx.x == 0 && tid == ATT_PROBE * 64) __hip_atomic_store((unsigned long long*)(F.ctl + 8400), att_tw, __ATOMIC_RELAXED, __HIP_MEMORY_SCOPE_AGENT);
#endif
}

__device__ __forceinline__ void phase_attention(Frame& F) {
    const float gq = wave_max(fabsf(F.inp(I_QNORM)[F.lane])), gk = wave_max(fabsf(F.inp(I_KNORM)[F.lane]));
    const float bound = 8.0f * LOG2E * gq * gk * 1.001f + 0.01f;
    if (bound > 96.0f) phase_attention_impl<true>(F, bound - 96.0f); else phase_attention_impl<false>(F, 0.0f);
}
constexpr int N_PHASES = 17;
#ifndef MK_N_LAUNCHES
#define MK_N_LAUNCHES 1
#endif
struct Args { const float* in[26]; float* out; unsigned char* ws; int ph_lo, ph_hi; };

__global__ void __launch_bounds__(NTHREADS, 2) yoco_fwd(Args args) {
    extern __shared__ __attribute__((aligned(16))) unsigned char lds_raw[];
    Frame F;
    F.lds = (LAS unsigned char*)lds_raw;
    const int wave0 = __builtin_amdgcn_readfirstlane((int)threadIdx.x >> 6);
    F.G = gridDim.x; { const int bx = blockIdx.x; F.vcu = (F.G % 8 == 0) ? (bx % 8) * (F.G / 8) + bx / 8 : bx; }
#define FRESH_IN() do { kargp_t _t = (kargp_t)__builtin_amdgcn_kernarg_segment_ptr(); asm volatile("" : "+s"(_t)); F.kin = _t; \
        F.out = (float*)(GAS float*)_t[26]; F.ws = (unsigned char*)(GAS unsigned char*)_t[27]; F.ctl = (unsigned*)(F.ws + WS_CTL); \
        int _tid; asm volatile("v_mbcnt_lo_u32_b32 %0, -1, 0\n\tv_mbcnt_hi_u32_b32 %0, -1, %0" : "=v"(_tid)); _tid += wave0 * 64; asm volatile("" : "+v"(_tid)); F.tid = _tid;     \
        F.lane = _tid & 63; F.wave = __builtin_amdgcn_readfirstlane(_tid >> 6); } while (0)
    FRESH_IN();
    volatile LAS unsigned* MISC = (volatile LAS unsigned*)(F.lds + MISC_OFF);
    LAS int* rbs = (LAS int*)(F.lds + MISC_OFF + 256);
    LAS int* rowtab = (LAS int*)(F.lds + ROWTAB_OFF);
    LAS int* utab = (LAS int*)(F.lds + MISC_OFF + 1024);
    for (int u = F.tid; u < 512; u += NTHREADS) MISC[u] = 0u;
#ifdef GEMM_PROBE
    if (blockIdx.x == 0 && F.tid == 0) g_pr = 0ull;
#endif
    __syncthreads();
    const int lo = args.ph_lo, hi = args.ph_hi;
    const bool multi = (hi - lo) > 1;
    XcdBarrier bar; bar.bar = nullptr; bar.x = 0; bar.st = nullptr;
    if (multi) bar = xcd_barrier_post(F.ctl + CW_BAR, MISC + 8);
#ifdef ONLY_PHASE
#define IN(k) ((k) == ONLY_PHASE && lo <= (k) && (k) < hi)
#else
#define IN(k) (lo <= (k) && (k) < hi)
#endif
#if defined(PROBE_A) || defined(PROBE_B)
#ifndef PROBE_A
#define PROBE_A 0
#endif
#ifndef PROBE_B
#define PROBE_B 0
#endif
#ifndef PROBE_CONST
#define PROBE_CONST 0ull
#endif
#ifndef PROBE_MUL
#define PROBE_MUL 0ull
#endif
    unsigned long long pr_prev = __builtin_amdgcn_s_memrealtime(), pr_a = 0, pr_b = 0;
#define PROBE_STAMP(k) do { const unsigned long long _n = __builtin_amdgcn_s_memrealtime(); if ((PROBE_A >> (k)) & 1) pr_a += _n - pr_prev; if ((PROBE_B >> (k)) & 1) pr_b += _n - pr_prev; pr_prev = _n; } while (0)
#else
#define PROBE_STAMP(k) do {} while (0)
#endif
#ifdef BAR_PROBE
#define SEAM(k) do { if (IN(k) && IN((k) + 1)) { bar.bar = F.ctl + CW_BAR; const unsigned long long _b0 = __builtin_amdgcn_s_memrealtime(); xcd_barrier(bar); pr_a += __builtin_amdgcn_s_memrealtime() - _b0; } else __syncthreads(); } while (0)
#else
#define SEAM(k) do { if (IN(k) && IN((k) + 1)) { bar.bar = F.ctl + CW_BAR; xcd_barrier(bar); } else __syncthreads(); PROBE_STAMP(k); } while (0)
#endif
    #define gw (F.vcu * NWAVES + F.wave)
#define NGW (F.G * NWAVES)

#if defined(P0_PROBE)
#define P0S(k) do { if (P0_PROBE == (k)) pr_a = __builtin_amdgcn_s_memrealtime() - pr_prev; } while (0)
#else
#define P0S(k) do {} while (0)
#endif
    if (IN(0)) { FRESH_IN(); P0S(0); adaln_phase(F); __syncthreads(); P0S(1); rope_table(F, blockIdx.x * NTHREADS + F.tid, F.G * NTHREADS); P0S(2); {
          const int blk = (int)blockIdx.x; if (blk < 224) convert_weights(F, 0, true, false, blk * 8 + F.wave, 1 << 20, 1792); else { const int s0 = 1792 + (blk - 224) * 40 + F.wave * 5; convert_weights(F, 0, true, false, s0, 1, s0 + 5); } }
        SEAM(0); }
    if (IN(1)) { FRESH_IN(); phase_h0(F); SEAM(1); }
    if (IN(2)) { FRESH_IN();
      {
        pg8::SchedPlain S{(const char*)(F.ws + WS_H), (const char*)(F.ws + WS_WIN), NTOK / 256, 24, 1024, F.G, (int)blockIdx.x};
        pg8::EpiInProj E{(bf16_t*)(F.ws + WS_QR), (bf16_t*)(F.ws + WS_KR), (bf16_t*)(F.ws + WS_VR), (bf16_t*)(F.ws + WS_SG), (const float*)(F.ws + WS_COS), (const float*)(F.ws + WS_SIN)};
        { const int nU = pg8::build_units(utab, S, F.tid); pg8::gemm_phase<pg8::EpiInProj, false>(F.lds, F.tid, 1024, utab, nU, E, rowtab); } }
      SEAM(2); }
    if (IN(3)) { FRESH_IN(); if (F.wave >= 4) __builtin_amdgcn_s_setprio(1);
        phase_retention(F); __builtin_amdgcn_s_setprio(0); SEAM(3); }
    if (IN(4)) { FRESH_IN(); phase_gate(F); SEAM(4); }
    if (IN(5)) { FRESH_IN(); pg8::SchedPlain S{(const char*)(F.ws + WS_VR), (const char*)(F.ws + WS_WRO), NTOK / 256, 4, 2048, F.G, (int)blockIdx.x};
        pg8::EpiResid<true> E{F.inp(I_X), (bf16_t*)(F.ws + WS_XB), (const float*)(F.ws + WS_MOD) + 2048};
        { const int nU = pg8::build_units(utab, S, F.tid); pg8::gemm_phase<pg8::EpiResid<true>, false>(F.lds, F.tid, 2048, utab, nU, E, rowtab); } SEAM(5); }
#pragma unroll 1
    for (int layer = 0; layer < 2; ++layer) {
        const int pb = layer ? 13 : 6;
        if (IN(pb)) { FRESH_IN(); phase_route(F, layer); SEAM(pb); }
        if (IN(pb + 1)) { FRESH_IN(); moe_tables(F, layer, rbs, rowtab, 8, true);
            pg8::SchedMoe S{(const char*)(F.ws + WS_H), (const char*)(F.ws + (layer ? WS_W13_L1 : WS_W13)), rbs, 8, F.G, (int)blockIdx.x, 1, (size_t)2048 * 1024 * 2};
            pg8::EpiMoeUp E{(bf16_t*)(F.ws + WS_HID)};
            { const int nU = pg8::build_units(utab, S, F.tid); pg8::gemm_phase<pg8::EpiMoeUp, true>(F.lds, F.tid, 1024, utab, nU, E, rowtab); } if (layer == 0) tail_convert(F, rbs, 8, 0); SEAM(pb + 1); }
        if (IN(pb + 2)) { FRESH_IN(); moe_tables(F, layer, rbs, rowtab, 4, false);
            pg8::SchedMoe S{(const char*)(F.ws + WS_HID), (const char*)(F.ws + (layer ? WS_W2_L1 : WS_W2)), rbs, 4, F.G, (int)blockIdx.x, 0, (size_t)1024 * 1024 * 2};
            pg8::EpiBf16 E{(bf16_t*)(F.ws + WS_YB), 1024};
            { const int nU = pg8::build_units(utab, S, F.tid); pg8::gemm_phase<pg8::EpiBf16, false>(F.lds, F.tid, 1024, utab, nU, E, rowtab); } if (layer == 0) tail_convert(F, rbs, 4, 1); SEAM(pb + 2); }
        if (layer == 0) {
            if (IN(9)) { FRESH_IN(); phase_mid(F, rbs); SEAM(9); }
            if (IN(10)) { FRESH_IN(); pg8::SchedQKV S{(const char*)(F.ws + WS_H), (const char*)(F.ws + WS_HKV), (const char*)(F.ws + WS_WQ), (const char*)(F.ws + WS_WKV), F.G, (int)blockIdx.x};
                pg8::EpiQKV E{(bf16_t*)(F.ws + WS_Q1), (bf16_t*)(F.ws + WS_K1), (bf16_t*)(F.ws + WS_V1), F.inp(I_QNORM), F.inp(I_KNORM)};
                { const int nU = pg8::build_units(utab, S, F.tid); pg8::gemm_phase<pg8::EpiQKV, false>(F.lds, F.tid, 1024, utab, nU, E, rowtab); } SEAM(10); }
            if (IN(11)) { FRESH_IN();
                if (F.wave >= 4) __builtin_amdgcn_s_setprio(1);
                phase_attention(F); __builtin_amdgcn_s_setprio(0);
                SEAM(11); }
            if (IN(12)) { FRESH_IN(); pg8::SchedPlain S{(const char*)(F.ws + WS_AO), (const char*)(F.ws + WS_WAO), NTOK / 256, 4, 1024, F.G, (int)blockIdx.x};
                pg8::EpiResid<false> E{(const void*)(F.ws + WS_XB), (bf16_t*)(F.ws + WS_XB), (const float*)(F.ws + WS_MOD) + 16 * 6144 + 2048};
                { const int nU = pg8::build_units(utab, S, F.tid); pg8::gemm_phase<pg8::EpiResid<false>, false>(F.lds, F.tid, 1024, utab, nU, E, rowtab); } SEAM(12); }
        }
    }
    if (IN(16)) { FRESH_IN(); phase_final(F, rbs); }
#if defined(PROBE_A) || defined(PROBE_B)
    __syncthreads(); PROBE_STAMP(16);
#if defined(ATT_PROBE) || defined(RET_PROBE)
    if (blockIdx.x == 0) pr_a = __hip_atomic_load((unsigned long long*)(F.ctl + 8400), __ATOMIC_RELAXED, __HIP_MEMORY_SCOPE_AGENT);
#endif
#ifdef GEMM_PROBE
    if (blockIdx.x == 0) pr_a = g_pr;
#endif
    if (blockIdx.x == 0) { const unsigned long long qa = (pr_a + 500ull) / 1000ull, spin = (PROBE_MUL ? pr_a * PROBE_MUL : qa * 100000ull) + pr_b + PROBE_CONST, t0 = __builtin_amdgcn_s_memrealtime();
        while (__builtin_amdgcn_s_memrealtime() - t0 < spin) __builtin_amdgcn_s_sleep(8); }
#endif
#undef IN
#undef SEAM
#undef gw
#undef NGW
}

extern "C" void kernel_launch(void* const* d_in, const int* in_sizes, int n_in, void* d_out, int out_size, void* d_ws, size_t ws_size, hipStream_t stream) {
    static int grid = 0;
    if (grid == 0) {
        if (n_in != 26 || in_sizes[0] != NTOK * DM || out_size != NTOK * DM || ws_size < WS_END) {
            fprintf(stderr, "kernel_launch: unexpected shapes (n_in %d, in0 %d, out %d, ws %zu < %zu); nothing launched\n", n_in, n_in > 0 ? in_sizes[0] : -1, out_size, ws_size, (size_t)WS_END); grid = -1; return; }
        int dev = 0, cus = 0, per_cu = 0;
        if (hipGetDevice(&dev) != hipSuccess || hipDeviceGetAttribute(&cus, hipDeviceAttributeMultiprocessorCount, dev) != hipSuccess) { grid = -1; return; }
        if (hipFuncSetAttribute((const void*)yoco_fwd, hipFuncAttributeMaxDynamicSharedMemorySize, LDS_BYTES) != hipSuccess) { fprintf(stderr, "kernel_launch: hipFuncSetAttribute failed\n"); grid = -1; return; }
        if (hipOccupancyMaxActiveBlocksPerMultiprocessor(&per_cu, (const void*)yoco_fwd, NTHREADS, LDS_BYTES) != hipSuccess || per_cu < 1) { fprintf(stderr, "kernel_launch: occupancy query says %d blocks per CU\n", per_cu); (void)hipGetLastError(); grid = -1; return; }
        if (cus != 256) { fprintf(stderr, "kernel_launch: built for a 256-CU device (got %d)\n", cus); grid = -1; return; }
        grid = cus;
    }
    if (grid < 0) return;
    (void)hipMemsetAsync((char*)d_ws + WS_CTL, 0, CTL_ZERO_BYTES, stream);
    Args a{};
    for (int i = 0; i < 26; ++i) a.in[i] = (const float*)d_in[i];
    a.out = (float*)d_out; a.ws = (unsigned char*)d_ws;
    if (MK_N_LAUNCHES == 1) { a.ph_lo = 0; a.ph_hi = N_PHASES; hipLaunchKernelGGL(yoco_fwd, dim3(grid), dim3(NTHREADS), LDS_BYTES, stream, a); }
    else { for (int p = 0; p < N_PHASES; ++p) { a.ph_lo = p; a.ph_hi = p + 1; hipLaunchKernelGGL(yoco_fwd, dim3(grid), dim3(NTHREADS), LDS_BYTES, stream, a); } }
}
```

```cpp
#include <hip/hip_runtime.h>
#include <cstdio>
#include <cstdint>

#define LAS __attribute__((address_space(3)))
#define GAS __attribute__((address_space(1)))
typedef unsigned short bf16_t;
typedef short bf16x8 __attribute__((ext_vector_type(8)));
typedef short s16x4 __attribute__((ext_vector_type(4)));
typedef float f32x2 __attribute__((ext_vector_type(2)));
typedef float f32x4 __attribute__((ext_vector_type(4)));
typedef float f32x16 __attribute__((ext_vector_type(16)));
typedef unsigned u32x2 __attribute__((ext_vector_type(2)));
typedef unsigned u32x4 __attribute__((ext_vector_type(4)));

constexpr int NTOK = 32768, DM = 1024, SEQ = 2048, NBATCH = 16;
constexpr float EPS = 1e-6f;
constexpr float LOG2E = 1.4426950408889634f;
constexpr int NWAVES = 8, NTHREADS = 512;

constexpr size_t MiB = 1u << 20;
constexpr size_t WS_CTL = 0, CTL_ZERO_BYTES = 1 * MiB;
constexpr size_t WS_MOD = 1 * MiB;
constexpr size_t WS_KVMOD = WS_MOD + 786432;
constexpr size_t WS_COS = 2 * MiB, WS_SIN = 3 * MiB;
constexpr size_t WS_LIST = 4 * MiB;
constexpr size_t WS_TOKSLOT = 6 * MiB;
constexpr size_t WS_TOKW = 6 * MiB + 512 * 1024;
constexpr size_t WS_WRT = 7 * MiB;
constexpr size_t WS_WIN = 8 * MiB, WS_WRO = 20 * MiB, WS_WKV = 24 * MiB, WS_WQ = 28 * MiB, WS_WAO = 30 * MiB;
constexpr size_t WS_W13 = 32 * MiB, WS_W2 = 96 * MiB;
constexpr size_t WS_W13_L1 = 192 * MiB, WS_W2_L1 = 32 * MiB;
constexpr size_t WS_XB = 128 * MiB;
constexpr size_t WS_SG = WS_XB;
constexpr size_t WS_H = 256 * MiB;
constexpr size_t WS_QR = 320 * MiB, WS_KR = 384 * MiB, WS_VR = 448 * MiB;
constexpr size_t WS_HID = 320 * MiB, WS_YB = 456 * MiB;
constexpr size_t WS_HKV = 320 * MiB, WS_Q1 = 384 * MiB, WS_K1 = 448 * MiB, WS_V1 = 512 * MiB, WS_AO = 320 * MiB;
constexpr size_t WS_END = 592 * MiB;
constexpr int MAXROWS = 69632;

constexpr int CW_BAR = 4096, CW_CNT0 = 8192, CW_CNT1 = 8256, CW_ATTQ = 8320, CW_ADALN = 8384;
constexpr int N_CONV = 16;

constexpr int RING_BYTES = 131072, ROWTAB_OFF = 131072, ROWTAB_BYTES = 16384, MISC_OFF = ROWTAB_OFF + ROWTAB_BYTES, LDS_BYTES = MISC_OFF + 2048;

__device__ __forceinline__ unsigned f2bf(float f) { unsigned u = __builtin_bit_cast(unsigned, f); return (u + 0x7fffu + ((u >> 16) & 1u)) >> 16; }
__device__ __forceinline__ unsigned pk2(float lo, float hi) { unsigned r; asm volatile("v_cvt_pk_bf16_f32 %0, %1, %2" : "=v"(r) : "v"(lo), "v"(hi)); return r; }
__device__ __forceinline__ float bf_lo(unsigned u) { return __builtin_bit_cast(float, u << 16); }
__device__ __forceinline__ float bf_hi(unsigned u) { return __builtin_bit_cast(float, u & 0xffff0000u); }
template <int CTRL> __device__ __forceinline__ float dppf(float v) { return __builtin_bit_cast(float, __builtin_amdgcn_update_dpp(0, __builtin_bit_cast(int, v), CTRL, 0xf, 0xf, true)); }
__device__ __forceinline__ float swap16_add(float a, float b) { asm volatile("s_nop 1\n\tv_permlane16_swap_b32 %0, %1" : "+v"(a), "+v"(b)); return a + b; }
__device__ __forceinline__ float swap32_add(float a, float b) { asm volatile("s_nop 1\n\tv_permlane32_swap_b32 %0, %1" : "+v"(a), "+v"(b)); return a + b; }
__device__ __forceinline__ float sum8(float v) { v += dppf<0xB1>(v); v += dppf<0x4E>(v); v += dppf<0x141>(v); return v; }
__device__ __forceinline__ float wave_sum(float v) { v = sum8(v); v += dppf<0x140>(v); v = swap16_add(v, v); return swap32_add(v, v); }
__device__ __forceinline__ float wave_max(float v) {
#pragma unroll
    for (int o = 1; o < 64; o <<= 1) v = fmaxf(v, __shfl_xor(v, o));
    return v;
}
__device__ __forceinline__ float fast_silu(float x) { return x * __builtin_amdgcn_rcpf(1.0f + __builtin_amdgcn_exp2f(-x * LOG2E)); }
#define LDS_WAIT() asm volatile("s_waitcnt lgkmcnt(0)" ::: "memory")
#define VM_WAIT() asm volatile("s_waitcnt vmcnt(0)" ::: "memory")

#define XB_TMO      128
#define XB_XCNT(j)  (256  + 64 * (j))
#define XB_XSUB(j)  (1280 + 64 * (j))
#define XB_XGEN(j)  (2304 + 64 * (j))
#define XB_TOP      3328
#define XB_TOPGEN   3392
#define XCD_BAR_WORDS 3456
#define XB_SPIN_CAP (1u << 22)
__device__ __forceinline__ unsigned xb_ld(unsigned* p)              { return __hip_atomic_load(p, __ATOMIC_RELAXED, __HIP_MEMORY_SCOPE_AGENT); }
__device__ __forceinline__ unsigned xb_add(unsigned* p, unsigned v) { return __hip_atomic_fetch_add(p, v, __ATOMIC_RELAXED, __HIP_MEMORY_SCOPE_AGENT); }
__device__ __forceinline__ unsigned xb_xcc_id() { return (unsigned)__builtin_amdgcn_s_getreg((3 << 11) | 20) & 0xFu; }
#define XB_SPIN(cond, bar) do { unsigned _sp = 0; while (cond) { __builtin_amdgcn_s_sleep(1); \
    if ((++_sp & 255u) == 0u) { if (xb_ld(&(bar)[XB_TMO])) break; if (_sp > XB_SPIN_CAP) { atomicAdd(&(bar)[XB_TMO], 1u); break; } } } } while (0)
struct XcdBarrier { unsigned* bar; unsigned x; volatile LAS unsigned* st; };
__device__ __forceinline__ XcdBarrier xcd_barrier_post(unsigned* bar, volatile LAS unsigned* st) {
    XcdBarrier b; b.bar = bar; b.x = xb_xcc_id(); b.st = st;
    if (threadIdx.x == 0) (void)xb_add(&bar[XB_XCNT(b.x)], 1u);
    return b;
}
__device__ __forceinline__ void xcd_barrier_complete(unsigned* bar, unsigned x, unsigned& nloc, unsigned& nx) {
    const unsigned G = gridDim.x * gridDim.y * gridDim.z;
    unsigned sum, cnt, mine, sp = 0u;
    for (;;) {
        sum = 0u; cnt = 0u; mine = 0u;
#pragma unroll
        for (unsigned j = 0; j < 16; ++j) { const unsigned c = xb_ld(&bar[XB_XCNT(j)]); sum += c; cnt += (c > 0u) ? 1u : 0u; mine = (j == x) ? c : mine; }
        if (sum == G) break;
        __builtin_amdgcn_s_sleep(1);
        if ((++sp & 255u) == 0u) { if (xb_ld(&bar[XB_TMO])) break; if (sp > XB_SPIN_CAP) { atomicAdd(&bar[XB_TMO], 1u); break; } }
    }
    nloc = mine > 0u ? mine : 1u; nx = cnt > 0u ? cnt : 1u;
}
__device__ __forceinline__ void xcd_barrier(const XcdBarrier& b) {
    asm volatile("s_waitcnt vmcnt(0)" ::: "memory");
    __syncthreads();
    if (threadIdx.x == 0) {
        unsigned* bar = b.bar;
        __builtin_amdgcn_s_waitcnt(0);
        unsigned nloc = b.st[0], nx = b.st[1];
        if (nloc == 0u) { xcd_barrier_complete(bar, b.x, nloc, nx); b.st[0] = nloc; b.st[1] = nx; }
        const unsigned old = xb_add(&bar[XB_XSUB(b.x)], 1u);
        const unsigned gen = old / nloc;
        if (old + 1u == (gen + 1u) * nloc) {
            __builtin_amdgcn_fence(__ATOMIC_RELEASE, "agent");
            asm volatile("s_waitcnt vmcnt(0)" ::: "memory");
            const unsigned og = xb_add(&bar[XB_TOP], 1u);
            const unsigned tg = og / nx;
            if (og + 1u == (tg + 1u) * nx) xb_add(&bar[XB_TOPGEN], 1u);
            else XB_SPIN(xb_ld(&bar[XB_TOPGEN]) == tg, bar);
            __builtin_amdgcn_fence(__ATOMIC_ACQUIRE, "agent");
            xb_add(&bar[XB_XGEN(b.x)], 1u);
            asm volatile("s_waitcnt vmcnt(0)" ::: "memory");
        } else {
            XB_SPIN(xb_ld(&bar[XB_XGEN(b.x)]) == gen, bar);
            __builtin_amdgcn_fence(__ATOMIC_ACQUIRE, "agent");
            asm volatile("s_waitcnt vmcnt(0)" ::: "memory");
        }
    }
    __syncthreads();
}
#ifdef GEMM_PROBE
#ifndef GEMM_PROBE_SEL
#define GEMM_PROBE_SEL 31
#endif
__device__ unsigned long long g_pr;
#endif
namespace pg8 {
constexpr int BM = 256, BK = 64, HALF = 128, HTB = HALF * BK * 2, STAGE_BYTES = 8 * HTB, NXCD = 8, WGM = 8;
__host__ __device__ __forceinline__ int lds_byte(int r, int c) { const int st = (r >> 4) * 2 + (c >> 5), rr = r & 15, cc = c & 31, ob = rr * 64 + cc * 2; return st * 1024 + (ob ^ (((ob >> 9) & 1) << 5)); }
__host__ __device__ __forceinline__ void stage_rc(int b, int& R, int& C) { const int st = b / 1024, sb = b % 1024, swz = sb ^ (((sb >> 9) & 1) << 5); R = (st >> 1) * 16 + swz / 64; C = (st & 1) * 32 + (swz % 64) / 2; }
__host__ __device__ __forceinline__ int perm32(int rho) { const int n = rho >> 4, i = rho & 15; return 8 * (i >> 2) + 4 * n + (i & 3); }

struct Unit { const char* A; const char* B; int pm, pn, rows; };

__device__ __forceinline__ bool static_order(int nM, int nN, int G, int c, int i, int& pm, int& pn) {
    const int nwg = nM * nN; const long L = (long)i * G + c; if (L >= nwg) return false;
    int wgid = (int)L; { const int q = nwg / NXCD, r = nwg % NXCD, xcd = wgid % NXCD, off = wgid / NXCD; wgid = (xcd < r ? xcd * (q + 1) : r * (q + 1) + (xcd - r) * q) + off; }
    const int nig = WGM * nN, gid = wgid / nig, fm = gid * WGM, gsz = (nM - fm) < WGM ? (nM - fm) : WGM;
    pm = fm + ((wgid % nig) % gsz); pn = (wgid % nig) / gsz; return true;
}
__device__ __forceinline__ int xcd_remap(int L, int nwg) { const int q = nwg / NXCD, r = nwg % NXCD, xcd = L % NXCD, off = L / NXCD; return (xcd < r ? xcd * (q + 1) : r * (q + 1) + (xcd - r) * q) + off; }

__device__ __forceinline__ bool load_unit(const LAS int* utab, int nU, int i, Unit& u) {
    if (i >= nU) return false;
    const LAS int* p = utab + i * 8;
    const unsigned alo = __builtin_amdgcn_readfirstlane(p[0]), ahi = __builtin_amdgcn_readfirstlane(p[1]), blo = __builtin_amdgcn_readfirstlane(p[2]), bhi = __builtin_amdgcn_readfirstlane(p[3]);
    u.A = (const char*)(((unsigned long long)ahi << 32) | alo); u.B = (const char*)(((unsigned long long)bhi << 32) | blo);
    u.pm = __builtin_amdgcn_readfirstlane(p[4]); u.pn = __builtin_amdgcn_readfirstlane(p[5]); u.rows = __builtin_amdgcn_readfirstlane(p[6]); return true;
}
template <class Sched>
__device__ __forceinline__ int build_units(LAS int* utab, const Sched& S, const int tid) {
    const int i = tid;
    if (i < 16) { Unit u; const bool ok = S.next(i, u); LAS int* p = utab + i * 8;
        if (ok) { const unsigned long long a = (unsigned long long)u.A, b = (unsigned long long)u.B; p[0] = (int)(unsigned)a; p[1] = (int)(unsigned)(a >> 32); p[2] = (int)(unsigned)b; p[3] = (int)(unsigned)(b >> 32); p[4] = u.pm; p[5] = u.pn; p[6] = u.rows; }
        p[7] = ok ? 1 : 0; }
    __syncthreads();
    int n = 0;
#pragma unroll
    for (int k = 0; k < 16; ++k) n += utab[k * 8 + 7];
    return __builtin_amdgcn_readfirstlane(n);
}
template <class Epi, bool GATHER>
__device__ __forceinline__ void gemm_phase(LAS unsigned char* lds, const int tid, const int K, const LAS int* utab, const int nU, const Epi& E, const LAS int* rowtab) {
    const int wid = __builtin_amdgcn_readfirstlane(tid >> 6), lane = tid & 63, wr = wid >> 2, wc = wid & 3, fr = lane & 15, fq = lane >> 4;
    const int nt = K / BK;
    unsigned vA[2][2], vN[2][2], voffB[2]; int Rr[2], Cc[2];
#pragma unroll
    for (int i = 0; i < 2; ++i) { int R, C; stage_rc(tid * 16 + i * 8192, R, C); const int Rb = Epi::PERM ? ((R & ~31) + perm32(R & 31)) : R; Rr[i] = R; Cc[i] = C;
        voffB[i] = (unsigned)(Rb * K + C) * 2u; }
#define PG8_CALCA(u, v) do { _Pragma("unroll") for (int _h = 0; _h < 2; ++_h) _Pragma("unroll") for (int _i = 0; _i < 2; ++_i) { const int _r = _h * HALF + Rr[_i]; \
        const int _row = GATHER ? rowtab[((u).rows >> 2) + _r] : _r; (v)[_h][_i] = (unsigned)(_row * K + Cc[_i]) * 2u; } } while (0)
    const size_t kstep = (size_t)(BK * 2);
    const size_t hstep = (size_t)HALF * K * 2;
    const unsigned ldsw = (unsigned)wid * 1024u;
    const int aoff = lds_byte(wr * 64 + fr, fq * 8), boff = lds_byte(wc * 32 + fr, fq * 8);
#define PG8_SA(b, h) (((b) * 2 + (h)) * HTB)
#define PG8_SB(b, h) ((4 + (b) * 2 + (h)) * HTB)
#define PG8_STAGE(bufoff, gbase, voff) do { _Pragma("unroll") for (int _i = 0; _i < 2; ++_i) \
        __builtin_amdgcn_global_load_lds((const unsigned*)((const char*)(gbase) + (voff)[_i]), (LAS unsigned*)(lds + (bufoff) + ldsw + _i * 8192), 16, 0, 0); } while (0)
#define PG8_LDA(dst, b, h) do { _Pragma("unroll") for (int m = 0; m < 4; ++m) _Pragma("unroll") for (int k = 0; k < 2; ++k) dst[m][k] = *(const LAS bf16x8*)(lds + PG8_SA(b, h) + aoff + m * 2048 + k * 1024); } while (0)
#define PG8_LDB(dst, b, h) do { _Pragma("unroll") for (int n = 0; n < 2; ++n) _Pragma("unroll") for (int k = 0; k < 2; ++k) dst[n][k] = *(const LAS bf16x8*)(lds + PG8_SB(b, h) + boff + n * 2048 + k * 1024); } while (0)
#define PG8_MMA(ai, bj, At, Bt) do { __builtin_amdgcn_s_setprio(1); _Pragma("unroll") for (int m = 0; m < 4; ++m) _Pragma("unroll") for (int n = 0; n < 2; ++n) _Pragma("unroll") for (int k = 0; k < 2; ++k) \
        acc[ai][bj][m][n] = __builtin_amdgcn_mfma_f32_16x16x32_bf16(Bt[n][k], At[m][k], acc[ai][bj][m][n], 0, 0, 0); __builtin_amdgcn_s_setprio(0); } while (0)
#define PG8_WAIT_V(n) asm volatile("s_waitcnt vmcnt(" #n ")" ::: "memory")
#define PG8_WAIT_L(n) asm volatile("s_waitcnt lgkmcnt(" #n ")" ::: "memory")
#define PG8_BAR __builtin_amdgcn_s_barrier()
#define PG8_SCHED __builtin_amdgcn_sched_barrier(0)
    Unit cur, nxt; int ui = 0;
    if (!load_unit(utab, nU, 0, cur)) return;
    f32x4 acc[2][2][4][2];
#pragma unroll
    for (int a = 0; a < 2; ++a)
#pragma unroll
        for (int b = 0; b < 2; ++b)
#pragma unroll
            for (int m = 0; m < 4; ++m)
#pragma unroll
                for (int n = 0; n < 2; ++n) acc[a][b][m][n] = (f32x4){0.f, 0.f, 0.f, 0.f};
    bf16x8 At[4][2], B0[2][2], B1[2][2];
    const char* cA = cur.A; const char* cB = cur.B;
    PG8_CALCA(cur, vA);
    PG8_STAGE(PG8_SB(0, 0), cB, voffB); PG8_STAGE(PG8_SB(0, 1), cB + hstep, voffB); PG8_STAGE(PG8_SA(0, 0), cA, vA[0]); PG8_STAGE(PG8_SA(0, 1), cA, vA[1]);
    if (wr == 1) PG8_BAR;
    PG8_WAIT_V(2); PG8_BAR;
    PG8_STAGE(PG8_SB(1, 0), cB + kstep, voffB); PG8_STAGE(PG8_SA(1, 0), cA + kstep, vA[0]); PG8_STAGE(PG8_SB(1, 1), cB + hstep + kstep, voffB);
    PG8_WAIT_V(6); PG8_BAR;
    for (;;) {
        const bool has_next = load_unit(utab, nU, ui + 1, nxt);
        const char* nA = has_next ? nxt.A : cA; const char* nB = has_next ? nxt.B : cB;
        if (GATHER) {
            if (has_next) { PG8_CALCA(nxt, vN); }
            else {
#pragma unroll
                for (int h = 0; h < 2; ++h) { vN[h][0] = vA[h][0]; vN[h][1] = vA[h][1]; }
            }
        }
#if defined(GEMM_PROBE) && GEMM_PROBE == 3
        const unsigned long long _k0 = __builtin_amdgcn_s_memrealtime();
#endif
        for (int t = 0; t < nt; t += 2) {
            const bool last = (t == nt - 2);
            const char* a1 = cA + (size_t)(t + 1) * kstep;
            const char* a2 = last ? nA : cA + (size_t)(t + 2) * kstep; const char* b2 = last ? nB : cB + (size_t)(t + 2) * kstep;
            const char* a3 = a2 + kstep; const char* b3 = b2 + kstep;
            unsigned w0[2], w1[2];
#pragma unroll
            for (int i = 0; i < 2; ++i) { w0[i] = (GATHER && last) ? vN[0][i] : vA[0][i]; w1[i] = (GATHER && last) ? vN[1][i] : vA[1][i]; }
            PG8_LDB(B0, 0, 0); PG8_LDB(B1, 0, 1); PG8_SCHED; PG8_LDA(At, 0, 0); PG8_STAGE(PG8_SA(1, 1), a1, vA[1]);
            PG8_WAIT_V(8); PG8_WAIT_L(0); PG8_BAR; PG8_MMA(0, 0, At, B0); PG8_MMA(0, 1, At, B1); PG8_BAR; PG8_SCHED;
            PG8_LDA(At, 0, 1); PG8_STAGE(PG8_SB(0, 0), b2, voffB); PG8_STAGE(PG8_SB(0, 1), b2 + hstep, voffB); PG8_STAGE(PG8_SA(0, 0), a2, w0);
            PG8_WAIT_V(8); PG8_WAIT_L(0); PG8_BAR; PG8_MMA(1, 0, At, B0); PG8_MMA(1, 1, At, B1); PG8_BAR; PG8_SCHED;
            PG8_LDB(B0, 1, 0); PG8_LDB(B1, 1, 1); PG8_SCHED; PG8_LDA(At, 1, 0); PG8_STAGE(PG8_SA(0, 1), a2, w1);
            PG8_WAIT_V(8); PG8_WAIT_L(0); PG8_BAR; PG8_MMA(0, 0, At, B0); PG8_MMA(0, 1, At, B1); PG8_BAR; PG8_SCHED;
            PG8_LDA(At, 1, 1); PG8_STAGE(PG8_SB(1, 0), b3, voffB); PG8_STAGE(PG8_SB(1, 1), b3 + hstep, voffB); PG8_STAGE(PG8_SA(1, 0), a3, w0);
            PG8_WAIT_V(8); PG8_WAIT_L(0); PG8_BAR; PG8_MMA(1, 0, At, B0); PG8_MMA(1, 1, At, B1); PG8_BAR; PG8_SCHED;
        }
#if defined(GEMM_PROBE) && GEMM_PROBE == 3
        if (blockIdx.x == 0 && tid == 0 && ((GEMM_PROBE_SEL >> Epi::PID) & 1)) g_pr += __builtin_amdgcn_s_memrealtime() - _k0;
#endif
#ifdef GEMM_PROBE
        const unsigned long long _g0 = __builtin_amdgcn_s_memrealtime();
#endif
        if (wr == 0) PG8_BAR;
        E(acc, cur, wr, wc, fr, fq);
#ifdef GEMM_PROBE
#if GEMM_PROBE == 2
        asm volatile("s_waitcnt vmcnt(0)" ::: "memory");
#endif
#if GEMM_PROBE != 3
        if (blockIdx.x == 0 && tid == 0 && ((GEMM_PROBE_SEL >> Epi::PID) & 1)) g_pr += __builtin_amdgcn_s_memrealtime() - _g0;
#endif
#endif
        if (!has_next) break;
#pragma unroll
        for (int a = 0; a < 2; ++a)
#pragma unroll
            for (int b = 0; b < 2; ++b)
#pragma unroll
                for (int m = 0; m < 4; ++m)
#pragma unroll
                    for (int n = 0; n < 2; ++n) acc[a][b][m][n] = (f32x4){0.f, 0.f, 0.f, 0.f};
        cur = nxt; cA = nA; cB = nB; ++ui;
        if (GATHER) {
#pragma unroll
            for (int h = 0; h < 2; ++h) { vA[h][0] = vN[h][0]; vA[h][1] = vN[h][1]; }
        }
        if (wr == 1) PG8_BAR;
    }
    PG8_WAIT_V(0);
    PG8_BAR;
#undef PG8_CALCA
#undef PG8_SA
#undef PG8_SB
#undef PG8_STAGE
#undef PG8_LDA
#undef PG8_LDB
#undef PG8_MMA
#undef PG8_WAIT_V
#undef PG8_WAIT_L
#undef PG8_BAR
#undef PG8_SCHED
}
}
namespace pg8 {
typedef f32x4 Acc[2][2][4][2];

struct EpiInProj {
    static constexpr bool PERM = true; static constexpr int PID = 0;
    bf16_t *Q, *Kk, *V, *G; const float *cosT, *sinT;
    __device__ __forceinline__ void operator()(const Acc& acc, const Unit& u, int wr, int wc, int fr, int fq) const {
        const int pn = u.pn, row0 = u.pm * BM + wr * 64 + fr;
        if (pn < 8) {
            const int head = pn & 3; const bool isk = pn >= 4;
            const float lg = __builtin_log2f(1.0f - __builtin_exp2f(-5.0f - (float)head));
            bf16_t* out = isk ? Kk : Q;
            const int j0 = wc * 32 + 8 * fq;
            const int pos0 = row0 & (SEQ - 1);
            f32x4 cb[2][2], sb[2][2], cst[2], sst[2];
#pragma unroll
            for (int n = 0; n < 2; ++n) {
#pragma unroll
                for (int ai = 0; ai < 2; ++ai) { cb[ai][n] = *(const f32x4*)(cosT + (pos0 + ai * HALF) * 128 + j0 + 4 * n); sb[ai][n] = *(const f32x4*)(sinT + (pos0 + ai * HALF) * 128 + j0 + 4 * n); }
                cst[n] = *(const f32x4*)(cosT + 16 * 128 + j0 + 4 * n); sst[n] = *(const f32x4*)(sinT + 16 * 128 + j0 + 4 * n); }
#pragma unroll
            for (int ai = 0; ai < 2; ++ai) {
                f32x4 c4[2] = {cb[ai][0], cb[ai][1]}, s4[2] = {sb[ai][0], sb[ai][1]};
#pragma unroll
                for (int m = 0; m < 4; ++m) {
                    const int row = row0 + ai * HALF + m * 16, pos = row & (SEQ - 1), nn = pos & 63;
                    const float sc = isk ? __builtin_exp2f(-(float)nn * lg) * 0.0625f : __builtin_exp2f((float)nn * lg);
                    u32x4 w1, w2;
#pragma unroll
                    for (int n = 0; n < 2; ++n) {
                        const f32x4 x1 = acc[ai][0][m][n], x2 = acc[ai][1][m][n];
                        const f32x4 o1 = (x1 * c4[n] - x2 * s4[n]) * sc, o2 = (x2 * c4[n] + x1 * s4[n]) * sc;
                        w1[2 * n] = pk2(o1[0], o1[1]); w1[2 * n + 1] = pk2(o1[2], o1[3]); w2[2 * n] = pk2(o2[0], o2[1]); w2[2 * n + 1] = pk2(o2[2], o2[3]);
                        if (m < 3) { const f32x4 cn = c4[n] * cst[n] - s4[n] * sst[n], sn = s4[n] * cst[n] + c4[n] * sst[n]; c4[n] = cn; s4[n] = sn; }
                    }
                    bf16_t* p = out + (size_t)row * 1024 + head * 256 + j0;
                    *(u32x4*)p = w1; *(u32x4*)(p + 128) = w2;
                }
            }
        } else {
            const bool isg = pn >= 16; bf16_t* out = isg ? G : V; const int col0 = (isg ? pn - 16 : pn - 8) * 256 + wc * 32 + 8 * fq;
#pragma unroll
            for (int ai = 0; ai < 2; ++ai)
#pragma unroll
                for (int m = 0; m < 4; ++m) { bf16_t* rowp = out + (size_t)(row0 + ai * HALF + m * 16) * 2048 + col0;
#pragma unroll
                    for (int bj = 0; bj < 2; ++bj) { f32x4 v0 = acc[ai][bj][m][0], v1 = acc[ai][bj][m][1];
                        if (isg) {
#pragma unroll
                            for (int e = 0; e < 4; ++e) { v0[e] = fast_silu(v0[e]); v1[e] = fast_silu(v1[e]); } }
                        u32x4 w; w.x = pk2(v0[0], v0[1]); w.y = pk2(v0[2], v0[3]); w.z = pk2(v1[0], v1[1]); w.w = pk2(v1[2], v1[3]);
                        *(u32x4*)(rowp + bj * HALF) = w; } }
        }
    }
};
struct EpiMoeUp {
    static constexpr bool PERM = true; static constexpr int PID = 1;
    bf16_t* O;
    __device__ __forceinline__ void operator()(const Acc& acc, const Unit& u, int wr, int wc, int fr, int fq) const {
        const int row0 = u.pm * BM + wr * 64 + fr, col0 = u.pn * 128 + wc * 32 + 8 * fq;
#pragma unroll
        for (int ai = 0; ai < 2; ++ai)
#pragma unroll
            for (int m = 0; m < 4; ++m) {
                f32x4 v0 = acc[ai][0][m][0], v1 = acc[ai][0][m][1]; const f32x4 g0 = acc[ai][1][m][0], g1 = acc[ai][1][m][1];
#pragma unroll
                for (int e = 0; e < 4; ++e) { v0[e] = fast_silu(v0[e]) * g0[e]; v1[e] = fast_silu(v1[e]) * g1[e]; }
                u32x4 w; w.x = pk2(v0[0], v0[1]); w.y = pk2(v0[2], v0[3]); w.z = pk2(v1[0], v1[1]); w.w = pk2(v1[2], v1[3]);
                *(u32x4*)(O + (size_t)(row0 + ai * HALF + m * 16) * 1024 + col0) = w;
            }
    }
};
struct EpiBf16 {
    static constexpr bool PERM = true; static constexpr int PID = 2;
    bf16_t* O; int ldc;
    __device__ __forceinline__ void operator()(const Acc& acc, const Unit& u, int wr, int wc, int fr, int fq) const {
        const int row0 = u.pm * BM + wr * 64 + fr, col0 = u.pn * BM + wc * 32 + 8 * fq;
#pragma unroll
        for (int ai = 0; ai < 2; ++ai)
#pragma unroll
            for (int m = 0; m < 4; ++m) { bf16_t* rowp = O + (size_t)(row0 + ai * HALF + m * 16) * ldc + col0;
#pragma unroll
                for (int bj = 0; bj < 2; ++bj) { const f32x4 v0 = acc[ai][bj][m][0], v1 = acc[ai][bj][m][1];
                    u32x4 w; w.x = pk2(v0[0], v0[1]); w.y = pk2(v0[2], v0[3]); w.z = pk2(v1[0], v1[1]); w.w = pk2(v1[2], v1[3]);
                    *(u32x4*)(rowp + bj * HALF) = w; } }
    }
};
template <bool BASE_F32>
struct EpiResid {
    static constexpr bool PERM = true; static constexpr int PID = 3;
    const void* base; bf16_t* out; const float* gate;
    __device__ __forceinline__ void operator()(const Acc& acc, const Unit& u, int wr, int wc, int fr, int fq) const {
        const int row0 = u.pm * BM + wr * 64 + fr, col0 = u.pn * BM + wc * 32 + 8 * fq;
        const float* gp = gate + (size_t)((u.pm * BM) / SEQ) * 6144 + col0;
        f32x4 gv[2][2];
#pragma unroll
        for (int bj = 0; bj < 2; ++bj)
#pragma unroll
            for (int n = 0; n < 2; ++n) gv[bj][n] = *(const f32x4*)(gp + bj * HALF + n * 4);
        if (BASE_F32) {
#pragma unroll
            for (int ai = 0; ai < 2; ++ai) { f32x4 b[4][2][2];
#pragma unroll
                for (int m = 0; m < 4; ++m)
#pragma unroll
                    for (int bj = 0; bj < 2; ++bj) { const float* bp = (const float*)base + (size_t)(row0 + ai * HALF + m * 16) * 1024 + col0 + bj * HALF; b[m][bj][0] = *(const f32x4*)bp; b[m][bj][1] = *(const f32x4*)(bp + 4); }
                asm volatile("" ::: "memory");
#pragma unroll
                for (int m = 0; m < 4; ++m)
#pragma unroll
                    for (int bj = 0; bj < 2; ++bj) { const size_t off = (size_t)(row0 + ai * HALF + m * 16) * 1024 + col0 + bj * HALF;
                        const f32x4 v0 = b[m][bj][0] + gv[bj][0] * acc[ai][bj][m][0], v1 = b[m][bj][1] + gv[bj][1] * acc[ai][bj][m][1];
                        u32x4 w; w.x = pk2(v0[0], v0[1]); w.y = pk2(v0[2], v0[3]); w.z = pk2(v1[0], v1[1]); w.w = pk2(v1[2], v1[3]);
                        *(u32x4*)(out + off) = w; }
                asm volatile("" ::: "memory"); }
        } else {
            u32x4 q[2][4][2];
#pragma unroll
            for (int ai = 0; ai < 2; ++ai)
#pragma unroll
                for (int m = 0; m < 4; ++m)
#pragma unroll
                    for (int bj = 0; bj < 2; ++bj) q[ai][m][bj] = *(const u32x4*)((const bf16_t*)base + (size_t)(row0 + ai * HALF + m * 16) * 1024 + col0 + bj * HALF);
            asm volatile("" ::: "memory");
#pragma unroll
            for (int ai = 0; ai < 2; ++ai)
#pragma unroll
                for (int m = 0; m < 4; ++m)
#pragma unroll
                    for (int bj = 0; bj < 2; ++bj) { const size_t off = (size_t)(row0 + ai * HALF + m * 16) * 1024 + col0 + bj * HALF; const u32x4 qq = q[ai][m][bj];
                        const f32x4 b0 = (f32x4){bf_lo(qq.x), bf_hi(qq.x), bf_lo(qq.y), bf_hi(qq.y)}, b1 = (f32x4){bf_lo(qq.z), bf_hi(qq.z), bf_lo(qq.w), bf_hi(qq.w)};
                        const f32x4 v0 = b0 + gv[bj][0] * acc[ai][bj][m][0], v1 = b1 + gv[bj][1] * acc[ai][bj][m][1];
                        u32x4 w; w.x = pk2(v0[0], v0[1]); w.y = pk2(v0[2], v0[3]); w.z = pk2(v1[0], v1[1]); w.w = pk2(v1[2], v1[3]);
                        *(u32x4*)(out + off) = w; }
        }
    }
};
struct EpiQKV {
    static constexpr bool PERM = true; static constexpr int PID = 4;
    bf16_t *Q, *Kk, *V; const float *qn, *kn;
    __device__ __forceinline__ void operator()(const Acc& acc, const Unit& u, int wr, int wc, int fr, int fq) const {
        const int pn = u.pn, row0 = u.pm * BM + wr * 64 + fr;
        if (pn < 8) {
            const bool isk = pn >= 4; bf16_t* out = isk ? Kk : Q; const float* gn = isk ? kn : qn; const float osc = isk ? 1.0f : 0.125f * LOG2E;
            const int col0 = (pn & 3) * 256 + 64 * wc + 8 * fq;
            f32x4 gq[2][2];
#pragma unroll
            for (int bj = 0; bj < 2; ++bj) { gq[bj][0] = *(const f32x4*)(gn + 32 * bj + 8 * fq); gq[bj][1] = *(const f32x4*)(gn + 32 * bj + 8 * fq + 4); }
#pragma unroll
            for (int ai = 0; ai < 2; ++ai)
#pragma unroll
                for (int m = 0; m < 4; ++m) {
                    float ss = 0.f;
#pragma unroll
                    for (int bj = 0; bj < 2; ++bj)
#pragma unroll
                        for (int n = 0; n < 2; ++n) { const f32x4 x = acc[ai][bj][m][n]; ss += (x[0] * x[0] + x[1] * x[1]) + (x[2] * x[2] + x[3] * x[3]); }
                    ss = swap16_add(ss, ss); ss = swap32_add(ss, ss);
                    const float rstd = __builtin_amdgcn_rsqf(ss * (1.0f / 64.0f) + EPS) * osc;
                    bf16_t* rowp = out + (size_t)(row0 + ai * HALF + m * 16) * 1024 + col0;
#pragma unroll
                    for (int bj = 0; bj < 2; ++bj) { const f32x4 g0 = gq[bj][0], g1 = gq[bj][1];
                        const f32x4 v0 = acc[ai][bj][m][0] * rstd * g0, v1 = acc[ai][bj][m][1] * rstd * g1;
                        u32x4 w; w.x = pk2(v0[0], v0[1]); w.y = pk2(v0[2], v0[3]); w.z = pk2(v1[0], v1[1]); w.w = pk2(v1[2], v1[3]);
                        *(u32x4*)(rowp + 32 * bj) = w; }
                    asm volatile("" ::: "memory");
                }
        } else {
            const int col0 = (pn - 8) * 256 + wc * 32 + 8 * fq;
#pragma unroll
            for (int ai = 0; ai < 2; ++ai)
#pragma unroll
                for (int m = 0; m < 4; ++m) { bf16_t* rowp = V + (size_t)(row0 + ai * HALF + m * 16) * 1024 + col0;
#pragma unroll
                    for (int bj = 0; bj < 2; ++bj) { const f32x4 v0 = acc[ai][bj][m][0], v1 = acc[ai][bj][m][1];
                        u32x4 w; w.x = pk2(v0[0], v0[1]); w.y = pk2(v0[2], v0[3]); w.z = pk2(v1[0], v1[1]); w.w = pk2(v1[2], v1[3]);
                        *(u32x4*)(rowp + bj * HALF) = w; } }
        }
    }
};

struct SchedPlain {
    const char *A, *B; int nM, nN, K, G, c;
    __device__ __forceinline__ bool next(int i, Unit& u) const { int pm, pn; if (!static_order(nM, nN, G, c, i, pm, pn)) return false;
        u.pm = pm; u.pn = pn; u.rows = 0; u.A = A + (size_t)pm * BM * K * 2; u.B = B + (size_t)pn * BM * K * 2; return true; }
};
struct SchedQKV {
    const char *Aq, *Akv, *Bq, *Bkv; int G, c;
    __device__ __forceinline__ bool next(int i, Unit& u) const { int pm, pn; if (!static_order(NTOK / BM, 12, G, c, i, pm, pn)) return false;
        u.pm = pm; u.pn = pn; u.rows = 0; const size_t ts = (size_t)BM * 1024 * 2;
        u.A = (pn < 4 ? Aq : Akv) + (size_t)pm * ts; u.B = pn < 4 ? Bq + (size_t)pn * ts : Bkv + (size_t)(pn - 4) * ts; return true; }
};
struct SchedMoe {
    const char *A, *B; const LAS int* rbs; int NT, G, c, gather; size_t estride;
    __device__ __forceinline__ bool next(int i, Unit& u) const {
        const int nrb = rbs[16], nwg = nrb * NT; const long L = (long)i * G + c; if (L >= nwg) return false;
        const int wg = xcd_remap((int)L, nwg), rb = wg / NT, pn = wg % NT;
        int e = 0;
#pragma unroll
        for (int k = 1; k < 16; ++k) e += (rb >= rbs[k]) ? 1 : 0;
        u.pm = rb; u.pn = pn; u.rows = i * 1024;
        u.A = gather ? A : A + (size_t)rb * BM * 1024 * 2; u.B = B + (size_t)e * estride + (size_t)pn * BM * 1024 * 2; return true; }
};
}
typedef __attribute__((address_space(4))) const unsigned long long* kargp_t;
struct Frame {
    LAS unsigned char* lds;
    unsigned* ctl;
    int tid, lane, wave, vcu, G;
    unsigned char* ws;
    kargp_t kin;
    __device__ __forceinline__ const float* inp(int i) const { return (const float*)(const GAS float*)kin[i]; }
    float* out;
};
enum { I_X = 0, I_C, I_ADAW, I_ADAB, I_NMIX, I_NFFN, I_RWIN, I_RGN, I_RWOUT, I_KVADAW, I_KVADAB, I_KVNORM, I_KVW, I_KNORM, I_WQ, I_QNORM, I_LAM, I_SUBLN, I_WOUT,
       I_WG, I_BG, I_WE, I_BE, I_W1, I_W3, I_W2 };

__device__ __forceinline__ int dest_row(int n, int mode) {
    if (mode == 1) { const int c = n & 255; return (n & ~255) + 128 * ((c >> 5) & 1) + 32 * (c >> 6) + (c & 31); }
    if (mode == 2) return (n >> 7) * 256 + (n & 127);
    if (mode == 3) return (n >> 7) * 256 + 128 + (n & 127);
    return n;
}
struct TItem { const float* W; bf16_t* WT; int K, N, mode, item; };
__device__ __forceinline__ void titem_load(const TItem& it, f32x4 (&v)[16], int lane) {
    const int nblk = it.N / 64, kb = it.item / nblk, nb = it.item % nblk, k0 = 64 * kb, n0 = 64 * nb;
    const float* p = it.W + (size_t)(k0 + (lane >> 4)) * it.N + n0 + 4 * (lane & 15);
#pragma unroll
    for (int i = 0; i < 16; ++i) v[i] = __builtin_nontemporal_load((const f32x4*)(p + (size_t)(4 * i) * it.N));
}
__device__ __forceinline__ void titem_store(const TItem& it, const f32x4 (&v)[16], LAS float* scr, int lane) {
    const int nblk = it.N / 64, kb = it.item / nblk, nb = it.item % nblk, k0 = 64 * kb, n0 = 64 * nb;
#pragma unroll
    for (int i = 0; i < 16; ++i) *(LAS f32x4*)(scr + (4 * i + (lane >> 4)) * 68 + 4 * (lane & 15)) = v[i];
    LDS_WAIT(); asm volatile("" ::: "memory");
    const int d = dest_row(n0 + (lane & 32), it.mode) + (lane & 31);
    bf16_t* op = it.WT + (size_t)d * it.K + k0;
#pragma unroll 2
    for (int c = 0; c < 8; ++c) { const LAS float* s = scr + (8 * c) * 68 + lane;
        u32x4 o; o.x = pk2(s[0 * 68], s[1 * 68]); o.y = pk2(s[2 * 68], s[3 * 68]); o.z = pk2(s[4 * 68], s[5 * 68]); o.w = pk2(s[6 * 68], s[7 * 68]);
        *(u32x4*)(op + 8 * c) = o; }
    LDS_WAIT(); asm volatile("" ::: "memory");
}
__device__ __forceinline__ void thalf_load(const TItem& it, int half, f32x4 (&v)[8], int lane) {
    const int nblk = it.N / 64, kb = it.item / nblk, nb = it.item % nblk, k0 = 64 * kb + 32 * half, n0 = 64 * nb;
    const float* p = it.W + (size_t)(k0 + (lane >> 4)) * it.N + n0 + 4 * (lane & 15);
#pragma unroll
    for (int i = 0; i < 8; ++i) v[i] = __builtin_nontemporal_load((const f32x4*)(p + (size_t)(4 * i) * it.N));
}
__device__ __forceinline__ void thalf_store(const TItem& it, int half, const f32x4 (&v)[8], LAS float* scr, int lane) {
    const int nblk = it.N / 64, kb = it.item / nblk, nb = it.item % nblk, k0 = 64 * kb + 32 * half, n0 = 64 * nb;
#pragma unroll
    for (int i = 0; i < 8; ++i) *(LAS f32x4*)(scr + (4 * i + (lane >> 4)) * 68 + 4 * (lane & 15)) = v[i];
    LDS_WAIT(); asm volatile("" ::: "memory");
    const int d = dest_row(n0 + (lane & 32), it.mode) + (lane & 31);
    bf16_t* op = it.WT + (size_t)d * it.K + k0;
#pragma unroll 2
    for (int c = 0; c < 4; ++c) { const LAS float* s = scr + (8 * c) * 68 + lane;
        u32x4 o; o.x = pk2(s[0 * 68], s[1 * 68]); o.y = pk2(s[2 * 68], s[3 * 68]); o.z = pk2(s[4 * 68], s[5 * 68]); o.w = pk2(s[6 * 68], s[7 * 68]);
        *(u32x4*)(op + 8 * c) = o; }
    LDS_WAIT(); asm volatile("" ::: "memory");
}
__device__ __forceinline__ TItem moe_item(Frame& F, int layer, int it) {
    constexpr int IPM = 256;
    int e, which, item;
    if (layer == 0) { e = it / (3 * IPM); const int r = it % (3 * IPM); which = r / IPM; item = r % IPM; }
    else if (it < 32 * IPM) { e = it / (2 * IPM); const int r = it % (2 * IPM); which = r / IPM; item = r % IPM; }
    else { const int j = it - 32 * IPM; e = j / IPM; which = 2; item = j % IPM; }
    const size_t wo = ((size_t)layer * 16 + e) * 1048576;
    bf16_t* w13 = (bf16_t*)(F.ws + (layer ? WS_W13_L1 : WS_W13)); bf16_t* w2 = (bf16_t*)(F.ws + (layer ? WS_W2_L1 : WS_W2));
    TItem t; t.K = 1024; t.N = 1024; t.item = item;
    if (which == 0) { t.W = F.inp(I_W1) + wo; t.WT = w13 + (size_t)e * 2097152; t.mode = 2; }
    else if (which == 1) { t.W = F.inp(I_W3) + wo; t.WT = w13 + (size_t)e * 2097152; t.mode = 3; }
    else { t.W = F.inp(I_W2) + wo; t.WT = w2 + (size_t)e * 1048576; t.mode = 0; }
    return t;
}
__device__ __forceinline__ TItem dense_item(Frame& F, int it) {
    constexpr int I_IN = 16 * 96, I_RO = 32 * 16, I_KV = 16 * 32, I_Q = 256;
    TItem t; int r = it;
    if (r < I_IN) { t.W = F.inp(I_RWIN); t.WT = (bf16_t*)(F.ws + WS_WIN); t.K = 1024; t.N = 6144; t.mode = 0; t.item = r; return t; } r -= I_IN;
    if (r < I_RO) { t.W = F.inp(I_RWOUT); t.WT = (bf16_t*)(F.ws + WS_WRO); t.K = 2048; t.N = 1024; t.mode = 0; t.item = r; return t; } r -= I_RO;
    if (r < I_KV) { t.W = F.inp(I_KVW); t.WT = (bf16_t*)(F.ws + WS_WKV); t.K = 1024; t.N = 2048; t.mode = (r % 32) < 16 ? 1 : 0; t.item = r; return t; } r -= I_KV;
    if (r < I_Q) { t.W = F.inp(I_WQ); t.WT = (bf16_t*)(F.ws + WS_WQ); t.K = 1024; t.N = 1024; t.mode = 1; t.item = r; return t; } r -= I_Q;
    t.W = F.inp(I_WOUT); t.WT = (bf16_t*)(F.ws + WS_WAO); t.K = 1024; t.N = 1024; t.mode = 0; t.item = r; return t;
}
constexpr int N_DENSE_ITEMS = 16 * 96 + 32 * 16 + 16 * 32 + 256 + 256, N_MOE_ITEMS = 16 * 3 * 256;
__device__ __forceinline__ void convert_weights(Frame& F, int layer, bool with_dense, bool with_moe, int gw, int NGW, int end = 1 << 30) {
    LAS float* scr = (LAS float*)(F.lds + F.wave * 17408);
    const int nd = with_dense ? N_DENSE_ITEMS : 0, total0 = nd + (with_moe ? N_MOE_ITEMS : 0), total = end < total0 ? end : total0;
    int it = gw; if (it >= total) return;
    TItem cur = it < nd ? dense_item(F, it) : moe_item(F, layer, it - nd);
    f32x4 va[16], vb[16];
    titem_load(cur, va, F.lane);
    for (;;) {
        const int itn = it + NGW; const bool more = itn < total;
        TItem nxt = cur;
        if (more) { nxt = itn < nd ? dense_item(F, itn) : moe_item(F, layer, itn - nd); titem_load(nxt, vb, F.lane); }
        titem_store(cur, va, scr, F.lane);
        if (!more) break;
        const int itn2 = itn + NGW; const bool more2 = itn2 < total;
        if (more2) { cur = itn2 < nd ? dense_item(F, itn2) : moe_item(F, layer, itn2 - nd); titem_load(cur, va, F.lane); }
        titem_store(nxt, vb, scr, F.lane);
        if (!more2) break;
        it = itn2;
    }
}
#ifndef TQ7
#define TQ7 3
#endif
#ifndef TQ8
#define TQ8 3
#endif
constexpr int TAILQ7 = TQ7, TAILQ8 = TQ8;
static_assert(TAILQ7 * NWAVES * 255 <= 8192, "the MoE-up tail may only convert w1 / w3 items");
__device__ __forceinline__ int tail_idle(int nrb, int NT) { const int rem = (nrb * NT) & 255; return rem ? 256 - rem : 0; }
__device__ __forceinline__ int tail_base(int nrb, int which) {
    int n = 0; if (which >= 1) n += tail_idle(nrb, 8) * NWAVES * TAILQ7; if (which >= 2) n += tail_idle(nrb, 4) * NWAVES * TAILQ8; return n < N_MOE_ITEMS ? n : N_MOE_ITEMS; }
__device__ __forceinline__ void tail_convert(Frame& F, const LAS int* rbs, int NT, int which) {
    const int nrb = rbs[16], rem = (nrb * NT) & 255; if (rem == 0 || (int)blockIdx.x < rem) return;
    const int Q = which ? TAILQ8 : TAILQ7, s0 = tail_base(nrb, which) + (((int)blockIdx.x - rem) * NWAVES + F.wave) * Q;
    convert_weights(F, 1, false, true, s0, 1, s0 + Q);
}
__device__ __forceinline__ void adaln_phase(Frame& F) {
    LAS float* cs = (LAS float*)F.lds;
    LAS float* red = (LAS float*)(F.lds + 65536);
    constexpr int NTASK = (2 * 6144 + 2048) / 64;
    if ((int)blockIdx.x >= NTASK) return;
    { const float* cp = F.inp(I_C) + F.tid; float cvv[32];
#pragma unroll
      for (int i = 0; i < 32; ++i) cvv[i] = cp[i * NTHREADS];
#pragma unroll
      for (int i = 0; i < 32; ++i) cs[i * NTHREADS + F.tid] = cvv[i] / (1.0f + __expf(-cvv[i])); }
    __syncthreads();
    for (int task = blockIdx.x; task < NTASK; task += F.G) {
        const int gc = task * 64; const float* W; const float* bias; float* outp; int N, c0, ostride;
        if (gc < 6144) { W = F.inp(I_ADAW); bias = F.inp(I_ADAB); N = 6144; c0 = gc; outp = (float*)(F.ws + WS_MOD); ostride = 6144; }
        else if (gc < 12288) { W = F.inp(I_ADAW) + (size_t)1024 * 6144; bias = F.inp(I_ADAB) + 6144; N = 6144; c0 = gc - 6144; outp = (float*)(F.ws + WS_MOD) + 16 * 6144; ostride = 6144; }
        else { W = F.inp(I_KVADAW); bias = F.inp(I_KVADAB); N = 2048; c0 = gc - 12288; outp = (float*)(F.ws + WS_KVMOD); ostride = 2048; }
        float acc[16];
#pragma unroll
        for (int b = 0; b < 16; ++b) acc[b] = 0.f;
        const int k0 = F.wave * 128;
        {
            const int k = k0; float w[128];
            const GAS float* wp = (const GAS float*)(W + (size_t)k * N + c0 + F.lane);
#pragma unroll
            for (int j = 0; j < 128; ++j) { w[j] = *wp; wp += N; asm volatile("" : "+v"(wp)); }
#pragma unroll
            for (int j4 = 0; j4 < 32; ++j4) { asm volatile("" ::: "memory");
#pragma unroll
                for (int b = 0; b < 16; ++b) { const f32x4 c4 = *(const LAS f32x4*)(cs + b * 1024 + k + 4 * j4); acc[b] += c4[0] * w[4 * j4] + c4[1] * w[4 * j4 + 1] + c4[2] * w[4 * j4 + 2] + c4[3] * w[4 * j4 + 3]; } }
        }
#pragma unroll
        for (int b = 0; b < 16; ++b) red[(F.wave * 16 + b) * 64 + F.lane] = acc[b];
        __syncthreads();
        for (int o = F.tid; o < 1024; o += NTHREADS) { const int b = o >> 6, col = o & 63; float s = 0.f;
#pragma unroll
            for (int w = 0; w < 8; ++w) s += red[(w * 16 + b) * 64 + col];
            outp[(size_t)b * ostride + c0 + col] = s + bias[c0 + col]; }
        __syncthreads();
    }
}
__device__ __forceinline__ void rope_table(Frame& F, int gt, int NGT) {
    float* ct = (float*)(F.ws + WS_COS); float* st = (float*)(F.ws + WS_SIN);
    for (int i = gt; i < 2048 * 128; i += NGT) { const int pos = i >> 7, j = i & 127;
        const float inv = 1.0f / powf(10000.0f, (float)j * (1.0f / 128.0f)); const float ang = (float)pos * inv;
        const float kq = rintf(ang * 0.15915494309189535f); float rr = fmaf(-kq, 6.28318548202514648f, ang); rr = fmaf(-kq, -1.74845553e-07f, rr);
        const float rev = rr * 0.15915494309189535f; ct[i] = __builtin_amdgcn_cosf(rev); st[i] = __builtin_amdgcn_sinf(rev); }
    float* wrt = (float*)(F.ws + WS_WRT);
    for (int i = gt; i < 2 * 20 * 1024; i += NGT) { const int l = i / 20480, r = i % 20480, q = r >> 10, k = r & 1023;
        wrt[i] = q < 4 ? F.inp(I_WG)[(size_t)l * 4096 + k * 4 + q] : F.inp(I_WE)[(size_t)l * 16384 + k * 16 + (q - 4)]; }
}

struct Row16 { f32x4 v[4]; };
__device__ __forceinline__ void row_load(Row16& r, const float* p, int lane) {
#pragma unroll
    for (int j = 0; j < 4; ++j) r.v[j] = ((const f32x4*)p)[64 * j + lane];
}
__device__ __forceinline__ void row_load_bf16(Row16& r, const bf16_t* p, int lane) {
#pragma unroll
    for (int j = 0; j < 4; ++j) { const u32x2 q = ((const u32x2*)p)[64 * j + lane]; r.v[j] = (f32x4){bf_lo(q.x), bf_hi(q.x), bf_lo(q.y), bf_hi(q.y)}; }
}
__device__ __forceinline__ void row_store_bf16(const Row16& r, bf16_t* p, int lane) {
#pragma unroll
    for (int j = 0; j < 4; ++j) { u32x2 w; w.x = pk2(r.v[j][0], r.v[j][1]); w.y = pk2(r.v[j][2], r.v[j][3]); ((u32x2*)p)[64 * j + lane] = w; }
}
__device__ __forceinline__ float row_sumsq(const Row16& r) { float s = 0.f;
#pragma unroll
    for (int j = 0; j < 4; ++j) s += (r.v[j][0] * r.v[j][0] + r.v[j][1] * r.v[j][1]) + (r.v[j][2] * r.v[j][2] + r.v[j][3] * r.v[j][3]);
    return wave_sum(s); }
__device__ __forceinline__ void row_norm_mod_store(const Row16& r, float rstd, const float* g, const float* shift, const float* scale, bf16_t* outp, int lane) {
#pragma unroll
    for (int j = 0; j < 4; ++j) { const int c = 64 * j + lane; const f32x4 gg = ((const f32x4*)g)[c], sh = ((const f32x4*)shift)[c], sc = ((const f32x4*)scale)[c];
        const f32x4 h = (r.v[j] * rstd * gg) * (sc + 1.0f) + sh; u32x2 w; w.x = pk2(h[0], h[1]); w.y = pk2(h[2], h[3]); ((u32x2*)outp)[c] = w; }
}
struct ModVec { f32x4 A[4], B[4]; };
__device__ __forceinline__ void modvec_load(ModVec& m, const float* g, const float* shift, const float* scale, int lane) {
#pragma unroll
    for (int j = 0; j < 4; ++j) { const int c = 64 * j + lane; m.A[j] = ((const f32x4*)g)[c] * (((const f32x4*)scale)[c] + 1.0f); m.B[j] = ((const f32x4*)shift)[c]; }
}
__device__ __forceinline__ void row_mod_store(const Row16& r, float rstd, const ModVec& m, bf16_t* outp, int lane) {
#pragma unroll
    for (int j = 0; j < 4; ++j) { const f32x4 h = r.v[j] * rstd * m.A[j] + m.B[j]; u32x2 w; w.x = pk2(h[0], h[1]); w.y = pk2(h[2], h[3]); ((u32x2*)outp)[64 * j + lane] = w; }
}
__device__ __forceinline__ void phase_h0(Frame& F) {
    const int gw = F.vcu * NWAVES + F.wave, NGW = F.G * NWAVES; const float* mod = (const float*)(F.ws + WS_MOD); bf16_t* H = (bf16_t*)(F.ws + WS_H);
    for (int t0 = gw * 16; t0 < NTOK; t0 += NGW * 16) { const int b = t0 / SEQ; ModVec m; modvec_load(m, F.inp(I_NMIX), mod + b * 6144, mod + b * 6144 + 1024, F.lane);
#pragma unroll 1
        for (int i = 0; i < 16; i += 4) { Row16 r[4];
#pragma unroll
            for (int u = 0; u < 4; ++u) row_load(r[u], F.inp(I_X) + (size_t)(t0 + i + u) * 1024, F.lane);
#pragma unroll
            for (int u = 0; u < 4; ++u) { const float rstd = __builtin_amdgcn_rsqf(row_sumsq(r[u]) * (1.0f / 1024.0f) + EPS); row_mod_store(r[u], rstd, m, H + (size_t)(t0 + i + u) * 1024, F.lane); } } }
}
__device__ __forceinline__ void phase_gate(Frame& F) {
    const int gw = F.vcu * NWAVES + F.wave, NGW = F.G * NWAVES; bf16_t* O = (bf16_t*)(F.ws + WS_VR); const bf16_t* SG = (const bf16_t*)(F.ws + WS_SG); const float* gn = F.inp(I_RGN);
    for (int t0 = gw; t0 < NTOK; t0 += 2 * NGW) {
        u32x4 o2[2][4], g2[2][4];
#pragma unroll
        for (int u = 0; u < 2; ++u)
#pragma unroll
            for (int j = 0; j < 4; ++j) { const size_t t = t0 + u * NGW; o2[u][j] = ((const u32x4*)(O + t * 2048))[64 * j + F.lane]; g2[u][j] = ((const u32x4*)(SG + t * 2048))[64 * j + F.lane]; }
#pragma unroll
        for (int u = 0; u < 2; ++u) { const size_t t = t0 + u * NGW;
#pragma unroll
        for (int j = 0; j < 4; ++j) {
            float ov[8]; float ss = 0.f;
#pragma unroll
            for (int e = 0; e < 4; ++e) { ov[2 * e] = bf_lo(o2[u][j][e]); ov[2 * e + 1] = bf_hi(o2[u][j][e]); ss += ov[2 * e] * ov[2 * e] + ov[2 * e + 1] * ov[2 * e + 1]; }
            const float rstd = __builtin_amdgcn_rsqf(wave_sum(ss) * (1.0f / 512.0f) + EPS);
            const f32x4 g0 = ((const f32x4*)gn)[2 * (64 * j + F.lane)], g1 = ((const f32x4*)gn)[2 * (64 * j + F.lane) + 1];
            u32x4 w;
#pragma unroll
            for (int e = 0; e < 4; ++e) { const float ga = e < 2 ? g0[2 * e] : g1[2 * e - 4], gb = e < 2 ? g0[2 * e + 1] : g1[2 * e - 3];
                w[e] = pk2(bf_lo(g2[u][j][e]) * (ov[2 * e] * rstd * ga), bf_hi(g2[u][j][e]) * (ov[2 * e + 1] * rstd * gb)); }
            ((u32x4*)(O + t * 2048))[64 * j + F.lane] = w;
        } }
    }
}
__device__ __forceinline__ void phase_route(Frame& F, int layer) {
    const int gwl = blockIdx.x * NWAVES + F.wave;
    const float* mod = (const float*)(F.ws + WS_MOD) + (size_t)layer * 16 * 6144; const bf16_t* XB = (const bf16_t*)(F.ws + WS_XB); bf16_t* H = (bf16_t*)(F.ws + WS_H);
    const float* nf = F.inp(I_NFFN) + layer * 1024;
    const float* bg = F.inp(I_BG) + layer * 4; const float* be = F.inp(I_BE) + layer * 16;
    unsigned* gcnt = F.ctl + (layer ? CW_CNT1 : CW_CNT0);
    int* list = (int*)(F.ws + WS_LIST); int* tokslot = (int*)(F.ws + WS_TOKSLOT); float* tokw = (float*)(F.ws + WS_TOKW);
    LAS float* WrT = (LAS float*)(F.lds);
    LAS float* lgs = (LAS float*)(F.lds + 81920) + F.wave * 96;
    LAS int* wcnt = (LAS int*)(F.lds + 81920 + 4096);
    LAS int* wbase = (LAS int*)(F.lds + 81920 + 4096 + 1024);
    { const f32x4* src = (const f32x4*)((const float*)(F.ws + WS_WRT) + (size_t)layer * 20480);
#pragma unroll
      for (int i = 0; i < 10; ++i) ((LAS f32x4*)WrT)[i * NTHREADS + F.tid] = src[i * NTHREADS + F.tid]; }
    __syncthreads();
    const int lane = F.lane; const bool b5 = lane & 32, b4 = lane & 16, b3 = lane & 8;
    const int NGWL = F.G * NWAVES;
    for (int base = 0; base < NTOK; base += NGWL * 16) {
        const int t0 = base + gwl * 16; const bool active = t0 < NTOK;
        int my_e0 = 0, my_e1 = 0; float my_w0 = 0.f, my_w1 = 0.f;
        if (active) {
            const int b = t0 / SEQ; ModVec mv; modvec_load(mv, nf, mod + b * 6144 + 3072, mod + b * 6144 + 4096, lane);
            u32x2 nx[4][4];
#pragma unroll
            for (int i = 0; i < 4; ++i)
#pragma unroll
                for (int j = 0; j < 4; ++j) nx[i][j] = ((const u32x2*)(XB + (size_t)(t0 + i) * 1024))[64 * j + lane];
#pragma unroll 1
            for (int grp = 0; grp < 4; ++grp) {
                const int tg = t0 + 4 * grp;
                Row16 r[4];
#pragma unroll
                for (int i = 0; i < 4; ++i)
#pragma unroll
                    for (int j = 0; j < 4; ++j) { const u32x2 q = nx[i][j]; r[i].v[j] = (f32x4){bf_lo(q.x), bf_hi(q.x), bf_lo(q.y), bf_hi(q.y)}; }
                if (grp < 3) {
#pragma unroll
                    for (int i = 0; i < 4; ++i)
#pragma unroll
                        for (int j = 0; j < 4; ++j) nx[i][j] = ((const u32x2*)(XB + (size_t)(tg + 4 + i) * 1024))[64 * j + lane];
                }
                float rstd[4];
#pragma unroll
                for (int i = 0; i < 4; ++i) rstd[i] = __builtin_amdgcn_rsqf(row_sumsq(r[i]) * (1.0f / 1024.0f) + EPS);
#pragma unroll
                for (int j = 0; j < 4; ++j) {
#pragma unroll
                    for (int i = 0; i < 4; ++i) { const f32x4 h = r[i].v[j] * rstd[i] * mv.A[j] + mv.B[j]; r[i].v[j] = h; u32x2 w; w.x = pk2(h[0], h[1]); w.y = pk2(h[2], h[3]); ((u32x2*)(H + (size_t)(tg + i) * 1024))[64 * j + lane] = w; } }
#pragma unroll
                for (int hq = 0; hq < 2; ++hq) {
                    float V[40];
#pragma unroll
                    for (int q = 0; q < 10; ++q) {
                        float a0 = 0.f, a1 = 0.f, a2 = 0.f, a3 = 0.f;
#pragma unroll
                        for (int j = 0; j < 4; ++j) { const f32x4 w4 = *(const LAS f32x4*)(WrT + (hq * 10 + q) * 1024 + 4 * (64 * j + lane));
                            a0 += r[0].v[j][0] * w4[0] + r[0].v[j][1] * w4[1] + r[0].v[j][2] * w4[2] + r[0].v[j][3] * w4[3];
                            a1 += r[1].v[j][0] * w4[0] + r[1].v[j][1] * w4[1] + r[1].v[j][2] * w4[2] + r[1].v[j][3] * w4[3];
                            a2 += r[2].v[j][0] * w4[0] + r[2].v[j][1] * w4[1] + r[2].v[j][2] * w4[2] + r[2].v[j][3] * w4[3];
                            a3 += r[3].v[j][0] * w4[0] + r[3].v[j][1] * w4[1] + r[3].v[j][2] * w4[2] + r[3].v[j][3] * w4[3]; }
                        V[q] = a0; V[10 + q] = a1; V[20 + q] = a2; V[30 + q] = a3;
                    }
                    float W20[20], W10[10];
#pragma unroll
                    for (int i = 0; i < 20; ++i) W20[i] = swap32_add(V[i], V[i + 20]);
#pragma unroll
                    for (int i = 0; i < 10; ++i) W10[i] = swap16_add(W20[i], W20[i + 10]);
                    const int vb = (b3 ? 5 : 0) + (b4 ? 10 : 0) + (b5 ? 20 : 0);
#pragma unroll
                    for (int i = 0; i < 5; ++i) { const float keep = b3 ? W10[i + 5] : W10[i], send = b3 ? W10[i] : W10[i + 5]; const float v = sum8(keep + dppf<0x128>(send));
                        const int vi = vb + i;
                        if ((lane & 7) == 0) lgs[(vi / 10) * 20 + hq * 10 + (vi % 10)] = v; }
                    asm volatile("" ::: "memory");
                }
                LDS_WAIT(); asm volatile("" ::: "memory");
                if ((lane >> 2) == grp) {
                    const LAS float* lp = lgs + (lane & 3) * 20;
                    float gl[4]; int gi = 0;
#pragma unroll
                    for (int q = 0; q < 4; ++q) gl[q] = lp[q] + bg[q];
                    float gm = gl[0];
#pragma unroll
                    for (int q = 1; q < 4; ++q) if (gl[q] > gm) { gm = gl[q]; gi = q; }
                    float gs = 0.f;
#pragma unroll
                    for (int q = 0; q < 4; ++q) gs += __expf(gl[q] - gm);
                    const float ggate = 1.0f / gs;
                    float el[4];
#pragma unroll
                    for (int q = 0; q < 4; ++q) el[q] = lp[4 + 4 * gi + q] + be[4 * gi + q];
                    int i0 = 0; float m0 = el[0];
#pragma unroll
                    for (int q = 1; q < 4; ++q) if (el[q] > m0) { m0 = el[q]; i0 = q; }
                    int i1 = 0; float m1 = -INFINITY;
#pragma unroll
                    for (int q = 0; q < 4; ++q) if (q != i0 && el[q] > m1) { m1 = el[q]; i1 = q; }
                    const float p1 = __expf(m1 - m0);
                    my_e0 = gi * 4 + i0; my_e1 = gi * 4 + i1; my_w0 = ggate / (1.0f + p1); my_w1 = ggate * p1 / (1.0f + p1);
                }
                LDS_WAIT(); asm volatile("" ::: "memory");
            }
        }
        const bool have = active && lane < 16; int rank0 = 0, rank1 = 0, mycount = 0;
        const unsigned long long lt = (1ull << lane) - 1ull;
#pragma unroll 1
        for (int e = 0; e < 16; ++e) {
            const unsigned long long b0 = __ballot(have && my_e0 == e), b1 = __ballot(have && my_e1 == e);
            if (my_e0 == e) rank0 = __popcll(b0 & lt);
            if (my_e1 == e) rank1 = __popcll(b0) + __popcll(b1 & lt);
            if (lane == e) mycount = __popcll(b0) + __popcll(b1);
        }
        if (lane < 16) wcnt[F.wave * 16 + lane] = mycount;
        __syncthreads();
        if (F.tid < 16) { int tot = 0;
#pragma unroll
            for (int w = 0; w < 8; ++w) { const int c = wcnt[w * 16 + F.tid]; wbase[w * 16 + F.tid] = tot; tot += c; }
            const int gb = tot ? (int)atomicAdd(gcnt + F.tid, (unsigned)tot) : 0;
#pragma unroll
            for (int w = 0; w < 8; ++w) wbase[w * 16 + F.tid] += gb; }
        __syncthreads();
        if (have) { const int t = t0 + lane; const int p0 = wbase[F.wave * 16 + my_e0] + rank0, p1 = wbase[F.wave * 16 + my_e1] + rank1;
            list[my_e0 * 32768 + p0] = t; list[my_e1 * 32768 + p1] = t;
            tokslot[2 * t] = (my_e0 << 16) | p0; tokslot[2 * t + 1] = (my_e1 << 16) | p1; tokw[2 * t] = my_w0; tokw[2 * t + 1] = my_w1; }
        __syncthreads();
    }
}
__device__ __forceinline__ void load_rbs(Frame& F, const unsigned* gcnt, LAS int* rbs, LAS int* cnts) {
    if (F.tid < 64) {
        const int e = F.tid & 15; const int c = (int)__hip_atomic_load(gcnt + e, __ATOMIC_RELAXED, __HIP_MEMORY_SCOPE_AGENT); const int nb = (c + 255) >> 8;
        int acc = 0, tot = 0;
#pragma unroll
        for (int k = 0; k < 16; ++k) { const int v = __builtin_amdgcn_readlane(nb, k); acc += (k < e) ? v : 0; tot += v; }
        if (F.tid < 16) { rbs[e] = acc; if (cnts) cnts[e] = c; if (e == 0) rbs[16] = tot; }
    }
    __syncthreads();
}
__device__ __forceinline__ void moe_tables(Frame& F, int layer, LAS int* rbs, LAS int* rowtab, int NT, bool gather) {
    const unsigned* gcnt = F.ctl + (layer ? CW_CNT1 : CW_CNT0);
    LAS int* cnts = rbs + 32;
    load_rbs(F, gcnt, rbs, cnts);
    if (gather) {
        const int* list = (const int*)(F.ws + WS_LIST); const int nrb = rbs[16], nwg = nrb * NT;
        int vals[8]; bool ok[8];
#pragma unroll
        for (int p = 0; p < 8; ++p) { const int i = 2 * p + (F.tid >> 8); const long L = (long)i * F.G + blockIdx.x; ok[p] = L < nwg; vals[p] = 0;
            if (ok[p]) { const int wg = pg8::xcd_remap((int)L, nwg), rb = wg / NT; int e = 0;
#pragma unroll
                for (int k = 1; k < 16; ++k) e += (rb >= rbs[k]) ? 1 : 0;
                const int lr0 = (rb - rbs[e]) * 256, cnt = cnts[e]; int r = lr0 + (F.tid & 255); r = r < cnt ? r : cnt - 1; vals[p] = list[e * 32768 + r]; } }
#pragma unroll
        for (int p = 0; p < 8; ++p) if (ok[p]) rowtab[(2 * p + (F.tid >> 8)) * 256 + (F.tid & 255)] = vals[p];
        __syncthreads();
    }
}
struct CombRow { Row16 x; u32x2 y0[4], y1[4]; float w0, w1; };
struct CombSlots { int r0, r1; float w0, w1; };
__device__ __forceinline__ void comb_slots(Frame& F, int t0, const LAS int* rbs, CombSlots& s) {
    const int* tokslot = (const int*)(F.ws + WS_TOKSLOT); const float* tokw = (const float*)(F.ws + WS_TOKW);
    const int i = F.lane & 15; const int s0 = tokslot[2 * (t0 + i)], s1 = tokslot[2 * (t0 + i) + 1]; s.w0 = tokw[2 * (t0 + i)]; s.w1 = tokw[2 * (t0 + i) + 1];
    s.r0 = rbs[s0 >> 16] * 256 + (s0 & 0xffff); s.r1 = rbs[s1 >> 16] * 256 + (s1 & 0xffff);
}
__device__ __forceinline__ void comb_issue(Frame& F, int t, int i, const CombSlots& s, CombRow& c) {
    const bf16_t* XB = (const bf16_t*)(F.ws + WS_XB); const bf16_t* YB = (const bf16_t*)(F.ws + WS_YB);
    row_load_bf16(c.x, XB + (size_t)t * 1024, F.lane);
    const int r0 = __builtin_amdgcn_readlane(s.r0, i), r1 = __builtin_amdgcn_readlane(s.r1, i);
    c.w0 = __builtin_bit_cast(float, __builtin_amdgcn_readlane(__builtin_bit_cast(int, s.w0), i)); c.w1 = __builtin_bit_cast(float, __builtin_amdgcn_readlane(__builtin_bit_cast(int, s.w1), i));
    const u32x2* y0 = (const u32x2*)(YB + (size_t)r0 * 1024); const u32x2* y1 = (const u32x2*)(YB + (size_t)r1 * 1024);
#pragma unroll
    for (int j = 0; j < 4; ++j) { c.y0[j] = y0[64 * j + F.lane]; c.y1[j] = y1[64 * j + F.lane]; }
}
__device__ __forceinline__ void comb_finish(const f32x4 (&g2)[4], CombRow& c) {
#pragma unroll
    for (int j = 0; j < 4; ++j) { const u32x2 a = c.y0[j], b = c.y1[j]; const float w0 = c.w0, w1 = c.w1;
        f32x4 m; m[0] = w0 * bf_lo(a.x) + w1 * bf_lo(b.x); m[1] = w0 * bf_hi(a.x) + w1 * bf_hi(b.x); m[2] = w0 * bf_lo(a.y) + w1 * bf_lo(b.y); m[3] = w0 * bf_hi(a.y) + w1 * bf_hi(b.y);
        c.x.v[j] = c.x.v[j] + g2[j] * m; }
}
__device__ __forceinline__ void rbs_only(Frame& F, int layer, LAS int* rbs) {
    const unsigned* gcnt = F.ctl + (layer ? CW_CNT1 : CW_CNT0);
    load_rbs(F, gcnt, rbs, (LAS int*)nullptr);
}
__device__ __forceinline__ void phase_mid(Frame& F, LAS int* rbs) {
    const int gw = F.vcu * NWAVES + F.wave, NGW = F.G * NWAVES; bf16_t* XB = (bf16_t*)(F.ws + WS_XB); bf16_t* HQ = (bf16_t*)(F.ws + WS_H); bf16_t* HKV = (bf16_t*)(F.ws + WS_HKV);
    const float* mod1 = (const float*)(F.ws + WS_MOD) + 16 * 6144; const float* kvmod = (const float*)(F.ws + WS_KVMOD);
    rbs_only(F, 0, rbs);
    const int cbase = tail_base(rbs[16], 2);
    for (int t0 = gw * 16; t0 < NTOK; t0 += NGW * 16) { const int b = t0 / SEQ;
        CombSlots sl; comb_slots(F, t0, rbs, sl);
        ModVec mq, mk; modvec_load(mq, F.inp(I_NMIX) + 1024, mod1 + b * 6144, mod1 + b * 6144 + 1024, F.lane); modvec_load(mk, F.inp(I_KVNORM), kvmod + b * 2048, kvmod + b * 2048 + 1024, F.lane);
        f32x4 g2[4];
#pragma unroll
        for (int j = 0; j < 4; ++j) g2[j] = ((const f32x4*)((const float*)(F.ws + WS_MOD) + (size_t)b * 6144 + 5120))[64 * j + F.lane];
#pragma unroll 1
        for (int i = 0; i < 16; ++i) { CombRow c;
            const int cit = cbase + gw + (i >> 1) * NGW; const bool conv = cit < N_MOE_ITEMS; TItem ti; f32x4 tv[8];
            if (conv) { ti = moe_item(F, 1, cit); thalf_load(ti, i & 1, tv, F.lane); }
            comb_issue(F, t0 + i, i, sl, c);
            { const int tt = t0 + i; comb_finish(g2, c); Row16& r = c.x;
                row_store_bf16(r, XB + (size_t)tt * 1024, F.lane);
                const float rstd = __builtin_amdgcn_rsqf(row_sumsq(r) * (1.0f / 1024.0f) + EPS);
                row_mod_store(r, rstd, mq, HQ + (size_t)tt * 1024, F.lane); row_mod_store(r, rstd, mk, HKV + (size_t)tt * 1024, F.lane); }
            if (conv) thalf_store(ti, i & 1, tv, (LAS float*)(F.lds + F.wave * 17408), F.lane);
        } }
}
__device__ __forceinline__ void phase_final(Frame& F, LAS int* rbs) {
    const int gw = F.vcu * NWAVES + F.wave, NGW = F.G * NWAVES;
    rbs_only(F, 1, rbs);
    for (int t0 = gw * 16; t0 < NTOK; t0 += NGW * 16) { const int b = t0 / SEQ;
        CombSlots sl; comb_slots(F, t0, rbs, sl);
        f32x4 g2[4];
#pragma unroll
        for (int j = 0; j < 4; ++j) g2[j] = ((const f32x4*)((const float*)(F.ws + WS_MOD) + (size_t)(16 + b) * 6144 + 5120))[64 * j + F.lane];
#pragma unroll 1
        for (int i = 0; i < 16; i += 4) { CombRow c[4];
#pragma unroll
            for (int u = 0; u < 4; ++u) comb_issue(F, t0 + i + u, i + u, sl, c[u]);
#pragma unroll
            for (int u = 0; u < 4; ++u) { const int tt = t0 + i + u; comb_finish(g2, c[u]);
#pragma unroll
                for (int j = 0; j < 4; ++j) ((f32x4*)(F.out + (size_t)tt * 1024))[64 * j + F.lane] = c[u].x.v[j]; } } }
}
__device__ __forceinline__ s16x4 tr_read(const LAS void* p) {
    typedef short v4s __attribute__((ext_vector_type(4)));
    return __builtin_bit_cast(s16x4, __builtin_amdgcn_ds_read_tr16_b64_v4i16((LAS v4s*)p));
}
__device__ __forceinline__ bf16x8 cat8(s16x4 a, s16x4 b) { return (bf16x8){a[0], a[1], a[2], a[3], b[0], b[1], b[2], b[3]}; }

constexpr int RQ_STRIDE = 528, RV_STRIDE = 272, RS_STRIDE = 144;
constexpr int R_QS = 0, R_KS = 64 * RQ_STRIDE, R_VS = 2 * 64 * RQ_STRIDE, R_SS = R_VS + 64 * RV_STRIDE, R_CV = R_SS + 64 * RS_STRIDE, R_OS = R_CV + 2 * 16384, R_END = R_OS + 64 * RV_STRIDE;
static_assert(R_CV % 16 == 0 && R_OS % 16 == 0 && R_CV + 2 * 16384 <= 131072 && R_END <= ROWTAB_OFF + ROWTAB_BYTES, "retention LDS");

__device__ __forceinline__ void bg_load(Frame& F, int pair, u32x4 (&cv)[4]) {
#pragma unroll
    for (int bsel = 0; bsel < 2; ++bsel) { const TItem it = moe_item(F, 0, (2 * pair + bsel) * F.G + (int)blockIdx.x);
        const int kb = it.item >> 4, nb = it.item & 15, k0 = 64 * kb, n0 = 64 * nb;
#pragma unroll
        for (int i = 0; i < 2; ++i) cv[2 * bsel + i] = *(const u32x4*)((const char*)(it.W + (size_t)(k0 + 32 * i) * 1024 + n0) + (unsigned)((F.tid >> 4) * 4096 + (F.tid & 15) * 16)); }
}
__device__ __forceinline__ void bg_stage(Frame& F, const u32x4 (&cv)[4]) {
#pragma unroll
    for (int bsel = 0; bsel < 2; ++bsel)
#pragma unroll
        for (int i = 0; i < 2; ++i) *(LAS u32x4*)(F.lds + R_CV + bsel * 16384 + (i * 512 + F.tid) * 16) = cv[2 * bsel + i];
}
__device__ __forceinline__ void bg_convert(Frame& F, int pair) {
    if (F.wave < 2) return;
    const int bsel = F.wave >= 5 ? 1 : 0, wi = F.wave - 2 - 3 * bsel, c0 = 3 * wi, cnt = wi < 2 ? 3 : 2;
    const TItem it = moe_item(F, 0, (2 * pair + bsel) * F.G + (int)blockIdx.x);
    const int kb = it.item >> 4, nb = it.item & 15, k0 = 64 * kb, n0 = 64 * nb;
    const int d = dest_row(n0 + (F.lane & 32), it.mode) + (F.lane & 31);
    bf16_t* op = it.WT + (size_t)d * it.K + k0;
    const LAS float* tile = (const LAS float*)(F.lds + R_CV + bsel * 16384) + F.lane;
    float tv[3][8];
#pragma unroll
    for (int i = 0; i < 3; ++i) { if (i < cnt) { const LAS float* s = tile + (8 * (c0 + i)) * 64;
#pragma unroll
        for (int e = 0; e < 8; ++e) tv[i][e] = s[e * 64]; } }
#pragma unroll
    for (int i = 0; i < 3; ++i) { if (i < cnt) { const int c = c0 + i;
        u32x4 o; o.x = pk2(tv[i][0], tv[i][1]); o.y = pk2(tv[i][2], tv[i][3]); o.z = pk2(tv[i][4], tv[i][5]); o.w = pk2(tv[i][6], tv[i][7]);
        *(u32x4*)(op + 8 * c) = o; } }
}

__device__ __forceinline__ void phase_retention(Frame& F) {
    LAS unsigned char* lds = F.lds;
    const int tid = F.tid, lane = F.lane, w = F.wave, g = lane >> 4, l15 = lane & 15, tq = (lane >> 2) & 3, tp = lane & 3;
    const bf16_t* QR = (const bf16_t*)(F.ws + WS_QR); const bf16_t* KR = (const bf16_t*)(F.ws + WS_KR); bf16_t* VR = (bf16_t*)(F.ws + WS_VR);
    const unsigned qaddr = (unsigned)(uintptr_t)(lds + R_QS + l15 * RQ_STRIDE + g * 8), kaddr = (unsigned)(uintptr_t)(lds + R_KS + (8 * g + tq) * RQ_STRIDE + 4 * tp * 2);
    for (int i = tid; i < 64 * RS_STRIDE / 4; i += NTHREADS) ((LAS unsigned*)(lds + R_SS))[i] = 0u;
    for (int unit = F.vcu; unit < 256; unit += F.G) {
        const int b = unit >> 4, h = (unit >> 2) & 3, s = unit & 3;
        const float lgam = __builtin_log2f(1.0f - __builtin_exp2f(-5.0f - (float)h)); const float cdec = __builtin_exp2f(64.0f * lgam);
        const size_t tok0 = (size_t)b * SEQ;
        const bf16_t* qg = QR + tok0 * 1024 + h * 256; const bf16_t* kg = KR + tok0 * 1024 + h * 256; bf16_t* vg = VR + tok0 * 2048 + h * 512 + s * 128;
        f32x4 St[16];
#pragma unroll
        for (int t = 0; t < 16; ++t) St[t] = (f32x4){0.f, 0.f, 0.f, 0.f};
        u32x4 pq[4], pk[4], pv[2], cv[4];
        const unsigned qko = (unsigned)((tid >> 5) * 2048 + (tid & 31) * 16), vo = (unsigned)((tid >> 4) * 4096 + (tid & 15) * 16);
#define RET_PREFETCH(ci) do { const char* _q = (const char*)qg + (size_t)(ci) * 131072; const char* _k = (const char*)kg + (size_t)(ci) * 131072; const char* _v = (const char*)vg + (size_t)(ci) * 262144; \
            _Pragma("unroll") for (int i = 0; i < 4; ++i) { pq[i] = *(const u32x4*)(_q + i * 32768 + qko); pk[i] = *(const u32x4*)(_k + i * 32768 + qko); } \
            _Pragma("unroll") for (int i = 0; i < 2; ++i) pv[i] = *(const u32x4*)(_v + i * 131072 + vo); } while (0)
        RET_PREFETCH(0);
#ifdef RET_PROBE
        unsigned long long rp_acc = 0, rp_prev = __builtin_amdgcn_s_memrealtime();
#define RS(k) do { const unsigned long long _n = __builtin_amdgcn_s_memrealtime(); if (RET_PROBE == (k)) rp_acc += _n - rp_prev; rp_prev = _n; } while (0)
#else
#define RS(k) do {} while (0)
#endif
        for (int ci = 0; ci < 32; ++ci) {
            RS(0);
#pragma unroll
            for (int i = 0; i < 4; ++i) { const int id = i * 512 + tid, row = id >> 5, c16 = id & 31;
                *(LAS u32x4*)(lds + R_QS + row * RQ_STRIDE + c16 * 16) = pq[i]; *(LAS u32x4*)(lds + R_KS + row * RQ_STRIDE + c16 * 16) = pk[i]; }
#pragma unroll
            for (int i = 0; i < 2; ++i) { const int id = i * 512 + tid, row = id >> 4, c16 = id & 15; *(LAS u32x4*)(lds + R_VS + row * RV_STRIDE + c16 * 16) = pv[i]; }
            if (ci >= 1 && ci <= 24) bg_stage(F, cv);
            RS(1); __syncthreads(); RS(2);
            if (ci >= 1) {
#pragma unroll
                for (int i = 0; i < 2; ++i) { const int id = i * 512 + tid, row = id >> 4, c16 = id & 15;
                    *(u32x4*)((char*)vg + (size_t)(ci - 1) * 262144 + i * 131072 + vo) = *(const LAS u32x4*)(lds + R_OS + row * RV_STRIDE + c16 * 16); } }
            if (ci + 1 < 32) RET_PREFETCH(ci + 1);
            if (ci < 24) bg_load(F, ci, cv);
            if (ci >= 1 && ci <= 24) bg_convert(F, ci - 1);
#pragma unroll
            for (int rep = 0; rep < 2; ++rep) {
                const int idx = w + 8 * rep;
                if (idx < 10) {
                    const int mt = idx < 4 ? 0 : idx < 7 ? 1 : idx < 9 ? 2 : 3, nt_ = idx < 4 ? idx : idx < 7 ? idx - 3 : idx < 9 ? idx - 5 : 3;
                    f32x4 sacc = (f32x4){0.f, 0.f, 0.f, 0.f};
                    const LAS unsigned char* ka = lds + R_KS + (mt * 16 + l15) * RQ_STRIDE + g * 16; const LAS unsigned char* qb = lds + R_QS + (nt_ * 16 + l15) * RQ_STRIDE + g * 16;
#pragma unroll
                    for (int hb = 0; hb < 2; ++hb) { bf16x8 fa[4], fb[4];
#pragma unroll
                        for (int kk = 0; kk < 4; ++kk) { fa[kk] = *(const LAS bf16x8*)(ka + (4 * hb + kk) * 64); fb[kk] = *(const LAS bf16x8*)(qb + (4 * hb + kk) * 64); }
                        __builtin_amdgcn_sched_barrier(0);
#pragma unroll
                        for (int kk = 0; kk < 4; ++kk) sacc = __builtin_amdgcn_mfma_f32_16x16x32_bf16(fa[kk], fb[kk], sacc, 0, 0, 0);
                        __builtin_amdgcn_sched_barrier(0); }
                    const int n = nt_ * 16 + l15, m0 = mt * 16 + 4 * g;
#pragma unroll
                    for (int r = 0; r < 4; ++r) if (n < m0 + r) sacc[r] = 0.f;
                    u32x2 pw; pw.x = pk2(sacc[0], sacc[1]); pw.y = pk2(sacc[2], sacc[3]);
                    *(LAS u32x2*)(lds + R_SS + n * RS_STRIDE + m0 * 2) = pw;
                }
            }
            bf16x8 vf[2];
#pragma unroll
            for (int kk = 0; kk < 2; ++kk) { const LAS unsigned char* vp = lds + R_VS + (32 * kk + 8 * g + tq) * RV_STRIDE + (16 * w + 4 * tp) * 2;
                vf[kk] = cat8(tr_read(vp), tr_read(vp + 4 * RV_STRIDE)); }
#define RET_PACKST(kk) ({ u32x4 _x; _x.x = pk2(St[2 * (kk)][0], St[2 * (kk)][1]); _x.y = pk2(St[2 * (kk)][2], St[2 * (kk)][3]); _x.z = pk2(St[2 * (kk) + 1][0], St[2 * (kk) + 1][1]); _x.w = pk2(St[2 * (kk) + 1][2], St[2 * (kk) + 1][3]); __builtin_bit_cast(bf16x8, _x); })
            f32x4 o[4];
#pragma unroll
            for (int nt_ = 0; nt_ < 4; ++nt_) o[nt_] = (f32x4){0.f, 0.f, 0.f, 0.f};
            __builtin_amdgcn_sched_barrier(0);
            {
                s16x4 rlo[4], rhi[4];
#define RET_LD(k, gi) do { if ((gi) < 32) asm volatile("ds_read_b64 %0, %2 offset:%3\n\tds_read_b64 %1, %2 offset:%4" : "=&v"(rlo[k]), "=&v"(rhi[k]) : "v"(qaddr), "i"(((gi) & 3) * 16 * RQ_STRIDE + ((gi) >> 2) * 64), "i"(((gi) & 3) * 16 * RQ_STRIDE + ((gi) >> 2) * 64 + 32) : "memory"); \
                else asm volatile("ds_read_b64_tr_b16 %0, %2 offset:%3\n\tds_read_b64_tr_b16 %1, %2 offset:%4" : "=&v"(rlo[k]), "=&v"(rhi[k]) : "v"(kaddr), "i"(((gi) & 1) * 32 * RQ_STRIDE + (((gi) - 32) >> 1) * 32), "i"(((gi) & 1) * 32 * RQ_STRIDE + (((gi) - 32) >> 1) * 32 + 4 * RQ_STRIDE) : "memory"); } while (0)
#define RET_WAIT(k, n) asm volatile("s_waitcnt lgkmcnt(%2)" : "+v"(rlo[k]), "+v"(rhi[k]) : "n"(n) : "memory")
                RET_LD(0, 0); RET_LD(1, 1); RET_LD(2, 2);
                bf16x8 sbc = RET_PACKST(0), sbn = RET_PACKST(1);
#pragma unroll
                for (int gi = 0; gi < 64; ++gi) {
                    if (gi + 3 < 64) RET_LD((gi + 3) & 3, gi + 3);
                    RET_WAIT(gi & 3, (63 - gi) < 3 ? 2 * (63 - gi) : 6);
                    const bf16x8 af = cat8(rlo[gi & 3], rhi[gi & 3]);
                    if (gi < 32) { o[gi & 3] = __builtin_amdgcn_mfma_f32_16x16x32_bf16(af, sbc, o[gi & 3], 0, 0, 0);
                        if ((gi & 3) == 3) { sbc = sbn; if ((gi >> 2) + 2 < 8) sbn = RET_PACKST((gi >> 2) + 2); } }
                    else { const int t = (gi - 32) >> 1; St[t] = __builtin_amdgcn_mfma_f32_16x16x32_bf16(af, vf[gi & 1], St[t], 0, 0, 0);
                        if ((gi & 1) && t >= 1) St[t - 1] = St[t - 1] * cdec; }
                    __builtin_amdgcn_sched_barrier(0);
                }
                St[15] = St[15] * cdec;
#undef RET_LD
#undef RET_WAIT
            }
            RS(3); __syncthreads(); RS(4);
            {
#pragma unroll
                for (int nt_ = 0; nt_ < 4; ++nt_) {
                    const LAS unsigned char* sp = lds + R_SS + (nt_ * 16 + l15) * RS_STRIDE + g * 16;
#pragma unroll
                    for (int kk = 0; kk < 2; ++kk) { if (kk * 32 < (nt_ + 1) * 16) { const bf16x8 a = *(const LAS bf16x8*)(sp + kk * 64); o[nt_] = __builtin_amdgcn_mfma_f32_16x16x32_bf16(a, vf[kk], o[nt_], 0, 0, 0); } }
                }
#undef RET_PACKST
            }
#pragma unroll
            for (int nt_ = 0; nt_ < 4; ++nt_)
#pragma unroll
                for (int r = 0; r < 4; ++r) *(LAS bf16_t*)(lds + R_OS + (nt_ * 16 + 4 * g + r) * RV_STRIDE + (16 * w + l15) * 2) = (bf16_t)f2bf(o[nt_][r]);
            RS(5); __syncthreads(); RS(6);
        }
#ifdef RET_PROBE
        if (blockIdx.x == 0 && tid == RET_PROBE_WAVE * 64) __hip_atomic_store((unsigned long long*)(F.ctl + 8400), rp_acc, __ATOMIC_RELAXED, __HIP_MEMORY_SCOPE_AGENT);
#endif
#undef RET_PREFETCH
#pragma unroll
        for (int i = 0; i < 2; ++i) { const int id = i * 512 + tid, row = id >> 4, c16 = id & 15;
            *(u32x4*)((char*)vg + (size_t)31 * 262144 + i * 131072 + vo) = *(const LAS u32x4*)(lds + R_OS + row * RV_STRIDE + c16 * 16); }
        __syncthreads();
    }
}

constexpr int A_SLOT = 16384, A_K0 = 0, A_V0 = 3 * A_SLOT, A_LS = 6 * A_SLOT, A_X = 0, A_OST = A_LS + 8 * 64 * 4, A_OSTRIDE = 272, A_END = A_OST + 4 * 32 * A_OSTRIDE;
static_assert(A_END <= ROWTAB_OFF + ROWTAB_BYTES && 4 * 16384 <= A_LS, "attention LDS");
__device__ __forceinline__ int crow(int r, int hi) { return (r & 3) + 8 * (r >> 2) + 4 * hi; }
#define ATT_SB() __builtin_amdgcn_sched_barrier(0)

template <bool SHIFT>
__device__ __forceinline__ void phase_attention_impl(Frame& F, const float M2) {
    LAS unsigned char* lds = F.lds;
    const int tid = F.tid, lane = F.lane, w = F.wave, r32 = lane & 31, hi = lane >> 5, tq = (lane >> 2) & 3, tp = lane & 3, ch = (lane >> 4) & 1, t = w >> 2, wq = w & 3;
    const bf16_t* Q1 = (const bf16_t*)(F.ws + WS_Q1); const bf16_t* K1 = (const bf16_t*)(F.ws + WS_K1); const bf16_t* V1 = (const bf16_t*)(F.ws + WS_V1); bf16_t* AO = (bf16_t*)(F.ws + WS_AO);
    const float* lam = F.inp(I_LAM);
    const float l01 = wave_sum(lam[lane] * lam[64 + lane]), l23 = wave_sum(lam[128 + lane] * lam[192 + lane]);
    const float lambda_init = 0.8f - 0.6f * 0.7408182206817179f;
    const float lam_full = __expf(l01) - __expf(l23) + lambda_init;
    LAS float* wsf = (LAS float*)(lds + A_LS) + w * 64;
    unsigned dsrc[2];
#pragma unroll
    for (int i = 0; i < 2; ++i) { const int row = 4 * (2 * w + i) + (lane >> 4), fr = ((row & 3) << 2) | ((row >> 2) & 3); dsrc[i] = (unsigned)(row * 2048 + (((lane & 15) ^ fr) << 4)); }
    const unsigned ddst = (unsigned)(w * 2048);
    const int frk = ((r32 & 3) << 2) | ((r32 >> 2) & 3);
    int koff[4];
#pragma unroll
    for (int ks = 0; ks < 4; ++ks) koff[ks] = r32 * 256 + (((8 * t + 2 * ks + hi) ^ frk) << 4);
    unsigned vofA[4], vofB[4];
#pragma unroll
    for (int d = 0; d < 4; ++d) { const int c = 4 * d + 2 * ch + (tp >> 1);
        vofA[d] = (unsigned)((4 * hi + tq) * 256 + ((c ^ ((tq << 2) | (hi & 3))) << 4) + 8 * (tp & 1));
        vofB[d] = (unsigned)((4 * hi + tq + 8) * 256 + ((c ^ ((tq << 2) | ((hi + 2) & 3))) << 4) + 8 * (tp & 1)); }
    const unsigned ldsb = (unsigned)(uintptr_t)lds;
#ifdef ATT_PROBE
    unsigned long long att_tw = 0;
#endif
#define ATT_UNIT(n, b_, h_, u_) const int _v##b_ = F.vcu + ((n) >> 3) * F.G, _bh##b_ = _v##b_ >> 1, b_ = _bh##b_ >> 3, h_ = _bh##b_ & 7, _pr##b_ = 2 * (((n) & 7) >> 1) + (_v##b_ & 1), u_ = ((n) & 1) ? 15 - _pr##b_ : _pr##b_
#define ATT_DMA(gbase, tile, NTu, slotbase) do { const int _tl = (tile) < (NTu) ? (tile) : (NTu) - 1; const char* _g = (gbase) + (size_t)_tl * 131072; const unsigned _s = (slotbase) + (unsigned)(((tile) % 3) * A_SLOT) + ddst; \
            __builtin_amdgcn_global_load_lds((const GAS unsigned*)(_g + dsrc[0]), (LAS unsigned*)(lds + _s), 16, 0, 0); \
            __builtin_amdgcn_global_load_lds((const GAS unsigned*)(_g + dsrc[1]), (LAS unsigned*)(lds + _s + 1024), 16, 0, 0); } while (0)
#define ATT_PROLOGUE_DMA(kgx, vgx, NTx) do { ATT_DMA(kgx, 0, NTx, A_K0); ATT_DMA(vgx, 0, NTx, A_V0); ATT_DMA(kgx, 1, NTx, A_K0); ATT_DMA(kgx, 2, NTx, A_K0); ATT_DMA(vgx, 1, NTx, A_V0); } while (0)
#define ATT_WAITBAR(n) asm volatile("s_waitcnt vmcnt(" #n ") lgkmcnt(0)\n\ts_barrier" ::: "memory")
    const int NU = 8 * ((256 - F.vcu + F.G - 1) / F.G);
    if (NU > 0) { ATT_UNIT(0, b0_, h0_, u0_); ATT_PROLOGUE_DMA((const char*)(K1 + (size_t)b0_ * SEQ * 1024 + h0_ * 128), (const char*)(V1 + (size_t)b0_ * SEQ * 1024 + h0_ * 128), 2 * u0_ + 2); }
    {
        for (int n = 0; n < NU; ++n) {
            ATT_UNIT(n, b, h, u);
            const size_t tok0 = (size_t)b * SEQ; const int q0 = u * 128 + wq * 32;
            const int NT = 2 * u + 2, jmax = 2 * u + (wq >> 1);
            const char* kg = (const char*)(K1 + tok0 * 1024 + h * 128); const char* vg = (const char*)(V1 + tok0 * 1024 + h * 128);
            bf16x8 qf[4];
#pragma unroll
            for (int ks = 0; ks < 4; ++ks) qf[ks] = *(const bf16x8*)((const char*)(Q1 + (tok0 + q0) * 1024 + h * 128 + t * 64) + (unsigned)(r32 * 2048 + hi * 16 + ks * 32));
            f32x16 O[4];
#pragma unroll
            for (int d = 0; d < 4; ++d) O[d] = f32x16{};
            float lsum = 0.f;
#define ATT_QK(S0, S1, kslot) do { const f32x16 _z = f32x16{}; bf16x8 _a0[2], _a1[2]; const LAS unsigned char* _kb = lds + A_K0 + (kslot) * A_SLOT; \
            _Pragma("unroll") for (int ks = 0; ks < 2; ++ks) { _a0[ks] = *(const LAS bf16x8*)(_kb + koff[ks]); _a1[ks] = *(const LAS bf16x8*)(_kb + koff[ks] + 32 * 256); } \
            S0 = __builtin_amdgcn_mfma_f32_32x32x16_bf16(_a0[0], qf[0], _z, 0, 0, 0); S1 = __builtin_amdgcn_mfma_f32_32x32x16_bf16(_a1[0], qf[0], _z, 0, 0, 0); \
            S0 = __builtin_amdgcn_mfma_f32_32x32x16_bf16(_a0[1], qf[1], S0, 0, 0, 0); S1 = __builtin_amdgcn_mfma_f32_32x32x16_bf16(_a1[1], qf[1], S1, 0, 0, 0); ATT_SB(); \
            _Pragma("unroll") for (int ks = 0; ks < 2; ++ks) { _a0[ks] = *(const LAS bf16x8*)(_kb + koff[ks + 2]); _a1[ks] = *(const LAS bf16x8*)(_kb + koff[ks + 2] + 32 * 256); } \
            S0 = __builtin_amdgcn_mfma_f32_32x32x16_bf16(_a0[0], qf[2], S0, 0, 0, 0); S1 = __builtin_amdgcn_mfma_f32_32x32x16_bf16(_a1[0], qf[2], S1, 0, 0, 0); \
            S0 = __builtin_amdgcn_mfma_f32_32x32x16_bf16(_a0[1], qf[3], S0, 0, 0, 0); S1 = __builtin_amdgcn_mfma_f32_32x32x16_bf16(_a1[1], qf[3], S1, 0, 0, 0); } while (0)
#define ATT_EXP4(S0, S1, PFN, e) do { float x0, x1, x2, x3; \
            if ((e) < 4) { x0 = S0[4 * (e)]; x1 = S0[4 * (e) + 1]; x2 = S0[4 * (e) + 2]; x3 = S0[4 * (e) + 3]; } else { x0 = S1[4 * ((e) - 4)]; x1 = S1[4 * ((e) - 4) + 1]; x2 = S1[4 * ((e) - 4) + 2]; x3 = S1[4 * ((e) - 4) + 3]; } \
            if (SHIFT) { x0 -= M2; x1 -= M2; x2 -= M2; x3 -= M2; } \
            x0 = __builtin_amdgcn_exp2f(x0); x1 = __builtin_amdgcn_exp2f(x1); x2 = __builtin_amdgcn_exp2f(x2); x3 = __builtin_amdgcn_exp2f(x3); lsum += (x0 + x1) + (x2 + x3); \
            PFN[(e) >> 1][((e) & 1) * 2] = pk2(x0, x1); PFN[(e) >> 1][((e) & 1) * 2 + 1] = pk2(x2, x3); } while (0)
#define ATT_VLD(k, i) asm volatile("ds_read_b64_tr_b16 %0, %2 offset:%4\n\tds_read_b64_tr_b16 %1, %3 offset:%4" : "=&v"(vlo[k]), "=&v"(vhi[k]) : "v"(va[(i) & 3]), "v"(vb[(i) & 3]), "i"(((i) >> 2) * 4096) : "memory")
#define ATT_VWAIT(k, n) asm volatile("s_waitcnt lgkmcnt(" #n ")" : "+v"(vlo[k]), "+v"(vhi[k]) :: "memory")
#define ATT_MM(PF, k, i) do { O[(i) & 3] = __builtin_amdgcn_mfma_f32_32x32x16_bf16(__builtin_bit_cast(bf16x8, PF[(i) >> 2]), cat8(vlo[k], vhi[k]), O[(i) & 3], 0, 0, 0); } while (0)
#define ATT_SLOT(PF, i) do { if ((i) + 3 < 16) ATT_VLD(((i) + 3) & 3, (i) + 3); \
            if ((i) < 13) ATT_VWAIT((i) & 3, 6); else if ((i) == 13) ATT_VWAIT((i) & 3, 4); else if ((i) == 14) ATT_VWAIT((i) & 3, 2); else ATT_VWAIT((i) & 3, 0); \
            ATT_MM(PF, (i) & 3, i); } while (0)
            ATT_WAITBAR(4);
            u32x4 pf[4];
            { f32x16 s0, s1; ATT_QK(s0, s1, 0);
#pragma unroll
              for (int e = 0; e < 8; ++e) ATT_EXP4(s0, s1, pf, e); }
            ATT_WAITBAR(4);
            int ks1 = 1, vs0 = 0;
#if defined(ATT_PROBE) && defined(ATT_PROBE_LOOP)
            const unsigned long long _tl0 = __builtin_amdgcn_s_memrealtime();
#endif
            for (int j = 0; j < NT; ++j) {
                ATT_DMA(kg, j + 3, NT, A_K0); ATT_DMA(vg, j + 2, NT, A_V0);
                unsigned va[4], vb[4];
#pragma unroll
                for (int d = 0; d < 4; ++d) { va[d] = ldsb + (unsigned)(A_V0 + vs0 * A_SLOT) + vofA[d]; vb[d] = ldsb + (unsigned)(A_V0 + vs0 * A_SLOT) + vofB[d]; }
                if (j + 1 <= jmax) {
                    f32x16 s0, s1; u32x4 pfn[4];
                    s16x4 vlo[4], vhi[4];
                    ATT_VLD(0, 0); ATT_VLD(1, 1); ATT_VLD(2, 2);
                    ATT_QK(s0, s1, ks1); ATT_SB();
#pragma unroll
                    for (int i = 0; i < 8; ++i) { ATT_SLOT(pf, i); ATT_SB(); }
#pragma unroll
                    for (int i = 8; i < 16; ++i) { ATT_SLOT(pf, i); ATT_EXP4(s0, s1, pfn, i - 8); ATT_SB(); }
#pragma unroll
                    for (int s = 0; s < 4; ++s) pf[s] = pfn[s];
                } else if (j <= jmax) {
                    s16x4 vlo[4], vhi[4];
                    ATT_VLD(0, 0); ATT_VLD(1, 1); ATT_VLD(2, 2);
#pragma unroll
                    for (int i = 0; i < 16; ++i) { ATT_SLOT(pf, i); ATT_SB(); }
                }
                ks1 = ks1 == 2 ? 0 : ks1 + 1; vs0 = vs0 == 2 ? 0 : vs0 + 1;
#if defined(ATT_PROBE) && !defined(ATT_PROBE_LOOP)
                { const unsigned long long _t0 = __builtin_amdgcn_s_memrealtime(); ATT_WAITBAR(4); att_tw += __builtin_amdgcn_s_memrealtime() - _t0; }
#else
                ATT_WAITBAR(4);
#endif
            }
#if defined(ATT_PROBE) && defined(ATT_PROBE_LOOP)
            att_tw += __builtin_amdgcn_s_memrealtime() - _tl0;
#endif
            asm volatile("s_waitcnt vmcnt(0)" ::: "memory");
            if (n + 1 < NU) { const int n1 = n + 1; ATT_UNIT(n1, bn_, hn_, un_);
                ATT_PROLOGUE_DMA((const char*)(K1 + (size_t)bn_ * SEQ * 1024 + hn_ * 128), (const char*)(V1 + (size_t)bn_ * SEQ * 1024 + hn_ * 128), 2 * un_ + 2); }
#undef ATT_QK
#undef ATT_EXP4
#undef ATT_VLD
#undef ATT_VWAIT
#undef ATT_MM
#undef ATT_SLOT
            lsum = swap32_add(lsum, lsum);
            if (hi == 0) wsf[r32] = (t ? lam_full : 1.0f) / lsum;
            LDS_WAIT(); asm volatile("" ::: "memory");
            float sc[16];
#pragma unroll
            for (int r = 0; r < 16; ++r) sc[r] = wsf[crow(r, hi)];
            LAS unsigned* XR = (LAS unsigned*)(lds + A_OST + wq * 32 * A_OSTRIDE);
            if (t == 1) {
#pragma unroll
                for (int d = 0; d < 4; ++d)
#pragma unroll
                    for (int rr = 0; rr < 8; ++rr) XR[(d * 8 + rr) * 64 + lane] = pk2(O[d][2 * rr] * sc[2 * rr], O[d][2 * rr + 1] * sc[2 * rr + 1]);
            }
            __syncthreads();
            if (t == 0) {
                const float osc = 1.0f - lambda_init;
                const float* subp = F.inp(I_SUBLN); const float sub0 = subp[r32], sub1 = subp[32 + r32], sub2 = subp[64 + r32], sub3 = subp[96 + r32];
                unsigned xr[32];
#pragma unroll
                for (int i = 0; i < 32; ++i) xr[i] = XR[i * 64 + lane];
                LDS_WAIT(); asm volatile("" ::: "memory");
#pragma unroll
                for (int r = 0; r < 16; ++r) { const int q = crow(r, hi);
#define ATT_X(d) ((r & 1) ? bf_hi(xr[(d) * 8 + (r >> 1)]) : bf_lo(xr[(d) * 8 + (r >> 1)]))
                    const float o0 = O[0][r] * sc[r] - ATT_X(0), o1 = O[1][r] * sc[r] - ATT_X(1), o2 = O[2][r] * sc[r] - ATT_X(2), o3 = O[3][r] * sc[r] - ATT_X(3);
#undef ATT_X
                    float ss = o0 * o0 + o1 * o1 + o2 * o2 + o3 * o3;
                    ss = sum8(ss); ss += dppf<0x140>(ss); ss = swap16_add(ss, ss);
                    const float rstd = __builtin_amdgcn_rsqf(ss * (1.0f / 128.0f) + EPS) * osc;
                    LAS bf16_t* sp = (LAS bf16_t*)(lds + A_OST + wq * 32 * A_OSTRIDE + q * A_OSTRIDE) + r32;
                    sp[0] = (bf16_t)f2bf(o0 * rstd * sub0); sp[32] = (bf16_t)f2bf(o1 * rstd * sub1); sp[64] = (bf16_t)f2bf(o2 * rstd * sub2); sp[96] = (bf16_t)f2bf(o3 * rstd * sub3); }
                LDS_WAIT(); asm volatile("" ::: "memory");
                char* ob = (char*)(AO + (tok0 + q0) * 1024 + h * 128);
#pragma unroll
                for (int i = 0; i < 8; ++i) { const int id = i * 64 + lane, row = id >> 4, c16 = id & 15;
                    *(u32x4*)(ob + (unsigned)(row * 2048 + c16 * 16)) = *(const LAS u32x4*)(lds + A_OST + wq * 32 * A_OSTRIDE + row * A_OSTRIDE + c16 * 16); }
            }
        }
    }
#undef ATT_DMA
#undef ATT_UNIT
#undef ATT_PROLOGUE_DMA
#undef ATT_WAITBAR
#ifdef ATT_PROBE
    if (blockIdx.x == 0 && tid == ATT_PROBE * 64) __hip_atomic_store((unsigned long long*)(F.ctl + 8400), att_tw, __ATOMIC_RELAXED, __HIP_MEMORY_SCOPE_AGENT);
#endif
}

__device__ __forceinline__ void phase_attention(Frame& F) {
    const float gq = wave_max(fabsf(F.inp(I_QNORM)[F.lane])), gk = wave_max(fabsf(F.inp(I_KNORM)[F.lane]));
    const float bound = 8.0f * LOG2E * gq * gk * 1.001f + 0.01f;
    if (bound > 96.0f) phase_attention_impl<true>(F, bound - 96.0f); else phase_attention_impl<false>(F, 0.0f);
}
constexpr int N_PHASES = 17;
#ifndef MK_N_LAUNCHES
#define MK_N_LAUNCHES 1
#endif
struct Args { const float* in[26]; float* out; unsigned char* ws; int ph_lo, ph_hi; };

__global__ void __launch_bounds__(NTHREADS, 2) yoco_fwd(Args args) {
    extern __shared__ __attribute__((aligned(16))) unsigned char lds_raw[];
    Frame F;
    F.lds = (LAS unsigned char*)lds_raw;
    const int wave0 = __builtin_amdgcn_readfirstlane((int)threadIdx.x >> 6);
    F.G = gridDim.x; { const int bx = blockIdx.x; F.vcu = (F.G % 8 == 0) ? (bx % 8) * (F.G / 8) + bx / 8 : bx; }
#define FRESH_IN() do { kargp_t _t = (kargp_t)__builtin_amdgcn_kernarg_segment_ptr(); asm volatile("" : "+s"(_t)); F.kin = _t; \
        F.out = (float*)(GAS float*)_t[26]; F.ws = (unsigned char*)(GAS unsigned char*)_t[27]; F.ctl = (unsigned*)(F.ws + WS_CTL); \
        int _tid; asm volatile("v_mbcnt_lo_u32_b32 %0, -1, 0\n\tv_mbcnt_hi_u32_b32 %0, -1, %0" : "=v"(_tid)); _tid += wave0 * 64; asm volatile("" : "+v"(_tid)); F.tid = _tid;     \
        F.lane = _tid & 63; F.wave = __builtin_amdgcn_readfirstlane(_tid >> 6); } while (0)
    FRESH_IN();
    volatile LAS unsigned* MISC = (volatile LAS unsigned*)(F.lds + MISC_OFF);
    LAS int* rbs = (LAS int*)(F.lds + MISC_OFF + 256);
    LAS int* rowtab = (LAS int*)(F.lds + ROWTAB_OFF);
    LAS int* utab = (LAS int*)(F.lds + MISC_OFF + 1024);
    for (int u = F.tid; u < 512; u += NTHREADS) MISC[u] = 0u;
#ifdef GEMM_PROBE
    if (blockIdx.x == 0 && F.tid == 0) g_pr = 0ull;
#endif
    __syncthreads();
    const int lo = args.ph_lo, hi = args.ph_hi;
    const bool multi = (hi - lo) > 1;
    XcdBarrier bar; bar.bar = nullptr; bar.x = 0; bar.st = nullptr;
    if (multi) bar = xcd_barrier_post(F.ctl + CW_BAR, MISC + 8);
#ifdef ONLY_PHASE
#define IN(k) ((k) == ONLY_PHASE && lo <= (k) && (k) < hi)
#else
#define IN(k) (lo <= (k) && (k) < hi)
#endif
#if defined(PROBE_A) || defined(PROBE_B)
#ifndef PROBE_A
#define PROBE_A 0
#endif
#ifndef PROBE_B
#define PROBE_B 0
#endif
#ifndef PROBE_CONST
#define PROBE_CONST 0ull
#endif
#ifndef PROBE_MUL
#define PROBE_MUL 0ull
#endif
    unsigned long long pr_prev = __builtin_amdgcn_s_memrealtime(), pr_a = 0, pr_b = 0;
#define PROBE_STAMP(k) do { const unsigned long long _n = __builtin_amdgcn_s_memrealtime(); if ((PROBE_A >> (k)) & 1) pr_a += _n - pr_prev; if ((PROBE_B >> (k)) & 1) pr_b += _n - pr_prev; pr_prev = _n; } while (0)
#else
#define PROBE_STAMP(k) do {} while (0)
#endif
#ifdef BAR_PROBE
#define SEAM(k) do { if (IN(k) && IN((k) + 1)) { bar.bar = F.ctl + CW_BAR; const unsigned long long _b0 = __builtin_amdgcn_s_memrealtime(); xcd_barrier(bar); pr_a += __builtin_amdgcn_s_memrealtime() - _b0; } else __syncthreads(); } while (0)
#else
#define SEAM(k) do { if (IN(k) && IN((k) + 1)) { bar.bar = F.ctl + CW_BAR; xcd_barrier(bar); } else __syncthreads(); PROBE_STAMP(k); } while (0)
#endif
    #define gw (F.vcu * NWAVES + F.wave)
#define NGW (F.G * NWAVES)

#if defined(P0_PROBE)
#define P0S(k) do { if (P0_PROBE == (k)) pr_a = __builtin_amdgcn_s_memrealtime() - pr_prev; } while (0)
#else
#define P0S(k) do {} while (0)
#endif
    if (IN(0)) { FRESH_IN(); P0S(0); adaln_phase(F); __syncthreads(); P0S(1); rope_table(F, blockIdx.x * NTHREADS + F.tid, F.G * NTHREADS); P0S(2); {
          const int blk = (int)blockIdx.x; if (blk < 224) convert_weights(F, 0, true, false, blk * 8 + F.wave, 1 << 20, 1792); else { const int s0 = 1792 + (blk - 224) * 40 + F.wave * 5; convert_weights(F, 0, true, false, s0, 1, s0 + 5); } }
        SEAM(0); }
    if (IN(1)) { FRESH_IN(); phase_h0(F); SEAM(1); }
    if (IN(2)) { FRESH_IN();
      {
        pg8::SchedPlain S{(const char*)(F.ws + WS_H), (const char*)(F.ws + WS_WIN), NTOK / 256, 24, 1024, F.G, (int)blockIdx.x};
        pg8::EpiInProj E{(bf16_t*)(F.ws + WS_QR), (bf16_t*)(F.ws + WS_KR), (bf16_t*)(F.ws + WS_VR), (bf16_t*)(F.ws + WS_SG), (const float*)(F.ws + WS_COS), (const float*)(F.ws + WS_SIN)};
        { const int nU = pg8::build_units(utab, S, F.tid); pg8::gemm_phase<pg8::EpiInProj, false>(F.lds, F.tid, 1024, utab, nU, E, rowtab); } }
      SEAM(2); }
    if (IN(3)) { FRESH_IN(); if (F.wave >= 4) __builtin_amdgcn_s_setprio(1);
        phase_retention(F); __builtin_amdgcn_s_setprio(0); SEAM(3); }
    if (IN(4)) { FRESH_IN(); phase_gate(F); SEAM(4); }
    if (IN(5)) { FRESH_IN(); pg8::SchedPlain S{(const char*)(F.ws + WS_VR), (const char*)(F.ws + WS_WRO), NTOK / 256, 4, 2048, F.G, (int)blockIdx.x};
        pg8::EpiResid<true> E{F.inp(I_X), (bf16_t*)(F.ws + WS_XB), (const float*)(F.ws + WS_MOD) + 2048};
        { const int nU = pg8::build_units(utab, S, F.tid); pg8::gemm_phase<pg8::EpiResid<true>, false>(F.lds, F.tid, 2048, utab, nU, E, rowtab); } SEAM(5); }
#pragma unroll 1
    for (int layer = 0; layer < 2; ++layer) {
        const int pb = layer ? 13 : 6;
        if (IN(pb)) { FRESH_IN(); phase_route(F, layer); SEAM(pb); }
        if (IN(pb + 1)) { FRESH_IN(); moe_tables(F, layer, rbs, rowtab, 8, true);
            pg8::SchedMoe S{(const char*)(F.ws + WS_H), (const char*)(F.ws + (layer ? WS_W13_L1 : WS_W13)), rbs, 8, F.G, (int)blockIdx.x, 1, (size_t)2048 * 1024 * 2};
            pg8::EpiMoeUp E{(bf16_t*)(F.ws + WS_HID)};
            { const int nU = pg8::build_units(utab, S, F.tid); pg8::gemm_phase<pg8::EpiMoeUp, true>(F.lds, F.tid, 1024, utab, nU, E, rowtab); } if (layer == 0) tail_convert(F, rbs, 8, 0); SEAM(pb + 1); }
        if (IN(pb + 2)) { FRESH_IN(); moe_tables(F, layer, rbs, rowtab, 4, false);
            pg8::SchedMoe S{(const char*)(F.ws + WS_HID), (const char*)(F.ws + (layer ? WS_W2_L1 : WS_W2)), rbs, 4, F.G, (int)blockIdx.x, 0, (size_t)1024 * 1024 * 2};
            pg8::EpiBf16 E{(bf16_t*)(F.ws + WS_YB), 1024};
            { const int nU = pg8::build_units(utab, S, F.tid); pg8::gemm_phase<pg8::EpiBf16, false>(F.lds, F.tid, 1024, utab, nU, E, rowtab); } if (layer == 0) tail_convert(F, rbs, 4, 1); SEAM(pb + 2); }
        if (layer == 0) {
            if (IN(9)) { FRESH_IN(); phase_mid(F, rbs); SEAM(9); }
            if (IN(10)) { FRESH_IN(); pg8::SchedQKV S{(const char*)(F.ws + WS_H), (const char*)(F.ws + WS_HKV), (const char*)(F.ws + WS_WQ), (const char*)(F.ws + WS_WKV), F.G, (int)blockIdx.x};
                pg8::EpiQKV E{(bf16_t*)(F.ws + WS_Q1), (bf16_t*)(F.ws + WS_K1), (bf16_t*)(F.ws + WS_V1), F.inp(I_QNORM), F.inp(I_KNORM)};
                { const int nU = pg8::build_units(utab, S, F.tid); pg8::gemm_phase<pg8::EpiQKV, false>(F.lds, F.tid, 1024, utab, nU, E, rowtab); } SEAM(10); }
            if (IN(11)) { FRESH_IN();
                if (F.wave >= 4) __builtin_amdgcn_s_setprio(1);
                phase_attention(F); __builtin_amdgcn_s_setprio(0);
                SEAM(11); }
            if (IN(12)) { FRESH_IN(); pg8::SchedPlain S{(const char*)(F.ws + WS_AO), (const char*)(F.ws + WS_WAO), NTOK / 256, 4, 1024, F.G, (int)blockIdx.x};
                pg8::EpiResid<false> E{(const void*)(F.ws + WS_XB), (bf16_t*)(F.ws + WS_XB), (const float*)(F.ws + WS_MOD) + 16 * 6144 + 2048};
                { const int nU = pg8::build_units(utab, S, F.tid); pg8::gemm_phase<pg8::EpiResid<false>, false>(F.lds, F.tid, 1024, utab, nU, E, rowtab); } SEAM(12); }
        }
    }
    if (IN(16)) { FRESH_IN(); phase_final(F, rbs); }
#if defined(PROBE_A) || defined(PROBE_B)
    __syncthreads(); PROBE_STAMP(16);
#if defined(ATT_PROBE) || defined(RET_PROBE)
    if (blockIdx.x == 0) pr_a = __hip_atomic_load((unsigned long long*)(F.ctl + 8400), __ATOMIC_RELAXED, __HIP_MEMORY_SCOPE_AGENT);
#endif
#ifdef GEMM_PROBE
    if (blockIdx.x == 0) pr_a = g_pr;
#endif
    if (blockIdx.x == 0) { const unsigned long long qa = (pr_a + 500ull) / 1000ull, spin = (PROBE_MUL ? pr_a * PROBE_MUL : qa * 100000ull) + pr_b + PROBE_CONST, t0 = __builtin_amdgcn_s_memrealtime();
        while (__builtin_amdgcn_s_memrealtime() - t0 < spin) __builtin_amdgcn_s_sleep(8); }
#endif
#undef IN
#undef SEAM
#undef gw
#undef NGW
}

extern "C" void kernel_launch(void* const* d_in, const int* in_sizes, int n_in, void* d_out, int out_size, void* d_ws, size_t ws_size, hipStream_t stream) {
    static int grid = 0;
    if (grid == 0) {
        if (n_in != 26 || in_sizes[0] != NTOK * DM || out_size != NTOK * DM || ws_size < WS_END) {
            fprintf(stderr, "kernel_launch: unexpected shapes (n_in %d, in0 %d, out %d, ws %zu < %zu); nothing launched\n", n_in, n_in > 0 ? in_sizes[0] : -1, out_size, ws_size, (size_t)WS_END); grid = -1; return; }
        int dev = 0, cus = 0, per_cu = 0;
        if (hipGetDevice(&dev) != hipSuccess || hipDeviceGetAttribute(&cus, hipDeviceAttributeMultiprocessorCount, dev) != hipSuccess) { grid = -1; return; }
        if (hipFuncSetAttribute((const void*)yoco_fwd, hipFuncAttributeMaxDynamicSharedMemorySize, LDS_BYTES) != hipSuccess) { fprintf(stderr, "kernel_launch: hipFuncSetAttribute failed\n"); grid = -1; return; }
        if (hipOccupancyMaxActiveBlocksPerMultiprocessor(&per_cu, (const void*)yoco_fwd, NTHREADS, LDS_BYTES) != hipSuccess || per_cu < 1) { fprintf(stderr, "kernel_launch: occupancy query says %d blocks per CU\n", per_cu); (void)hipGetLastError(); grid = -1; return; }
        if (cus != 256) { fprintf(stderr, "kernel_launch: built for a 256-CU device (got %d)\n", cus); grid = -1; return; }
        grid = cus;
    }
    if (grid < 0) return;
    (void)hipMemsetAsync((char*)d_ws + WS_CTL, 0, CTL_ZERO_BYTES, stream);
    Args a{};
    for (int i = 0; i < 26; ++i) a.in[i] = (const float*)d_in[i];
    a.out = (float*)d_out; a.ws = (unsigned char*)d_ws;
    if (MK_N_LAUNCHES == 1) { a.ph_lo = 0; a.ph_hi = N_PHASES; hipLaunchKernelGGL(yoco_fwd, dim3(grid), dim3(NTHREADS), LDS_BYTES, stream, a); }
    else { for (int p = 0; p < N_PHASES; ++p) { a.ph_lo = p; a.ph_hi = p + 1; hipLaunchKernelGGL(yoco_fwd, dim3(grid), dim3(NTHREADS), LDS_BYTES, stream, a); } }
}
```

```cpp
#include <hip/hip_runtime.h>
#include <cstdio>
#include <cstdint>

#define LAS __attribute__((address_space(3)))
#define GAS __attribute__((address_space(1)))
typedef unsigned short bf16_t;
typedef short bf16x8 __attribute__((ext_vector_type(8)));
typedef short s16x4 __attribute__((ext_vector_type(4)));
typedef float f32x2 __attribute__((ext_vector_type(2)));
typedef float f32x4 __attribute__((ext_vector_type(4)));
typedef float f32x16 __attribute__((ext_vector_type(16)));
typedef unsigned u32x2 __attribute__((ext_vector_type(2)));
typedef unsigned u32x4 __attribute__((ext_vector_type(4)));

constexpr int NTOK = 32768, DM = 1024, SEQ = 2048, NBATCH = 16;
constexpr float EPS = 1e-6f;
constexpr float LOG2E = 1.4426950408889634f;
constexpr int NWAVES = 8, NTHREADS = 512;

constexpr size_t MiB = 1u << 20;
constexpr size_t WS_CTL = 0, CTL_ZERO_BYTES = 1 * MiB;
constexpr size_t WS_MOD = 1 * MiB;
constexpr size_t WS_KVMOD = WS_MOD + 786432;
constexpr size_t WS_COS = 2 * MiB, WS_SIN = 3 * MiB;
constexpr size_t WS_LIST = 4 * MiB;
constexpr size_t WS_TOKSLOT = 6 * MiB;
constexpr size_t WS_TOKW = 6 * MiB + 512 * 1024;
constexpr size_t WS_WRT = 7 * MiB;
constexpr size_t WS_WIN = 8 * MiB, WS_WRO = 20 * MiB, WS_WKV = 24 * MiB, WS_WQ = 28 * MiB, WS_WAO = 30 * MiB;
constexpr size_t WS_W13 = 32 * MiB, WS_W2 = 96 * MiB;
constexpr size_t WS_W13_L1 = 192 * MiB, WS_W2_L1 = 32 * MiB;
constexpr size_t WS_XB = 128 * MiB;
constexpr size_t WS_SG = WS_XB;
constexpr size_t WS_H = 256 * MiB;
constexpr size_t WS_QR = 320 * MiB, WS_KR = 384 * MiB, WS_VR = 448 * MiB;
constexpr size_t WS_HID = 320 * MiB, WS_YB = 456 * MiB;
constexpr size_t WS_HKV = 320 * MiB, WS_Q1 = 384 * MiB, WS_K1 = 448 * MiB, WS_V1 = 512 * MiB, WS_AO = 320 * MiB;
constexpr size_t WS_END = 592 * MiB;
constexpr int MAXROWS = 69632;

constexpr int CW_BAR = 4096, CW_CNT0 = 8192, CW_CNT1 = 8256, CW_ATTQ = 8320, CW_ADALN = 8384;
constexpr int N_CONV = 16;

constexpr int RING_BYTES = 131072, ROWTAB_OFF = 131072, ROWTAB_BYTES = 16384, MISC_OFF = ROWTAB_OFF + ROWTAB_BYTES, LDS_BYTES = MISC_OFF + 2048;

__device__ __forceinline__ unsigned f2bf(float f) { unsigned u = __builtin_bit_cast(unsigned, f); return (u + 0x7fffu + ((u >> 16) & 1u)) >> 16; }
__device__ __forceinline__ unsigned pk2(float lo, float hi) { unsigned r; asm volatile("v_cvt_pk_bf16_f32 %0, %1, %2" : "=v"(r) : "v"(lo), "v"(hi)); return r; }
__device__ __forceinline__ float bf_lo(unsigned u) { return __builtin_bit_cast(float, u << 16); }
__device__ __forceinline__ float bf_hi(unsigned u) { return __builtin_bit_cast(float, u & 0xffff0000u); }
template <int CTRL> __device__ __forceinline__ float dppf(float v) { return __builtin_bit_cast(float, __builtin_amdgcn_update_dpp(0, __builtin_bit_cast(int, v), CTRL, 0xf, 0xf, true)); }
__device__ __forceinline__ float swap16_add(float a, float b) { asm volatile("s_nop 1\n\tv_permlane16_swap_b32 %0, %1" : "+v"(a), "+v"(b)); return a + b; }
__device__ __forceinline__ float swap32_add(float a, float b) { asm volatile("s_nop 1\n\tv_permlane32_swap_b32 %0, %1" : "+v"(a), "+v"(b)); return a + b; }
__device__ __forceinline__ float sum8(float v) { v += dppf<0xB1>(v); v += dppf<0x4E>(v); v += dppf<0x141>(v); return v; }
__device__ __forceinline__ float wave_sum(float v) { v = sum8(v); v += dppf<0x140>(v); v = swap16_add(v, v); return swap32_add(v, v); }
__device__ __forceinline__ float wave_max(float v) {
#pragma unroll
    for (int o = 1; o < 64; o <<= 1) v = fmaxf(v, __shfl_xor(v, o));
    return v;
}
__device__ __forceinline__ float fast_silu(float x) { return x * __builtin_amdgcn_rcpf(1.0f + __builtin_amdgcn_exp2f(-x * LOG2E)); }
#define LDS_WAIT() asm volatile("s_waitcnt lgkmcnt(0)" ::: "memory")
#define VM_WAIT() asm volatile("s_waitcnt vmcnt(0)" ::: "memory")

#define XB_TMO      128
#define XB_XCNT(j)  (256  + 64 * (j))
#define XB_XSUB(j)  (1280 + 64 * (j))
#define XB_XGEN(j)  (2304 + 64 * (j))
#define XB_TOP      3328
#define XB_TOPGEN   3392
#define XCD_BAR_WORDS 3456
#define XB_SPIN_CAP (1u << 22)
__device__ __forceinline__ unsigned xb_ld(unsigned* p)              { return __hip_atomic_load(p, __ATOMIC_RELAXED, __HIP_MEMORY_SCOPE_AGENT); }
__device__ __forceinline__ unsigned xb_add(unsigned* p, unsigned v) { return __hip_atomic_fetch_add(p, v, __ATOMIC_RELAXED, __HIP_MEMORY_SCOPE_AGENT); }
__device__ __forceinline__ unsigned xb_xcc_id() { return (unsigned)__builtin_amdgcn_s_getreg((3 << 11) | 20) & 0xFu; }
#define XB_SPIN(cond, bar) do { unsigned _sp = 0; while (cond) { __builtin_amdgcn_s_sleep(1); \
    if ((++_sp & 255u) == 0u) { if (xb_ld(&(bar)[XB_TMO])) break; if (_sp > XB_SPIN_CAP) { atomicAdd(&(bar)[XB_TMO], 1u); break; } } } } while (0)
struct XcdBarrier { unsigned* bar; unsigned x; volatile LAS unsigned* st; };
__device__ __forceinline__ XcdBarrier xcd_barrier_post(unsigned* bar, volatile LAS unsigned* st) {
    XcdBarrier b; b.bar = bar; b.x = xb_xcc_id(); b.st = st;
    if (threadIdx.x == 0) (void)xb_add(&bar[XB_XCNT(b.x)], 1u);
    return b;
}
__device__ __forceinline__ void xcd_barrier_complete(unsigned* bar, unsigned x, unsigned& nloc, unsigned& nx) {
    const unsigned G = gridDim.x * gridDim.y * gridDim.z;
    unsigned sum, cnt, mine, sp = 0u;
    for (;;) {
        sum = 0u; cnt = 0u; mine = 0u;
#pragma unroll
        for (unsigned j = 0; j < 16; ++j) { const unsigned c = xb_ld(&bar[XB_XCNT(j)]); sum += c; cnt += (c > 0u) ? 1u : 0u; mine = (j == x) ? c : mine; }
        if (sum == G) break;
        __builtin_amdgcn_s_sleep(1);
        if ((++sp & 255u) == 0u) { if (xb_ld(&bar[XB_TMO])) break; if (sp > XB_SPIN_CAP) { atomicAdd(&bar[XB_TMO], 1u); break; } }
    }
    nloc = mine > 0u ? mine : 1u; nx = cnt > 0u ? cnt : 1u;
}
__device__ __forceinline__ void xcd_barrier(const XcdBarrier& b) {
    asm volatile("s_waitcnt vmcnt(0)" ::: "memory");
    __syncthreads();
    if (threadIdx.x == 0) {
        unsigned* bar = b.bar;
        __builtin_amdgcn_s_waitcnt(0);
        unsigned nloc = b.st[0], nx = b.st[1];
        if (nloc == 0u) { xcd_barrier_complete(bar, b.x, nloc, nx); b.st[0] = nloc; b.st[1] = nx; }
        const unsigned old = xb_add(&bar[XB_XSUB(b.x)], 1u);
        const unsigned gen = old / nloc;
        if (old + 1u == (gen + 1u) * nloc) {
            __builtin_amdgcn_fence(__ATOMIC_RELEASE, "agent");
            asm volatile("s_waitcnt vmcnt(0)" ::: "memory");
            const unsigned og = xb_add(&bar[XB_TOP], 1u);
            const unsigned tg = og / nx;
            if (og + 1u == (tg + 1u) * nx) xb_add(&bar[XB_TOPGEN], 1u);
            else XB_SPIN(xb_ld(&bar[XB_TOPGEN]) == tg, bar);
            __builtin_amdgcn_fence(__ATOMIC_ACQUIRE, "agent");
            xb_add(&bar[XB_XGEN(b.x)], 1u);
            asm volatile("s_waitcnt vmcnt(0)" ::: "memory");
        } else {
            XB_SPIN(xb_ld(&bar[XB_XGEN(b.x)]) == gen, bar);
            __builtin_amdgcn_fence(__ATOMIC_ACQUIRE, "agent");
            asm volatile("s_waitcnt vmcnt(0)" ::: "memory");
        }
    }
    __syncthreads();
}
#ifdef GEMM_PROBE
#ifndef GEMM_PROBE_SEL
#define GEMM_PROBE_SEL 31
#endif
__device__ unsigned long long g_pr;
#endif
namespace pg8 {
constexpr int BM = 256, BK = 64, HALF = 128, HTB = HALF * BK * 2, STAGE_BYTES = 8 * HTB, NXCD = 8, WGM = 8;
__host__ __device__ __forceinline__ int lds_byte(int r, int c) { const int st = (r >> 4) * 2 + (c >> 5), rr = r & 15, cc = c & 31, ob = rr * 64 + cc * 2; return st * 1024 + (ob ^ (((ob >> 9) & 1) << 5)); }
__host__ __device__ __forceinline__ void stage_rc(int b, int& R, int& C) { const int st = b / 1024, sb = b % 1024, swz = sb ^ (((sb >> 9) & 1) << 5); R = (st >> 1) * 16 + swz / 64; C = (st & 1) * 32 + (swz % 64) / 2; }
__host__ __device__ __forceinline__ int perm32(int rho) { const int n = rho >> 4, i = rho & 15; return 8 * (i >> 2) + 4 * n + (i & 3); }

struct Unit { const char* A; const char* B; int pm, pn, rows; };

__device__ __forceinline__ bool static_order(int nM, int nN, int G, int c, int i, int& pm, int& pn) {
    const int nwg = nM * nN; const long L = (long)i * G + c; if (L >= nwg) return false;
    int wgid = (int)L; { const int q = nwg / NXCD, r = nwg % NXCD, xcd = wgid % NXCD, off = wgid / NXCD; wgid = (xcd < r ? xcd * (q + 1) : r * (q + 1) + (xcd - r) * q) + off; }
    const int nig = WGM * nN, gid = wgid / nig, fm = gid * WGM, gsz = (nM - fm) < WGM ? (nM - fm) : WGM;
    pm = fm + ((wgid % nig) % gsz); pn = (wgid % nig) / gsz; return true;
}
__device__ __forceinline__ int xcd_remap(int L, int nwg) { const int q = nwg / NXCD, r = nwg % NXCD, xcd = L % NXCD, off = L / NXCD; return (xcd < r ? xcd * (q + 1) : r * (q + 1) + (xcd - r) * q) + off; }

__device__ __forceinline__ bool load_unit(const LAS int* utab, int nU, int i, Unit& u) {
    if (i >= nU) return false;
    const LAS int* p = utab + i * 8;
    const unsigned alo = __builtin_amdgcn_readfirstlane(p[0]), ahi = __builtin_amdgcn_readfirstlane(p[1]), blo = __builtin_amdgcn_readfirstlane(p[2]), bhi = __builtin_amdgcn_readfirstlane(p[3]);
    u.A = (const char*)(((unsigned long long)ahi << 32) | alo); u.B = (const char*)(((unsigned long long)bhi << 32) | blo);
    u.pm = __builtin_amdgcn_readfirstlane(p[4]); u.pn = __builtin_amdgcn_readfirstlane(p[5]); u.rows = __builtin_amdgcn_readfirstlane(p[6]); return true;
}
template <class Sched>
__device__ __forceinline__ int build_units(LAS int* utab, const Sched& S, const int tid) {
    const int i = tid;
    if (i < 16) { Unit u; const bool ok = S.next(i, u); LAS int* p = utab + i * 8;
        if (ok) { const unsigned long long a = (unsigned long long)u.A, b = (unsigned long long)u.B; p[0] = (int)(unsigned)a; p[1] = (int)(unsigned)(a >> 32); p[2] = (int)(unsigned)b; p[3] = (int)(unsigned)(b >> 32); p[4] = u.pm; p[5] = u.pn; p[6] = u.rows; }
        p[7] = ok ? 1 : 0; }
    __syncthreads();
    int n = 0;
#pragma unroll
    for (int k = 0; k < 16; ++k) n += utab[k * 8 + 7];
    return __builtin_amdgcn_readfirstlane(n);
}
template <class Epi, bool GATHER>
__device__ __forceinline__ void gemm_phase(LAS unsigned char* lds, const int tid, const int K, const LAS int* utab, const int nU, const Epi& E, const LAS int* rowtab) {
    const int wid = __builtin_amdgcn_readfirstlane(tid >> 6), lane = tid & 63, wr = wid >> 2, wc = wid & 3, fr = lane & 15, fq = lane >> 4;
    const int nt = K / BK;
    unsigned vA[2][2], vN[2][2], voffB[2]; int Rr[2], Cc[2];
#pragma unroll
    for (int i = 0; i < 2; ++i) { int R, C; stage_rc(tid * 16 + i * 8192, R, C); const int Rb = Epi::PERM ? ((R & ~31) + perm32(R & 31)) : R; Rr[i] = R; Cc[i] = C;
        voffB[i] = (unsigned)(Rb * K + C) * 2u; }
#define PG8_CALCA(u, v) do { _Pragma("unroll") for (int _h = 0; _h < 2; ++_h) _Pragma("unroll") for (int _i = 0; _i < 2; ++_i) { const int _r = _h * HALF + Rr[_i]; \
        const int _row = GATHER ? rowtab[((u).rows >> 2) + _r] : _r; (v)[_h][_i] = (unsigned)(_row * K + Cc[_i]) * 2u; } } while (0)
    const size_t kstep = (size_t)(BK * 2);
    const size_t hstep = (size_t)HALF * K * 2;
    const unsigned ldsw = (unsigned)wid * 1024u;
    const int aoff = lds_byte(wr * 64 + fr, fq * 8), boff = lds_byte(wc * 32 + fr, fq * 8);
#define PG8_SA(b, h) (((b) * 2 + (h)) * HTB)
#define PG8_SB(b, h) ((4 + (b) * 2 + (h)) * HTB)
#define PG8_STAGE(bufoff, gbase, voff) do { _Pragma("unroll") for (int _i = 0; _i < 2; ++_i) \
        __builtin_amdgcn_global_load_lds((const unsigned*)((const char*)(gbase) + (voff)[_i]), (LAS unsigned*)(lds + (bufoff) + ldsw + _i * 8192), 16, 0, 0); } while (0)
#define PG8_LDA(dst, b, h) do { _Pragma("unroll") for (int m = 0; m < 4; ++m) _Pragma("unroll") for (int k = 0; k < 2; ++k) dst[m][k] = *(const LAS bf16x8*)(lds + PG8_SA(b, h) + aoff + m * 2048 + k * 1024); } while (0)
#define PG8_LDB(dst, b, h) do { _Pragma("unroll") for (int n = 0; n < 2; ++n) _Pragma("unroll") for (int k = 0; k < 2; ++k) dst[n][k] = *(const LAS bf16x8*)(lds + PG8_SB(b, h) + boff + n * 2048 + k * 1024); } while (0)
#define PG8_MMA(ai, bj, At, Bt) do { __builtin_amdgcn_s_setprio(1); _Pragma("unroll") for (int m = 0; m < 4; ++m) _Pragma("unroll") for (int n = 0; n < 2; ++n) _Pragma("unroll") for (int k = 0; k < 2; ++k) \
        acc[ai][bj][m][n] = __builtin_amdgcn_mfma_f32_16x16x32_bf16(Bt[n][k], At[m][k], acc[ai][bj][m][n], 0, 0, 0); __builtin_amdgcn_s_setprio(0); } while (0)
#define PG8_WAIT_V(n) asm volatile("s_waitcnt vmcnt(" #n ")" ::: "memory")
#define PG8_WAIT_L(n) asm volatile("s_waitcnt lgkmcnt(" #n ")" ::: "memory")
#define PG8_BAR __builtin_amdgcn_s_barrier()
#define PG8_SCHED __builtin_amdgcn_sched_barrier(0)
    Unit cur, nxt; int ui = 0;
    if (!load_unit(utab, nU, 0, cur)) return;
    f32x4 acc[2][2][4][2];
#pragma unroll
    for (int a = 0; a < 2; ++a)
#pragma unroll
        for (int b = 0; b < 2; ++b)
#pragma unroll
            for (int m = 0; m < 4; ++m)
#pragma unroll
                for (int n = 0; n < 2; ++n) acc[a][b][m][n] = (f32x4){0.f, 0.f, 0.f, 0.f};
    bf16x8 At[4][2], B0[2][2], B1[2][2];
    const char* cA = cur.A; const char* cB = cur.B;
    PG8_CALCA(cur, vA);
    PG8_STAGE(PG8_SB(0, 0), cB, voffB); PG8_STAGE(PG8_SB(0, 1), cB + hstep, voffB); PG8_STAGE(PG8_SA(0, 0), cA, vA[0]); PG8_STAGE(PG8_SA(0, 1), cA, vA[1]);
    if (wr == 1) PG8_BAR;
    PG8_WAIT_V(2); PG8_BAR;
    PG8_STAGE(PG8_SB(1, 0), cB + kstep, voffB); PG8_STAGE(PG8_SA(1, 0), cA + kstep, vA[0]); PG8_STAGE(PG8_SB(1, 1), cB + hstep + kstep, voffB);
    PG8_WAIT_V(6); PG8_BAR;
    for (;;) {
        const bool has_next = load_unit(utab, nU, ui + 1, nxt);
        const char* nA = has_next ? nxt.A : cA; const char* nB = has_next ? nxt.B : cB;
        if (GATHER) {
            if (has_next) { PG8_CALCA(nxt, vN); }
            else {
#pragma unroll
                for (int h = 0; h < 2; ++h) { vN[h][0] = vA[h][0]; vN[h][1] = vA[h][1]; }
            }
        }
#if defined(GEMM_PROBE) && GEMM_PROBE == 3
        const unsigned long long _k0 = __builtin_amdgcn_s_memrealtime();
#endif
        for (int t = 0; t < nt; t += 2) {
            const bool last = (t == nt - 2);
            const char* a1 = cA + (size_t)(t + 1) * kstep;
            const char* a2 = last ? nA : cA + (size_t)(t + 2) * kstep; const char* b2 = last ? nB : cB + (size_t)(t + 2) * kstep;
            const char* a3 = a2 + kstep; const char* b3 = b2 + kstep;
            unsigned w0[2], w1[2];
#pragma unroll
            for (int i = 0; i < 2; ++i) { w0[i] = (GATHER && last) ? vN[0][i] : vA[0][i]; w1[i] = (GATHER && last) ? vN[1][i] : vA[1][i]; }
            PG8_LDB(B0, 0, 0); PG8_LDB(B1, 0, 1); PG8_SCHED; PG8_LDA(At, 0, 0); PG8_STAGE(PG8_SA(1, 1), a1, vA[1]);
            PG8_WAIT_V(8); PG8_WAIT_L(0); PG8_BAR; PG8_MMA(0, 0, At, B0); PG8_MMA(0, 1, At, B1); PG8_BAR; PG8_SCHED;
            PG8_LDA(At, 0, 1); PG8_STAGE(PG8_SB(0, 0), b2, voffB); PG8_STAGE(PG8_SB(0, 1), b2 + hstep, voffB); PG8_STAGE(PG8_SA(0, 0), a2, w0);
            PG8_WAIT_V(8); PG8_WAIT_L(0); PG8_BAR; PG8_MMA(1, 0, At, B0); PG8_MMA(1, 1, At, B1); PG8_BAR; PG8_SCHED;
            PG8_LDB(B0, 1, 0); PG8_LDB(B1, 1, 1); PG8_SCHED; PG8_LDA(At, 1, 0); PG8_STAGE(PG8_SA(0, 1), a2, w1);
            PG8_WAIT_V(8); PG8_WAIT_L(0); PG8_BAR; PG8_MMA(0, 0, At, B0); PG8_MMA(0, 1, At, B1); PG8_BAR; PG8_SCHED;
            PG8_LDA(At, 1, 1); PG8_STAGE(PG8_SB(1, 0), b3, voffB); PG8_STAGE(PG8_SB(1, 1), b3 + hstep, voffB); PG8_STAGE(PG8_SA(1, 0), a3, w0);
            PG8_WAIT_V(8); PG8_WAIT_L(0); PG8_BAR; PG8_MMA(1, 0, At, B0); PG8_MMA(1, 1, At, B1); PG8_BAR; PG8_SCHED;
        }
#if defined(GEMM_PROBE) && GEMM_PROBE == 3
        if (blockIdx.x == 0 && tid == 0 && ((GEMM_PROBE_SEL >> Epi::PID) & 1)) g_pr += __builtin_amdgcn_s_memrealtime() - _k0;
#endif
#ifdef GEMM_PROBE
        const unsigned long long _g0 = __builtin_amdgcn_s_memrealtime();
#endif
        if (wr == 0) PG8_BAR;
        E(acc, cur, wr, wc, fr, fq);
#ifdef EPI_TWICE
        if ((EPI_TWICE >> Epi::PID) & 1) { asm volatile("" ::: "memory"); E(acc, cur, wr, wc, fr, fq); }
#endif
#ifdef GEMM_PROBE
#if GEMM_PROBE == 2
        asm volatile("s_waitcnt vmcnt(0)" ::: "memory");
#endif
#if GEMM_PROBE != 3
        if (blockIdx.x == 0 && tid == 0 && ((GEMM_PROBE_SEL >> Epi::PID) & 1)) g_pr += __builtin_amdgcn_s_memrealtime() - _g0;
#endif
#endif
        if (!has_next) break;
#pragma unroll
        for (int a = 0; a < 2; ++a)
#pragma unroll
            for (int b = 0; b < 2; ++b)
#pragma unroll
                for (int m = 0; m < 4; ++m)
#pragma unroll
                    for (int n = 0; n < 2; ++n) acc[a][b][m][n] = (f32x4){0.f, 0.f, 0.f, 0.f};
        cur = nxt; cA = nA; cB = nB; ++ui;
        if (GATHER) {
#pragma unroll
            for (int h = 0; h < 2; ++h) { vA[h][0] = vN[h][0]; vA[h][1] = vN[h][1]; }
        }
        if (wr == 1) PG8_BAR;
    }
    PG8_WAIT_V(0);
    PG8_BAR;
#undef PG8_CALCA
#undef PG8_SA
#undef PG8_SB
#undef PG8_STAGE
#undef PG8_LDA
#undef PG8_LDB
#undef PG8_MMA
#undef PG8_WAIT_V
#undef PG8_WAIT_L
#undef PG8_BAR
#undef PG8_SCHED
}
}
namespace pg8 {
typedef f32x4 Acc[2][2][4][2];

struct EpiInProj {
    static constexpr bool PERM = true; static constexpr int PID = 0;
    bf16_t *Q, *Kk, *V, *G; const float *cosT, *sinT;
    __device__ __forceinline__ void operator()(const Acc& acc, const Unit& u, int wr, int wc, int fr, int fq) const {
        const int pn = u.pn, row0 = u.pm * BM + wr * 64 + fr;
        if (pn < 8) {
            const int head = pn & 3; const bool isk = pn >= 4;
            const float lg = __builtin_log2f(1.0f - __builtin_exp2f(-5.0f - (float)head));
            bf16_t* out = isk ? Kk : Q;
            const int j0 = wc * 32 + 8 * fq;
            const int pos0 = row0 & (SEQ - 1);
            f32x4 cb[2][2], sb[2][2], cst[2], sst[2];
#pragma unroll
            for (int n = 0; n < 2; ++n) {
#pragma unroll
                for (int ai = 0; ai < 2; ++ai) { cb[ai][n] = *(const f32x4*)(cosT + (pos0 + ai * HALF) * 128 + j0 + 4 * n); sb[ai][n] = *(const f32x4*)(sinT + (pos0 + ai * HALF) * 128 + j0 + 4 * n); }
                cst[n] = *(const f32x4*)(cosT + 16 * 128 + j0 + 4 * n); sst[n] = *(const f32x4*)(sinT + 16 * 128 + j0 + 4 * n); }
#pragma unroll
            for (int ai = 0; ai < 2; ++ai) {
                f32x4 c4[2] = {cb[ai][0], cb[ai][1]}, s4[2] = {sb[ai][0], sb[ai][1]};
#pragma unroll
                for (int m = 0; m < 4; ++m) {
                    const int row = row0 + ai * HALF + m * 16, pos = row & (SEQ - 1), nn = pos & 63;
                    const float sc = isk ? __builtin_exp2f(-(float)nn * lg) * 0.0625f : __builtin_exp2f((float)nn * lg);
                    u32x4 w1, w2;
#pragma unroll
                    for (int n = 0; n < 2; ++n) {
                        const f32x4 x1 = acc[ai][0][m][n], x2 = acc[ai][1][m][n];
                        const f32x4 o1 = (x1 * c4[n] - x2 * s4[n]) * sc, o2 = (x2 * c4[n] + x1 * s4[n]) * sc;
                        w1[2 * n] = pk2(o1[0], o1[1]); w1[2 * n + 1] = pk2(o1[2], o1[3]); w2[2 * n] = pk2(o2[0], o2[1]); w2[2 * n + 1] = pk2(o2[2], o2[3]);
                        if (m < 3) { const f32x4 cn = c4[n] * cst[n] - s4[n] * sst[n], sn = s4[n] * cst[n] + c4[n] * sst[n]; c4[n] = cn; s4[n] = sn; }
                    }
                    bf16_t* p = out + (size_t)row * 1024 + head * 256 + j0;
                    *(u32x4*)p = w1; *(u32x4*)(p + 128) = w2;
                }
            }
        } else {
            const bool isg = pn >= 16; bf16_t* out = isg ? G : V; const int col0 = (isg ? pn - 16 : pn - 8) * 256 + wc * 32 + 8 * fq;
#pragma unroll
            for (int ai = 0; ai < 2; ++ai)
#pragma unroll
                for (int m = 0; m < 4; ++m) { bf16_t* rowp = out + (size_t)(row0 + ai * HALF + m * 16) * 2048 + col0;
#pragma unroll
                    for (int bj = 0; bj < 2; ++bj) { f32x4 v0 = acc[ai][bj][m][0], v1 = acc[ai][bj][m][1];
                        if (isg) {
#pragma unroll
                            for (int e = 0; e < 4; ++e) { v0[e] = fast_silu(v0[e]); v1[e] = fast_silu(v1[e]); } }
                        u32x4 w; w.x = pk2(v0[0], v0[1]); w.y = pk2(v0[2], v0[3]); w.z = pk2(v1[0], v1[1]); w.w = pk2(v1[2], v1[3]);
                        *(u32x4*)(rowp + bj * HALF) = w; } }
        }
    }
};
struct EpiMoeUp {
    static constexpr bool PERM = true; static constexpr int PID = 1;
    bf16_t* O;
    __device__ __forceinline__ void operator()(const Acc& acc, const Unit& u, int wr, int wc, int fr, int fq) const {
        const int row0 = u.pm * BM + wr * 64 + fr, col0 = u.pn * 128 + wc * 32 + 8 * fq;
#pragma unroll
        for (int ai = 0; ai < 2; ++ai)
#pragma unroll
            for (int m = 0; m < 4; ++m) {
                f32x4 v0 = acc[ai][0][m][0], v1 = acc[ai][0][m][1]; const f32x4 g0 = acc[ai][1][m][0], g1 = acc[ai][1][m][1];
#pragma unroll
                for (int e = 0; e < 4; ++e) { v0[e] = fast_silu(v0[e]) * g0[e]; v1[e] = fast_silu(v1[e]) * g1[e]; }
                u32x4 w; w.x = pk2(v0[0], v0[1]); w.y = pk2(v0[2], v0[3]); w.z = pk2(v1[0], v1[1]); w.w = pk2(v1[2], v1[3]);
                *(u32x4*)(O + (size_t)(row0 + ai * HALF + m * 16) * 1024 + col0) = w;
            }
    }
};
struct EpiBf16 {
    static constexpr bool PERM = true; static constexpr int PID = 2;
    bf16_t* O; int ldc;
    __device__ __forceinline__ void operator()(const Acc& acc, const Unit& u, int wr, int wc, int fr, int fq) const {
        const int row0 = u.pm * BM + wr * 64 + fr, col0 = u.pn * BM + wc * 32 + 8 * fq;
#pragma unroll
        for (int ai = 0; ai < 2; ++ai)
#pragma unroll
            for (int m = 0; m < 4; ++m) { bf16_t* rowp = O + (size_t)(row0 + ai * HALF + m * 16) * ldc + col0;
#pragma unroll
                for (int bj = 0; bj < 2; ++bj) { const f32x4 v0 = acc[ai][bj][m][0], v1 = acc[ai][bj][m][1];
                    u32x4 w; w.x = pk2(v0[0], v0[1]); w.y = pk2(v0[2], v0[3]); w.z = pk2(v1[0], v1[1]); w.w = pk2(v1[2], v1[3]);
                    *(u32x4*)(rowp + bj * HALF) = w; } }
    }
};
template <bool BASE_F32>
struct EpiResid {
    static constexpr bool PERM = true; static constexpr int PID = 3;
    const void* base; bf16_t* out; const float* gate;
    __device__ __forceinline__ void operator()(const Acc& acc, const Unit& u, int wr, int wc, int fr, int fq) const {
        const int row0 = u.pm * BM + wr * 64 + fr, col0 = u.pn * BM + wc * 32 + 8 * fq;
        const float* gp = gate + (size_t)((u.pm * BM) / SEQ) * 6144 + col0;
        f32x4 gv[2][2];
#pragma unroll
        for (int bj = 0; bj < 2; ++bj)
#pragma unroll
            for (int n = 0; n < 2; ++n) gv[bj][n] = *(const f32x4*)(gp + bj * HALF + n * 4);
        if (BASE_F32) {
#pragma unroll
            for (int ai = 0; ai < 2; ++ai) { f32x4 b[4][2][2];
#pragma unroll
                for (int m = 0; m < 4; ++m)
#pragma unroll
                    for (int bj = 0; bj < 2; ++bj) { const float* bp = (const float*)base + (size_t)(row0 + ai * HALF + m * 16) * 1024 + col0 + bj * HALF; b[m][bj][0] = *(const f32x4*)bp; b[m][bj][1] = *(const f32x4*)(bp + 4); }
                asm volatile("" ::: "memory");
#pragma unroll
                for (int m = 0; m < 4; ++m)
#pragma unroll
                    for (int bj = 0; bj < 2; ++bj) { const size_t off = (size_t)(row0 + ai * HALF + m * 16) * 1024 + col0 + bj * HALF;
                        const f32x4 v0 = b[m][bj][0] + gv[bj][0] * acc[ai][bj][m][0], v1 = b[m][bj][1] + gv[bj][1] * acc[ai][bj][m][1];
                        u32x4 w; w.x = pk2(v0[0], v0[1]); w.y = pk2(v0[2], v0[3]); w.z = pk2(v1[0], v1[1]); w.w = pk2(v1[2], v1[3]);
                        *(u32x4*)(out + off) = w; }
                asm volatile("" ::: "memory"); }
        } else {
            u32x4 q[2][4][2];
#pragma unroll
            for (int ai = 0; ai < 2; ++ai)
#pragma unroll
                for (int m = 0; m < 4; ++m)
#pragma unroll
                    for (int bj = 0; bj < 2; ++bj) q[ai][m][bj] = *(const u32x4*)((const bf16_t*)base + (size_t)(row0 + ai * HALF + m * 16) * 1024 + col0 + bj * HALF);
            asm volatile("" ::: "memory");
#pragma unroll
            for (int ai = 0; ai < 2; ++ai)
#pragma unroll
                for (int m = 0; m < 4; ++m)
#pragma unroll
                    for (int bj = 0; bj < 2; ++bj) { const size_t off = (size_t)(row0 + ai * HALF + m * 16) * 1024 + col0 + bj * HALF; const u32x4 qq = q[ai][m][bj];
                        const f32x4 b0 = (f32x4){bf_lo(qq.x), bf_hi(qq.x), bf_lo(qq.y), bf_hi(qq.y)}, b1 = (f32x4){bf_lo(qq.z), bf_hi(qq.z), bf_lo(qq.w), bf_hi(qq.w)};
                        const f32x4 v0 = b0 + gv[bj][0] * acc[ai][bj][m][0], v1 = b1 + gv[bj][1] * acc[ai][bj][m][1];
                        u32x4 w; w.x = pk2(v0[0], v0[1]); w.y = pk2(v0[2], v0[3]); w.z = pk2(v1[0], v1[1]); w.w = pk2(v1[2], v1[3]);
                        *(u32x4*)(out + off) = w; }
        }
    }
};
struct EpiQKV {
    static constexpr bool PERM = true; static constexpr int PID = 4;
    bf16_t *Q, *Kk, *V; const float *qn, *kn;
    __device__ __forceinline__ void operator()(const Acc& acc, const Unit& u, int wr, int wc, int fr, int fq) const {
        const int pn = u.pn, row0 = u.pm * BM + wr * 64 + fr;
        if (pn < 8) {
            const bool isk = pn >= 4; bf16_t* out = isk ? Kk : Q; const float* gn = isk ? kn : qn; const float osc = isk ? 1.0f : 0.125f * LOG2E;
            const int col0 = (pn & 3) * 256 + 64 * wc + 8 * fq;
            f32x4 gq[2][2];
#pragma unroll
            for (int bj = 0; bj < 2; ++bj) { gq[bj][0] = *(const f32x4*)(gn + 32 * bj + 8 * fq); gq[bj][1] = *(const f32x4*)(gn + 32 * bj + 8 * fq + 4); }
#pragma unroll
            for (int ai = 0; ai < 2; ++ai)
#pragma unroll
                for (int m = 0; m < 4; ++m) {
                    float ss = 0.f;
#pragma unroll
                    for (int bj = 0; bj < 2; ++bj)
#pragma unroll
                        for (int n = 0; n < 2; ++n) { const f32x4 x = acc[ai][bj][m][n]; ss += (x[0] * x[0] + x[1] * x[1]) + (x[2] * x[2] + x[3] * x[3]); }
                    ss = swap16_add(ss, ss); ss = swap32_add(ss, ss);
                    const float rstd = __builtin_amdgcn_rsqf(ss * (1.0f / 64.0f) + EPS) * osc;
                    bf16_t* rowp = out + (size_t)(row0 + ai * HALF + m * 16) * 1024 + col0;
#pragma unroll
                    for (int bj = 0; bj < 2; ++bj) { const f32x4 g0 = gq[bj][0], g1 = gq[bj][1];
                        const f32x4 v0 = acc[ai][bj][m][0] * rstd * g0, v1 = acc[ai][bj][m][1] * rstd * g1;
                        u32x4 w; w.x = pk2(v0[0], v0[1]); w.y = pk2(v0[2], v0[3]); w.z = pk2(v1[0], v1[1]); w.w = pk2(v1[2], v1[3]);
                        *(u32x4*)(rowp + 32 * bj) = w; }
                    asm volatile("" ::: "memory");
                }
        } else {
            const int col0 = (pn - 8) * 256 + wc * 32 + 8 * fq;
#pragma unroll
            for (int ai = 0; ai < 2; ++ai)
#pragma unroll
                for (int m = 0; m < 4; ++m) { bf16_t* rowp = V + (size_t)(row0 + ai * HALF + m * 16) * 1024 + col0;
#pragma unroll
                    for (int bj = 0; bj < 2; ++bj) { const f32x4 v0 = acc[ai][bj][m][0], v1 = acc[ai][bj][m][1];
                        u32x4 w; w.x = pk2(v0[0], v0[1]); w.y = pk2(v0[2], v0[3]); w.z = pk2(v1[0], v1[1]); w.w = pk2(v1[2], v1[3]);
                        *(u32x4*)(rowp + bj * HALF) = w; } }
        }
    }
};

struct SchedPlain {
    const char *A, *B; int nM, nN, K, G, c;
    __device__ __forceinline__ bool next(int i, Unit& u) const { int pm, pn; if (!static_order(nM, nN, G, c, i, pm, pn)) return false;
        u.pm = pm; u.pn = pn; u.rows = 0; u.A = A + (size_t)pm * BM * K * 2; u.B = B + (size_t)pn * BM * K * 2; return true; }
};
struct SchedQKV {
    const char *Aq, *Akv, *Bq, *Bkv; int G, c;
    __device__ __forceinline__ bool next(int i, Unit& u) const { int pm, pn; if (!static_order(NTOK / BM, 12, G, c, i, pm, pn)) return false;
        u.pm = pm; u.pn = pn; u.rows = 0; const size_t ts = (size_t)BM * 1024 * 2;
        u.A = (pn < 4 ? Aq : Akv) + (size_t)pm * ts; u.B = pn < 4 ? Bq + (size_t)pn * ts : Bkv + (size_t)(pn - 4) * ts; return true; }
};
struct SchedMoe {
    const char *A, *B; const LAS int* rbs; int NT, G, c, gather; size_t estride;
    __device__ __forceinline__ bool next(int i, Unit& u) const {
        const int nrb = rbs[16], nwg = nrb * NT; const long L = (long)i * G + c; if (L >= nwg) return false;
        const int wg = xcd_remap((int)L, nwg), rb = wg / NT, pn = wg % NT;
        int e = 0;
#pragma unroll
        for (int k = 1; k < 16; ++k) e += (rb >= rbs[k]) ? 1 : 0;
        u.pm = rb; u.pn = pn; u.rows = i * 1024;
        u.A = gather ? A : A + (size_t)rb * BM * 1024 * 2; u.B = B + (size_t)e * estride + (size_t)pn * BM * 1024 * 2; return true; }
};
}
typedef __attribute__((address_space(4))) const unsigned long long* kargp_t;
struct Frame {
    LAS unsigned char* lds;
    unsigned* ctl;
    int tid, lane, wave, vcu, G;
    unsigned char* ws;
    kargp_t kin;
    __device__ __forceinline__ const float* inp(int i) const { return (const float*)(const GAS float*)kin[i]; }
    float* out;
};
enum { I_X = 0, I_C, I_ADAW, I_ADAB, I_NMIX, I_NFFN, I_RWIN, I_RGN, I_RWOUT, I_KVADAW, I_KVADAB, I_KVNORM, I_KVW, I_KNORM, I_WQ, I_QNORM, I_LAM, I_SUBLN, I_WOUT,
       I_WG, I_BG, I_WE, I_BE, I_W1, I_W3, I_W2 };

__device__ __forceinline__ int dest_row(int n, int mode) {
    if (mode == 1) { const int c = n & 255; return (n & ~255) + 128 * ((c >> 5) & 1) + 32 * (c >> 6) + (c & 31); }
    if (mode == 2) return (n >> 7) * 256 + (n & 127);
    if (mode == 3) return (n >> 7) * 256 + 128 + (n & 127);
    return n;
}
struct TItem { const float* W; bf16_t* WT; int K, N, mode, item; };
__device__ __forceinline__ void titem_load(const TItem& it, f32x4 (&v)[16], int lane) {
    const int nblk = it.N / 64, kb = it.item / nblk, nb = it.item % nblk, k0 = 64 * kb, n0 = 64 * nb;
    const float* p = it.W + (size_t)(k0 + (lane >> 4)) * it.N + n0 + 4 * (lane & 15);
#pragma unroll
    for (int i = 0; i < 16; ++i) v[i] = __builtin_nontemporal_load((const f32x4*)(p + (size_t)(4 * i) * it.N));
}
__device__ __forceinline__ void titem_store(const TItem& it, const f32x4 (&v)[16], LAS float* scr, int lane) {
    const int nblk = it.N / 64, kb = it.item / nblk, nb = it.item % nblk, k0 = 64 * kb, n0 = 64 * nb;
#pragma unroll
    for (int i = 0; i < 16; ++i) *(LAS f32x4*)(scr + (4 * i + (lane >> 4)) * 68 + 4 * (lane & 15)) = v[i];
    LDS_WAIT(); asm volatile("" ::: "memory");
    const int d = dest_row(n0 + (lane & 32), it.mode) + (lane & 31);
    bf16_t* op = it.WT + (size_t)d * it.K + k0;
#pragma unroll 2
    for (int c = 0; c < 8; ++c) { const LAS float* s = scr + (8 * c) * 68 + lane;
        u32x4 o; o.x = pk2(s[0 * 68], s[1 * 68]); o.y = pk2(s[2 * 68], s[3 * 68]); o.z = pk2(s[4 * 68], s[5 * 68]); o.w = pk2(s[6 * 68], s[7 * 68]);
        *(u32x4*)(op + 8 * c) = o; }
    LDS_WAIT(); asm volatile("" ::: "memory");
}
__device__ __forceinline__ void thalf_load(const TItem& it, int half, f32x4 (&v)[8], int lane) {
    const int nblk = it.N / 64, kb = it.item / nblk, nb = it.item % nblk, k0 = 64 * kb + 32 * half, n0 = 64 * nb;
    const float* p = it.W + (size_t)(k0 + (lane >> 4)) * it.N + n0 + 4 * (lane & 15);
#pragma unroll
    for (int i = 0; i < 8; ++i) v[i] = __builtin_nontemporal_load((const f32x4*)(p + (size_t)(4 * i) * it.N));
}
__device__ __forceinline__ void thalf_store(const TItem& it, int half, const f32x4 (&v)[8], LAS float* scr, int lane) {
    const int nblk = it.N / 64, kb = it.item / nblk, nb = it.item % nblk, k0 = 64 * kb + 32 * half, n0 = 64 * nb;
#pragma unroll
    for (int i = 0; i < 8; ++i) *(LAS f32x4*)(scr + (4 * i + (lane >> 4)) * 68 + 4 * (lane & 15)) = v[i];
    LDS_WAIT(); asm volatile("" ::: "memory");
    const int d = dest_row(n0 + (lane & 32), it.mode) + (lane & 31);
    bf16_t* op = it.WT + (size_t)d * it.K + k0;
#pragma unroll 2
    for (int c = 0; c < 4; ++c) { const LAS float* s = scr + (8 * c) * 68 + lane;
        u32x4 o; o.x = pk2(s[0 * 68], s[1 * 68]); o.y = pk2(s[2 * 68], s[3 * 68]); o.z = pk2(s[4 * 68], s[5 * 68]); o.w = pk2(s[6 * 68], s[7 * 68]);
        *(u32x4*)(op + 8 * c) = o; }
    LDS_WAIT(); asm volatile("" ::: "memory");
}
__device__ __forceinline__ TItem moe_item(Frame& F, int layer, int it) {
    constexpr int IPM = 256;
    int e, which, item;
    if (layer == 0) { e = it / (3 * IPM); const int r = it % (3 * IPM); which = r / IPM; item = r % IPM; }
    else if (it < 32 * IPM) { e = it / (2 * IPM); const int r = it % (2 * IPM); which = r / IPM; item = r % IPM; }
    else { const int j = it - 32 * IPM; e = j / IPM; which = 2; item = j % IPM; }
    const size_t wo = ((size_t)layer * 16 + e) * 1048576;
    bf16_t* w13 = (bf16_t*)(F.ws + (layer ? WS_W13_L1 : WS_W13)); bf16_t* w2 = (bf16_t*)(F.ws + (layer ? WS_W2_L1 : WS_W2));
    TItem t; t.K = 1024; t.N = 1024; t.item = item;
    if (which == 0) { t.W = F.inp(I_W1) + wo; t.WT = w13 + (size_t)e * 2097152; t.mode = 2; }
    else if (which == 1) { t.W = F.inp(I_W3) + wo; t.WT = w13 + (size_t)e * 2097152; t.mode = 3; }
    else { t.W = F.inp(I_W2) + wo; t.WT = w2 + (size_t)e * 1048576; t.mode = 0; }
    return t;
}
__device__ __forceinline__ TItem dense_item(Frame& F, int it) {
    constexpr int I_IN = 16 * 96, I_RO = 32 * 16, I_KV = 16 * 32, I_Q = 256;
    TItem t; int r = it;
    if (r < I_IN) { t.W = F.inp(I_RWIN); t.WT = (bf16_t*)(F.ws + WS_WIN); t.K = 1024; t.N = 6144; t.mode = 0; t.item = r; return t; } r -= I_IN;
    if (r < I_RO) { t.W = F.inp(I_RWOUT); t.WT = (bf16_t*)(F.ws + WS_WRO); t.K = 2048; t.N = 1024; t.mode = 0; t.item = r; return t; } r -= I_RO;
    if (r < I_KV) { t.W = F.inp(I_KVW); t.WT = (bf16_t*)(F.ws + WS_WKV); t.K = 1024; t.N = 2048; t.mode = (r % 32) < 16 ? 1 : 0; t.item = r; return t; } r -= I_KV;
    if (r < I_Q) { t.W = F.inp(I_WQ); t.WT = (bf16_t*)(F.ws + WS_WQ); t.K = 1024; t.N = 1024; t.mode = 1; t.item = r; return t; } r -= I_Q;
    t.W = F.inp(I_WOUT); t.WT = (bf16_t*)(F.ws + WS_WAO); t.K = 1024; t.N = 1024; t.mode = 0; t.item = r; return t;
}
constexpr int N_DENSE_ITEMS = 16 * 96 + 32 * 16 + 16 * 32 + 256 + 256, N_MOE_ITEMS = 16 * 3 * 256;
__device__ __forceinline__ void convert_weights(Frame& F, int layer, bool with_dense, bool with_moe, int gw, int NGW, int end = 1 << 30) {
    LAS float* scr = (LAS float*)(F.lds + F.wave * 17408);
    const int nd = with_dense ? N_DENSE_ITEMS : 0, total0 = nd + (with_moe ? N_MOE_ITEMS : 0), total = end < total0 ? end : total0;
    int it = gw; if (it >= total) return;
    TItem cur = it < nd ? dense_item(F, it) : moe_item(F, layer, it - nd);
    f32x4 va[16], vb[16];
    titem_load(cur, va, F.lane);
    for (;;) {
        const int itn = it + NGW; const bool more = itn < total;
        TItem nxt = cur;
        if (more) { nxt = itn < nd ? dense_item(F, itn) : moe_item(F, layer, itn - nd); titem_load(nxt, vb, F.lane); }
        titem_store(cur, va, scr, F.lane);
        if (!more) break;
        const int itn2 = itn + NGW; const bool more2 = itn2 < total;
        if (more2) { cur = itn2 < nd ? dense_item(F, itn2) : moe_item(F, layer, itn2 - nd); titem_load(cur, va, F.lane); }
        titem_store(nxt, vb, scr, F.lane);
        if (!more2) break;
        it = itn2;
    }
}
#ifndef TQ7
#define TQ7 3
#endif
#ifndef TQ8
#define TQ8 3
#endif
constexpr int TAILQ7 = TQ7, TAILQ8 = TQ8;
static_assert(TAILQ7 * NWAVES * 255 <= 8192, "the MoE-up tail may only convert w1 / w3 items");
__device__ __forceinline__ int tail_idle(int nrb, int NT) { const int rem = (nrb * NT) & 255; return rem ? 256 - rem : 0; }
__device__ __forceinline__ int tail_base(int nrb, int which) {
    int n = 0; if (which >= 1) n += tail_idle(nrb, 8) * NWAVES * TAILQ7; if (which >= 2) n += tail_idle(nrb, 4) * NWAVES * TAILQ8; return n < N_MOE_ITEMS ? n : N_MOE_ITEMS; }
__device__ __forceinline__ void tail_convert(Frame& F, const LAS int* rbs, int NT, int which) {
    const int nrb = rbs[16], rem = (nrb * NT) & 255; if (rem == 0 || (int)blockIdx.x < rem) return;
    const int Q = which ? TAILQ8 : TAILQ7, s0 = tail_base(nrb, which) + (((int)blockIdx.x - rem) * NWAVES + F.wave) * Q;
    convert_weights(F, 1, false, true, s0, 1, s0 + Q);
}
__device__ __forceinline__ void adaln_phase(Frame& F) {
    LAS float* cs = (LAS float*)F.lds;
    LAS float* red = (LAS float*)(F.lds + 65536);
    constexpr int NTASK = (2 * 6144 + 2048) / 64;
    if ((int)blockIdx.x >= NTASK) return;
    { const float* cp = F.inp(I_C) + F.tid; float cvv[32];
#pragma unroll
      for (int i = 0; i < 32; ++i) cvv[i] = cp[i * NTHREADS];
#pragma unroll
      for (int i = 0; i < 32; ++i) cs[i * NTHREADS + F.tid] = cvv[i] / (1.0f + __expf(-cvv[i])); }
    __syncthreads();
    for (int task = blockIdx.x; task < NTASK; task += F.G) {
        const int gc = task * 64; const float* W; const float* bias; float* outp; int N, c0, ostride;
        if (gc < 6144) { W = F.inp(I_ADAW); bias = F.inp(I_ADAB); N = 6144; c0 = gc; outp = (float*)(F.ws + WS_MOD); ostride = 6144; }
        else if (gc < 12288) { W = F.inp(I_ADAW) + (size_t)1024 * 6144; bias = F.inp(I_ADAB) + 6144; N = 6144; c0 = gc - 6144; outp = (float*)(F.ws + WS_MOD) + 16 * 6144; ostride = 6144; }
        else { W = F.inp(I_KVADAW); bias = F.inp(I_KVADAB); N = 2048; c0 = gc - 12288; outp = (float*)(F.ws + WS_KVMOD); ostride = 2048; }
        float acc[16];
#pragma unroll
        for (int b = 0; b < 16; ++b) acc[b] = 0.f;
        const int k0 = F.wave * 128;
        {
            const int k = k0; float w[128];
            const GAS float* wp = (const GAS float*)(W + (size_t)k * N + c0 + F.lane);
#pragma unroll
            for (int j = 0; j < 128; ++j) { w[j] = *wp; wp += N; asm volatile("" : "+v"(wp)); }
#pragma unroll
            for (int j4 = 0; j4 < 32; ++j4) { asm volatile("" ::: "memory");
#pragma unroll
                for (int b = 0; b < 16; ++b) { const f32x4 c4 = *(const LAS f32x4*)(cs + b * 1024 + k + 4 * j4); acc[b] += c4[0] * w[4 * j4] + c4[1] * w[4 * j4 + 1] + c4[2] * w[4 * j4 + 2] + c4[3] * w[4 * j4 + 3]; } }
        }
#pragma unroll
        for (int b = 0; b < 16; ++b) red[(F.wave * 16 + b) * 64 + F.lane] = acc[b];
        __syncthreads();
        for (int o = F.tid; o < 1024; o += NTHREADS) { const int b = o >> 6, col = o & 63; float s = 0.f;
#pragma unroll
            for (int w = 0; w < 8; ++w) s += red[(w * 16 + b) * 64 + col];
            outp[(size_t)b * ostride + c0 + col] = s + bias[c0 + col]; }
        __syncthreads();
    }
}
__device__ __forceinline__ void rope_table(Frame& F, int gt, int NGT) {
    float* ct = (float*)(F.ws + WS_COS); float* st = (float*)(F.ws + WS_SIN);
    for (int i = gt; i < 2048 * 128; i += NGT) { const int pos = i >> 7, j = i & 127;
        const float inv = 1.0f / powf(10000.0f, (float)j * (1.0f / 128.0f)); const float ang = (float)pos * inv;
        const float kq = rintf(ang * 0.15915494309189535f); float rr = fmaf(-kq, 6.28318548202514648f, ang); rr = fmaf(-kq, -1.74845553e-07f, rr);
        const float rev = rr * 0.15915494309189535f; ct[i] = __builtin_amdgcn_cosf(rev); st[i] = __builtin_amdgcn_sinf(rev); }
    float* wrt = (float*)(F.ws + WS_WRT);
    for (int i = gt; i < 2 * 20 * 1024; i += NGT) { const int l = i / 20480, r = i % 20480, q = r >> 10, k = r & 1023;
        wrt[i] = q < 4 ? F.inp(I_WG)[(size_t)l * 4096 + k * 4 + q] : F.inp(I_WE)[(size_t)l * 16384 + k * 16 + (q - 4)]; }
}

struct Row16 { f32x4 v[4]; };
__device__ __forceinline__ void row_load(Row16& r, const float* p, int lane) {
#pragma unroll
    for (int j = 0; j < 4; ++j) r.v[j] = __builtin_nontemporal_load(((const f32x4*)p) + 64 * j + lane);
}
__device__ __forceinline__ void row_load_bf16(Row16& r, const bf16_t* p, int lane) {
#pragma unroll
    for (int j = 0; j < 4; ++j) { const u32x2 q = __builtin_nontemporal_load(((const u32x2*)p) + 64 * j + lane); r.v[j] = (f32x4){bf_lo(q.x), bf_hi(q.x), bf_lo(q.y), bf_hi(q.y)}; }
}
__device__ __forceinline__ void row_store_bf16(const Row16& r, bf16_t* p, int lane) {
#pragma unroll
    for (int j = 0; j < 4; ++j) { u32x2 w; w.x = pk2(r.v[j][0], r.v[j][1]); w.y = pk2(r.v[j][2], r.v[j][3]); ((u32x2*)p)[64 * j + lane] = w; }
}
__device__ __forceinline__ float row_sumsq(const Row16& r) { float s = 0.f;
#pragma unroll
    for (int j = 0; j < 4; ++j) s += (r.v[j][0] * r.v[j][0] + r.v[j][1] * r.v[j][1]) + (r.v[j][2] * r.v[j][2] + r.v[j][3] * r.v[j][3]);
    return wave_sum(s); }
__device__ __forceinline__ void row_norm_mod_store(const Row16& r, float rstd, const float* g, const float* shift, const float* scale, bf16_t* outp, int lane) {
#pragma unroll
    for (int j = 0; j < 4; ++j) { const int c = 64 * j + lane; const f32x4 gg = ((const f32x4*)g)[c], sh = ((const f32x4*)shift)[c], sc = ((const f32x4*)scale)[c];
        const f32x4 h = (r.v[j] * rstd * gg) * (sc + 1.0f) + sh; u32x2 w; w.x = pk2(h[0], h[1]); w.y = pk2(h[2], h[3]); ((u32x2*)outp)[c] = w; }
}
struct ModVec { f32x4 A[4], B[4]; };
__device__ __forceinline__ void modvec_load(ModVec& m, const float* g, const float* shift, const float* scale, int lane) {
#pragma unroll
    for (int j = 0; j < 4; ++j) { const int c = 64 * j + lane; m.A[j] = ((const f32x4*)g)[c] * (((const f32x4*)scale)[c] + 1.0f); m.B[j] = ((const f32x4*)shift)[c]; }
}
__device__ __forceinline__ void row_mod_store(const Row16& r, float rstd, const ModVec& m, bf16_t* outp, int lane) {
#pragma unroll
    for (int j = 0; j < 4; ++j) { const f32x4 h = r.v[j] * rstd * m.A[j] + m.B[j]; u32x2 w; w.x = pk2(h[0], h[1]); w.y = pk2(h[2], h[3]); ((u32x2*)outp)[64 * j + lane] = w; }
}
__device__ __forceinline__ void phase_h0(Frame& F) {
    const int gw = F.vcu * NWAVES + F.wave, NGW = F.G * NWAVES; const float* mod = (const float*)(F.ws + WS_MOD); bf16_t* H = (bf16_t*)(F.ws + WS_H);
    for (int t0 = gw * 16; t0 < NTOK; t0 += NGW * 16) { const int b = t0 / SEQ; ModVec m; modvec_load(m, F.inp(I_NMIX), mod + b * 6144, mod + b * 6144 + 1024, F.lane);
#pragma unroll 1
        for (int i = 0; i < 16; i += 4) { Row16 r[4];
#pragma unroll
            for (int u = 0; u < 4; ++u) row_load(r[u], F.inp(I_X) + (size_t)(t0 + i + u) * 1024, F.lane);
#pragma unroll
            for (int u = 0; u < 4; ++u) { const float rstd = __builtin_amdgcn_rsqf(row_sumsq(r[u]) * (1.0f / 1024.0f) + EPS); row_mod_store(r[u], rstd, m, H + (size_t)(t0 + i + u) * 1024, F.lane); } } }
}
__device__ __forceinline__ void phase_gate(Frame& F) {
    const int gw = F.vcu * NWAVES + F.wave, NGW = F.G * NWAVES; bf16_t* O = (bf16_t*)(F.ws + WS_VR); const bf16_t* SG = (const bf16_t*)(F.ws + WS_SG); const float* gn = F.inp(I_RGN);
    for (int t0 = gw; t0 < NTOK; t0 += 2 * NGW) {
        u32x4 o2[2][4], g2[2][4];
#pragma unroll
        for (int u = 0; u < 2; ++u)
#pragma unroll
            for (int j = 0; j < 4; ++j) { const size_t t = t0 + u * NGW; o2[u][j] = __builtin_nontemporal_load(((const u32x4*)(O + t * 2048)) + 64 * j + F.lane); g2[u][j] = __builtin_nontemporal_load(((const u32x4*)(SG + t * 2048)) + 64 * j + F.lane); }
#pragma unroll
        for (int u = 0; u < 2; ++u) { const size_t t = t0 + u * NGW;
#pragma unroll
        for (int j = 0; j < 4; ++j) {
            float ov[8]; float ss = 0.f;
#pragma unroll
            for (int e = 0; e < 4; ++e) { ov[2 * e] = bf_lo(o2[u][j][e]); ov[2 * e + 1] = bf_hi(o2[u][j][e]); ss += ov[2 * e] * ov[2 * e] + ov[2 * e + 1] * ov[2 * e + 1]; }
            const float rstd = __builtin_amdgcn_rsqf(wave_sum(ss) * (1.0f / 512.0f) + EPS);
            const f32x4 g0 = ((const f32x4*)gn)[2 * (64 * j + F.lane)], g1 = ((const f32x4*)gn)[2 * (64 * j + F.lane) + 1];
            u32x4 w;
#pragma unroll
            for (int e = 0; e < 4; ++e) { const float ga = e < 2 ? g0[2 * e] : g1[2 * e - 4], gb = e < 2 ? g0[2 * e + 1] : g1[2 * e - 3];
                w[e] = pk2(bf_lo(g2[u][j][e]) * (ov[2 * e] * rstd * ga), bf_hi(g2[u][j][e]) * (ov[2 * e + 1] * rstd * gb)); }
            ((u32x4*)(O + t * 2048))[64 * j + F.lane] = w;
        } }
    }
}
__device__ __forceinline__ void phase_route(Frame& F, int layer) {
    const int gwl = blockIdx.x * NWAVES + F.wave;
    const float* mod = (const float*)(F.ws + WS_MOD) + (size_t)layer * 16 * 6144; const bf16_t* XB = (const bf16_t*)(F.ws + WS_XB); bf16_t* H = (bf16_t*)(F.ws + WS_H);
    const float* nf = F.inp(I_NFFN) + layer * 1024;
    const float* bg = F.inp(I_BG) + layer * 4; const float* be = F.inp(I_BE) + layer * 16;
    unsigned* gcnt = F.ctl + (layer ? CW_CNT1 : CW_CNT0);
    int* list = (int*)(F.ws + WS_LIST); int* tokslot = (int*)(F.ws + WS_TOKSLOT); float* tokw = (float*)(F.ws + WS_TOKW);
    LAS float* WrT = (LAS float*)(F.lds);
    LAS float* lgs = (LAS float*)(F.lds + 81920) + F.wave * 96;
    LAS int* wcnt = (LAS int*)(F.lds + 81920 + 4096);
    LAS int* wbase = (LAS int*)(F.lds + 81920 + 4096 + 1024);
    { const f32x4* src = (const f32x4*)((const float*)(F.ws + WS_WRT) + (size_t)layer * 20480);
#pragma unroll
      for (int i = 0; i < 10; ++i) ((LAS f32x4*)WrT)[i * NTHREADS + F.tid] = src[i * NTHREADS + F.tid]; }
    __syncthreads();
    const int lane = F.lane; const bool b5 = lane & 32, b4 = lane & 16, b3 = lane & 8;
    const int NGWL = F.G * NWAVES;
    for (int base = 0; base < NTOK; base += NGWL * 16) {
        const int t0 = base + gwl * 16; const bool active = t0 < NTOK;
        int my_e0 = 0, my_e1 = 0; float my_w0 = 0.f, my_w1 = 0.f;
        if (active) {
            const int b = t0 / SEQ; ModVec mv; modvec_load(mv, nf, mod + b * 6144 + 3072, mod + b * 6144 + 4096, lane);
            u32x2 nx[4][4];
#pragma unroll
            for (int i = 0; i < 4; ++i)
#pragma unroll
                for (int j = 0; j < 4; ++j) nx[i][j] = ((const u32x2*)(XB + (size_t)(t0 + i) * 1024))[64 * j + lane];
#pragma unroll 1
            for (int grp = 0; grp < 4; ++grp) {
                const int tg = t0 + 4 * grp;
                Row16 r[4];
#pragma unroll
                for (int i = 0; i < 4; ++i)
#pragma unroll
                    for (int j = 0; j < 4; ++j) { const u32x2 q = nx[i][j]; r[i].v[j] = (f32x4){bf_lo(q.x), bf_hi(q.x), bf_lo(q.y), bf_hi(q.y)}; }
                if (grp < 3) {
#pragma unroll
                    for (int i = 0; i < 4; ++i)
#pragma unroll
                        for (int j = 0; j < 4; ++j) nx[i][j] = ((const u32x2*)(XB + (size_t)(tg + 4 + i) * 1024))[64 * j + lane];
                }
                float rstd[4];
#pragma unroll
                for (int i = 0; i < 4; ++i) rstd[i] = __builtin_amdgcn_rsqf(row_sumsq(r[i]) * (1.0f / 1024.0f) + EPS);
#pragma unroll
                for (int j = 0; j < 4; ++j) {
#pragma unroll
                    for (int i = 0; i < 4; ++i) { const f32x4 h = r[i].v[j] * rstd[i] * mv.A[j] + mv.B[j]; r[i].v[j] = h; u32x2 w; w.x = pk2(h[0], h[1]); w.y = pk2(h[2], h[3]); ((u32x2*)(H + (size_t)(tg + i) * 1024))[64 * j + lane] = w; } }
#pragma unroll
                for (int hq = 0; hq < 2; ++hq) {
                    float V[40];
#pragma unroll
                    for (int q = 0; q < 10; ++q) {
                        float a0 = 0.f, a1 = 0.f, a2 = 0.f, a3 = 0.f;
#pragma unroll
                        for (int j = 0; j < 4; ++j) { const f32x4 w4 = *(const LAS f32x4*)(WrT + (hq * 10 + q) * 1024 + 4 * (64 * j + lane));
                            a0 += r[0].v[j][0] * w4[0] + r[0].v[j][1] * w4[1] + r[0].v[j][2] * w4[2] + r[0].v[j][3] * w4[3];
                            a1 += r[1].v[j][0] * w4[0] + r[1].v[j][1] * w4[1] + r[1].v[j][2] * w4[2] + r[1].v[j][3] * w4[3];
                            a2 += r[2].v[j][0] * w4[0] + r[2].v[j][1] * w4[1] + r[2].v[j][2] * w4[2] + r[2].v[j][3] * w4[3];
                            a3 += r[3].v[j][0] * w4[0] + r[3].v[j][1] * w4[1] + r[3].v[j][2] * w4[2] + r[3].v[j][3] * w4[3]; }
                        V[q] = a0; V[10 + q] = a1; V[20 + q] = a2; V[30 + q] = a3;
                    }
                    float W20[20], W10[10];
#pragma unroll
                    for (int i = 0; i < 20; ++i) W20[i] = swap32_add(V[i], V[i + 20]);
#pragma unroll
                    for (int i = 0; i < 10; ++i) W10[i] = swap16_add(W20[i], W20[i + 10]);
                    const int vb = (b3 ? 5 : 0) + (b4 ? 10 : 0) + (b5 ? 20 : 0);
#pragma unroll
                    for (int i = 0; i < 5; ++i) { const float keep = b3 ? W10[i + 5] : W10[i], send = b3 ? W10[i] : W10[i + 5]; const float v = sum8(keep + dppf<0x128>(send));
                        const int vi = vb + i;
                        if ((lane & 7) == 0) lgs[(vi / 10) * 20 + hq * 10 + (vi % 10)] = v; }
                    asm volatile("" ::: "memory");
                }
                LDS_WAIT(); asm volatile("" ::: "memory");
                if ((lane >> 2) == grp) {
                    const LAS float* lp = lgs + (lane & 3) * 20;
                    float gl[4]; int gi = 0;
#pragma unroll
                    for (int q = 0; q < 4; ++q) gl[q] = lp[q] + bg[q];
                    float gm = gl[0];
#pragma unroll
                    for (int q = 1; q < 4; ++q) if (gl[q] > gm) { gm = gl[q]; gi = q; }
                    float gs = 0.f;
#pragma unroll
                    for (int q = 0; q < 4; ++q) gs += __expf(gl[q] - gm);
                    const float ggate = 1.0f / gs;
                    float el[4];
#pragma unroll
                    for (int q = 0; q < 4; ++q) el[q] = lp[4 + 4 * gi + q] + be[4 * gi + q];
                    int i0 = 0; float m0 = el[0];
#pragma unroll
                    for (int q = 1; q < 4; ++q) if (el[q] > m0) { m0 = el[q]; i0 = q; }
                    int i1 = 0; float m1 = -INFINITY;
#pragma unroll
                    for (int q = 0; q < 4; ++q) if (q != i0 && el[q] > m1) { m1 = el[q]; i1 = q; }
                    const float p1 = __expf(m1 - m0);
                    my_e0 = gi * 4 + i0; my_e1 = gi * 4 + i1; my_w0 = ggate / (1.0f + p1); my_w1 = ggate * p1 / (1.0f + p1);
                }
                LDS_WAIT(); asm volatile("" ::: "memory");
            }
        }
        const bool have = active && lane < 16; int rank0 = 0, rank1 = 0, mycount = 0;
        const unsigned long long lt = (1ull << lane) - 1ull;
#pragma unroll 1
        for (int e = 0; e < 16; ++e) {
            const unsigned long long b0 = __ballot(have && my_e0 == e), b1 = __ballot(have && my_e1 == e);
            if (my_e0 == e) rank0 = __popcll(b0 & lt);
            if (my_e1 == e) rank1 = __popcll(b0) + __popcll(b1 & lt);
            if (lane == e) mycount = __popcll(b0) + __popcll(b1);
        }
        if (lane < 16) wcnt[F.wave * 16 + lane] = mycount;
        __syncthreads();
        if (F.tid < 16) { int tot = 0;
#pragma unroll
            for (int w = 0; w < 8; ++w) { const int c = wcnt[w * 16 + F.tid]; wbase[w * 16 + F.tid] = tot; tot += c; }
            const int gb = tot ? (int)atomicAdd(gcnt + F.tid, (unsigned)tot) : 0;
#pragma unroll
            for (int w = 0; w < 8; ++w) wbase[w * 16 + F.tid] += gb; }
        __syncthreads();
        if (have) { const int t = t0 + lane; const int p0 = wbase[F.wave * 16 + my_e0] + rank0, p1 = wbase[F.wave * 16 + my_e1] + rank1;
            list[my_e0 * 32768 + p0] = t; list[my_e1 * 32768 + p1] = t;
            tokslot[2 * t] = (my_e0 << 16) | p0; tokslot[2 * t + 1] = (my_e1 << 16) | p1; tokw[2 * t] = my_w0; tokw[2 * t + 1] = my_w1; }
        __syncthreads();
    }
}
__device__ __forceinline__ void load_rbs(Frame& F, const unsigned* gcnt, LAS int* rbs, LAS int* cnts) {
    if (F.tid < 64) {
        const int e = F.tid & 15; const int c = (int)__hip_atomic_load(gcnt + e, __ATOMIC_RELAXED, __HIP_MEMORY_SCOPE_AGENT); const int nb = (c + 255) >> 8;
        int acc = 0, tot = 0;
#pragma unroll
        for (int k = 0; k < 16; ++k) { const int v = __builtin_amdgcn_readlane(nb, k); acc += (k < e) ? v : 0; tot += v; }
        if (F.tid < 16) { rbs[e] = acc; if (cnts) cnts[e] = c; if (e == 0) rbs[16] = tot; }
    }
    __syncthreads();
}
__device__ __forceinline__ void moe_tables(Frame& F, int layer, LAS int* rbs, LAS int* rowtab, int NT, bool gather) {
    const unsigned* gcnt = F.ctl + (layer ? CW_CNT1 : CW_CNT0);
    LAS int* cnts = rbs + 32;
    load_rbs(F, gcnt, rbs, cnts);
    if (gather) {
        const int* list = (const int*)(F.ws + WS_LIST); const int nrb = rbs[16], nwg = nrb * NT;
        int vals[8]; bool ok[8];
#pragma unroll
        for (int p = 0; p < 8; ++p) { const int i = 2 * p + (F.tid >> 8); const long L = (long)i * F.G + blockIdx.x; ok[p] = L < nwg; vals[p] = 0;
            if (ok[p]) { const int wg = pg8::xcd_remap((int)L, nwg), rb = wg / NT; int e = 0;
#pragma unroll
                for (int k = 1; k < 16; ++k) e += (rb >= rbs[k]) ? 1 : 0;
                const int lr0 = (rb - rbs[e]) * 256, cnt = cnts[e]; int r = lr0 + (F.tid & 255); r = r < cnt ? r : cnt - 1; vals[p] = list[e * 32768 + r]; } }
#pragma unroll
        for (int p = 0; p < 8; ++p) if (ok[p]) rowtab[(2 * p + (F.tid >> 8)) * 256 + (F.tid & 255)] = vals[p];
        __syncthreads();
    }
}
struct CombRow { Row16 x; u32x2 y0[4], y1[4]; float w0, w1; };
struct CombSlots { int r0, r1; float w0, w1; };
__device__ __forceinline__ void comb_slots(Frame& F, int t0, const LAS int* rbs, CombSlots& s) {
    const int* tokslot = (const int*)(F.ws + WS_TOKSLOT); const float* tokw = (const float*)(F.ws + WS_TOKW);
    const int i = F.lane & 15; const int s0 = tokslot[2 * (t0 + i)], s1 = tokslot[2 * (t0 + i) + 1]; s.w0 = tokw[2 * (t0 + i)]; s.w1 = tokw[2 * (t0 + i) + 1];
    s.r0 = rbs[s0 >> 16] * 256 + (s0 & 0xffff); s.r1 = rbs[s1 >> 16] * 256 + (s1 & 0xffff);
}
__device__ __forceinline__ void comb_issue(Frame& F, int t, int i, const CombSlots& s, CombRow& c) {
    const bf16_t* XB = (const bf16_t*)(F.ws + WS_XB); const bf16_t* YB = (const bf16_t*)(F.ws + WS_YB);
    row_load_bf16(c.x, XB + (size_t)t * 1024, F.lane);
    const int r0 = __builtin_amdgcn_readlane(s.r0, i), r1 = __builtin_amdgcn_readlane(s.r1, i);
    c.w0 = __builtin_bit_cast(float, __builtin_amdgcn_readlane(__builtin_bit_cast(int, s.w0), i)); c.w1 = __builtin_bit_cast(float, __builtin_amdgcn_readlane(__builtin_bit_cast(int, s.w1), i));
    const u32x2* y0 = (const u32x2*)(YB + (size_t)r0 * 1024); const u32x2* y1 = (const u32x2*)(YB + (size_t)r1 * 1024);
#pragma unroll
    for (int j = 0; j < 4; ++j) { c.y0[j] = __builtin_nontemporal_load(y0 + 64 * j + F.lane); c.y1[j] = __builtin_nontemporal_load(y1 + 64 * j + F.lane); }
}
__device__ __forceinline__ void comb_finish(const f32x4 (&g2)[4], CombRow& c) {
#pragma unroll
    for (int j = 0; j < 4; ++j) { const u32x2 a = c.y0[j], b = c.y1[j]; const float w0 = c.w0, w1 = c.w1;
        f32x4 m; m[0] = w0 * bf_lo(a.x) + w1 * bf_lo(b.x); m[1] = w0 * bf_hi(a.x) + w1 * bf_hi(b.x); m[2] = w0 * bf_lo(a.y) + w1 * bf_lo(b.y); m[3] = w0 * bf_hi(a.y) + w1 * bf_hi(b.y);
        c.x.v[j] = c.x.v[j] + g2[j] * m; }
}
__device__ __forceinline__ void rbs_only(Frame& F, int layer, LAS int* rbs) {
    const unsigned* gcnt = F.ctl + (layer ? CW_CNT1 : CW_CNT0);
    load_rbs(F, gcnt, rbs, (LAS int*)nullptr);
}
__device__ __forceinline__ void phase_mid(Frame& F, LAS int* rbs) {
    const int gw = F.vcu * NWAVES + F.wave, NGW = F.G * NWAVES; bf16_t* XB = (bf16_t*)(F.ws + WS_XB); bf16_t* HQ = (bf16_t*)(F.ws + WS_H); bf16_t* HKV = (bf16_t*)(F.ws + WS_HKV);
    const float* mod1 = (const float*)(F.ws + WS_MOD) + 16 * 6144; const float* kvmod = (const float*)(F.ws + WS_KVMOD);
    rbs_only(F, 0, rbs);
    const int cbase = tail_base(rbs[16], 2);
    for (int t0 = gw * 16; t0 < NTOK; t0 += NGW * 16) { const int b = t0 / SEQ;
        CombSlots sl; comb_slots(F, t0, rbs, sl);
        ModVec mq, mk; modvec_load(mq, F.inp(I_NMIX) + 1024, mod1 + b * 6144, mod1 + b * 6144 + 1024, F.lane); modvec_load(mk, F.inp(I_KVNORM), kvmod + b * 2048, kvmod + b * 2048 + 1024, F.lane);
        f32x4 g2[4];
#pragma unroll
        for (int j = 0; j < 4; ++j) g2[j] = ((const f32x4*)((const float*)(F.ws + WS_MOD) + (size_t)b * 6144 + 5120))[64 * j + F.lane];
#pragma unroll 1
        for (int i = 0; i < 16; ++i) { CombRow c;
            const int cit = cbase + gw + (i >> 1) * NGW; const bool conv = cit < N_MOE_ITEMS; TItem ti; f32x4 tv[8];
            if (conv) { ti = moe_item(F, 1, cit); thalf_load(ti, i & 1, tv, F.lane); }
            comb_issue(F, t0 + i, i, sl, c);
            { const int tt = t0 + i; comb_finish(g2, c); Row16& r = c.x;
                row_store_bf16(r, XB + (size_t)tt * 1024, F.lane);
                const float rstd = __builtin_amdgcn_rsqf(row_sumsq(r) * (1.0f / 1024.0f) + EPS);
                row_mod_store(r, rstd, mq, HQ + (size_t)tt * 1024, F.lane); row_mod_store(r, rstd, mk, HKV + (size_t)tt * 1024, F.lane); }
            if (conv) thalf_store(ti, i & 1, tv, (LAS float*)(F.lds + F.wave * 17408), F.lane);
        } }
}
__device__ __forceinline__ void phase_final(Frame& F, LAS int* rbs) {
    const int gw = F.vcu * NWAVES + F.wave, NGW = F.G * NWAVES;
    rbs_only(F, 1, rbs);
    for (int t0 = gw * 16; t0 < NTOK; t0 += NGW * 16) { const int b = t0 / SEQ;
        CombSlots sl; comb_slots(F, t0, rbs, sl);
        f32x4 g2[4];
#pragma unroll
        for (int j = 0; j < 4; ++j) g2[j] = ((const f32x4*)((const float*)(F.ws + WS_MOD) + (size_t)(16 + b) * 6144 + 5120))[64 * j + F.lane];
#pragma unroll 1
        for (int i = 0; i < 16; i += 4) { CombRow c[4];
#pragma unroll
            for (int u = 0; u < 4; ++u) comb_issue(F, t0 + i + u, i + u, sl, c[u]);
#pragma unroll
            for (int u = 0; u < 4; ++u) { const int tt = t0 + i + u; comb_finish(g2, c[u]);
#pragma unroll
                for (int j = 0; j < 4; ++j) ((f32x4*)(F.out + (size_t)tt * 1024))[64 * j + F.lane] = c[u].x.v[j]; } } }
}
__device__ __forceinline__ s16x4 tr_read(const LAS void* p) {
    typedef short v4s __attribute__((ext_vector_type(4)));
    return __builtin_bit_cast(s16x4, __builtin_amdgcn_ds_read_tr16_b64_v4i16((LAS v4s*)p));
}
__device__ __forceinline__ bf16x8 cat8(s16x4 a, s16x4 b) { return (bf16x8){a[0], a[1], a[2], a[3], b[0], b[1], b[2], b[3]}; }

constexpr int RQ_STRIDE = 528, RV_STRIDE = 272, RS_STRIDE = 144;
constexpr int R_QS = 0, R_KS = 64 * RQ_STRIDE, R_VS = 2 * 64 * RQ_STRIDE, R_SS = R_VS + 64 * RV_STRIDE, R_CV = R_SS + 64 * RS_STRIDE, R_OS = R_CV + 2 * 16384, R_END = R_OS + 64 * RV_STRIDE;
static_assert(R_CV % 16 == 0 && R_OS % 16 == 0 && R_CV + 2 * 16384 <= 131072 && R_END <= ROWTAB_OFF + ROWTAB_BYTES, "retention LDS");

__device__ __forceinline__ void bg_load(Frame& F, int pair, u32x4 (&cv)[4]) {
#pragma unroll
    for (int bsel = 0; bsel < 2; ++bsel) { const TItem it = moe_item(F, 0, (2 * pair + bsel) * F.G + (int)blockIdx.x);
        const int kb = it.item >> 4, nb = it.item & 15, k0 = 64 * kb, n0 = 64 * nb;
#pragma unroll
        for (int i = 0; i < 2; ++i) cv[2 * bsel + i] = *(const u32x4*)((const char*)(it.W + (size_t)(k0 + 32 * i) * 1024 + n0) + (unsigned)((F.tid >> 4) * 4096 + (F.tid & 15) * 16)); }
}
__device__ __forceinline__ void bg_stage(Frame& F, const u32x4 (&cv)[4]) {
#pragma unroll
    for (int bsel = 0; bsel < 2; ++bsel)
#pragma unroll
        for (int i = 0; i < 2; ++i) *(LAS u32x4*)(F.lds + R_CV + bsel * 16384 + (i * 512 + F.tid) * 16) = cv[2 * bsel + i];
}
__device__ __forceinline__ void bg_convert(Frame& F, int pair) {
    if (F.wave < 2) return;
    const int bsel = F.wave >= 5 ? 1 : 0, wi = F.wave - 2 - 3 * bsel, c0 = 3 * wi, cnt = wi < 2 ? 3 : 2;
    const TItem it = moe_item(F, 0, (2 * pair + bsel) * F.G + (int)blockIdx.x);
    const int kb = it.item >> 4, nb = it.item & 15, k0 = 64 * kb, n0 = 64 * nb;
    const int d = dest_row(n0 + (F.lane & 32), it.mode) + (F.lane & 31);
    bf16_t* op = it.WT + (size_t)d * it.K + k0;
    const LAS float* tile = (const LAS float*)(F.lds + R_CV + bsel * 16384) + F.lane;
    float tv[3][8];
#pragma unroll
    for (int i = 0; i < 3; ++i) { if (i < cnt) { const LAS float* s = tile + (8 * (c0 + i)) * 64;
#pragma unroll
        for (int e = 0; e < 8; ++e) tv[i][e] = s[e * 64]; } }
#pragma unroll
    for (int i = 0; i < 3; ++i) { if (i < cnt) { const int c = c0 + i;
        u32x4 o; o.x = pk2(tv[i][0], tv[i][1]); o.y = pk2(tv[i][2], tv[i][3]); o.z = pk2(tv[i][4], tv[i][5]); o.w = pk2(tv[i][6], tv[i][7]);
        *(u32x4*)(op + 8 * c) = o; } }
}

__device__ __forceinline__ void phase_retention(Frame& F) {
    LAS unsigned char* lds = F.lds;
    const int tid = F.tid, lane = F.lane, w = F.wave, g = lane >> 4, l15 = lane & 15, tq = (lane >> 2) & 3, tp = lane & 3;
    const bf16_t* QR = (const bf16_t*)(F.ws + WS_QR); const bf16_t* KR = (const bf16_t*)(F.ws + WS_KR); bf16_t* VR = (bf16_t*)(F.ws + WS_VR);
    const unsigned qaddr = (unsigned)(uintptr_t)(lds + R_QS + l15 * RQ_STRIDE + g * 8), kaddr = (unsigned)(uintptr_t)(lds + R_KS + (8 * g + tq) * RQ_STRIDE + 4 * tp * 2);
    for (int i = tid; i < 64 * RS_STRIDE / 4; i += NTHREADS) ((LAS unsigned*)(lds + R_SS))[i] = 0u;
    for (int unit = F.vcu; unit < 256; unit += F.G) {
        const int b = unit >> 4, h = (unit >> 2) & 3, s = unit & 3;
        const float lgam = __builtin_log2f(1.0f - __builtin_exp2f(-5.0f - (float)h)); const float cdec = __builtin_exp2f(64.0f * lgam);
        const size_t tok0 = (size_t)b * SEQ;
        const bf16_t* qg = QR + tok0 * 1024 + h * 256; const bf16_t* kg = KR + tok0 * 1024 + h * 256; bf16_t* vg = VR + tok0 * 2048 + h * 512 + s * 128;
        f32x4 St[16];
#pragma unroll
        for (int t = 0; t < 16; ++t) St[t] = (f32x4){0.f, 0.f, 0.f, 0.f};
        u32x4 pq[4], pk[4], pv[2], cv[4];
        const unsigned qko = (unsigned)((tid >> 5) * 2048 + (tid & 31) * 16), vo = (unsigned)((tid >> 4) * 4096 + (tid & 15) * 16);
#define RET_PREFETCH(ci) do { const char* _q = (const char*)qg + (size_t)(ci) * 131072; const char* _k = (const char*)kg + (size_t)(ci) * 131072; const char* _v = (const char*)vg + (size_t)(ci) * 262144; \
            _Pragma("unroll") for (int i = 0; i < 4; ++i) { pq[i] = *(const u32x4*)(_q + i * 32768 + qko); pk[i] = *(const u32x4*)(_k + i * 32768 + qko); } \
            _Pragma("unroll") for (int i = 0; i < 2; ++i) pv[i] = *(const u32x4*)(_v + i * 131072 + vo); } while (0)
        RET_PREFETCH(0);
#ifdef RET_PROBE
        unsigned long long rp_acc = 0, rp_prev = __builtin_amdgcn_s_memrealtime();
#define RS(k) do { const unsigned long long _n = __builtin_amdgcn_s_memrealtime(); if (RET_PROBE == (k)) rp_acc += _n - rp_prev; rp_prev = _n; } while (0)
#else
#define RS(k) do {} while (0)
#endif
        for (int ci = 0; ci < 32; ++ci) {
            RS(0);
#pragma unroll
            for (int i = 0; i < 4; ++i) { const int id = i * 512 + tid, row = id >> 5, c16 = id & 31;
                *(LAS u32x4*)(lds + R_QS + row * RQ_STRIDE + c16 * 16) = pq[i]; *(LAS u32x4*)(lds + R_KS + row * RQ_STRIDE + c16 * 16) = pk[i]; }
#pragma unroll
            for (int i = 0; i < 2; ++i) { const int id = i * 512 + tid, row = id >> 4, c16 = id & 15; *(LAS u32x4*)(lds + R_VS + row * RV_STRIDE + c16 * 16) = pv[i]; }
            if (ci >= 1 && ci <= 24) bg_stage(F, cv);
            RS(1); __syncthreads(); RS(2);
            if (ci >= 1) {
#pragma unroll
                for (int i = 0; i < 2; ++i) { const int id = i * 512 + tid, row = id >> 4, c16 = id & 15;
                    *(u32x4*)((char*)vg + (size_t)(ci - 1) * 262144 + i * 131072 + vo) = *(const LAS u32x4*)(lds + R_OS + row * RV_STRIDE + c16 * 16); } }
            if (ci + 1 < 32) RET_PREFETCH(ci + 1);
            if (ci < 24) bg_load(F, ci, cv);
            if (ci >= 1 && ci <= 24) bg_convert(F, ci - 1);
#pragma unroll
            for (int rep = 0; rep < 2; ++rep) {
                const int idx = w + 8 * rep;
                if (idx < 10) {
                    const int mt = idx < 4 ? 0 : idx < 7 ? 1 : idx < 9 ? 2 : 3, nt_ = idx < 4 ? idx : idx < 7 ? idx - 3 : idx < 9 ? idx - 5 : 3;
                    f32x4 sacc = (f32x4){0.f, 0.f, 0.f, 0.f};
                    const LAS unsigned char* ka = lds + R_KS + (mt * 16 + l15) * RQ_STRIDE + g * 16; const LAS unsigned char* qb = lds + R_QS + (nt_ * 16 + l15) * RQ_STRIDE + g * 16;
#pragma unroll
                    for (int hb = 0; hb < 2; ++hb) { bf16x8 fa[4], fb[4];
#pragma unroll
                        for (int kk = 0; kk < 4; ++kk) { fa[kk] = *(const LAS bf16x8*)(ka + (4 * hb + kk) * 64); fb[kk] = *(const LAS bf16x8*)(qb + (4 * hb + kk) * 64); }
                        __builtin_amdgcn_sched_barrier(0);
#pragma unroll
                        for (int kk = 0; kk < 4; ++kk) sacc = __builtin_amdgcn_mfma_f32_16x16x32_bf16(fa[kk], fb[kk], sacc, 0, 0, 0);
                        __builtin_amdgcn_sched_barrier(0); }
                    const int n = nt_ * 16 + l15, m0 = mt * 16 + 4 * g;
#pragma unroll
                    for (int r = 0; r < 4; ++r) if (n < m0 + r) sacc[r] = 0.f;
                    u32x2 pw; pw.x = pk2(sacc[0], sacc[1]); pw.y = pk2(sacc[2], sacc[3]);
                    *(LAS u32x2*)(lds + R_SS + n * RS_STRIDE + m0 * 2) = pw;
                }
            }
            bf16x8 vf[2];
#pragma unroll
            for (int kk = 0; kk < 2; ++kk) { const LAS unsigned char* vp = lds + R_VS + (32 * kk + 8 * g + tq) * RV_STRIDE + (16 * w + 4 * tp) * 2;
                vf[kk] = cat8(tr_read(vp), tr_read(vp + 4 * RV_STRIDE)); }
#define RET_PACKST(kk) ({ u32x4 _x; _x.x = pk2(St[2 * (kk)][0], St[2 * (kk)][1]); _x.y = pk2(St[2 * (kk)][2], St[2 * (kk)][3]); _x.z = pk2(St[2 * (kk) + 1][0], St[2 * (kk) + 1][1]); _x.w = pk2(St[2 * (kk) + 1][2], St[2 * (kk) + 1][3]); __builtin_bit_cast(bf16x8, _x); })
            f32x4 o[4];
#pragma unroll
            for (int nt_ = 0; nt_ < 4; ++nt_) o[nt_] = (f32x4){0.f, 0.f, 0.f, 0.f};
            __builtin_amdgcn_sched_barrier(0);
            {
                s16x4 rlo[4], rhi[4];
#define RET_LD(k, gi) do { if ((gi) < 32) asm volatile("ds_read_b64 %0, %2 offset:%3\n\tds_read_b64 %1, %2 offset:%4" : "=&v"(rlo[k]), "=&v"(rhi[k]) : "v"(qaddr), "i"(((gi) & 3) * 16 * RQ_STRIDE + ((gi) >> 2) * 64), "i"(((gi) & 3) * 16 * RQ_STRIDE + ((gi) >> 2) * 64 + 32) : "memory"); \
                else asm volatile("ds_read_b64_tr_b16 %0, %2 offset:%3\n\tds_read_b64_tr_b16 %1, %2 offset:%4" : "=&v"(rlo[k]), "=&v"(rhi[k]) : "v"(kaddr), "i"(((gi) & 1) * 32 * RQ_STRIDE + (((gi) - 32) >> 1) * 32), "i"(((gi) & 1) * 32 * RQ_STRIDE + (((gi) - 32) >> 1) * 32 + 4 * RQ_STRIDE) : "memory"); } while (0)
#define RET_WAIT(k, n) asm volatile("s_waitcnt lgkmcnt(%2)" : "+v"(rlo[k]), "+v"(rhi[k]) : "n"(n) : "memory")
                RET_LD(0, 0); RET_LD(1, 1); RET_LD(2, 2);
                bf16x8 sbc = RET_PACKST(0), sbn = RET_PACKST(1);
#pragma unroll
                for (int gi = 0; gi < 64; ++gi) {
                    if (gi + 3 < 64) RET_LD((gi + 3) & 3, gi + 3);
                    RET_WAIT(gi & 3, (63 - gi) < 3 ? 2 * (63 - gi) : 6);
                    const bf16x8 af = cat8(rlo[gi & 3], rhi[gi & 3]);
                    if (gi < 32) { o[gi & 3] = __builtin_amdgcn_mfma_f32_16x16x32_bf16(af, sbc, o[gi & 3], 0, 0, 0);
                        if ((gi & 3) == 3) { sbc = sbn; if ((gi >> 2) + 2 < 8) sbn = RET_PACKST((gi >> 2) + 2); } }
                    else { const int t = (gi - 32) >> 1; St[t] = __builtin_amdgcn_mfma_f32_16x16x32_bf16(af, vf[gi & 1], St[t], 0, 0, 0);
                        if ((gi & 1) && t >= 1) St[t - 1] = St[t - 1] * cdec; }
                    __builtin_amdgcn_sched_barrier(0);
                }
                St[15] = St[15] * cdec;
#undef RET_LD
#undef RET_WAIT
            }
            RS(3); __syncthreads(); RS(4);
            {
#pragma unroll
                for (int nt_ = 0; nt_ < 4; ++nt_) {
                    const LAS unsigned char* sp = lds + R_SS + (nt_ * 16 + l15) * RS_STRIDE + g * 16;
#pragma unroll
                    for (int kk = 0; kk < 2; ++kk) { if (kk * 32 < (nt_ + 1) * 16) { const bf16x8 a = *(const LAS bf16x8*)(sp + kk * 64); o[nt_] = __builtin_amdgcn_mfma_f32_16x16x32_bf16(a, vf[kk], o[nt_], 0, 0, 0); } }
                }
#undef RET_PACKST
            }
#pragma unroll
            for (int nt_ = 0; nt_ < 4; ++nt_)
#pragma unroll
                for (int r = 0; r < 4; ++r) *(LAS bf16_t*)(lds + R_OS + (nt_ * 16 + 4 * g + r) * RV_STRIDE + (16 * w + l15) * 2) = (bf16_t)f2bf(o[nt_][r]);
            RS(5); __syncthreads(); RS(6);
        }
#ifdef RET_PROBE
        if (blockIdx.x == 0 && tid == RET_PROBE_WAVE * 64) __hip_atomic_store((unsigned long long*)(F.ctl + 8400), rp_acc, __ATOMIC_RELAXED, __HIP_MEMORY_SCOPE_AGENT);
#endif
#undef RET_PREFETCH
#pragma unroll
        for (int i = 0; i < 2; ++i) { const int id = i * 512 + tid, row = id >> 4, c16 = id & 15;
            *(u32x4*)((char*)vg + (size_t)31 * 262144 + i * 131072 + vo) = *(const LAS u32x4*)(lds + R_OS + row * RV_STRIDE + c16 * 16); }
        __syncthreads();
    }
}

constexpr int A_SLOT = 16384, A_K0 = 0, A_V0 = 3 * A_SLOT, A_LS = 6 * A_SLOT, A_X = 0, A_OST = A_LS + 8 * 64 * 4, A_OSTRIDE = 272, A_END = A_OST + 4 * 32 * A_OSTRIDE;
static_assert(A_END <= ROWTAB_OFF + ROWTAB_BYTES && 4 * 16384 <= A_LS, "attention LDS");
__device__ __forceinline__ int crow(int r, int hi) { return (r & 3) + 8 * (r >> 2) + 4 * hi; }
#define ATT_SB() __builtin_amdgcn_sched_barrier(0)

template <bool SHIFT>
__device__ __forceinline__ void phase_attention_impl(Frame& F, const float M2) {
    LAS unsigned char* lds = F.lds;
    const int tid = F.tid, lane = F.lane, w = F.wave, r32 = lane & 31, hi = lane >> 5, tq = (lane >> 2) & 3, tp = lane & 3, ch = (lane >> 4) & 1, t = w >> 2, wq = w & 3;
    const bf16_t* Q1 = (const bf16_t*)(F.ws + WS_Q1); const bf16_t* K1 = (const bf16_t*)(F.ws + WS_K1); const bf16_t* V1 = (const bf16_t*)(F.ws + WS_V1); bf16_t* AO = (bf16_t*)(F.ws + WS_AO);
    const float* lam = F.inp(I_LAM);
    const float l01 = wave_sum(lam[lane] * lam[64 + lane]), l23 = wave_sum(lam[128 + lane] * lam[192 + lane]);
    const float lambda_init = 0.8f - 0.6f * 0.7408182206817179f;
    const float lam_full = __expf(l01) - __expf(l23) + lambda_init;
    LAS float* wsf = (LAS float*)(lds + A_LS) + w * 64;
    unsigned dsrc[2];
#pragma unroll
    for (int i = 0; i < 2; ++i) { const int row = 4 * (2 * w + i) + (lane >> 4), fr = ((row & 3) << 2) | ((row >> 2) & 3); dsrc[i] = (unsigned)(row * 2048 + (((lane & 15) ^ fr) << 4)); }
    const unsigned ddst = (unsigned)(w * 2048);
    const int frk = ((r32 & 3) << 2) | ((r32 >> 2) & 3);
    int koff[4];
#pragma unroll
    for (int ks = 0; ks < 4; ++ks) koff[ks] = r32 * 256 + (((8 * t + 2 * ks + hi) ^ frk) << 4);
    unsigned vofA[4], vofB[4];
#pragma unroll
    for (int d = 0; d < 4; ++d) { const int c = 4 * d + 2 * ch + (tp >> 1);
        vofA[d] = (unsigned)((4 * hi + tq) * 256 + ((c ^ ((tq << 2) | (hi & 3))) << 4) + 8 * (tp & 1));
        vofB[d] = (unsigned)((4 * hi + tq + 8) * 256 + ((c ^ ((tq << 2) | ((hi + 2) & 3))) << 4) + 8 * (tp & 1)); }
    const unsigned ldsb = (unsigned)(uintptr_t)lds;
#ifdef ATT_PROBE
    unsigned long long att_tw = 0;
#endif
#define ATT_UNIT(n, b_, h_, u_) const int _v##b_ = F.vcu + ((n) >> 3) * F.G, _bh##b_ = _v##b_ >> 1, b_ = _bh##b_ >> 3, h_ = _bh##b_ & 7, _pr##b_ = 2 * (((n) & 7) >> 1) + (_v##b_ & 1), u_ = ((n) & 1) ? 15 - _pr##b_ : _pr##b_
#define ATT_DMA(gbase, tile, NTu, slotbase) do { const int _tl = (tile) < (NTu) ? (tile) : (NTu) - 1; const char* _g = (gbase) + (size_t)_tl * 131072; const unsigned _s = (slotbase) + (unsigned)(((tile) % 3) * A_SLOT) + ddst; \
            __builtin_amdgcn_global_load_lds((const GAS unsigned*)(_g + dsrc[0]), (LAS unsigned*)(lds + _s), 16, 0, 0); \
            __builtin_amdgcn_global_load_lds((const GAS unsigned*)(_g + dsrc[1]), (LAS unsigned*)(lds + _s + 1024), 16, 0, 0); } while (0)
#define ATT_PROLOGUE_DMA(kgx, vgx, NTx) do { ATT_DMA(kgx, 0, NTx, A_K0); ATT_DMA(vgx, 0, NTx, A_V0); ATT_DMA(kgx, 1, NTx, A_K0); ATT_DMA(kgx, 2, NTx, A_K0); ATT_DMA(vgx, 1, NTx, A_V0); } while (0)
#define ATT_WAITBAR(n) asm volatile("s_waitcnt vmcnt(" #n ") lgkmcnt(0)\n\ts_barrier" ::: "memory")
    const int NU = 8 * ((256 - F.vcu + F.G - 1) / F.G);
    if (NU > 0) { ATT_UNIT(0, b0_, h0_, u0_); ATT_PROLOGUE_DMA((const char*)(K1 + (size_t)b0_ * SEQ * 1024 + h0_ * 128), (const char*)(V1 + (size_t)b0_ * SEQ * 1024 + h0_ * 128), 2 * u0_ + 2); }
    {
        for (int n = 0; n < NU; ++n) {
            ATT_UNIT(n, b, h, u);
            const size_t tok0 = (size_t)b * SEQ; const int q0 = u * 128 + wq * 32;
            const int NT = 2 * u + 2, jmax = 2 * u + (wq >> 1);
            const char* kg = (const char*)(K1 + tok0 * 1024 + h * 128); const char* vg = (const char*)(V1 + tok0 * 1024 + h * 128);
            bf16x8 qf[4];
#pragma unroll
            for (int ks = 0; ks < 4; ++ks) qf[ks] = *(const bf16x8*)((const char*)(Q1 + (tok0 + q0) * 1024 + h * 128 + t * 64) + (unsigned)(r32 * 2048 + hi * 16 + ks * 32));
            f32x16 O[4];
#pragma unroll
            for (int d = 0; d < 4; ++d) O[d] = f32x16{};
            float lsum = 0.f;
#define ATT_QK(S0, S1, kslot) do { const f32x16 _z = f32x16{}; bf16x8 _a0[2], _a1[2]; const LAS unsigned char* _kb = lds + A_K0 + (kslot) * A_SLOT; \
            _Pragma("unroll") for (int ks = 0; ks < 2; ++ks) { _a0[ks] = *(const LAS bf16x8*)(_kb + koff[ks]); _a1[ks] = *(const LAS bf16x8*)(_kb + koff[ks] + 32 * 256); } \
            S0 = __builtin_amdgcn_mfma_f32_32x32x16_bf16(_a0[0], qf[0], _z, 0, 0, 0); S1 = __builtin_amdgcn_mfma_f32_32x32x16_bf16(_a1[0], qf[0], _z, 0, 0, 0); \
            S0 = __builtin_amdgcn_mfma_f32_32x32x16_bf16(_a0[1], qf[1], S0, 0, 0, 0); S1 = __builtin_amdgcn_mfma_f32_32x32x16_bf16(_a1[1], qf[1], S1, 0, 0, 0); ATT_SB(); \
            _Pragma("unroll") for (int ks = 0; ks < 2; ++ks) { _a0[ks] = *(const LAS bf16x8*)(_kb + koff[ks + 2]); _a1[ks] = *(const LAS bf16x8*)(_kb + koff[ks + 2] + 32 * 256); } \
            S0 = __builtin_amdgcn_mfma_f32_32x32x16_bf16(_a0[0], qf[2], S0, 0, 0, 0); S1 = __builtin_amdgcn_mfma_f32_32x32x16_bf16(_a1[0], qf[2], S1, 0, 0, 0); \
            S0 = __builtin_amdgcn_mfma_f32_32x32x16_bf16(_a0[1], qf[3], S0, 0, 0, 0); S1 = __builtin_amdgcn_mfma_f32_32x32x16_bf16(_a1[1], qf[3], S1, 0, 0, 0); } while (0)
#define ATT_EXP4(S0, S1, PFN, e) do { float x0, x1, x2, x3; \
            if ((e) < 4) { x0 = S0[4 * (e)]; x1 = S0[4 * (e) + 1]; x2 = S0[4 * (e) + 2]; x3 = S0[4 * (e) + 3]; } else { x0 = S1[4 * ((e) - 4)]; x1 = S1[4 * ((e) - 4) + 1]; x2 = S1[4 * ((e) - 4) + 2]; x3 = S1[4 * ((e) - 4) + 3]; } \
            if (SHIFT) { x0 -= M2; x1 -= M2; x2 -= M2; x3 -= M2; } \
            x0 = __builtin_amdgcn_exp2f(x0); x1 = __builtin_amdgcn_exp2f(x1); x2 = __builtin_amdgcn_exp2f(x2); x3 = __builtin_amdgcn_exp2f(x3); lsum += (x0 + x1) + (x2 + x3); \
            PFN[(e) >> 1][((e) & 1) * 2] = pk2(x0, x1); PFN[(e) >> 1][((e) & 1) * 2 + 1] = pk2(x2, x3); } while (0)
#define ATT_VLD(k, i) asm volatile("ds_read_b64_tr_b16 %0, %2 offset:%4\n\tds_read_b64_tr_b16 %1, %3 offset:%4" : "=&v"(vlo[k]), "=&v"(vhi[k]) : "v"(va[(i) & 3]), "v"(vb[(i) & 3]), "i"(((i) >> 2) * 4096) : "memory")
#define ATT_VWAIT(k, n) asm volatile("s_waitcnt lgkmcnt(" #n ")" : "+v"(vlo[k]), "+v"(vhi[k]) :: "memory")
#define ATT_MM(PF, k, i) do { O[(i) & 3] = __builtin_amdgcn_mfma_f32_32x32x16_bf16(__builtin_bit_cast(bf16x8, PF[(i) >> 2]), cat8(vlo[k], vhi[k]), O[(i) & 3], 0, 0, 0); } while (0)
#define ATT_SLOT(PF, i) do { if ((i) + 3 < 16) ATT_VLD(((i) + 3) & 3, (i) + 3); \
            if ((i) < 13) ATT_VWAIT((i) & 3, 6); else if ((i) == 13) ATT_VWAIT((i) & 3, 4); else if ((i) == 14) ATT_VWAIT((i) & 3, 2); else ATT_VWAIT((i) & 3, 0); \
            ATT_MM(PF, (i) & 3, i); } while (0)
            ATT_WAITBAR(4);
            u32x4 pf[4];
            { f32x16 s0, s1; ATT_QK(s0, s1, 0);
#pragma unroll
              for (int e = 0; e < 8; ++e) ATT_EXP4(s0, s1, pf, e); }
            ATT_WAITBAR(4);
            int ks1 = 1, vs0 = 0;
#if defined(ATT_PROBE) && defined(ATT_PROBE_LOOP)
            const unsigned long long _tl0 = __builtin_amdgcn_s_memrealtime();
#endif
            for (int j = 0; j < NT; ++j) {
                ATT_DMA(kg, j + 3, NT, A_K0); ATT_DMA(vg, j + 2, NT, A_V0);
                unsigned va[4], vb[4];
#pragma unroll
                for (int d = 0; d < 4; ++d) { va[d] = ldsb + (unsigned)(A_V0 + vs0 * A_SLOT) + vofA[d]; vb[d] = ldsb + (unsigned)(A_V0 + vs0 * A_SLOT) + vofB[d]; }
                if (j + 1 <= jmax) {
                    f32x16 s0, s1; u32x4 pfn[4];
                    s16x4 vlo[4], vhi[4];
                    ATT_VLD(0, 0); ATT_VLD(1, 1); ATT_VLD(2, 2);
                    ATT_QK(s0, s1, ks1); ATT_SB();
#pragma unroll
                    for (int i = 0; i < 8; ++i) { ATT_SLOT(pf, i); ATT_SB(); }
#pragma unroll
                    for (int i = 8; i < 16; ++i) { ATT_SLOT(pf, i); ATT_EXP4(s0, s1, pfn, i - 8); ATT_SB(); }
#pragma unroll
                    for (int s = 0; s < 4; ++s) pf[s] = pfn[s];
                } else if (j <= jmax) {
                    s16x4 vlo[4], vhi[4];
                    ATT_VLD(0, 0); ATT_VLD(1, 1); ATT_VLD(2, 2);
#pragma unroll
                    for (int i = 0; i < 16; ++i) { ATT_SLOT(pf, i); ATT_SB(); }
                }
                ks1 = ks1 == 2 ? 0 : ks1 + 1; vs0 = vs0 == 2 ? 0 : vs0 + 1;
#if defined(ATT_PROBE) && !defined(ATT_PROBE_LOOP)
                { const unsigned long long _t0 = __builtin_amdgcn_s_memrealtime(); ATT_WAITBAR(4); att_tw += __builtin_amdgcn_s_memrealtime() - _t0; }
#else
                ATT_WAITBAR(4);
#endif
            }
#if defined(ATT_PROBE) && defined(ATT_PROBE_LOOP)
            att_tw += __builtin_amdgcn_s_memrealtime() - _tl0;
#endif
            asm volatile("s_waitcnt vmcnt(0)" ::: "memory");
            if (n + 1 < NU) { const int n1 = n + 1; ATT_UNIT(n1, bn_, hn_, un_);
                ATT_PROLOGUE_DMA((const char*)(K1 + (size_t)bn_ * SEQ * 1024 + hn_ * 128), (const char*)(V1 + (size_t)bn_ * SEQ * 1024 + hn_ * 128), 2 * un_ + 2); }
#undef ATT_QK
#undef ATT_EXP4
#undef ATT_VLD
#undef ATT_VWAIT
#undef ATT_MM
#undef ATT_SLOT
            lsum = swap32_add(lsum, lsum);
            if (hi == 0) wsf[r32] = (t ? lam_full : 1.0f) / lsum;
            LDS_WAIT(); asm volatile("" ::: "memory");
            float sc[16];
#pragma unroll
            for (int r = 0; r < 16; ++r) sc[r] = wsf[crow(r, hi)];
            LAS unsigned* XR = (LAS unsigned*)(lds + A_OST + wq * 32 * A_OSTRIDE);
            if (t == 1) {
#pragma unroll
                for (int d = 0; d < 4; ++d)
#pragma unroll
                    for (int rr = 0; rr < 8; ++rr) XR[(d * 8 + rr) * 64 + lane] = pk2(O[d][2 * rr] * sc[2 * rr], O[d][2 * rr + 1] * sc[2 * rr + 1]);
            }
            __syncthreads();
            if (t == 0) {
                const float osc = 1.0f - lambda_init;
                const float* subp = F.inp(I_SUBLN); const float sub0 = subp[r32], sub1 = subp[32 + r32], sub2 = subp[64 + r32], sub3 = subp[96 + r32];
                unsigned xr[32];
#pragma unroll
                for (int i = 0; i < 32; ++i) xr[i] = XR[i * 64 + lane];
                LDS_WAIT(); asm volatile("" ::: "memory");
#pragma unroll
                for (int r = 0; r < 16; ++r) { const int q = crow(r, hi);
#define ATT_X(d) ((r & 1) ? bf_hi(xr[(d) * 8 + (r >> 1)]) : bf_lo(xr[(d) * 8 + (r >> 1)]))
                    const float o0 = O[0][r] * sc[r] - ATT_X(0), o1 = O[1][r] * sc[r] - ATT_X(1), o2 = O[2][r] * sc[r] - ATT_X(2), o3 = O[3][r] * sc[r] - ATT_X(3);
#undef ATT_X
                    float ss = o0 * o0 + o1 * o1 + o2 * o2 + o3 * o3;
                    ss = sum8(ss); ss += dppf<0x140>(ss); ss = swap16_add(ss, ss);
                    const float rstd = __builtin_amdgcn_rsqf(ss * (1.0f / 128.0f) + EPS) * osc;
                    LAS bf16_t* sp = (LAS bf16_t*)(lds + A_OST + wq * 32 * A_OSTRIDE + q * A_OSTRIDE) + r32;
                    sp[0] = (bf16_t)f2bf(o0 * rstd * sub0); sp[32] = (bf16_t)f2bf(o1 * rstd * sub1); sp[64] = (bf16_t)f2bf(o2 * rstd * sub2); sp[96] = (bf16_t)f2bf(o3 * rstd * sub3); }
                LDS_WAIT(); asm volatile("" ::: "memory");
                char* ob = (char*)(AO + (tok0 + q0) * 1024 + h * 128);
#pragma unroll
                for (int i = 0; i < 8; ++i) { const int id = i * 64 + lane, row = id >> 4, c16 = id & 15;
                    *(u32x4*)(ob + (unsigned)(row * 2048 + c16 * 16)) = *(const LAS u32x4*)(lds + A_OST + wq * 32 * A_OSTRIDE + row * A_OSTRIDE + c16 * 16); }
            }
        }
    }
#undef ATT_DMA
#undef ATT_UNIT
#undef ATT_PROLOGUE_DMA
#undef ATT_WAITBAR
#ifdef ATT_PROBE
    if (blockIdx.x == 0 && tid == ATT_PROBE * 64) __hip_atomic_store((unsigned long long*)(F.ctl + 8400), att_tw, __ATOMIC_RELAXED, __HIP_MEMORY_SCOPE_AGENT);
#endif
}

__device__ __forceinline__ void phase_attention(Frame& F) {
    const float gq = wave_max(fabsf(F.inp(I_QNORM)[F.lane])), gk = wave_max(fabsf(F.inp(I_KNORM)[F.lane]));
    const float bound = 8.0f * LOG2E * gq * gk * 1.001f + 0.01f;
    if (bound > 96.0f) phase_attention_impl<true>(F, bound - 96.0f); else phase_attention_impl<false>(F, 0.0f);
}
constexpr int N_PHASES = 17;
#ifndef MK_N_LAUNCHES
#define MK_N_LAUNCHES 1
#endif
struct Args { const float* in[26]; float* out; unsigned char* ws; int ph_lo, ph_hi; };

__global__ void __launch_bounds__(NTHREADS, 2) yoco_fwd(Args args) {
    extern __shared__ __attribute__((aligned(16))) unsigned char lds_raw[];
    Frame F;
    F.lds = (LAS unsigned char*)lds_raw;
    const int wave0 = __builtin_amdgcn_readfirstlane((int)threadIdx.x >> 6);
    F.G = gridDim.x; { const int bx = blockIdx.x; F.vcu = (F.G % 8 == 0) ? (bx % 8) * (F.G / 8) + bx / 8 : bx; }
#define FRESH_IN() do { kargp_t _t = (kargp_t)__builtin_amdgcn_kernarg_segment_ptr(); asm volatile("" : "+s"(_t)); F.kin = _t; \
        F.out = (float*)(GAS float*)_t[26]; F.ws = (unsigned char*)(GAS unsigned char*)_t[27]; F.ctl = (unsigned*)(F.ws + WS_CTL); \
        int _tid; asm volatile("v_mbcnt_lo_u32_b32 %0, -1, 0\n\tv_mbcnt_hi_u32_b32 %0, -1, %0" : "=v"(_tid)); _tid += wave0 * 64; asm volatile("" : "+v"(_tid)); F.tid = _tid;     \
        F.lane = _tid & 63; F.wave = __builtin_amdgcn_readfirstlane(_tid >> 6); } while (0)
    FRESH_IN();
    volatile LAS unsigned* MISC = (volatile LAS unsigned*)(F.lds + MISC_OFF);
    LAS int* rbs = (LAS int*)(F.lds + MISC_OFF + 256);
    LAS int* rowtab = (LAS int*)(F.lds + ROWTAB_OFF);
    LAS int* utab = (LAS int*)(F.lds + MISC_OFF + 1024);
    for (int u = F.tid; u < 512; u += NTHREADS) MISC[u] = 0u;
#ifdef GEMM_PROBE
    if (blockIdx.x == 0 && F.tid == 0) g_pr = 0ull;
#endif
    __syncthreads();
    const int lo = args.ph_lo, hi = args.ph_hi;
    const bool multi = (hi - lo) > 1;
    XcdBarrier bar; bar.bar = nullptr; bar.x = 0; bar.st = nullptr;
    if (multi) bar = xcd_barrier_post(F.ctl + CW_BAR, MISC + 8);
#ifdef ONLY_PHASE
#define IN(k) ((k) == ONLY_PHASE && lo <= (k) && (k) < hi)
#else
#define IN(k) (lo <= (k) && (k) < hi)
#endif
#if defined(PROBE_A) || defined(PROBE_B)
#ifndef PROBE_A
#define PROBE_A 0
#endif
#ifndef PROBE_B
#define PROBE_B 0
#endif
#ifndef PROBE_CONST
#define PROBE_CONST 0ull
#endif
#ifndef PROBE_MUL
#define PROBE_MUL 0ull
#endif
    unsigned long long pr_prev = __builtin_amdgcn_s_memrealtime(), pr_a = 0, pr_b = 0;
#define PROBE_STAMP(k) do { const unsigned long long _n = __builtin_amdgcn_s_memrealtime(); if ((PROBE_A >> (k)) & 1) pr_a += _n - pr_prev; if ((PROBE_B >> (k)) & 1) pr_b += _n - pr_prev; pr_prev = _n; } while (0)
#else
#define PROBE_STAMP(k) do {} while (0)
#endif
#ifdef BAR_PROBE
#define SEAM(k) do { if (IN(k) && IN((k) + 1)) { bar.bar = F.ctl + CW_BAR; const unsigned long long _b0 = __builtin_amdgcn_s_memrealtime(); xcd_barrier(bar); pr_a += __builtin_amdgcn_s_memrealtime() - _b0; } else __syncthreads(); } while (0)
#else
#define SEAM(k) do { if (IN(k) && IN((k) + 1)) { bar.bar = F.ctl + CW_BAR; xcd_barrier(bar); } else __syncthreads(); PROBE_STAMP(k); } while (0)
#endif
    #define gw (F.vcu * NWAVES + F.wave)
#define NGW (F.G * NWAVES)

#if defined(P0_PROBE)
#define P0S(k) do { if (P0_PROBE == (k)) pr_a = __builtin_amdgcn_s_memrealtime() - pr_prev; } while (0)
#else
#define P0S(k) do {} while (0)
#endif
    if (IN(0)) { FRESH_IN(); P0S(0); adaln_phase(F); __syncthreads(); P0S(1); rope_table(F, blockIdx.x * NTHREADS + F.tid, F.G * NTHREADS); P0S(2); {
          const int blk = (int)blockIdx.x; if (blk < 224) convert_weights(F, 0, true, false, blk * 8 + F.wave, 1 << 20, 1792); else { const int s0 = 1792 + (blk - 224) * 40 + F.wave * 5; convert_weights(F, 0, true, false, s0, 1, s0 + 5); } }
        SEAM(0); }
    if (IN(1)) { FRESH_IN(); phase_h0(F); SEAM(1); }
    if (IN(2)) { FRESH_IN();
      {
        pg8::SchedPlain S{(const char*)(F.ws + WS_H), (const char*)(F.ws + WS_WIN), NTOK / 256, 24, 1024, F.G, (int)blockIdx.x};
        pg8::EpiInProj E{(bf16_t*)(F.ws + WS_QR), (bf16_t*)(F.ws + WS_KR), (bf16_t*)(F.ws + WS_VR), (bf16_t*)(F.ws + WS_SG), (const float*)(F.ws + WS_COS), (const float*)(F.ws + WS_SIN)};
        { const int nU = pg8::build_units(utab, S, F.tid); pg8::gemm_phase<pg8::EpiInProj, false>(F.lds, F.tid, 1024, utab, nU, E, rowtab); } }
      SEAM(2); }
    if (IN(3)) { FRESH_IN(); if (F.wave >= 4) __builtin_amdgcn_s_setprio(1);
        phase_retention(F); __builtin_amdgcn_s_setprio(0); SEAM(3); }
    if (IN(4)) { FRESH_IN(); phase_gate(F); SEAM(4); }
    if (IN(5)) { FRESH_IN(); pg8::SchedPlain S{(const char*)(F.ws + WS_VR), (const char*)(F.ws + WS_WRO), NTOK / 256, 4, 2048, F.G, (int)blockIdx.x};
        pg8::EpiResid<true> E{F.inp(I_X), (bf16_t*)(F.ws + WS_XB), (const float*)(F.ws + WS_MOD) + 2048};
        { const int nU = pg8::build_units(utab, S, F.tid); pg8::gemm_phase<pg8::EpiResid<true>, false>(F.lds, F.tid, 2048, utab, nU, E, rowtab); } SEAM(5); }
#pragma unroll 1
    for (int layer = 0; layer < 2; ++layer) {
        const int pb = layer ? 13 : 6;
        if (IN(pb)) { FRESH_IN(); phase_route(F, layer); SEAM(pb); }
        if (IN(pb + 1)) { FRESH_IN(); moe_tables(F, layer, rbs, rowtab, 8, true);
            pg8::SchedMoe S{(const char*)(F.ws + WS_H), (const char*)(F.ws + (layer ? WS_W13_L1 : WS_W13)), rbs, 8, F.G, (int)blockIdx.x, 1, (size_t)2048 * 1024 * 2};
            pg8::EpiMoeUp E{(bf16_t*)(F.ws + WS_HID)};
            { const int nU = pg8::build_units(utab, S, F.tid); pg8::gemm_phase<pg8::EpiMoeUp, true>(F.lds, F.tid, 1024, utab, nU, E, rowtab); } if (layer == 0) tail_convert(F, rbs, 8, 0); SEAM(pb + 1); }
        if (IN(pb + 2)) { FRESH_IN(); moe_tables(F, layer, rbs, rowtab, 4, false);
            pg8::SchedMoe S{(const char*)(F.ws + WS_HID), (const char*)(F.ws + (layer ? WS_W2_L1 : WS_W2)), rbs, 4, F.G, (int)blockIdx.x, 0, (size_t)1024 * 1024 * 2};
            pg8::EpiBf16 E{(bf16_t*)(F.ws + WS_YB), 1024};
            { const int nU = pg8::build_units(utab, S, F.tid); pg8::gemm_phase<pg8::EpiBf16, false>(F.lds, F.tid, 1024, utab, nU, E, rowtab); } if (layer == 0) tail_convert(F, rbs, 4, 1); SEAM(pb + 2); }
        if (layer == 0) {
            if (IN(9)) { FRESH_IN(); phase_mid(F, rbs); SEAM(9); }
            if (IN(10)) { FRESH_IN(); pg8::SchedQKV S{(const char*)(F.ws + WS_H), (const char*)(F.ws + WS_HKV), (const char*)(F.ws + WS_WQ), (const char*)(F.ws + WS_WKV), F.G, (int)blockIdx.x};
                pg8::EpiQKV E{(bf16_t*)(F.ws + WS_Q1), (bf16_t*)(F.ws + WS_K1), (bf16_t*)(F.ws + WS_V1), F.inp(I_QNORM), F.inp(I_KNORM)};
                { const int nU = pg8::build_units(utab, S, F.tid); pg8::gemm_phase<pg8::EpiQKV, false>(F.lds, F.tid, 1024, utab, nU, E, rowtab); } SEAM(10); }
            if (IN(11)) { FRESH_IN();
                if (F.wave >= 4) __builtin_amdgcn_s_setprio(1);
                phase_attention(F); __builtin_amdgcn_s_setprio(0);
                SEAM(11); }
            if (IN(12)) { FRESH_IN(); pg8::SchedPlain S{(const char*)(F.ws + WS_AO), (const char*)(F.ws + WS_WAO), NTOK / 256, 4, 1024, F.G, (int)blockIdx.x};
                pg8::EpiResid<false> E{(const void*)(F.ws + WS_XB), (bf16_t*)(F.ws + WS_XB), (const float*)(F.ws + WS_MOD) + 16 * 6144 + 2048};
                { const int nU = pg8::build_units(utab, S, F.tid); pg8::gemm_phase<pg8::EpiResid<false>, false>(F.lds, F.tid, 1024, utab, nU, E, rowtab); } SEAM(12); }
        }
    }
    if (IN(16)) { FRESH_IN(); phase_final(F, rbs); }
#if defined(PROBE_A) || defined(PROBE_B)
    __syncthreads(); PROBE_STAMP(16);
#if defined(ATT_PROBE) || defined(RET_PROBE)
    if (blockIdx.x == 0) pr_a = __hip_atomic_load((unsigned long long*)(F.ctl + 8400), __ATOMIC_RELAXED, __HIP_MEMORY_SCOPE_AGENT);
#endif
#ifdef GEMM_PROBE
    if (blockIdx.x == 0) pr_a = g_pr;
#endif
    if (blockIdx.x == 0) { const unsigned long long qa = (pr_a + 500ull) / 1000ull, spin = (PROBE_MUL ? pr_a * PROBE_MUL : qa * 100000ull) + pr_b + PROBE_CONST, t0 = __builtin_amdgcn_s_memrealtime();
        while (__builtin_amdgcn_s_memrealtime() - t0 < spin) __builtin_amdgcn_s_sleep(8); }
#endif
#undef IN
#undef SEAM
#undef gw
#undef NGW
}

extern "C" void kernel_launch(void* const* d_in, const int* in_sizes, int n_in, void* d_out, int out_size, void* d_ws, size_t ws_size, hipStream_t stream) {
    static int grid = 0;
    if (grid == 0) {
        if (n_in != 26 || in_sizes[0] != NTOK * DM || out_size != NTOK * DM || ws_size < WS_END) {
            fprintf(stderr, "kernel_launch: unexpected shapes (n_in %d, in0 %d, out %d, ws %zu < %zu); nothing launched\n", n_in, n_in > 0 ? in_sizes[0] : -1, out_size, ws_size, (size_t)WS_END); grid = -1; return; }
        int dev = 0, cus = 0, per_cu = 0;
        if (hipGetDevice(&dev) != hipSuccess || hipDeviceGetAttribute(&cus, hipDeviceAttributeMultiprocessorCount, dev) != hipSuccess) { grid = -1; return; }
        if (hipFuncSetAttribute((const void*)yoco_fwd, hipFuncAttributeMaxDynamicSharedMemorySize, LDS_BYTES) != hipSuccess) { fprintf(stderr, "kernel_launch: hipFuncSetAttribute failed\n"); grid = -1; return; }
        if (hipOccupancyMaxActiveBlocksPerMultiprocessor(&per_cu, (const void*)yoco_fwd, NTHREADS, LDS_BYTES) != hipSuccess || per_cu < 1) { fprintf(stderr, "kernel_launch: occupancy query says %d blocks per CU\n", per_cu); (void)hipGetLastError(); grid = -1; return; }
        if (cus != 256) { fprintf(stderr, "kernel_launch: built for a 256-CU device (got %d)\n", cus); grid = -1; return; }
        grid = cus;
    }
    if (grid < 0) return;
    (void)hipMemsetAsync((char*)d_ws + WS_CTL, 0, CTL_ZERO_BYTES, stream);
    Args a{};
    for (int i = 0; i < 26; ++i) a.in[i] = (const float*)d_in[i];
    a.out = (float*)d_out; a.ws = (unsigned char*)d_ws;
    if (MK_N_LAUNCHES == 1) { a.ph_lo = 0; a.ph_hi = N_PHASES; hipLaunchKernelGGL(yoco_fwd, dim3(grid), dim3(NTHREADS), LDS_BYTES, stream, a); }
    else { for (int p = 0; p < N_PHASES; ++p) { a.ph_lo = p; a.ph_hi = p + 1; hipLaunchKernelGGL(yoco_fwd, dim3(grid), dim3(NTHREADS), LDS_BYTES, stream, a); } }
}
```

```cpp
#include <hip/hip_runtime.h>
#include <cstdio>
#include <cstdint>

#define LAS __attribute__((address_space(3)))
#define GAS __attribute__((address_space(1)))
typedef unsigned short bf16_t;
typedef short bf16x8 __attribute__((ext_vector_type(8)));
typedef short s16x4 __attribute__((ext_vector_type(4)));
typedef float f32x2 __attribute__((ext_vector_type(2)));
typedef float f32x4 __attribute__((ext_vector_type(4)));
typedef float f32x16 __attribute__((ext_vector_type(16)));
typedef unsigned u32x2 __attribute__((ext_vector_type(2)));
typedef unsigned u32x4 __attribute__((ext_vector_type(4)));

constexpr int NTOK = 32768, DM = 1024, SEQ = 2048, NBATCH = 16;
constexpr float EPS = 1e-6f;
constexpr float LOG2E = 1.4426950408889634f;
constexpr int NWAVES = 8, NTHREADS = 512;

constexpr size_t MiB = 1u << 20;
constexpr size_t WS_CTL = 0, CTL_ZERO_BYTES = 1 * MiB;
constexpr size_t WS_MOD = 1 * MiB;
constexpr size_t WS_KVMOD = WS_MOD + 786432;
constexpr size_t WS_COS = 2 * MiB, WS_SIN = 3 * MiB;
constexpr size_t WS_LIST = 4 * MiB;
constexpr size_t WS_TOKSLOT = 6 * MiB;
constexpr size_t WS_TOKW = 6 * MiB + 512 * 1024;
constexpr size_t WS_WRT = 7 * MiB;
constexpr size_t WS_WIN = 8 * MiB, WS_WRO = 20 * MiB, WS_WKV = 24 * MiB, WS_WQ = 28 * MiB, WS_WAO = 30 * MiB;
constexpr size_t WS_W13 = 32 * MiB, WS_W2 = 96 * MiB;
constexpr size_t WS_W13_L1 = 192 * MiB, WS_W2_L1 = 32 * MiB;
constexpr size_t WS_XB = 128 * MiB;
constexpr size_t WS_SG = WS_XB;
constexpr size_t WS_H = 256 * MiB;
constexpr size_t WS_QR = 320 * MiB, WS_KR = 384 * MiB, WS_VR = 448 * MiB;
constexpr size_t WS_HID = 320 * MiB, WS_YB = 456 * MiB;
constexpr size_t WS_HKV = 320 * MiB, WS_Q1 = 384 * MiB, WS_K1 = 448 * MiB, WS_V1 = 512 * MiB, WS_AO = 320 * MiB;
constexpr size_t WS_END = 592 * MiB;
constexpr int MAXROWS = 69632;

constexpr int CW_BAR = 4096, CW_CNT0 = 8192, CW_CNT1 = 8256, CW_ATTQ = 8320, CW_ADALN = 8384;
constexpr int N_CONV = 16;

constexpr int RING_BYTES = 131072, ROWTAB_OFF = 131072, ROWTAB_BYTES = 16384, MISC_OFF = ROWTAB_OFF + ROWTAB_BYTES, LDS_BYTES = MISC_OFF + 2048;

__device__ __forceinline__ unsigned f2bf(float f) { unsigned u = __builtin_bit_cast(unsigned, f); return (u + 0x7fffu + ((u >> 16) & 1u)) >> 16; }
__device__ __forceinline__ unsigned pk2(float lo, float hi) { unsigned r; asm volatile("v_cvt_pk_bf16_f32 %0, %1, %2" : "=v"(r) : "v"(lo), "v"(hi)); return r; }
__device__ __forceinline__ unsigned pk2e(float lo, float hi) { unsigned r; asm("v_cvt_pk_bf16_f32 %0, %1, %2" : "=v"(r) : "v"(lo), "v"(hi)); return r; }
__device__ __forceinline__ float bf_lo(unsigned u) { return __builtin_bit_cast(float, u << 16); }
__device__ __forceinline__ float bf_hi(unsigned u) { return __builtin_bit_cast(float, u & 0xffff0000u); }
template <int CTRL> __device__ __forceinline__ float dppf(float v) { return __builtin_bit_cast(float, __builtin_amdgcn_update_dpp(0, __builtin_bit_cast(int, v), CTRL, 0xf, 0xf, true)); }
__device__ __forceinline__ float swap16_add(float a, float b) { asm volatile("s_nop 1\n\tv_permlane16_swap_b32 %0, %1" : "+v"(a), "+v"(b)); return a + b; }
__device__ __forceinline__ float swap32_add(float a, float b) { asm volatile("s_nop 1\n\tv_permlane32_swap_b32 %0, %1" : "+v"(a), "+v"(b)); return a + b; }
__device__ __forceinline__ float sum8(float v) { v += dppf<0xB1>(v); v += dppf<0x4E>(v); v += dppf<0x141>(v); return v; }
__device__ __forceinline__ float wave_sum(float v) { v = sum8(v); v += dppf<0x140>(v); v = swap16_add(v, v); return swap32_add(v, v); }
__device__ __forceinline__ float wave_max(float v) {
#pragma unroll
    for (int o = 1; o < 64; o <<= 1) v = fmaxf(v, __shfl_xor(v, o));
    return v;
}
__device__ __forceinline__ float fast_silu(float x) { return x * __builtin_amdgcn_rcpf(1.0f + __builtin_amdgcn_exp2f(-x * LOG2E)); }
__device__ __forceinline__ f32x2 silu2(const f32x2 a) { f32x2 t = a * (-LOG2E); t.x = __builtin_amdgcn_exp2f(t.x); t.y = __builtin_amdgcn_exp2f(t.y); t = t + 1.0f; f32x2 r; r.x = __builtin_amdgcn_rcpf(t.x); r.y = __builtin_amdgcn_rcpf(t.y); return a * r; }
__device__ __forceinline__ f32x4 silu4(const f32x4 a) { const f32x2 lo = silu2(a.xy), hi = silu2(a.zw); return (f32x4){lo.x, lo.y, hi.x, hi.y}; }
__device__ __forceinline__ f32x4 silu_mul4(const f32x4 a, const f32x4 b) { const f32x2 lo = silu2(a.xy) * b.xy, hi = silu2(a.zw) * b.zw; return (f32x4){lo.x, lo.y, hi.x, hi.y}; }
#define LDS_WAIT() asm volatile("s_waitcnt lgkmcnt(0)" ::: "memory")
#define VM_WAIT() asm volatile("s_waitcnt vmcnt(0)" ::: "memory")

#define XB_TMO      128
#define XB_XCNT(j)  (256  + 64 * (j))
#define XB_XSUB(j)  (1280 + 64 * (j))
#define XB_XGEN(j)  (2304 + 64 * (j))
#define XB_TOP      3328
#define XB_TOPGEN   3392
#define XCD_BAR_WORDS 3456
#define XB_SPIN_CAP (1u << 22)
__device__ __forceinline__ unsigned xb_ld(unsigned* p)              { return __hip_atomic_load(p, __ATOMIC_RELAXED, __HIP_MEMORY_SCOPE_AGENT); }
__device__ __forceinline__ unsigned xb_add(unsigned* p, unsigned v) { return __hip_atomic_fetch_add(p, v, __ATOMIC_RELAXED, __HIP_MEMORY_SCOPE_AGENT); }
__device__ __forceinline__ unsigned xb_xcc_id() { return (unsigned)__builtin_amdgcn_s_getreg((3 << 11) | 20) & 0xFu; }
#define XB_SPIN(cond, bar) do { unsigned _sp = 0; while (cond) { __builtin_amdgcn_s_sleep(1); \
    if ((++_sp & 255u) == 0u) { if (xb_ld(&(bar)[XB_TMO])) break; if (_sp > XB_SPIN_CAP) { atomicAdd(&(bar)[XB_TMO], 1u); break; } } } } while (0)
struct XcdBarrier { unsigned* bar; unsigned x; volatile LAS unsigned* st; };
__device__ __forceinline__ XcdBarrier xcd_barrier_post(unsigned* bar, volatile LAS unsigned* st) {
    XcdBarrier b; b.bar = bar; b.x = xb_xcc_id(); b.st = st;
    if (threadIdx.x == 0) (void)xb_add(&bar[XB_XCNT(b.x)], 1u);
    return b;
}
__device__ __forceinline__ void xcd_barrier_complete(unsigned* bar, unsigned x, unsigned& nloc, unsigned& nx) {
    const unsigned G = gridDim.x * gridDim.y * gridDim.z;
    unsigned sum, cnt, mine, sp = 0u;
    for (;;) {
        sum = 0u; cnt = 0u; mine = 0u;
#pragma unroll
        for (unsigned j = 0; j < 16; ++j) { const unsigned c = xb_ld(&bar[XB_XCNT(j)]); sum += c; cnt += (c > 0u) ? 1u : 0u; mine = (j == x) ? c : mine; }
        if (sum == G) break;
        __builtin_amdgcn_s_sleep(1);
        if ((++sp & 255u) == 0u) { if (xb_ld(&bar[XB_TMO])) break; if (sp > XB_SPIN_CAP) { atomicAdd(&bar[XB_TMO], 1u); break; } }
    }
    nloc = mine > 0u ? mine : 1u; nx = cnt > 0u ? cnt : 1u;
}
__device__ __forceinline__ void xcd_barrier(const XcdBarrier& b) {
    asm volatile("s_waitcnt vmcnt(0)" ::: "memory");
    __syncthreads();
    if (threadIdx.x == 0) {
        unsigned* bar = b.bar;
        __builtin_amdgcn_s_waitcnt(0);
        unsigned nloc = b.st[0], nx = b.st[1];
        if (nloc == 0u) { xcd_barrier_complete(bar, b.x, nloc, nx); b.st[0] = nloc; b.st[1] = nx; }
        const unsigned old = xb_add(&bar[XB_XSUB(b.x)], 1u);
        const unsigned gen = old / nloc;
        if (old + 1u == (gen + 1u) * nloc) {
            __builtin_amdgcn_fence(__ATOMIC_RELEASE, "agent");
            asm volatile("s_waitcnt vmcnt(0)" ::: "memory");
            const unsigned og = xb_add(&bar[XB_TOP], 1u);
            const unsigned tg = og / nx;
            if (og + 1u == (tg + 1u) * nx) xb_add(&bar[XB_TOPGEN], 1u);
            else XB_SPIN(xb_ld(&bar[XB_TOPGEN]) == tg, bar);
            __builtin_amdgcn_fence(__ATOMIC_ACQUIRE, "agent");
            xb_add(&bar[XB_XGEN(b.x)], 1u);
            asm volatile("s_waitcnt vmcnt(0)" ::: "memory");
        } else {
            XB_SPIN(xb_ld(&bar[XB_XGEN(b.x)]) == gen, bar);
            __builtin_amdgcn_fence(__ATOMIC_ACQUIRE, "agent");
            asm volatile("s_waitcnt vmcnt(0)" ::: "memory");
        }
    }
    __syncthreads();
}
#ifdef GEMM_PROBE
#ifndef GEMM_PROBE_SEL
#define GEMM_PROBE_SEL 31
#endif
__device__ unsigned long long g_pr;
#endif
namespace pg8 {
constexpr int BM = 256, BK = 64, HALF = 128, HTB = HALF * BK * 2, STAGE_BYTES = 8 * HTB, NXCD = 8, WGM = 8;
__host__ __device__ __forceinline__ int lds_byte(int r, int c) { const int st = (r >> 4) * 2 + (c >> 5), rr = r & 15, cc = c & 31, ob = rr * 64 + cc * 2; return st * 1024 + (ob ^ (((ob >> 9) & 1) << 5)); }
__host__ __device__ __forceinline__ void stage_rc(int b, int& R, int& C) { const int st = b / 1024, sb = b % 1024, swz = sb ^ (((sb >> 9) & 1) << 5); R = (st >> 1) * 16 + swz / 64; C = (st & 1) * 32 + (swz % 64) / 2; }
__host__ __device__ __forceinline__ int perm32(int rho) { const int n = rho >> 4, i = rho & 15; return 8 * (i >> 2) + 4 * n + (i & 3); }

struct Unit { const char* A; const char* B; int pm, pn, rows; };

__device__ __forceinline__ bool static_order(int nM, int nN, int G, int c, int i, int& pm, int& pn) {
    const int nwg = nM * nN; const long L = (long)i * G + c; if (L >= nwg) return false;
    int wgid = (int)L; { const int q = nwg / NXCD, r = nwg % NXCD, xcd = wgid % NXCD, off = wgid / NXCD; wgid = (xcd < r ? xcd * (q + 1) : r * (q + 1) + (xcd - r) * q) + off; }
    const int nig = WGM * nN, gid = wgid / nig, fm = gid * WGM, gsz = (nM - fm) < WGM ? (nM - fm) : WGM;
    pm = fm + ((wgid % nig) % gsz); pn = (wgid % nig) / gsz; return true;
}
__device__ __forceinline__ int xcd_remap(int L, int nwg) { const int q = nwg / NXCD, r = nwg % NXCD, xcd = L % NXCD, off = L / NXCD; return (xcd < r ? xcd * (q + 1) : r * (q + 1) + (xcd - r) * q) + off; }

__device__ __forceinline__ bool load_unit(const LAS int* utab, int nU, int i, Unit& u) {
    if (i >= nU) return false;
    const LAS int* p = utab + i * 8;
    const unsigned alo = __builtin_amdgcn_readfirstlane(p[0]), ahi = __builtin_amdgcn_readfirstlane(p[1]), blo = __builtin_amdgcn_readfirstlane(p[2]), bhi = __builtin_amdgcn_readfirstlane(p[3]);
    u.A = (const char*)(((unsigned long long)ahi << 32) | alo); u.B = (const char*)(((unsigned long long)bhi << 32) | blo);
    u.pm = __builtin_amdgcn_readfirstlane(p[4]); u.pn = __builtin_amdgcn_readfirstlane(p[5]); u.rows = __builtin_amdgcn_readfirstlane(p[6]); return true;
}
template <class Sched>
__device__ __forceinline__ int build_units(LAS int* utab, const Sched& S, const int tid) {
    const int i = tid;
    if (i < 16) { Unit u; const bool ok = S.next(i, u); LAS int* p = utab + i * 8;
        if (ok) { const unsigned long long a = (unsigned long long)u.A, b = (unsigned long long)u.B; p[0] = (int)(unsigned)a; p[1] = (int)(unsigned)(a >> 32); p[2] = (int)(unsigned)b; p[3] = (int)(unsigned)(b >> 32); p[4] = u.pm; p[5] = u.pn; p[6] = u.rows; }
        p[7] = ok ? 1 : 0; }
    __syncthreads();
    int n = 0;
#pragma unroll
    for (int k = 0; k < 16; ++k) n += utab[k * 8 + 7];
    return __builtin_amdgcn_readfirstlane(n);
}
template <class Epi, bool GATHER>
__device__ __forceinline__ void gemm_phase(LAS unsigned char* lds, const int tid, const int K, const LAS int* utab, const int nU, const Epi& E, const LAS int* rowtab) {
    const int wid = __builtin_amdgcn_readfirstlane(tid >> 6), lane = tid & 63, wr = wid >> 2, wc = wid & 3, fr = lane & 15, fq = lane >> 4;
    const int nt = K / BK;
    unsigned vA[2][2], vN[2][2], voffB[2]; int Rr[2], Cc[2];
#pragma unroll
    for (int i = 0; i < 2; ++i) { int R, C; stage_rc(tid * 16 + i * 8192, R, C); const int Rb = Epi::PERM ? ((R & ~31) + perm32(R & 31)) : R; Rr[i] = R; Cc[i] = C;
        voffB[i] = (unsigned)(Rb * K + C) * 2u; }
#define PG8_CALCA(u, v) do { _Pragma("unroll") for (int _h = 0; _h < 2; ++_h) _Pragma("unroll") for (int _i = 0; _i < 2; ++_i) { const int _r = _h * HALF + Rr[_i]; \
        const int _row = GATHER ? rowtab[((u).rows >> 2) + _r] : _r; (v)[_h][_i] = (unsigned)(_row * K + Cc[_i]) * 2u; } } while (0)
    const size_t kstep = (size_t)(BK * 2);
    const size_t hstep = (size_t)HALF * K * 2;
    const unsigned ldsw = (unsigned)wid * 1024u;
    const int aoff = lds_byte(wr * 64 + fr, fq * 8), boff = lds_byte(wc * 32 + fr, fq * 8);
#define PG8_SA(b, h) (((b) * 2 + (h)) * HTB)
#define PG8_SB(b, h) ((4 + (b) * 2 + (h)) * HTB)
#define PG8_STAGE(bufoff, gbase, voff) do { _Pragma("unroll") for (int _i = 0; _i < 2; ++_i) \
        __builtin_amdgcn_global_load_lds((const unsigned*)((const char*)(gbase) + (voff)[_i]), (LAS unsigned*)(lds + (bufoff) + ldsw + _i * 8192), 16, 0, 0); } while (0)
#ifndef PG8_A_AUX
#define PG8_A_AUX 0
#endif
#define PG8_STAGEA(bufoff, gbase, voff) do { _Pragma("unroll") for (int _i = 0; _i < 2; ++_i) \
        __builtin_amdgcn_global_load_lds((const unsigned*)((const char*)(gbase) + (voff)[_i]), (LAS unsigned*)(lds + (bufoff) + ldsw + _i * 8192), 16, 0, PG8_A_AUX); } while (0)
#define PG8_LDA(dst, b, h) do { _Pragma("unroll") for (int m = 0; m < 4; ++m) _Pragma("unroll") for (int k = 0; k < 2; ++k) dst[m][k] = *(const LAS bf16x8*)(lds + PG8_SA(b, h) + aoff + m * 2048 + k * 1024); } while (0)
#define PG8_LDB(dst, b, h) do { _Pragma("unroll") for (int n = 0; n < 2; ++n) _Pragma("unroll") for (int k = 0; k < 2; ++k) dst[n][k] = *(const LAS bf16x8*)(lds + PG8_SB(b, h) + boff + n * 2048 + k * 1024); } while (0)
#define PG8_MMA(ai, bj, At, Bt) do { __builtin_amdgcn_s_setprio(1); _Pragma("unroll") for (int m = 0; m < 4; ++m) _Pragma("unroll") for (int n = 0; n < 2; ++n) _Pragma("unroll") for (int k = 0; k < 2; ++k) \
        acc[ai][bj][m][n] = __builtin_amdgcn_mfma_f32_16x16x32_bf16(Bt[n][k], At[m][k], acc[ai][bj][m][n], 0, 0, 0); __builtin_amdgcn_s_setprio(0); } while (0)
#define PG8_WAIT_V(n) asm volatile("s_waitcnt vmcnt(" #n ")" ::: "memory")
#define PG8_WAIT_L(n) asm volatile("s_waitcnt lgkmcnt(" #n ")" ::: "memory")
#define PG8_BAR __builtin_amdgcn_s_barrier()
#define PG8_SCHED __builtin_amdgcn_sched_barrier(0)
    Unit cur, nxt; int ui = 0;
    if (!load_unit(utab, nU, 0, cur)) return;
    f32x4 acc[2][2][4][2];
#pragma unroll
    for (int a = 0; a < 2; ++a)
#pragma unroll
        for (int b = 0; b < 2; ++b)
#pragma unroll
            for (int m = 0; m < 4; ++m)
#pragma unroll
                for (int n = 0; n < 2; ++n) acc[a][b][m][n] = (f32x4){0.f, 0.f, 0.f, 0.f};
    bf16x8 At[4][2], B0[2][2], B1[2][2];
    const char* cA = cur.A; const char* cB = cur.B;
    PG8_CALCA(cur, vA);
    PG8_STAGE(PG8_SB(0, 0), cB, voffB); PG8_STAGE(PG8_SB(0, 1), cB + hstep, voffB); PG8_STAGEA(PG8_SA(0, 0), cA, vA[0]); PG8_STAGEA(PG8_SA(0, 1), cA, vA[1]);
    if (wr == 1) PG8_BAR;
    PG8_WAIT_V(2); PG8_BAR;
    PG8_STAGE(PG8_SB(1, 0), cB + kstep, voffB); PG8_STAGEA(PG8_SA(1, 0), cA + kstep, vA[0]); PG8_STAGE(PG8_SB(1, 1), cB + hstep + kstep, voffB);
    PG8_WAIT_V(6); PG8_BAR;
    for (;;) {
        const bool has_next = load_unit(utab, nU, ui + 1, nxt);
        const char* nA = has_next ? nxt.A : cA; const char* nB = has_next ? nxt.B : cB;
        if (GATHER) {
            if (has_next) { PG8_CALCA(nxt, vN); }
            else {
#pragma unroll
                for (int h = 0; h < 2; ++h) { vN[h][0] = vA[h][0]; vN[h][1] = vA[h][1]; }
            }
        }
#if defined(GEMM_PROBE) && GEMM_PROBE == 3
        const unsigned long long _k0 = __builtin_amdgcn_s_memrealtime();
#endif
        for (int t = 0; t < nt; t += 2) {
            const bool last = (t == nt - 2);
            const char* a1 = cA + (size_t)(t + 1) * kstep;
            const char* a2 = last ? nA : cA + (size_t)(t + 2) * kstep; const char* b2 = last ? nB : cB + (size_t)(t + 2) * kstep;
            const char* a3 = a2 + kstep; const char* b3 = b2 + kstep;
            unsigned w0[2], w1[2];
#pragma unroll
            for (int i = 0; i < 2; ++i) { w0[i] = (GATHER && last) ? vN[0][i] : vA[0][i]; w1[i] = (GATHER && last) ? vN[1][i] : vA[1][i]; }
            PG8_LDB(B0, 0, 0); PG8_LDB(B1, 0, 1); PG8_SCHED; PG8_LDA(At, 0, 0); PG8_STAGEA(PG8_SA(1, 1), a1, vA[1]);
            PG8_WAIT_V(8); PG8_WAIT_L(0); PG8_BAR; PG8_MMA(0, 0, At, B0); PG8_MMA(0, 1, At, B1); PG8_BAR; PG8_SCHED;
            PG8_LDA(At, 0, 1); PG8_STAGE(PG8_SB(0, 0), b2, voffB); PG8_STAGE(PG8_SB(0, 1), b2 + hstep, voffB); PG8_STAGEA(PG8_SA(0, 0), a2, w0);
            PG8_WAIT_V(8); PG8_WAIT_L(0); PG8_BAR; PG8_MMA(1, 0, At, B0); PG8_MMA(1, 1, At, B1); PG8_BAR; PG8_SCHED;
            PG8_LDB(B0, 1, 0); PG8_LDB(B1, 1, 1); PG8_SCHED; PG8_LDA(At, 1, 0); PG8_STAGEA(PG8_SA(0, 1), a2, w1);
            PG8_WAIT_V(8); PG8_WAIT_L(0); PG8_BAR; PG8_MMA(0, 0, At, B0); PG8_MMA(0, 1, At, B1); PG8_BAR; PG8_SCHED;
            PG8_LDA(At, 1, 1); PG8_STAGE(PG8_SB(1, 0), b3, voffB); PG8_STAGE(PG8_SB(1, 1), b3 + hstep, voffB); PG8_STAGEA(PG8_SA(1, 0), a3, w0);
            PG8_WAIT_V(8); PG8_WAIT_L(0); PG8_BAR; PG8_MMA(1, 0, At, B0); PG8_MMA(1, 1, At, B1); PG8_BAR; PG8_SCHED;
        }
#if defined(GEMM_PROBE) && GEMM_PROBE == 3
        if (blockIdx.x == 0 && tid == 0 && ((GEMM_PROBE_SEL >> Epi::PID) & 1)) g_pr += __builtin_amdgcn_s_memrealtime() - _k0;
#endif
#ifdef GEMM_PROBE
        const unsigned long long _g0 = __builtin_amdgcn_s_memrealtime();
#endif
        if (wr == 0) PG8_BAR;
        E(acc, cur, wr, wc, fr, fq);
#ifdef EPI_TWICE
        if ((EPI_TWICE >> Epi::PID) & 1) { asm volatile("" ::: "memory"); E(acc, cur, wr, wc, fr, fq); }
#endif
#ifdef GEMM_PROBE
#if GEMM_PROBE == 2
        asm volatile("s_waitcnt vmcnt(0)" ::: "memory");
#endif
#if GEMM_PROBE != 3
        if (blockIdx.x == 0 && tid == 0 && ((GEMM_PROBE_SEL >> Epi::PID) & 1)) g_pr += __builtin_amdgcn_s_memrealtime() - _g0;
#endif
#endif
        if (!has_next) break;
#pragma unroll
        for (int a = 0; a < 2; ++a)
#pragma unroll
            for (int b = 0; b < 2; ++b)
#pragma unroll
                for (int m = 0; m < 4; ++m)
#pragma unroll
                    for (int n = 0; n < 2; ++n) acc[a][b][m][n] = (f32x4){0.f, 0.f, 0.f, 0.f};
        cur = nxt; cA = nA; cB = nB; ++ui;
        if (GATHER) {
#pragma unroll
            for (int h = 0; h < 2; ++h) { vA[h][0] = vN[h][0]; vA[h][1] = vN[h][1]; }
        }
        if (wr == 1) PG8_BAR;
    }
    PG8_WAIT_V(0);
    PG8_BAR;
#undef PG8_CALCA
#undef PG8_SA
#undef PG8_SB
#undef PG8_STAGE
#undef PG8_STAGEA
#undef PG8_LDA
#undef PG8_LDB
#undef PG8_MMA
#undef PG8_WAIT_V
#undef PG8_WAIT_L
#undef PG8_BAR
#undef PG8_SCHED
}
}
namespace pg8 {
typedef f32x4 Acc[2][2][4][2];
__device__ __forceinline__ void st16(void* p, const u32x4 w) {
#ifdef EPI_SC1
    asm volatile("global_store_dwordx4 %0, %1, off sc1" :: "v"(p), "v"(w) : "memory");
#else
    *(u32x4*)p = w;
#endif
}

struct EpiInProj {
    static constexpr bool PERM = true; static constexpr int PID = 0;
    bf16_t *Q, *Kk, *V, *G; const float *cosT, *sinT;
    __device__ __forceinline__ void operator()(const Acc& acc, const Unit& u, int wr, int wc, int fr, int fq) const {
        const int pn = u.pn, row0 = u.pm * BM + wr * 64 + fr;
        if (pn < 8) {
            const int head = pn & 3; const bool isk = pn >= 4;
            const float lg = __builtin_log2f(1.0f - __builtin_exp2f(-5.0f - (float)head));
            bf16_t* out = isk ? Kk : Q;
            const int j0 = wc * 32 + 8 * fq;
            const int pos0 = row0 & (SEQ - 1);
            f32x4 cb[2][2], sb[2][2], cst[2], sst[2];
#pragma unroll
            for (int n = 0; n < 2; ++n) {
#pragma unroll
                for (int ai = 0; ai < 2; ++ai) { cb[ai][n] = *(const f32x4*)(cosT + (pos0 + ai * HALF) * 128 + j0 + 4 * n); sb[ai][n] = *(const f32x4*)(sinT + (pos0 + ai * HALF) * 128 + j0 + 4 * n); }
                cst[n] = *(const f32x4*)(cosT + 16 * 128 + j0 + 4 * n); sst[n] = *(const f32x4*)(sinT + 16 * 128 + j0 + 4 * n); }
#pragma unroll
            for (int ai = 0; ai < 2; ++ai) {
                f32x4 c4[2] = {cb[ai][0], cb[ai][1]}, s4[2] = {sb[ai][0], sb[ai][1]};
#pragma unroll
                for (int m = 0; m < 4; ++m) {
                    const int row = row0 + ai * HALF + m * 16, pos = row & (SEQ - 1), nn = pos & 63;
                    const float sc = isk ? __builtin_exp2f(-(float)nn * lg) * 0.0625f : __builtin_exp2f((float)nn * lg);
                    u32x4 w1, w2;
#pragma unroll
                    for (int n = 0; n < 2; ++n) {
                        const f32x4 x1 = acc[ai][0][m][n], x2 = acc[ai][1][m][n];
                        const f32x4 o1 = (x1 * c4[n] - x2 * s4[n]) * sc, o2 = (x2 * c4[n] + x1 * s4[n]) * sc;
                        w1[2 * n] = pk2e(o1[0], o1[1]); w1[2 * n + 1] = pk2e(o1[2], o1[3]); w2[2 * n] = pk2e(o2[0], o2[1]); w2[2 * n + 1] = pk2e(o2[2], o2[3]);
                        if (m < 3) { const f32x4 cn = c4[n] * cst[n] - s4[n] * sst[n], sn = s4[n] * cst[n] + c4[n] * sst[n]; c4[n] = cn; s4[n] = sn; }
                    }
                    bf16_t* p = out + (size_t)row * 1024 + head * 256 + j0;
                    st16(p, w1); st16(p + 128, w2);
                }
            }
        } else {
            const bool isg = pn >= 16; bf16_t* out = isg ? G : V; const int col0 = (isg ? pn - 16 : pn - 8) * 256 + wc * 32 + 8 * fq;
#pragma unroll
            for (int ai = 0; ai < 2; ++ai)
#pragma unroll
                for (int m = 0; m < 4; ++m) { bf16_t* rowp = out + (size_t)(row0 + ai * HALF + m * 16) * 2048 + col0;
#pragma unroll
                    for (int bj = 0; bj < 2; ++bj) { f32x4 v0 = acc[ai][bj][m][0], v1 = acc[ai][bj][m][1];
                        if (isg) {
                            v0 = silu4(v0); v1 = silu4(v1); }
                        u32x4 w; w.x = pk2e(v0[0], v0[1]); w.y = pk2e(v0[2], v0[3]); w.z = pk2e(v1[0], v1[1]); w.w = pk2e(v1[2], v1[3]);
                        st16(rowp + bj * HALF, w); } }
        }
    }
};
struct EpiMoeUp {
    static constexpr bool PERM = true; static constexpr int PID = 1;
    bf16_t* O;
    __device__ __forceinline__ void operator()(const Acc& acc, const Unit& u, int wr, int wc, int fr, int fq) const {
        const int row0 = u.pm * BM + wr * 64 + fr, col0 = u.pn * 128 + wc * 32 + 8 * fq;
#pragma unroll
        for (int ai = 0; ai < 2; ++ai)
#pragma unroll
            for (int m = 0; m < 4; ++m) {
                f32x4 v0 = acc[ai][0][m][0], v1 = acc[ai][0][m][1]; const f32x4 g0 = acc[ai][1][m][0], g1 = acc[ai][1][m][1];
                v0 = silu_mul4(v0, g0); v1 = silu_mul4(v1, g1);
                u32x4 w; w.x = pk2e(v0[0], v0[1]); w.y = pk2e(v0[2], v0[3]); w.z = pk2e(v1[0], v1[1]); w.w = pk2e(v1[2], v1[3]);
                *(u32x4*)(O + (size_t)(row0 + ai * HALF + m * 16) * 1024 + col0) = w;
            }
    }
};
struct EpiBf16 {
    static constexpr bool PERM = true; static constexpr int PID = 2;
    bf16_t* O; int ldc;
    __device__ __forceinline__ void operator()(const Acc& acc, const Unit& u, int wr, int wc, int fr, int fq) const {
        const int row0 = u.pm * BM + wr * 64 + fr, col0 = u.pn * BM + wc * 32 + 8 * fq;
#pragma unroll
        for (int ai = 0; ai < 2; ++ai)
#pragma unroll
            for (int m = 0; m < 4; ++m) { bf16_t* rowp = O + (size_t)(row0 + ai * HALF + m * 16) * ldc + col0;
#pragma unroll
                for (int bj = 0; bj < 2; ++bj) { const f32x4 v0 = acc[ai][bj][m][0], v1 = acc[ai][bj][m][1];
                    u32x4 w; w.x = pk2e(v0[0], v0[1]); w.y = pk2e(v0[2], v0[3]); w.z = pk2e(v1[0], v1[1]); w.w = pk2e(v1[2], v1[3]);
                    *(u32x4*)(rowp + bj * HALF) = w; } }
    }
};
template <bool BASE_F32>
struct EpiResid {
    static constexpr bool PERM = true; static constexpr int PID = 3;
    const void* base; bf16_t* out; const float* gate;
    __device__ __forceinline__ void operator()(const Acc& acc, const Unit& u, int wr, int wc, int fr, int fq) const {
        const int row0 = u.pm * BM + wr * 64 + fr, col0 = u.pn * BM + wc * 32 + 8 * fq;
        const float* gp = gate + (size_t)((u.pm * BM) / SEQ) * 6144 + col0;
        f32x4 gv[2][2];
#pragma unroll
        for (int bj = 0; bj < 2; ++bj)
#pragma unroll
            for (int n = 0; n < 2; ++n) gv[bj][n] = *(const f32x4*)(gp + bj * HALF + n * 4);
        if (BASE_F32) {
#pragma unroll
            for (int ai = 0; ai < 2; ++ai) { f32x4 b[4][2][2];
#pragma unroll
                for (int m = 0; m < 4; ++m)
#pragma unroll
                    for (int bj = 0; bj < 2; ++bj) { const float* bp = (const float*)base + (size_t)(row0 + ai * HALF + m * 16) * 1024 + col0 + bj * HALF; b[m][bj][0] = __builtin_nontemporal_load((const f32x4*)bp); b[m][bj][1] = __builtin_nontemporal_load((const f32x4*)(bp + 4)); }
                asm volatile("" ::: "memory");
#pragma unroll
                for (int m = 0; m < 4; ++m)
#pragma unroll
                    for (int bj = 0; bj < 2; ++bj) { const size_t off = (size_t)(row0 + ai * HALF + m * 16) * 1024 + col0 + bj * HALF;
                        const f32x4 v0 = b[m][bj][0] + gv[bj][0] * acc[ai][bj][m][0], v1 = b[m][bj][1] + gv[bj][1] * acc[ai][bj][m][1];
                        u32x4 w; w.x = pk2e(v0[0], v0[1]); w.y = pk2e(v0[2], v0[3]); w.z = pk2e(v1[0], v1[1]); w.w = pk2e(v1[2], v1[3]);
                        *(u32x4*)(out + off) = w; }
                asm volatile("" ::: "memory"); }
        } else {
            u32x4 q[2][4][2];
#pragma unroll
            for (int ai = 0; ai < 2; ++ai)
#pragma unroll
                for (int m = 0; m < 4; ++m)
#pragma unroll
                    for (int bj = 0; bj < 2; ++bj) q[ai][m][bj] = *(const u32x4*)((const bf16_t*)base + (size_t)(row0 + ai * HALF + m * 16) * 1024 + col0 + bj * HALF);
            asm volatile("" ::: "memory");
#pragma unroll
            for (int ai = 0; ai < 2; ++ai)
#pragma unroll
                for (int m = 0; m < 4; ++m)
#pragma unroll
                    for (int bj = 0; bj < 2; ++bj) { const size_t off = (size_t)(row0 + ai * HALF + m * 16) * 1024 + col0 + bj * HALF; const u32x4 qq = q[ai][m][bj];
                        const f32x4 b0 = (f32x4){bf_lo(qq.x), bf_hi(qq.x), bf_lo(qq.y), bf_hi(qq.y)}, b1 = (f32x4){bf_lo(qq.z), bf_hi(qq.z), bf_lo(qq.w), bf_hi(qq.w)};
                        const f32x4 v0 = b0 + gv[bj][0] * acc[ai][bj][m][0], v1 = b1 + gv[bj][1] * acc[ai][bj][m][1];
                        u32x4 w; w.x = pk2e(v0[0], v0[1]); w.y = pk2e(v0[2], v0[3]); w.z = pk2e(v1[0], v1[1]); w.w = pk2e(v1[2], v1[3]);
                        *(u32x4*)(out + off) = w; }
        }
    }
};
struct EpiQKV {
    static constexpr bool PERM = true; static constexpr int PID = 4;
    bf16_t *Q, *Kk, *V; const float *qn, *kn;
    __device__ __forceinline__ void operator()(const Acc& acc, const Unit& u, int wr, int wc, int fr, int fq) const {
        const int pn = u.pn, row0 = u.pm * BM + wr * 64 + fr;
        if (pn < 8) {
            const bool isk = pn >= 4; bf16_t* out = isk ? Kk : Q; const float* gn = isk ? kn : qn; const float osc = isk ? 1.0f : 0.125f * LOG2E;
            const int col0 = (pn & 3) * 256 + 64 * wc + 8 * fq;
            f32x4 gq[2][2];
#pragma unroll
            for (int bj = 0; bj < 2; ++bj) { gq[bj][0] = *(const f32x4*)(gn + 32 * bj + 8 * fq); gq[bj][1] = *(const f32x4*)(gn + 32 * bj + 8 * fq + 4); }
#pragma unroll
            for (int ai = 0; ai < 2; ++ai)
#pragma unroll
                for (int m = 0; m < 4; ++m) {
                    float ss = 0.f;
#pragma unroll
                    for (int bj = 0; bj < 2; ++bj)
#pragma unroll
                        for (int n = 0; n < 2; ++n) { const f32x4 x = acc[ai][bj][m][n]; ss += (x[0] * x[0] + x[1] * x[1]) + (x[2] * x[2] + x[3] * x[3]); }
                    ss = swap16_add(ss, ss); ss = swap32_add(ss, ss);
                    const float rstd = __builtin_amdgcn_rsqf(ss * (1.0f / 64.0f) + EPS) * osc;
                    bf16_t* rowp = out + (size_t)(row0 + ai * HALF + m * 16) * 1024 + col0;
#pragma unroll
                    for (int bj = 0; bj < 2; ++bj) { const f32x4 g0 = gq[bj][0], g1 = gq[bj][1];
                        const f32x4 v0 = acc[ai][bj][m][0] * rstd * g0, v1 = acc[ai][bj][m][1] * rstd * g1;
                        u32x4 w; w.x = pk2e(v0[0], v0[1]); w.y = pk2e(v0[2], v0[3]); w.z = pk2e(v1[0], v1[1]); w.w = pk2e(v1[2], v1[3]);
                        *(u32x4*)(rowp + 32 * bj) = w; }
                    asm volatile("" ::: "memory");
                }
        } else {
            const int col0 = (pn - 8) * 256 + wc * 32 + 8 * fq;
#pragma unroll
            for (int ai = 0; ai < 2; ++ai)
#pragma unroll
                for (int m = 0; m < 4; ++m) { bf16_t* rowp = V + (size_t)(row0 + ai * HALF + m * 16) * 1024 + col0;
#pragma unroll
                    for (int bj = 0; bj < 2; ++bj) { const f32x4 v0 = acc[ai][bj][m][0], v1 = acc[ai][bj][m][1];
                        u32x4 w; w.x = pk2e(v0[0], v0[1]); w.y = pk2e(v0[2], v0[3]); w.z = pk2e(v1[0], v1[1]); w.w = pk2e(v1[2], v1[3]);
                        *(u32x4*)(rowp + bj * HALF) = w; } }
        }
    }
};

struct SchedPlain {
    const char *A, *B; int nM, nN, K, G, c;
    __device__ __forceinline__ bool next(int i, Unit& u) const { int pm, pn; if (!static_order(nM, nN, G, c, i, pm, pn)) return false;
        u.pm = pm; u.pn = pn; u.rows = 0; u.A = A + (size_t)pm * BM * K * 2; u.B = B + (size_t)pn * BM * K * 2; return true; }
};
struct SchedQKV {
    const char *Aq, *Akv, *Bq, *Bkv; int G, c;
    __device__ __forceinline__ bool next(int i, Unit& u) const { int pm, pn; if (!static_order(NTOK / BM, 12, G, c, i, pm, pn)) return false;
        u.pm = pm; u.pn = pn; u.rows = 0; const size_t ts = (size_t)BM * 1024 * 2;
        u.A = (pn < 4 ? Aq : Akv) + (size_t)pm * ts; u.B = pn < 4 ? Bq + (size_t)pn * ts : Bkv + (size_t)(pn - 4) * ts; return true; }
};
struct SchedMoe {
    const char *A, *B; const LAS int* rbs; int NT, G, c, gather; size_t estride;
    __device__ __forceinline__ bool next(int i, Unit& u) const {
        const int nrb = rbs[16], nwg = nrb * NT; const long L = (long)i * G + c; if (L >= nwg) return false;
        const int wg = xcd_remap((int)L, nwg), rb = wg / NT, pn = wg % NT;
        int e = 0;
#pragma unroll
        for (int k = 1; k < 16; ++k) e += (rb >= rbs[k]) ? 1 : 0;
        u.pm = rb; u.pn = pn; u.rows = i * 1024;
        u.A = gather ? A : A + (size_t)rb * BM * 1024 * 2; u.B = B + (size_t)e * estride + (size_t)pn * BM * 1024 * 2; return true; }
};
}
typedef __attribute__((address_space(4))) const unsigned long long* kargp_t;
struct Frame {
    LAS unsigned char* lds;
    unsigned* ctl;
    int tid, lane, wave, vcu, G;
    unsigned char* ws;
    kargp_t kin;
    __device__ __forceinline__ const float* inp(int i) const { return (const float*)(const GAS float*)kin[i]; }
    float* out;
};
enum { I_X = 0, I_C, I_ADAW, I_ADAB, I_NMIX, I_NFFN, I_RWIN, I_RGN, I_RWOUT, I_KVADAW, I_KVADAB, I_KVNORM, I_KVW, I_KNORM, I_WQ, I_QNORM, I_LAM, I_SUBLN, I_WOUT,
       I_WG, I_BG, I_WE, I_BE, I_W1, I_W3, I_W2 };

__device__ __forceinline__ int dest_row(int n, int mode) {
    if (mode == 1) { const int c = n & 255; return (n & ~255) + 128 * ((c >> 5) & 1) + 32 * (c >> 6) + (c & 31); }
    if (mode == 2) return (n >> 7) * 256 + (n & 127);
    if (mode == 3) return (n >> 7) * 256 + 128 + (n & 127);
    return n;
}
struct TItem { const float* W; bf16_t* WT; int K, N, mode, item; };
__device__ __forceinline__ void titem_load(const TItem& it, f32x4 (&v)[16], int lane) {
    const int nblk = it.N / 64, kb = it.item / nblk, nb = it.item % nblk, k0 = 64 * kb, n0 = 64 * nb;
    const float* p = it.W + (size_t)(k0 + (lane >> 4)) * it.N + n0 + 4 * (lane & 15);
#pragma unroll
    for (int i = 0; i < 16; ++i) v[i] = __builtin_nontemporal_load((const f32x4*)(p + (size_t)(4 * i) * it.N));
}
__device__ __forceinline__ void titem_store(const TItem& it, const f32x4 (&v)[16], LAS float* scr, int lane) {
    const int nblk = it.N / 64, kb = it.item / nblk, nb = it.item % nblk, k0 = 64 * kb, n0 = 64 * nb;
#pragma unroll
    for (int i = 0; i < 16; ++i) *(LAS f32x4*)(scr + (4 * i + (lane >> 4)) * 68 + 4 * (lane & 15)) = v[i];
    LDS_WAIT(); asm volatile("" ::: "memory");
    const int d = dest_row(n0 + (lane & 32), it.mode) + (lane & 31);
    bf16_t* op = it.WT + (size_t)d * it.K + k0;
#pragma unroll 2
    for (int c = 0; c < 8; ++c) { const LAS float* s = scr + (8 * c) * 68 + lane;
        u32x4 o; o.x = pk2(s[0 * 68], s[1 * 68]); o.y = pk2(s[2 * 68], s[3 * 68]); o.z = pk2(s[4 * 68], s[5 * 68]); o.w = pk2(s[6 * 68], s[7 * 68]);
        *(u32x4*)(op + 8 * c) = o; }
    LDS_WAIT(); asm volatile("" ::: "memory");
}
__device__ __forceinline__ void thalf_load(const TItem& it, int half, f32x4 (&v)[8], int lane) {
    const int nblk = it.N / 64, kb = it.item / nblk, nb = it.item % nblk, k0 = 64 * kb + 32 * half, n0 = 64 * nb;
    const float* p = it.W + (size_t)(k0 + (lane >> 4)) * it.N + n0 + 4 * (lane & 15);
#pragma unroll
    for (int i = 0; i < 8; ++i) v[i] = __builtin_nontemporal_load((const f32x4*)(p + (size_t)(4 * i) * it.N));
}
__device__ __forceinline__ void thalf_store(const TItem& it, int half, const f32x4 (&v)[8], LAS float* scr, int lane) {
    const int nblk = it.N / 64, kb = it.item / nblk, nb = it.item % nblk, k0 = 64 * kb + 32 * half, n0 = 64 * nb;
#pragma unroll
    for (int i = 0; i < 8; ++i) *(LAS f32x4*)(scr + (4 * i + (lane >> 4)) * 68 + 4 * (lane & 15)) = v[i];
    LDS_WAIT(); asm volatile("" ::: "memory");
    const int d = dest_row(n0 + (lane & 32), it.mode) + (lane & 31);
    bf16_t* op = it.WT + (size_t)d * it.K + k0;
#pragma unroll 2
    for (int c = 0; c < 4; ++c) { const LAS float* s = scr + (8 * c) * 68 + lane;
        u32x4 o; o.x = pk2(s[0 * 68], s[1 * 68]); o.y = pk2(s[2 * 68], s[3 * 68]); o.z = pk2(s[4 * 68], s[5 * 68]); o.w = pk2(s[6 * 68], s[7 * 68]);
        *(u32x4*)(op + 8 * c) = o; }
    LDS_WAIT(); asm volatile("" ::: "memory");
}
__device__ __forceinline__ TItem moe_item(Frame& F, int layer, int it) {
    constexpr int IPM = 256;
    int e, which, item;
    if (layer == 0) { e = it / (3 * IPM); const int r = it % (3 * IPM); which = r / IPM; item = r % IPM; }
    else if (it < 32 * IPM) { e = it / (2 * IPM); const int r = it % (2 * IPM); which = r / IPM; item = r % IPM; }
    else { const int j = it - 32 * IPM; e = j / IPM; which = 2; item = j % IPM; }
    const size_t wo = ((size_t)layer * 16 + e) * 1048576;
    bf16_t* w13 = (bf16_t*)(F.ws + (layer ? WS_W13_L1 : WS_W13)); bf16_t* w2 = (bf16_t*)(F.ws + (layer ? WS_W2_L1 : WS_W2));
    TItem t; t.K = 1024; t.N = 1024; t.item = item;
    if (which == 0) { t.W = F.inp(I_W1) + wo; t.WT = w13 + (size_t)e * 2097152; t.mode = 2; }
    else if (which == 1) { t.W = F.inp(I_W3) + wo; t.WT = w13 + (size_t)e * 2097152; t.mode = 3; }
    else { t.W = F.inp(I_W2) + wo; t.WT = w2 + (size_t)e * 1048576; t.mode = 0; }
    return t;
}
__device__ __forceinline__ TItem dense_item(Frame& F, int it) {
    constexpr int I_IN = 16 * 96, I_RO = 32 * 16, I_KV = 16 * 32, I_Q = 256;
    TItem t; int r = it;
    if (r < I_IN) { t.W = F.inp(I_RWIN); t.WT = (bf16_t*)(F.ws + WS_WIN); t.K = 1024; t.N = 6144; t.mode = 0; t.item = r; return t; } r -= I_IN;
    if (r < I_RO) { t.W = F.inp(I_RWOUT); t.WT = (bf16_t*)(F.ws + WS_WRO); t.K = 2048; t.N = 1024; t.mode = 0; t.item = r; return t; } r -= I_RO;
    if (r < I_KV) { t.W = F.inp(I_KVW); t.WT = (bf16_t*)(F.ws + WS_WKV); t.K = 1024; t.N = 2048; t.mode = (r % 32) < 16 ? 1 : 0; t.item = r; return t; } r -= I_KV;
    if (r < I_Q) { t.W = F.inp(I_WQ); t.WT = (bf16_t*)(F.ws + WS_WQ); t.K = 1024; t.N = 1024; t.mode = 1; t.item = r; return t; } r -= I_Q;
    t.W = F.inp(I_WOUT); t.WT = (bf16_t*)(F.ws + WS_WAO); t.K = 1024; t.N = 1024; t.mode = 0; t.item = r; return t;
}
constexpr int N_DENSE_ITEMS = 16 * 96 + 32 * 16 + 16 * 32 + 256 + 256, N_MOE_ITEMS = 16 * 3 * 256;
__device__ __forceinline__ void convert_weights(Frame& F, int layer, bool with_dense, bool with_moe, int gw, int NGW, int end = 1 << 30) {
    LAS float* scr = (LAS float*)(F.lds + F.wave * 17408);
    const int nd = with_dense ? N_DENSE_ITEMS : 0, total0 = nd + (with_moe ? N_MOE_ITEMS : 0), total = end < total0 ? end : total0;
    int it = gw; if (it >= total) return;
    TItem cur = it < nd ? dense_item(F, it) : moe_item(F, layer, it - nd);
    f32x4 va[16], vb[16];
    titem_load(cur, va, F.lane);
    for (;;) {
        const int itn = it + NGW; const bool more = itn < total;
        TItem nxt = cur;
        if (more) { nxt = itn < nd ? dense_item(F, itn) : moe_item(F, layer, itn - nd); titem_load(nxt, vb, F.lane); }
        titem_store(cur, va, scr, F.lane);
        if (!more) break;
        const int itn2 = itn + NGW; const bool more2 = itn2 < total;
        if (more2) { cur = itn2 < nd ? dense_item(F, itn2) : moe_item(F, layer, itn2 - nd); titem_load(cur, va, F.lane); }
        titem_store(nxt, vb, scr, F.lane);
        if (!more2) break;
        it = itn2;
    }
}
#ifndef TQ7
#define TQ7 3
#endif
#ifndef TQ8
#define TQ8 3
#endif
constexpr int TAILQ7 = TQ7, TAILQ8 = TQ8;
static_assert(TAILQ7 * NWAVES * 255 <= 8192, "the MoE-up tail may only convert w1 / w3 items");
__device__ __forceinline__ int tail_idle(int nrb, int NT) { const int rem = (nrb * NT) & 255; return rem ? 256 - rem : 0; }
__device__ __forceinline__ int tail_base(int nrb, int which) {
    int n = 0; if (which >= 1) n += tail_idle(nrb, 8) * NWAVES * TAILQ7; if (which >= 2) n += tail_idle(nrb, 4) * NWAVES * TAILQ8; return n < N_MOE_ITEMS ? n : N_MOE_ITEMS; }
__device__ __forceinline__ void tail_convert(Frame& F, const LAS int* rbs, int NT, int which) {
    const int nrb = rbs[16], rem = (nrb * NT) & 255; if (rem == 0 || (int)blockIdx.x < rem) return;
    const int Q = which ? TAILQ8 : TAILQ7, s0 = tail_base(nrb, which) + (((int)blockIdx.x - rem) * NWAVES + F.wave) * Q;
    convert_weights(F, 1, false, true, s0, 1, s0 + Q);
}
#ifndef TQ14
#define TQ14 3
#endif
constexpr int DEFER_X = 3072, TAILQ14 = TQ14;
static_assert(DEFER_X <= 4096, "only w2 items may be deferred past the layer-1 MoE-up phase");
__device__ __forceinline__ int defer_start(int nrb0) { const int b = tail_base(nrb0, 2), s = N_MOE_ITEMS - DEFER_X; return b > s ? b : s; }
__device__ __forceinline__ void defer_convert(Frame& F, int nrb0, int nrb1, bool tailpart) {
    const int ds = defer_start(nrb0), nd = N_MOE_ITEMS - ds, rem = (nrb1 * 8) & 255, idle = rem ? 256 - rem : 0, cap = idle * NWAVES * TAILQ14, left = nd > cap ? nd - cap : 0;
    if (!tailpart) { convert_weights(F, 1, false, true, ds + F.vcu * NWAVES + F.wave, F.G * NWAVES, ds + left); return; }
    if (rem == 0 || (int)blockIdx.x < rem) return;
    const int s0 = ds + left + (((int)blockIdx.x - rem) * NWAVES + F.wave) * TAILQ14;
    convert_weights(F, 1, false, true, s0, 1, s0 + TAILQ14);
}
__device__ __forceinline__ void adaln_phase(Frame& F) {
    LAS float* cs = (LAS float*)F.lds;
    LAS float* red = (LAS float*)(F.lds + 65536);
    constexpr int NTASK = (2 * 6144 + 2048) / 64;
    if ((int)blockIdx.x >= NTASK) return;
    { const float* cp = F.inp(I_C) + F.tid; float cvv[32];
#pragma unroll
      for (int i = 0; i < 32; ++i) cvv[i] = cp[i * NTHREADS];
#pragma unroll
      for (int i = 0; i < 32; ++i) cs[i * NTHREADS + F.tid] = cvv[i] / (1.0f + __expf(-cvv[i])); }
    __syncthreads();
    for (int task = blockIdx.x; task < NTASK; task += F.G) {
        const int gc = task * 64; const float* W; const float* bias; float* outp; int N, c0, ostride;
        if (gc < 6144) { W = F.inp(I_ADAW); bias = F.inp(I_ADAB); N = 6144; c0 = gc; outp = (float*)(F.ws + WS_MOD); ostride = 6144; }
        else if (gc < 12288) { W = F.inp(I_ADAW) + (size_t)1024 * 6144; bias = F.inp(I_ADAB) + 6144; N = 6144; c0 = gc - 6144; outp = (float*)(F.ws + WS_MOD) + 16 * 6144; ostride = 6144; }
        else { W = F.inp(I_KVADAW); bias = F.inp(I_KVADAB); N = 2048; c0 = gc - 12288; outp = (float*)(F.ws + WS_KVMOD); ostride = 2048; }
        f32x2 acc2[16];
#pragma unroll
        for (int b = 0; b < 16; ++b) acc2[b] = (f32x2){0.f, 0.f};
        const int k0 = F.wave * 128;
        {
            const int k = k0; f32x2 w[64];
            const GAS float* wp = (const GAS float*)(W + (size_t)k * N + c0 + F.lane);
#pragma unroll
            for (int j = 0; j < 128; ++j) { w[j >> 1][j & 1] = __builtin_nontemporal_load(wp); wp += N; asm volatile("" : "+v"(wp)); }
#pragma unroll
            for (int j4 = 0; j4 < 32; ++j4) { asm volatile("" ::: "memory");
#pragma unroll
                for (int b = 0; b < 16; ++b) { const f32x4 c4 = *(const LAS f32x4*)(cs + b * 1024 + k + 4 * j4); acc2[b] += c4.xy * w[2 * j4]; acc2[b] += c4.zw * w[2 * j4 + 1]; } }
        }
#pragma unroll
        for (int b = 0; b < 16; ++b) red[(F.wave * 16 + b) * 64 + F.lane] = acc2[b].x + acc2[b].y;
        __syncthreads();
        for (int o = F.tid; o < 1024; o += NTHREADS) { const int b = o >> 6, col = o & 63; float s = 0.f;
#pragma unroll
            for (int w = 0; w < 8; ++w) s += red[(w * 16 + b) * 64 + col];
            outp[(size_t)b * ostride + c0 + col] = s + bias[c0 + col]; }
        __syncthreads();
    }
}
__device__ __forceinline__ void rope_table(Frame& F, int gt, int NGT) {
    float* ct = (float*)(F.ws + WS_COS); float* st = (float*)(F.ws + WS_SIN);
    for (int i = gt; i < 2048 * 128; i += NGT) { const int pos = i >> 7, j = i & 127;
        const float inv = 1.0f / powf(10000.0f, (float)j * (1.0f / 128.0f)); const float ang = (float)pos * inv;
        const float kq = rintf(ang * 0.15915494309189535f); float rr = fmaf(-kq, 6.28318548202514648f, ang); rr = fmaf(-kq, -1.74845553e-07f, rr);
        const float rev = rr * 0.15915494309189535f; ct[i] = __builtin_amdgcn_cosf(rev); st[i] = __builtin_amdgcn_sinf(rev); }
    float* wrt = (float*)(F.ws + WS_WRT);
    for (int i = gt; i < 2 * 20 * 1024; i += NGT) { const int l = i / 20480, r = i % 20480, q = r >> 10, k = r & 1023;
        wrt[i] = q < 4 ? F.inp(I_WG)[(size_t)l * 4096 + k * 4 + q] : F.inp(I_WE)[(size_t)l * 16384 + k * 16 + (q - 4)]; }
}

struct Row16 { f32x4 v[4]; };
__device__ __forceinline__ void row_load(Row16& r, const float* p, int lane) {
#pragma unroll
    for (int j = 0; j < 4; ++j) r.v[j] = __builtin_nontemporal_load(((const f32x4*)p) + 64 * j + lane);
}
__device__ __forceinline__ void row_load_bf16(Row16& r, const bf16_t* p, int lane) {
#pragma unroll
    for (int j = 0; j < 4; ++j) { const u32x2 q = __builtin_nontemporal_load(((const u32x2*)p) + 64 * j + lane); r.v[j] = (f32x4){bf_lo(q.x), bf_hi(q.x), bf_lo(q.y), bf_hi(q.y)}; }
}
__device__ __forceinline__ void row_store_bf16(const Row16& r, bf16_t* p, int lane) {
#pragma unroll
    for (int j = 0; j < 4; ++j) { u32x2 w; w.x = pk2(r.v[j][0], r.v[j][1]); w.y = pk2(r.v[j][2], r.v[j][3]); ((u32x2*)p)[64 * j + lane] = w; }
}
__device__ __forceinline__ float row_sumsq(const Row16& r) { float s = 0.f;
#pragma unroll
    for (int j = 0; j < 4; ++j) s += (r.v[j][0] * r.v[j][0] + r.v[j][1] * r.v[j][1]) + (r.v[j][2] * r.v[j][2] + r.v[j][3] * r.v[j][3]);
    return wave_sum(s); }
__device__ __forceinline__ void row_norm_mod_store(const Row16& r, float rstd, const float* g, const float* shift, const float* scale, bf16_t* outp, int lane) {
#pragma unroll
    for (int j = 0; j < 4; ++j) { const int c = 64 * j + lane; const f32x4 gg = ((const f32x4*)g)[c], sh = ((const f32x4*)shift)[c], sc = ((const f32x4*)scale)[c];
        const f32x4 h = (r.v[j] * rstd * gg) * (sc + 1.0f) + sh; u32x2 w; w.x = pk2(h[0], h[1]); w.y = pk2(h[2], h[3]); ((u32x2*)outp)[c] = w; }
}
struct ModVec { f32x4 A[4], B[4]; };
__device__ __forceinline__ void modvec_load(ModVec& m, const float* g, const float* shift, const float* scale, int lane) {
#pragma unroll
    for (int j = 0; j < 4; ++j) { const int c = 64 * j + lane; m.A[j] = ((const f32x4*)g)[c] * (((const f32x4*)scale)[c] + 1.0f); m.B[j] = ((const f32x4*)shift)[c]; }
}
__device__ __forceinline__ void row_mod_store(const Row16& r, float rstd, const ModVec& m, bf16_t* outp, int lane) {
#pragma unroll
    for (int j = 0; j < 4; ++j) { const f32x4 h = r.v[j] * rstd * m.A[j] + m.B[j]; u32x2 w; w.x = pk2(h[0], h[1]); w.y = pk2(h[2], h[3]); ((u32x2*)outp)[64 * j + lane] = w; }
}
__device__ __forceinline__ void phase_h0(Frame& F) {
    const int gw = F.vcu * NWAVES + F.wave, NGW = F.G * NWAVES; const float* mod = (const float*)(F.ws + WS_MOD); bf16_t* H = (bf16_t*)(F.ws + WS_H);
    for (int t0 = gw * 16; t0 < NTOK; t0 += NGW * 16) { const int b = t0 / SEQ; ModVec m; modvec_load(m, F.inp(I_NMIX), mod + b * 6144, mod + b * 6144 + 1024, F.lane);
#pragma unroll 1
        for (int i = 0; i < 16; i += 4) { Row16 r[4];
#pragma unroll
            for (int u = 0; u < 4; ++u) row_load(r[u], F.inp(I_X) + (size_t)(t0 + i + u) * 1024, F.lane);
#pragma unroll
            for (int u = 0; u < 4; ++u) { const float rstd = __builtin_amdgcn_rsqf(row_sumsq(r[u]) * (1.0f / 1024.0f) + EPS); row_mod_store(r[u], rstd, m, H + (size_t)(t0 + i + u) * 1024, F.lane); } } }
}
__device__ __forceinline__ void phase_gate(Frame& F) {
    const int gw = F.vcu * NWAVES + F.wave, NGW = F.G * NWAVES; bf16_t* O = (bf16_t*)(F.ws + WS_VR); const bf16_t* SG = (const bf16_t*)(F.ws + WS_SG); const float* gn = F.inp(I_RGN);
    for (int t0 = gw; t0 < NTOK; t0 += 2 * NGW) {
        u32x4 o2[2][4], g2[2][4];
#pragma unroll
        for (int u = 0; u < 2; ++u)
#pragma unroll
            for (int j = 0; j < 4; ++j) { const size_t t = t0 + u * NGW; o2[u][j] = ((const u32x4*)(O + t * 2048))[64 * j + F.lane]; g2[u][j] = __builtin_nontemporal_load(((const u32x4*)(SG + t * 2048)) + 64 * j + F.lane); }
#pragma unroll
        for (int u = 0; u < 2; ++u) { const size_t t = t0 + u * NGW;
#pragma unroll
        for (int j = 0; j < 4; ++j) {
            float ov[8]; float ss = 0.f;
#pragma unroll
            for (int e = 0; e < 4; ++e) { ov[2 * e] = bf_lo(o2[u][j][e]); ov[2 * e + 1] = bf_hi(o2[u][j][e]); ss += ov[2 * e] * ov[2 * e] + ov[2 * e + 1] * ov[2 * e + 1]; }
            const float rstd = __builtin_amdgcn_rsqf(wave_sum(ss) * (1.0f / 512.0f) + EPS);
            const f32x4 g0 = ((const f32x4*)gn)[2 * (64 * j + F.lane)], g1 = ((const f32x4*)gn)[2 * (64 * j + F.lane) + 1];
            u32x4 w;
#pragma unroll
            for (int e = 0; e < 4; ++e) { const float ga = e < 2 ? g0[2 * e] : g1[2 * e - 4], gb = e < 2 ? g0[2 * e + 1] : g1[2 * e - 3];
                w[e] = pk2(bf_lo(g2[u][j][e]) * (ov[2 * e] * rstd * ga), bf_hi(g2[u][j][e]) * (ov[2 * e + 1] * rstd * gb)); }
            ((u32x4*)(O + t * 2048))[64 * j + F.lane] = w;
        } }
    }
}
__device__ __forceinline__ void phase_route(Frame& F, int layer) {
    const int gwl = blockIdx.x * NWAVES + F.wave;
    const float* mod = (const float*)(F.ws + WS_MOD) + (size_t)layer * 16 * 6144; const bf16_t* XB = (const bf16_t*)(F.ws + WS_XB); bf16_t* H = (bf16_t*)(F.ws + WS_H);
    const float* nf = F.inp(I_NFFN) + layer * 1024;
    const float* bg = F.inp(I_BG) + layer * 4; const float* be = F.inp(I_BE) + layer * 16;
    unsigned* gcnt = F.ctl + (layer ? CW_CNT1 : CW_CNT0);
    int* list = (int*)(F.ws + WS_LIST); int* tokslot = (int*)(F.ws + WS_TOKSLOT); float* tokw = (float*)(F.ws + WS_TOKW);
    LAS float* WrT = (LAS float*)(F.lds);
    LAS float* lgs = (LAS float*)(F.lds + 81920) + F.wave * 96;
    LAS int* wcnt = (LAS int*)(F.lds + 81920 + 4096);
    LAS int* wbase = (LAS int*)(F.lds + 81920 + 4096 + 1024);
    { const f32x4* src = (const f32x4*)((const float*)(F.ws + WS_WRT) + (size_t)layer * 20480);
#pragma unroll
      for (int i = 0; i < 10; ++i) ((LAS f32x4*)WrT)[i * NTHREADS + F.tid] = src[i * NTHREADS + F.tid]; }
    __syncthreads();
    const int lane = F.lane; const bool b5 = lane & 32, b4 = lane & 16, b3 = lane & 8;
    const int NGWL = F.G * NWAVES;
    for (int base = 0; base < NTOK; base += NGWL * 16) {
        const int t0 = base + gwl * 16; const bool active = t0 < NTOK;
        int my_e0 = 0, my_e1 = 0; float my_w0 = 0.f, my_w1 = 0.f;
        if (active) {
            const int b = t0 / SEQ; ModVec mv; modvec_load(mv, nf, mod + b * 6144 + 3072, mod + b * 6144 + 4096, lane);
            u32x2 nx[4][4];
#pragma unroll
            for (int i = 0; i < 4; ++i)
#pragma unroll
                for (int j = 0; j < 4; ++j) nx[i][j] = __builtin_nontemporal_load(((const u32x2*)(XB + (size_t)(t0 + i) * 1024)) + 64 * j + lane);
#pragma unroll 1
            for (int grp = 0; grp < 4; ++grp) {
                const int tg = t0 + 4 * grp;
                Row16 r[4];
#pragma unroll
                for (int i = 0; i < 4; ++i)
#pragma unroll
                    for (int j = 0; j < 4; ++j) { const u32x2 q = nx[i][j]; r[i].v[j] = (f32x4){bf_lo(q.x), bf_hi(q.x), bf_lo(q.y), bf_hi(q.y)}; }
                if (grp < 3) {
#pragma unroll
                    for (int i = 0; i < 4; ++i)
#pragma unroll
                        for (int j = 0; j < 4; ++j) nx[i][j] = __builtin_nontemporal_load(((const u32x2*)(XB + (size_t)(tg + 4 + i) * 1024)) + 64 * j + lane);
                }
                float rstd[4];
#pragma unroll
                for (int i = 0; i < 4; ++i) rstd[i] = __builtin_amdgcn_rsqf(row_sumsq(r[i]) * (1.0f / 1024.0f) + EPS);
#pragma unroll
                for (int j = 0; j < 4; ++j) {
#pragma unroll
                    for (int i = 0; i < 4; ++i) { const f32x4 h = r[i].v[j] * rstd[i] * mv.A[j] + mv.B[j]; r[i].v[j] = h; u32x2 w; w.x = pk2(h[0], h[1]); w.y = pk2(h[2], h[3]); ((u32x2*)(H + (size_t)(tg + i) * 1024))[64 * j + lane] = w; } }
#pragma unroll
                for (int hq = 0; hq < 2; ++hq) {
                    float V[40];
#pragma unroll
                    for (int q = 0; q < 10; ++q) {
                        f32x2 A0 = {0.f, 0.f}, A1 = {0.f, 0.f}, A2 = {0.f, 0.f}, A3 = {0.f, 0.f};
#pragma unroll
                        for (int j = 0; j < 4; ++j) { const f32x4 w4 = *(const LAS f32x4*)(WrT + (hq * 10 + q) * 1024 + 4 * (64 * j + lane)); const f32x2 wl = w4.xy, wh = w4.zw;
                            A0 += r[0].v[j].xy * wl; A1 += r[1].v[j].xy * wl; A2 += r[2].v[j].xy * wl; A3 += r[3].v[j].xy * wl;
                            A0 += r[0].v[j].zw * wh; A1 += r[1].v[j].zw * wh; A2 += r[2].v[j].zw * wh; A3 += r[3].v[j].zw * wh; }
                        const float a0 = A0.x + A0.y, a1 = A1.x + A1.y, a2 = A2.x + A2.y, a3 = A3.x + A3.y;
                        V[q] = a0; V[10 + q] = a1; V[20 + q] = a2; V[30 + q] = a3;
                    }
                    float W20[20], W10[10];
#pragma unroll
                    for (int i = 0; i < 20; ++i) W20[i] = swap32_add(V[i], V[i + 20]);
#pragma unroll
                    for (int i = 0; i < 10; ++i) W10[i] = swap16_add(W20[i], W20[i + 10]);
                    const int vb = (b3 ? 5 : 0) + (b4 ? 10 : 0) + (b5 ? 20 : 0);
#pragma unroll
                    for (int i = 0; i < 5; ++i) { const float keep = b3 ? W10[i + 5] : W10[i], send = b3 ? W10[i] : W10[i + 5]; const float v = sum8(keep + dppf<0x128>(send));
                        const int vi = vb + i;
                        if ((lane & 7) == 0) lgs[(vi / 10) * 20 + hq * 10 + (vi % 10)] = v; }
                    asm volatile("" ::: "memory");
                }
                LDS_WAIT(); asm volatile("" ::: "memory");
                if ((lane >> 2) == grp) {
                    const LAS float* lp = lgs + (lane & 3) * 20;
                    float gl[4]; int gi = 0;
#pragma unroll
                    for (int q = 0; q < 4; ++q) gl[q] = lp[q] + bg[q];
                    float gm = gl[0];
#pragma unroll
                    for (int q = 1; q < 4; ++q) if (gl[q] > gm) { gm = gl[q]; gi = q; }
                    float gs = 0.f;
#pragma unroll
                    for (int q = 0; q < 4; ++q) gs += __expf(gl[q] - gm);
                    const float ggate = 1.0f / gs;
                    float el[4];
#pragma unroll
                    for (int q = 0; q < 4; ++q) el[q] = lp[4 + 4 * gi + q] + be[4 * gi + q];
                    int i0 = 0; float m0 = el[0];
#pragma unroll
                    for (int q = 1; q < 4; ++q) if (el[q] > m0) { m0 = el[q]; i0 = q; }
                    int i1 = 0; float m1 = -INFINITY;
#pragma unroll
                    for (int q = 0; q < 4; ++q) if (q != i0 && el[q] > m1) { m1 = el[q]; i1 = q; }
                    const float p1 = __expf(m1 - m0);
                    my_e0 = gi * 4 + i0; my_e1 = gi * 4 + i1; my_w0 = ggate / (1.0f + p1); my_w1 = ggate * p1 / (1.0f + p1);
                }
                LDS_WAIT(); asm volatile("" ::: "memory");
            }
        }
        const bool have = active && lane < 16; int rank0 = 0, rank1 = 0, mycount = 0;
        const unsigned long long lt = (1ull << lane) - 1ull;
#pragma unroll 1
        for (int e = 0; e < 16; ++e) {
            const unsigned long long b0 = __ballot(have && my_e0 == e), b1 = __ballot(have && my_e1 == e);
            if (my_e0 == e) rank0 = __popcll(b0 & lt);
            if (my_e1 == e) rank1 = __popcll(b0) + __popcll(b1 & lt);
            if (lane == e) mycount = __popcll(b0) + __popcll(b1);
        }
        if (lane < 16) wcnt[F.wave * 16 + lane] = mycount;
        __syncthreads();
        if (F.tid < 16) { int tot = 0;
#pragma unroll
            for (int w = 0; w < 8; ++w) { const int c = wcnt[w * 16 + F.tid]; wbase[w * 16 + F.tid] = tot; tot += c; }
            const int gb = tot ? (int)atomicAdd(gcnt + F.tid, (unsigned)tot) : 0;
#pragma unroll
            for (int w = 0; w < 8; ++w) wbase[w * 16 + F.tid] += gb; }
        __syncthreads();
        if (have) { const int t = t0 + lane; const int p0 = wbase[F.wave * 16 + my_e0] + rank0, p1 = wbase[F.wave * 16 + my_e1] + rank1;
            list[my_e0 * 32768 + p0] = t; list[my_e1 * 32768 + p1] = t;
            tokslot[2 * t] = (my_e0 << 16) | p0; tokslot[2 * t + 1] = (my_e1 << 16) | p1; tokw[2 * t] = my_w0; tokw[2 * t + 1] = my_w1; }
        __syncthreads();
    }
}
__device__ __forceinline__ void load_rbs(Frame& F, const unsigned* gcnt, LAS int* rbs, LAS int* cnts) {
    if (F.tid < 64) {
        const int e = F.tid & 15; const int c = (int)__hip_atomic_load(gcnt + e, __ATOMIC_RELAXED, __HIP_MEMORY_SCOPE_AGENT); const int nb = (c + 255) >> 8;
        int acc = 0, tot = 0;
#pragma unroll
        for (int k = 0; k < 16; ++k) { const int v = __builtin_amdgcn_readlane(nb, k); acc += (k < e) ? v : 0; tot += v; }
        if (F.tid < 16) { rbs[e] = acc; if (cnts) cnts[e] = c; if (e == 0) rbs[16] = tot; }
    }
    __syncthreads();
}
__device__ __forceinline__ void moe_tables(Frame& F, int layer, LAS int* rbs, LAS int* rowtab, int NT, bool gather) {
    const unsigned* gcnt = F.ctl + (layer ? CW_CNT1 : CW_CNT0);
    LAS int* cnts = rbs + 32;
    load_rbs(F, gcnt, rbs, cnts);
    if (gather) {
        const int* list = (const int*)(F.ws + WS_LIST); const int nrb = rbs[16], nwg = nrb * NT;
        int vals[8]; bool ok[8];
#pragma unroll
        for (int p = 0; p < 8; ++p) { const int i = 2 * p + (F.tid >> 8); const long L = (long)i * F.G + blockIdx.x; ok[p] = L < nwg; vals[p] = 0;
            if (ok[p]) { const int wg = pg8::xcd_remap((int)L, nwg), rb = wg / NT; int e = 0;
#pragma unroll
                for (int k = 1; k < 16; ++k) e += (rb >= rbs[k]) ? 1 : 0;
                const int lr0 = (rb - rbs[e]) * 256, cnt = cnts[e]; int r = lr0 + (F.tid & 255); r = r < cnt ? r : cnt - 1; vals[p] = list[e * 32768 + r]; } }
#pragma unroll
        for (int p = 0; p < 8; ++p) if (ok[p]) rowtab[(2 * p + (F.tid >> 8)) * 256 + (F.tid & 255)] = vals[p];
        __syncthreads();
    }
}
struct CombRow { Row16 x; u32x2 y0[4], y1[4]; float w0, w1; };
struct CombSlots { int r0, r1; float w0, w1; };
__device__ __forceinline__ void comb_slots(Frame& F, int t0, const LAS int* rbs, CombSlots& s) {
    const int* tokslot = (const int*)(F.ws + WS_TOKSLOT); const float* tokw = (const float*)(F.ws + WS_TOKW);
    const int i = F.lane & 15; const int s0 = tokslot[2 * (t0 + i)], s1 = tokslot[2 * (t0 + i) + 1]; s.w0 = tokw[2 * (t0 + i)]; s.w1 = tokw[2 * (t0 + i) + 1];
    s.r0 = rbs[s0 >> 16] * 256 + (s0 & 0xffff); s.r1 = rbs[s1 >> 16] * 256 + (s1 & 0xffff);
}
__device__ __forceinline__ void comb_issue(Frame& F, int t, int i, const CombSlots& s, CombRow& c) {
    const bf16_t* XB = (const bf16_t*)(F.ws + WS_XB); const bf16_t* YB = (const bf16_t*)(F.ws + WS_YB);
    row_load_bf16(c.x, XB + (size_t)t * 1024, F.lane);
    const int r0 = __builtin_amdgcn_readlane(s.r0, i), r1 = __builtin_amdgcn_readlane(s.r1, i);
    c.w0 = __builtin_bit_cast(float, __builtin_amdgcn_readlane(__builtin_bit_cast(int, s.w0), i)); c.w1 = __builtin_bit_cast(float, __builtin_amdgcn_readlane(__builtin_bit_cast(int, s.w1), i));
    const u32x2* y0 = (const u32x2*)(YB + (size_t)r0 * 1024); const u32x2* y1 = (const u32x2*)(YB + (size_t)r1 * 1024);
#pragma unroll
    for (int j = 0; j < 4; ++j) { c.y0[j] = __builtin_nontemporal_load(y0 + 64 * j + F.lane); c.y1[j] = __builtin_nontemporal_load(y1 + 64 * j + F.lane); }
}
__device__ __forceinline__ void comb_finish(const f32x4 (&g2)[4], CombRow& c) {
#pragma unroll
    for (int j = 0; j < 4; ++j) { const u32x2 a = c.y0[j], b = c.y1[j]; const float w0 = c.w0, w1 = c.w1;
        f32x4 m; m[0] = w0 * bf_lo(a.x) + w1 * bf_lo(b.x); m[1] = w0 * bf_hi(a.x) + w1 * bf_hi(b.x); m[2] = w0 * bf_lo(a.y) + w1 * bf_lo(b.y); m[3] = w0 * bf_hi(a.y) + w1 * bf_hi(b.y);
        c.x.v[j] = c.x.v[j] + g2[j] * m; }
}
__device__ __forceinline__ void rbs_only(Frame& F, int layer, LAS int* rbs) {
    const unsigned* gcnt = F.ctl + (layer ? CW_CNT1 : CW_CNT0);
    load_rbs(F, gcnt, rbs, (LAS int*)nullptr);
}
__device__ __forceinline__ void phase_mid(Frame& F, LAS int* rbs) {
    const int gw = F.vcu * NWAVES + F.wave, NGW = F.G * NWAVES; bf16_t* XB = (bf16_t*)(F.ws + WS_XB); bf16_t* HQ = (bf16_t*)(F.ws + WS_H); bf16_t* HKV = (bf16_t*)(F.ws + WS_HKV);
    const float* mod1 = (const float*)(F.ws + WS_MOD) + 16 * 6144; const float* kvmod = (const float*)(F.ws + WS_KVMOD);
    rbs_only(F, 0, rbs);
    const int cbase = tail_base(rbs[16], 2), cend = defer_start(rbs[16]);
    for (int t0 = gw * 16; t0 < NTOK; t0 += NGW * 16) { const int b = t0 / SEQ;
        CombSlots sl; comb_slots(F, t0, rbs, sl);
        ModVec mq, mk; modvec_load(mq, F.inp(I_NMIX) + 1024, mod1 + b * 6144, mod1 + b * 6144 + 1024, F.lane); modvec_load(mk, F.inp(I_KVNORM), kvmod + b * 2048, kvmod + b * 2048 + 1024, F.lane);
        f32x4 g2[4];
#pragma unroll
        for (int j = 0; j < 4; ++j) g2[j] = ((const f32x4*)((const float*)(F.ws + WS_MOD) + (size_t)b * 6144 + 5120))[64 * j + F.lane];
#pragma unroll 1
        for (int i = 0; i < 16; ++i) { CombRow c;
            const int cit = cbase + gw + (i >> 1) * NGW; const bool conv = cit < cend; TItem ti; f32x4 tv[8];
            if (conv) { ti = moe_item(F, 1, cit); thalf_load(ti, i & 1, tv, F.lane); }
            comb_issue(F, t0 + i, i, sl, c);
            { const int tt = t0 + i; comb_finish(g2, c); Row16& r = c.x;
                row_store_bf16(r, XB + (size_t)tt * 1024, F.lane);
                const float rstd = __builtin_amdgcn_rsqf(row_sumsq(r) * (1.0f / 1024.0f) + EPS);
                row_mod_store(r, rstd, mq, HQ + (size_t)tt * 1024, F.lane); row_mod_store(r, rstd, mk, HKV + (size_t)tt * 1024, F.lane); }
            if (conv) thalf_store(ti, i & 1, tv, (LAS float*)(F.lds + F.wave * 17408), F.lane);
        } }
}
__device__ __forceinline__ void phase_final(Frame& F, LAS int* rbs) {
    const int gw = F.vcu * NWAVES + F.wave, NGW = F.G * NWAVES;
    rbs_only(F, 1, rbs);
    for (int t0 = gw * 16; t0 < NTOK; t0 += NGW * 16) { const int b = t0 / SEQ;
        CombSlots sl; comb_slots(F, t0, rbs, sl);
        f32x4 g2[4];
#pragma unroll
        for (int j = 0; j < 4; ++j) g2[j] = ((const f32x4*)((const float*)(F.ws + WS_MOD) + (size_t)(16 + b) * 6144 + 5120))[64 * j + F.lane];
#pragma unroll 1
        for (int i = 0; i < 16; i += 4) { CombRow c[4];
#pragma unroll
            for (int u = 0; u < 4; ++u) comb_issue(F, t0 + i + u, i + u, sl, c[u]);
#pragma unroll
            for (int u = 0; u < 4; ++u) { const int tt = t0 + i + u; comb_finish(g2, c[u]);
#pragma unroll
                for (int j = 0; j < 4; ++j) ((f32x4*)(F.out + (size_t)tt * 1024))[64 * j + F.lane] = c[u].x.v[j]; } } }
}
__device__ __forceinline__ s16x4 tr_read(const LAS void* p) {
    typedef short v4s __attribute__((ext_vector_type(4)));
    return __builtin_bit_cast(s16x4, __builtin_amdgcn_ds_read_tr16_b64_v4i16((LAS v4s*)p));
}
__device__ __forceinline__ bf16x8 cat8(s16x4 a, s16x4 b) { return (bf16x8){a[0], a[1], a[2], a[3], b[0], b[1], b[2], b[3]}; }

constexpr int RQ_STRIDE = 528, RV_STRIDE = 272, RS_STRIDE = 144;
constexpr int R_QS = 0, R_KS = 64 * RQ_STRIDE, R_VS = 2 * 64 * RQ_STRIDE, R_SS = R_VS + 64 * RV_STRIDE, R_CV = R_SS + 64 * RS_STRIDE, R_OS = R_CV + 2 * 16384, R_END = R_OS + 64 * RV_STRIDE;
static_assert(R_CV % 16 == 0 && R_OS % 16 == 0 && R_CV + 2 * 16384 <= 131072 && R_END <= ROWTAB_OFF + ROWTAB_BYTES, "retention LDS");

__device__ __forceinline__ void bg_load(Frame& F, int pair, u32x4 (&cv)[4]) {
#pragma unroll
    for (int bsel = 0; bsel < 2; ++bsel) { const TItem it = moe_item(F, 0, (2 * pair + bsel) * F.G + (int)blockIdx.x);
        const int kb = it.item >> 4, nb = it.item & 15, k0 = 64 * kb, n0 = 64 * nb;
#pragma unroll
        for (int i = 0; i < 2; ++i) cv[2 * bsel + i] = __builtin_nontemporal_load((const u32x4*)((const char*)(it.W + (size_t)(k0 + 32 * i) * 1024 + n0) + (unsigned)((F.tid >> 4) * 4096 + (F.tid & 15) * 16))); }
}
__device__ __forceinline__ void bg_stage(Frame& F, const u32x4 (&cv)[4]) {
#pragma unroll
    for (int bsel = 0; bsel < 2; ++bsel)
#pragma unroll
        for (int i = 0; i < 2; ++i) *(LAS u32x4*)(F.lds + R_CV + bsel * 16384 + (i * 512 + F.tid) * 16) = cv[2 * bsel + i];
}
__device__ __forceinline__ void bg_convert(Frame& F, int pair) {
    if (F.wave < 2) return;
    const int bsel = F.wave >= 5 ? 1 : 0, wi = F.wave - 2 - 3 * bsel, c0 = 3 * wi, cnt = wi < 2 ? 3 : 2;
    const TItem it = moe_item(F, 0, (2 * pair + bsel) * F.G + (int)blockIdx.x);
    const int kb = it.item >> 4, nb = it.item & 15, k0 = 64 * kb, n0 = 64 * nb;
    const int d = dest_row(n0 + (F.lane & 32), it.mode) + (F.lane & 31);
    bf16_t* op = it.WT + (size_t)d * it.K + k0;
    const LAS float* tile = (const LAS float*)(F.lds + R_CV + bsel * 16384) + F.lane;
    float tv[3][8];
#pragma unroll
    for (int i = 0; i < 3; ++i) { if (i < cnt) { const LAS float* s = tile + (8 * (c0 + i)) * 64;
#pragma unroll
        for (int e = 0; e < 8; ++e) tv[i][e] = s[e * 64]; } }
#pragma unroll
    for (int i = 0; i < 3; ++i) { if (i < cnt) { const int c = c0 + i;
        u32x4 o; o.x = pk2(tv[i][0], tv[i][1]); o.y = pk2(tv[i][2], tv[i][3]); o.z = pk2(tv[i][4], tv[i][5]); o.w = pk2(tv[i][6], tv[i][7]);
        *(u32x4*)(op + 8 * c) = o; } }
}

__device__ __forceinline__ void phase_retention(Frame& F) {
    LAS unsigned char* lds = F.lds;
    const int tid = F.tid, lane = F.lane, w = F.wave, g = lane >> 4, l15 = lane & 15, tq = (lane >> 2) & 3, tp = lane & 3;
    const bf16_t* QR = (const bf16_t*)(F.ws + WS_QR); const bf16_t* KR = (const bf16_t*)(F.ws + WS_KR); bf16_t* VR = (bf16_t*)(F.ws + WS_VR);
    const unsigned qaddr = (unsigned)(uintptr_t)(lds + R_QS + l15 * RQ_STRIDE + g * 8), kaddr = (unsigned)(uintptr_t)(lds + R_KS + (8 * g + tq) * RQ_STRIDE + 4 * tp * 2);
    for (int i = tid; i < 64 * RS_STRIDE / 4; i += NTHREADS) ((LAS unsigned*)(lds + R_SS))[i] = 0u;
    for (int unit = F.vcu; unit < 256; unit += F.G) {
        const int b = unit >> 4, h = (unit >> 2) & 3, s = unit & 3;
        const float lgam = __builtin_log2f(1.0f - __builtin_exp2f(-5.0f - (float)h)); const float cdec = __builtin_exp2f(64.0f * lgam);
        const size_t tok0 = (size_t)b * SEQ;
        const bf16_t* qg = QR + tok0 * 1024 + h * 256; const bf16_t* kg = KR + tok0 * 1024 + h * 256; bf16_t* vg = VR + tok0 * 2048 + h * 512 + s * 128;
        f32x4 St[16];
#pragma unroll
        for (int t = 0; t < 16; ++t) St[t] = (f32x4){0.f, 0.f, 0.f, 0.f};
        u32x4 pq[4], pk[4], pv[2], cv[4];
        const unsigned qko = (unsigned)((tid >> 5) * 2048 + (tid & 31) * 16), vo = (unsigned)((tid >> 4) * 4096 + (tid & 15) * 16);
#define RET_PREFETCH(ci) do { const char* _q = (const char*)qg + (size_t)(ci) * 131072; const char* _k = (const char*)kg + (size_t)(ci) * 131072; const char* _v = (const char*)vg + (size_t)(ci) * 262144; \
            _Pragma("unroll") for (int i = 0; i < 4; ++i) { pq[i] = *(const u32x4*)(_q + i * 32768 + qko); pk[i] = *(const u32x4*)(_k + i * 32768 + qko); } \
            _Pragma("unroll") for (int i = 0; i < 2; ++i) pv[i] = *(const u32x4*)(_v + i * 131072 + vo); } while (0)
        RET_PREFETCH(0);
#ifdef RET_PROBE
        unsigned long long rp_acc = 0, rp_prev = __builtin_amdgcn_s_memrealtime();
#define RS(k) do { const unsigned long long _n = __builtin_amdgcn_s_memrealtime(); if (RET_PROBE == (k)) rp_acc += _n - rp_prev; rp_prev = _n; } while (0)
#else
#define RS(k) do {} while (0)
#endif
        for (int ci = 0; ci < 32; ++ci) {
            RS(0);
#pragma unroll
            for (int i = 0; i < 4; ++i) { const int id = i * 512 + tid, row = id >> 5, c16 = id & 31;
                *(LAS u32x4*)(lds + R_QS + row * RQ_STRIDE + c16 * 16) = pq[i]; *(LAS u32x4*)(lds + R_KS + row * RQ_STRIDE + c16 * 16) = pk[i]; }
#pragma unroll
            for (int i = 0; i < 2; ++i) { const int id = i * 512 + tid, row = id >> 4, c16 = id & 15; *(LAS u32x4*)(lds + R_VS + row * RV_STRIDE + c16 * 16) = pv[i]; }
            if (ci >= 1 && ci <= 24) bg_stage(F, cv);
            RS(1); __syncthreads(); RS(2);
            if (ci >= 1) {
#pragma unroll
                for (int i = 0; i < 2; ++i) { const int id = i * 512 + tid, row = id >> 4, c16 = id & 15;
                    *(u32x4*)((char*)vg + (size_t)(ci - 1) * 262144 + i * 131072 + vo) = *(const LAS u32x4*)(lds + R_OS + row * RV_STRIDE + c16 * 16); } }
            if (ci + 1 < 32) RET_PREFETCH(ci + 1);
            if (ci < 24) bg_load(F, ci, cv);
            if (ci >= 1 && ci <= 24) bg_convert(F, ci - 1);
#pragma unroll
            for (int rep = 0; rep < 2; ++rep) {
                const int idx = w + 8 * rep;
                if (idx < 10) {
                    const int mt = idx < 4 ? 0 : idx < 7 ? 1 : idx < 9 ? 2 : 3, nt_ = idx < 4 ? idx : idx < 7 ? idx - 3 : idx < 9 ? idx - 5 : 3;
                    f32x4 sacc = (f32x4){0.f, 0.f, 0.f, 0.f};
                    const LAS unsigned char* ka = lds + R_KS + (mt * 16 + l15) * RQ_STRIDE + g * 16; const LAS unsigned char* qb = lds + R_QS + (nt_ * 16 + l15) * RQ_STRIDE + g * 16;
#pragma unroll
                    for (int hb = 0; hb < 2; ++hb) { bf16x8 fa[4], fb[4];
#pragma unroll
                        for (int kk = 0; kk < 4; ++kk) { fa[kk] = *(const LAS bf16x8*)(ka + (4 * hb + kk) * 64); fb[kk] = *(const LAS bf16x8*)(qb + (4 * hb + kk) * 64); }
                        __builtin_amdgcn_sched_barrier(0);
#pragma unroll
                        for (int kk = 0; kk < 4; ++kk) sacc = __builtin_amdgcn_mfma_f32_16x16x32_bf16(fa[kk], fb[kk], sacc, 0, 0, 0);
                        __builtin_amdgcn_sched_barrier(0); }
                    const int n = nt_ * 16 + l15, m0 = mt * 16 + 4 * g;
#pragma unroll
                    for (int r = 0; r < 4; ++r) if (n < m0 + r) sacc[r] = 0.f;
                    u32x2 pw; pw.x = pk2(sacc[0], sacc[1]); pw.y = pk2(sacc[2], sacc[3]);
                    *(LAS u32x2*)(lds + R_SS + n * RS_STRIDE + m0 * 2) = pw;
                }
            }
            bf16x8 vf[2];
#pragma unroll
            for (int kk = 0; kk < 2; ++kk) { const LAS unsigned char* vp = lds + R_VS + (32 * kk + 8 * g + tq) * RV_STRIDE + (16 * w + 4 * tp) * 2;
                vf[kk] = cat8(tr_read(vp), tr_read(vp + 4 * RV_STRIDE)); }
#define RET_PACKST(kk) ({ u32x4 _x; _x.x = pk2(St[2 * (kk)][0], St[2 * (kk)][1]); _x.y = pk2(St[2 * (kk)][2], St[2 * (kk)][3]); _x.z = pk2(St[2 * (kk) + 1][0], St[2 * (kk) + 1][1]); _x.w = pk2(St[2 * (kk) + 1][2], St[2 * (kk) + 1][3]); __builtin_bit_cast(bf16x8, _x); })
            f32x4 o[4];
#pragma unroll
            for (int nt_ = 0; nt_ < 4; ++nt_) o[nt_] = (f32x4){0.f, 0.f, 0.f, 0.f};
            __builtin_amdgcn_sched_barrier(0);
            {
                s16x4 rlo[4], rhi[4];
#define RET_LD(k, gi) do { if ((gi) < 32) asm volatile("ds_read_b64 %0, %2 offset:%3\n\tds_read_b64 %1, %2 offset:%4" : "=&v"(rlo[k]), "=&v"(rhi[k]) : "v"(qaddr), "i"(((gi) & 3) * 16 * RQ_STRIDE + ((gi) >> 2) * 64), "i"(((gi) & 3) * 16 * RQ_STRIDE + ((gi) >> 2) * 64 + 32) : "memory"); \
                else asm volatile("ds_read_b64_tr_b16 %0, %2 offset:%3\n\tds_read_b64_tr_b16 %1, %2 offset:%4" : "=&v"(rlo[k]), "=&v"(rhi[k]) : "v"(kaddr), "i"(((gi) & 1) * 32 * RQ_STRIDE + (((gi) - 32) >> 1) * 32), "i"(((gi) & 1) * 32 * RQ_STRIDE + (((gi) - 32) >> 1) * 32 + 4 * RQ_STRIDE) : "memory"); } while (0)
#define RET_WAIT(k, n) asm volatile("s_waitcnt lgkmcnt(%2)" : "+v"(rlo[k]), "+v"(rhi[k]) : "n"(n) : "memory")
                RET_LD(0, 0); RET_LD(1, 1); RET_LD(2, 2);
                bf16x8 sbc = RET_PACKST(0), sbn = RET_PACKST(1);
#pragma unroll
                for (int gi = 0; gi < 64; ++gi) {
                    if (gi + 3 < 64) RET_LD((gi + 3) & 3, gi + 3);
                    RET_WAIT(gi & 3, (63 - gi) < 3 ? 2 * (63 - gi) : 6);
                    const bf16x8 af = cat8(rlo[gi & 3], rhi[gi & 3]);
                    if (gi < 32) { o[gi & 3] = __builtin_amdgcn_mfma_f32_16x16x32_bf16(af, sbc, o[gi & 3], 0, 0, 0);
                        if ((gi & 3) == 3) { sbc = sbn; if ((gi >> 2) + 2 < 8) sbn = RET_PACKST((gi >> 2) + 2); } }
                    else { const int t = (gi - 32) >> 1; St[t] = __builtin_amdgcn_mfma_f32_16x16x32_bf16(af, vf[gi & 1], St[t], 0, 0, 0);
                        if ((gi & 1) && t >= 1) St[t - 1] = St[t - 1] * cdec; }
                    __builtin_amdgcn_sched_barrier(0);
                }
                St[15] = St[15] * cdec;
#undef RET_LD
#undef RET_WAIT
            }
            RS(3); __syncthreads(); RS(4);
            {
#pragma unroll
                for (int nt_ = 0; nt_ < 4; ++nt_) {
                    const LAS unsigned char* sp = lds + R_SS + (nt_ * 16 + l15) * RS_STRIDE + g * 16;
#pragma unroll
                    for (int kk = 0; kk < 2; ++kk) { if (kk * 32 < (nt_ + 1) * 16) { const bf16x8 a = *(const LAS bf16x8*)(sp + kk * 64); o[nt_] = __builtin_amdgcn_mfma_f32_16x16x32_bf16(a, vf[kk], o[nt_], 0, 0, 0); } }
                }
#undef RET_PACKST
            }
#pragma unroll
            for (int nt_ = 0; nt_ < 4; ++nt_)
#pragma unroll
                for (int r = 0; r < 4; ++r) *(LAS bf16_t*)(lds + R_OS + (nt_ * 16 + 4 * g + r) * RV_STRIDE + (16 * w + l15) * 2) = (bf16_t)f2bf(o[nt_][r]);
            RS(5); __syncthreads(); RS(6);
        }
#ifdef RET_PROBE
        if (blockIdx.x == 0 && tid == RET_PROBE_WAVE * 64) __hip_atomic_store((unsigned long long*)(F.ctl + 8400), rp_acc, __ATOMIC_RELAXED, __HIP_MEMORY_SCOPE_AGENT);
#endif
#undef RET_PREFETCH
#pragma unroll
        for (int i = 0; i < 2; ++i) { const int id = i * 512 + tid, row = id >> 4, c16 = id & 15;
            *(u32x4*)((char*)vg + (size_t)31 * 262144 + i * 131072 + vo) = *(const LAS u32x4*)(lds + R_OS + row * RV_STRIDE + c16 * 16); }
        __syncthreads();
    }
}

constexpr int A_SLOT = 16384, A_K0 = 0, A_V0 = 3 * A_SLOT, A_LS = 6 * A_SLOT, A_X = 0, A_OST = A_LS + 8 * 64 * 4, A_OSTRIDE = 272, A_END = A_OST + 4 * 32 * A_OSTRIDE;
static_assert(A_END <= ROWTAB_OFF + ROWTAB_BYTES && 4 * 16384 <= A_LS, "attention LDS");
__device__ __forceinline__ int crow(int r, int hi) { return (r & 3) + 8 * (r >> 2) + 4 * hi; }
#define ATT_SB() __builtin_amdgcn_sched_barrier(0)

template <bool SHIFT>
__device__ __forceinline__ void phase_attention_impl(Frame& F, const float M2) {
    LAS unsigned char* lds = F.lds;
    const int tid = F.tid, lane = F.lane, w = F.wave, r32 = lane & 31, hi = lane >> 5, tq = (lane >> 2) & 3, tp = lane & 3, ch = (lane >> 4) & 1, t = w >> 2, wq = w & 3;
    const bf16_t* Q1 = (const bf16_t*)(F.ws + WS_Q1); const bf16_t* K1 = (const bf16_t*)(F.ws + WS_K1); const bf16_t* V1 = (const bf16_t*)(F.ws + WS_V1); bf16_t* AO = (bf16_t*)(F.ws + WS_AO);
    const float* lam = F.inp(I_LAM);
    const float l01 = wave_sum(lam[lane] * lam[64 + lane]), l23 = wave_sum(lam[128 + lane] * lam[192 + lane]);
    const float lambda_init = 0.8f - 0.6f * 0.7408182206817179f;
    const float lam_full = __expf(l01) - __expf(l23) + lambda_init;
    LAS float* wsf = (LAS float*)(lds + A_LS) + w * 64;
    unsigned dsrc[2];
#pragma unroll
    for (int i = 0; i < 2; ++i) { const int row = 4 * (2 * w + i) + (lane >> 4), fr = ((row & 3) << 2) | ((row >> 2) & 3); dsrc[i] = (unsigned)(row * 2048 + (((lane & 15) ^ fr) << 4)); }
    const unsigned ddst = (unsigned)(w * 2048);
    const int frk = ((r32 & 3) << 2) | ((r32 >> 2) & 3);
    int koff[4];
#pragma unroll
    for (int ks = 0; ks < 4; ++ks) koff[ks] = r32 * 256 + (((8 * t + 2 * ks + hi) ^ frk) << 4);
    unsigned vofA[4], vofB[4];
#pragma unroll
    for (int d = 0; d < 4; ++d) { const int c = 4 * d + 2 * ch + (tp >> 1);
        vofA[d] = (unsigned)((4 * hi + tq) * 256 + ((c ^ ((tq << 2) | (hi & 3))) << 4) + 8 * (tp & 1));
        vofB[d] = (unsigned)((4 * hi + tq + 8) * 256 + ((c ^ ((tq << 2) | ((hi + 2) & 3))) << 4) + 8 * (tp & 1)); }
    const unsigned ldsb = (unsigned)(uintptr_t)lds;
#ifdef ATT_PROBE
    unsigned long long att_tw = 0;
#endif
#define ATT_UNIT(n, b_, h_, u_) const int _v##b_ = F.vcu + ((n) >> 3) * F.G, _bh##b_ = _v##b_ >> 1, b_ = _bh##b_ >> 3, h_ = _bh##b_ & 7, _pr##b_ = 2 * (((n) & 7) >> 1) + (_v##b_ & 1), u_ = ((n) & 1) ? 15 - _pr##b_ : _pr##b_
#define ATT_DMA(gbase, tile, NTu, slotbase) do { const int _tl = (tile) < (NTu) ? (tile) : (NTu) - 1; const char* _g = (gbase) + (size_t)_tl * 131072; const unsigned _s = (slotbase) + (unsigned)(((tile) % 3) * A_SLOT) + ddst; \
            __builtin_amdgcn_global_load_lds((const GAS unsigned*)(_g + dsrc[0]), (LAS unsigned*)(lds + _s), 16, 0, 0); \
            __builtin_amdgcn_global_load_lds((const GAS unsigned*)(_g + dsrc[1]), (LAS unsigned*)(lds + _s + 1024), 16, 0, 0); } while (0)
#define ATT_PROLOGUE_DMA(kgx, vgx, NTx) do { ATT_DMA(kgx, 0, NTx, A_K0); ATT_DMA(vgx, 0, NTx, A_V0); ATT_DMA(kgx, 1, NTx, A_K0); ATT_DMA(kgx, 2, NTx, A_K0); ATT_DMA(vgx, 1, NTx, A_V0); } while (0)
#define ATT_WAITBAR(n) asm volatile("s_waitcnt vmcnt(" #n ") lgkmcnt(0)\n\ts_barrier" ::: "memory")
    const int NU = 8 * ((256 - F.vcu + F.G - 1) / F.G);
    if (NU > 0) { ATT_UNIT(0, b0_, h0_, u0_); ATT_PROLOGUE_DMA((const char*)(K1 + (size_t)b0_ * SEQ * 1024 + h0_ * 128), (const char*)(V1 + (size_t)b0_ * SEQ * 1024 + h0_ * 128), 2 * u0_ + 2); }
    {
        for (int n = 0; n < NU; ++n) {
            ATT_UNIT(n, b, h, u);
            const size_t tok0 = (size_t)b * SEQ; const int q0 = u * 128 + wq * 32;
            const int NT = 2 * u + 2, jmax = 2 * u + (wq >> 1);
            const char* kg = (const char*)(K1 + tok0 * 1024 + h * 128); const char* vg = (const char*)(V1 + tok0 * 1024 + h * 128);
            bf16x8 qf[4];
#pragma unroll
            for (int ks = 0; ks < 4; ++ks) qf[ks] = *(const bf16x8*)((const char*)(Q1 + (tok0 + q0) * 1024 + h * 128 + t * 64) + (unsigned)(r32 * 2048 + hi * 16 + ks * 32));
            f32x16 O[4];
#pragma unroll
            for (int d = 0; d < 4; ++d) O[d] = f32x16{};
            f32x2 lsum2 = {0.f, 0.f};
#define ATT_QK(S0, S1, kslot) do { const f32x16 _z = f32x16{}; bf16x8 _a0[2], _a1[2]; const LAS unsigned char* _kb = lds + A_K0 + (kslot) * A_SLOT; \
            _Pragma("unroll") for (int ks = 0; ks < 2; ++ks) { _a0[ks] = *(const LAS bf16x8*)(_kb + koff[ks]); _a1[ks] = *(const LAS bf16x8*)(_kb + koff[ks] + 32 * 256); } \
            S0 = __builtin_amdgcn_mfma_f32_32x32x16_bf16(_a0[0], qf[0], _z, 0, 0, 0); S1 = __builtin_amdgcn_mfma_f32_32x32x16_bf16(_a1[0], qf[0], _z, 0, 0, 0); \
            S0 = __builtin_amdgcn_mfma_f32_32x32x16_bf16(_a0[1], qf[1], S0, 0, 0, 0); S1 = __builtin_amdgcn_mfma_f32_32x32x16_bf16(_a1[1], qf[1], S1, 0, 0, 0); ATT_SB(); \
            _Pragma("unroll") for (int ks = 0; ks < 2; ++ks) { _a0[ks] = *(const LAS bf16x8*)(_kb + koff[ks + 2]); _a1[ks] = *(const LAS bf16x8*)(_kb + koff[ks + 2] + 32 * 256); } \
            S0 = __builtin_amdgcn_mfma_f32_32x32x16_bf16(_a0[0], qf[2], S0, 0, 0, 0); S1 = __builtin_amdgcn_mfma_f32_32x32x16_bf16(_a1[0], qf[2], S1, 0, 0, 0); \
            S0 = __builtin_amdgcn_mfma_f32_32x32x16_bf16(_a0[1], qf[3], S0, 0, 0, 0); S1 = __builtin_amdgcn_mfma_f32_32x32x16_bf16(_a1[1], qf[3], S1, 0, 0, 0); } while (0)
#define ATT_EXP4(S0, S1, PFN, e) do { float x0, x1, x2, x3; \
            if ((e) < 4) { x0 = S0[4 * (e)]; x1 = S0[4 * (e) + 1]; x2 = S0[4 * (e) + 2]; x3 = S0[4 * (e) + 3]; } else { x0 = S1[4 * ((e) - 4)]; x1 = S1[4 * ((e) - 4) + 1]; x2 = S1[4 * ((e) - 4) + 2]; x3 = S1[4 * ((e) - 4) + 3]; } \
            if (SHIFT) { x0 -= M2; x1 -= M2; x2 -= M2; x3 -= M2; } \
            f32x2 _pa, _pb; _pa.x = __builtin_amdgcn_exp2f(x0); _pa.y = __builtin_amdgcn_exp2f(x1); _pb.x = __builtin_amdgcn_exp2f(x2); _pb.y = __builtin_amdgcn_exp2f(x3); \
            PFN[(e) >> 1][((e) & 1) * 2] = pk2(_pa.x, _pa.y); PFN[(e) >> 1][((e) & 1) * 2 + 1] = pk2(_pb.x, _pb.y); \
            asm volatile("v_pk_add_f32 %0, %0, %1\n\tv_pk_add_f32 %0, %0, %2" : "+v"(lsum2) : "v"(_pa), "v"(_pb)); } while (0)
#define ATT_VLD(k, i) asm volatile("ds_read_b64_tr_b16 %0, %2 offset:%4\n\tds_read_b64_tr_b16 %1, %3 offset:%4" : "=&v"(vlo[k]), "=&v"(vhi[k]) : "v"(va[(i) & 3]), "v"(vb[(i) & 3]), "i"(((i) >> 2) * 4096) : "memory")
#define ATT_VWAIT(k, n) asm volatile("s_waitcnt lgkmcnt(" #n ")" : "+v"(vlo[k]), "+v"(vhi[k]) :: "memory")
#define ATT_MM(PF, k, i) do { O[(i) & 3] = __builtin_amdgcn_mfma_f32_32x32x16_bf16(__builtin_bit_cast(bf16x8, PF[(i) >> 2]), cat8(vlo[k], vhi[k]), O[(i) & 3], 0, 0, 0); } while (0)
#define ATT_SLOT(PF, i) do { if ((i) + 3 < 16) ATT_VLD(((i) + 3) & 3, (i) + 3); \
            if ((i) < 13) ATT_VWAIT((i) & 3, 6); else if ((i) == 13) ATT_VWAIT((i) & 3, 4); else if ((i) == 14) ATT_VWAIT((i) & 3, 2); else ATT_VWAIT((i) & 3, 0); \
            ATT_MM(PF, (i) & 3, i); } while (0)
            ATT_WAITBAR(4);
            u32x4 pf[4];
            { f32x16 s0, s1; ATT_QK(s0, s1, 0);
#pragma unroll
              for (int e = 0; e < 8; ++e) ATT_EXP4(s0, s1, pf, e); }
            ATT_WAITBAR(4);
            int ks1 = 1, vs0 = 0;
#if defined(ATT_PROBE) && defined(ATT_PROBE_LOOP)
            const unsigned long long _tl0 = __builtin_amdgcn_s_memrealtime();
#endif
            for (int j = 0; j < NT; ++j) {
                ATT_DMA(kg, j + 3, NT, A_K0); ATT_DMA(vg, j + 2, NT, A_V0);
                unsigned va[4], vb[4];
#pragma unroll
                for (int d = 0; d < 4; ++d) { va[d] = ldsb + (unsigned)(A_V0 + vs0 * A_SLOT) + vofA[d]; vb[d] = ldsb + (unsigned)(A_V0 + vs0 * A_SLOT) + vofB[d]; }
                if (j + 1 <= jmax) {
                    f32x16 s0, s1; u32x4 pfn[4];
                    s16x4 vlo[4], vhi[4];
                    ATT_VLD(0, 0); ATT_VLD(1, 1); ATT_VLD(2, 2);
                    ATT_QK(s0, s1, ks1); ATT_SB();
#pragma unroll
                    for (int i = 0; i < 8; ++i) { ATT_SLOT(pf, i); ATT_SB(); }
#pragma unroll
                    for (int i = 8; i < 16; ++i) { ATT_SLOT(pf, i); ATT_EXP4(s0, s1, pfn, i - 8); ATT_SB(); }
#pragma unroll
                    for (int s = 0; s < 4; ++s) pf[s] = pfn[s];
                } else if (j <= jmax) {
                    s16x4 vlo[4], vhi[4];
                    ATT_VLD(0, 0); ATT_VLD(1, 1); ATT_VLD(2, 2);
#pragma unroll
                    for (int i = 0; i < 16; ++i) { ATT_SLOT(pf, i); ATT_SB(); }
                }
                ks1 = ks1 == 2 ? 0 : ks1 + 1; vs0 = vs0 == 2 ? 0 : vs0 + 1;
#if defined(ATT_PROBE) && !defined(ATT_PROBE_LOOP)
                { const unsigned long long _t0 = __builtin_amdgcn_s_memrealtime(); ATT_WAITBAR(4); att_tw += __builtin_amdgcn_s_memrealtime() - _t0; }
#else
                ATT_WAITBAR(4);
#endif
            }
#if defined(ATT_PROBE) && defined(ATT_PROBE_LOOP)
            att_tw += __builtin_amdgcn_s_memrealtime() - _tl0;
#endif
            asm volatile("s_waitcnt vmcnt(0)" ::: "memory");
            if (n + 1 < NU) { const int n1 = n + 1; ATT_UNIT(n1, bn_, hn_, un_);
                ATT_PROLOGUE_DMA((const char*)(K1 + (size_t)bn_ * SEQ * 1024 + hn_ * 128), (const char*)(V1 + (size_t)bn_ * SEQ * 1024 + hn_ * 128), 2 * un_ + 2); }
#undef ATT_QK
#undef ATT_EXP4
#undef ATT_VLD
#undef ATT_VWAIT
#undef ATT_MM
#undef ATT_SLOT
            float lsum = lsum2.x + lsum2.y; lsum = swap32_add(lsum, lsum);
            if (hi == 0) wsf[r32] = (t ? lam_full : 1.0f) / lsum;
            LDS_WAIT(); asm volatile("" ::: "memory");
            float sc[16];
#pragma unroll
            for (int r = 0; r < 16; ++r) sc[r] = wsf[crow(r, hi)];
            LAS unsigned* XR = (LAS unsigned*)(lds + A_OST + wq * 32 * A_OSTRIDE);
            if (t == 1) {
#pragma unroll
                for (int d = 0; d < 4; ++d)
#pragma unroll
                    for (int rr = 0; rr < 8; ++rr) XR[(d * 8 + rr) * 64 + lane] = pk2(O[d][2 * rr] * sc[2 * rr], O[d][2 * rr + 1] * sc[2 * rr + 1]);
            }
            __syncthreads();
            if (t == 0) {
                const float osc = 1.0f - lambda_init;
                const float* subp = F.inp(I_SUBLN); const float sub0 = subp[r32], sub1 = subp[32 + r32], sub2 = subp[64 + r32], sub3 = subp[96 + r32];
                unsigned xr[32];
#pragma unroll
                for (int i = 0; i < 32; ++i) xr[i] = XR[i * 64 + lane];
                LDS_WAIT(); asm volatile("" ::: "memory");
#pragma unroll
                for (int r = 0; r < 16; ++r) { const int q = crow(r, hi);
#define ATT_X(d) ((r & 1) ? bf_hi(xr[(d) * 8 + (r >> 1)]) : bf_lo(xr[(d) * 8 + (r >> 1)]))
                    const float o0 = O[0][r] * sc[r] - ATT_X(0), o1 = O[1][r] * sc[r] - ATT_X(1), o2 = O[2][r] * sc[r] - ATT_X(2), o3 = O[3][r] * sc[r] - ATT_X(3);
#undef ATT_X
                    float ss = o0 * o0 + o1 * o1 + o2 * o2 + o3 * o3;
                    ss = sum8(ss); ss += dppf<0x140>(ss); ss = swap16_add(ss, ss);
                    const float rstd = __builtin_amdgcn_rsqf(ss * (1.0f / 128.0f) + EPS) * osc;
                    LAS bf16_t* sp = (LAS bf16_t*)(lds + A_OST + wq * 32 * A_OSTRIDE + q * A_OSTRIDE) + r32;
                    sp[0] = (bf16_t)f2bf(o0 * rstd * sub0); sp[32] = (bf16_t)f2bf(o1 * rstd * sub1); sp[64] = (bf16_t)f2bf(o2 * rstd * sub2); sp[96] = (bf16_t)f2bf(o3 * rstd * sub3); }
                LDS_WAIT(); asm volatile("" ::: "memory");
                char* ob = (char*)(AO + (tok0 + q0) * 1024 + h * 128);
#pragma unroll
                for (int i = 0; i < 8; ++i) { const int id = i * 64 + lane, row = id >> 4, c16 = id & 15;
                    *(u32x4*)(ob + (unsigned)(row * 2048 + c16 * 16)) = *(const LAS u32x4*)(lds + A_OST + wq * 32 * A_OSTRIDE + row * A_OSTRIDE + c16 * 16); }
            }
        }
    }
#undef ATT_DMA
#undef ATT_UNIT
#undef ATT_PROLOGUE_DMA
#undef ATT_WAITBAR
#ifdef ATT_PROBE
    if (blockIdx.x == 0 && tid == ATT_PROBE * 64) __hip_atomic_store((unsigned long long*)(F.ctl + 8400), att_tw, __ATOMIC_RELAXED, __HIP_MEMORY_SCOPE_AGENT);
#endif
}

__device__ __forceinline__ void phase_attention(Frame& F) {
    const float gq = wave_max(fabsf(F.inp(I_QNORM)[F.lane])), gk = wave_max(fabsf(F.inp(I_KNORM)[F.lane]));
    const float bound = 8.0f * LOG2E * gq * gk * 1.001f + 0.01f;
    if (bound > 96.0f) phase_attention_impl<true>(F, bound - 96.0f); else phase_attention_impl<false>(F, 0.0f);
}
constexpr int N_PHASES = 17;
#ifndef MK_N_LAUNCHES
#define MK_N_LAUNCHES 1
#endif
struct Args { const float* in[26]; float* out; unsigned char* ws; int ph_lo, ph_hi; };

__global__ void __launch_bounds__(NTHREADS, 2) yoco_fwd(Args args) {
    extern __shared__ __attribute__((aligned(16))) unsigned char lds_raw[];
    Frame F;
    F.lds = (LAS unsigned char*)lds_raw;
    const int wave0 = __builtin_amdgcn_readfirstlane((int)threadIdx.x >> 6);
    F.G = gridDim.x; { const int bx = blockIdx.x; F.vcu = (F.G % 8 == 0) ? (bx % 8) * (F.G / 8) + bx / 8 : bx; }
#define FRESH_IN() do { kargp_t _t = (kargp_t)__builtin_amdgcn_kernarg_segment_ptr(); asm volatile("" : "+s"(_t)); F.kin = _t; \
        F.out = (float*)(GAS float*)_t[26]; F.ws = (unsigned char*)(GAS unsigned char*)_t[27]; F.ctl = (unsigned*)(F.ws + WS_CTL); \
        int _tid; asm volatile("v_mbcnt_lo_u32_b32 %0, -1, 0\n\tv_mbcnt_hi_u32_b32 %0, -1, %0" : "=v"(_tid)); _tid += wave0 * 64; asm volatile("" : "+v"(_tid)); F.tid = _tid;     \
        F.lane = _tid & 63; F.wave = __builtin_amdgcn_readfirstlane(_tid >> 6); } while (0)
    FRESH_IN();
    volatile LAS unsigned* MISC = (volatile LAS unsigned*)(F.lds + MISC_OFF);
    LAS int* rbs = (LAS int*)(F.lds + MISC_OFF + 256);
    LAS int* rowtab = (LAS int*)(F.lds + ROWTAB_OFF);
    LAS int* utab = (LAS int*)(F.lds + MISC_OFF + 1024);
    for (int u = F.tid; u < 512; u += NTHREADS) MISC[u] = 0u;
#ifdef GEMM_PROBE
    if (blockIdx.x == 0 && F.tid == 0) g_pr = 0ull;
#endif
    __syncthreads();
    const int lo = args.ph_lo, hi = args.ph_hi;
    const bool multi = (hi - lo) > 1;
    XcdBarrier bar; bar.bar = nullptr; bar.x = 0; bar.st = nullptr;
    if (multi) bar = xcd_barrier_post(F.ctl + CW_BAR, MISC + 8);
#ifdef ONLY_PHASE
#define IN(k) ((k) == ONLY_PHASE && lo <= (k) && (k) < hi)
#else
#define IN(k) (lo <= (k) && (k) < hi)
#endif
#if defined(PROBE_A) || defined(PROBE_B)
#ifndef PROBE_A
#define PROBE_A 0
#endif
#ifndef PROBE_B
#define PROBE_B 0
#endif
#ifndef PROBE_CONST
#define PROBE_CONST 0ull
#endif
#ifndef PROBE_MUL
#define PROBE_MUL 0ull
#endif
    unsigned long long pr_prev = __builtin_amdgcn_s_memrealtime(), pr_a = 0, pr_b = 0;
#define PROBE_STAMP(k) do { const unsigned long long _n = __builtin_amdgcn_s_memrealtime(); if ((PROBE_A >> (k)) & 1) pr_a += _n - pr_prev; if ((PROBE_B >> (k)) & 1) pr_b += _n - pr_prev; pr_prev = _n; } while (0)
#else
#define PROBE_STAMP(k) do {} while (0)
#endif
#ifdef BAR_PROBE
#define SEAM(k) do { if (IN(k) && IN((k) + 1)) { bar.bar = F.ctl + CW_BAR; const unsigned long long _b0 = __builtin_amdgcn_s_memrealtime(); xcd_barrier(bar); if ((BAR_PROBE >> (k)) & 1) pr_a += __builtin_amdgcn_s_memrealtime() - _b0; } else __syncthreads(); } while (0)
#else
#define SEAM(k) do { if (IN(k) && IN((k) + 1)) { bar.bar = F.ctl + CW_BAR; xcd_barrier(bar); } else __syncthreads(); PROBE_STAMP(k); } while (0)
#endif
    #define gw (F.vcu * NWAVES + F.wave)
#define NGW (F.G * NWAVES)

#ifndef P0_NA
#define P0_NA 10
#endif
#define P0_NB ((3072 - 224 * P0_NA) / 32)
    static_assert(224 * P0_NA + 32 * P0_NB == 3072 && N_DENSE_ITEMS == 3072, "P0 item split");
#if defined(P0_PROBE)
#define P0S(k) do { if (P0_PROBE == (k)) pr_a = __builtin_amdgcn_s_memrealtime() - pr_prev; } while (0)
#else
#define P0S(k) do {} while (0)
#endif
    if (IN(0)) { FRESH_IN(); P0S(0); adaln_phase(F); __syncthreads(); P0S(1); rope_table(F, blockIdx.x * NTHREADS + F.tid, F.G * NTHREADS); P0S(2); {
          const int blk = (int)blockIdx.x;
          const int s0 = blk < 224 ? blk * P0_NA : 224 * P0_NA + (blk - 224) * P0_NB, cnt = blk < 224 ? P0_NA : P0_NB; convert_weights(F, 0, true, false, s0 + F.wave, NWAVES, s0 + cnt); }
        SEAM(0); }
    if (IN(1)) { FRESH_IN(); phase_h0(F); SEAM(1); }
    if (IN(2)) { FRESH_IN();
      {
        pg8::SchedPlain S{(const char*)(F.ws + WS_H), (const char*)(F.ws + WS_WIN), NTOK / 256, 24, 1024, F.G, (int)blockIdx.x};
        pg8::EpiInProj E{(bf16_t*)(F.ws + WS_QR), (bf16_t*)(F.ws + WS_KR), (bf16_t*)(F.ws + WS_VR), (bf16_t*)(F.ws + WS_SG), (const float*)(F.ws + WS_COS), (const float*)(F.ws + WS_SIN)};
        { const int nU = pg8::build_units(utab, S, F.tid); pg8::gemm_phase<pg8::EpiInProj, false>(F.lds, F.tid, 1024, utab, nU, E, rowtab); } }
      SEAM(2); }
    if (IN(3)) { FRESH_IN(); if (F.wave >= 4) __builtin_amdgcn_s_setprio(1);
        phase_retention(F); __builtin_amdgcn_s_setprio(0); SEAM(3); }
    if (IN(4)) { FRESH_IN(); phase_gate(F); SEAM(4); }
    if (IN(5)) { FRESH_IN(); pg8::SchedPlain S{(const char*)(F.ws + WS_VR), (const char*)(F.ws + WS_WRO), NTOK / 256, 4, 2048, F.G, (int)blockIdx.x};
        pg8::EpiResid<true> E{F.inp(I_X), (bf16_t*)(F.ws + WS_XB), (const float*)(F.ws + WS_MOD) + 2048};
        { const int nU = pg8::build_units(utab, S, F.tid); pg8::gemm_phase<pg8::EpiResid<true>, false>(F.lds, F.tid, 2048, utab, nU, E, rowtab); } SEAM(5); }
#pragma unroll 1
    for (int layer = 0; layer < 2; ++layer) {
        const int pb = layer ? 13 : 6;
        if (IN(pb)) { FRESH_IN(); phase_route(F, layer); SEAM(pb); }
        if (IN(pb + 1)) { FRESH_IN();
            if (layer == 1) { load_rbs(F, F.ctl + CW_CNT0, rbs + 64, (LAS int*)nullptr); load_rbs(F, F.ctl + CW_CNT1, rbs, (LAS int*)nullptr); defer_convert(F, rbs[80], rbs[16], false); __syncthreads(); }
            moe_tables(F, layer, rbs, rowtab, 8, true);
            pg8::SchedMoe S{(const char*)(F.ws + WS_H), (const char*)(F.ws + (layer ? WS_W13_L1 : WS_W13)), rbs, 8, F.G, (int)blockIdx.x, 1, (size_t)2048 * 1024 * 2};
            pg8::EpiMoeUp E{(bf16_t*)(F.ws + WS_HID)};
            { const int nU = pg8::build_units(utab, S, F.tid); pg8::gemm_phase<pg8::EpiMoeUp, true>(F.lds, F.tid, 1024, utab, nU, E, rowtab); } if (layer == 0) tail_convert(F, rbs, 8, 0); else defer_convert(F, rbs[80], rbs[16], true); SEAM(pb + 1); }
        if (IN(pb + 2)) { FRESH_IN(); moe_tables(F, layer, rbs, rowtab, 4, false);
            pg8::SchedMoe S{(const char*)(F.ws + WS_HID), (const char*)(F.ws + (layer ? WS_W2_L1 : WS_W2)), rbs, 4, F.G, (int)blockIdx.x, 0, (size_t)1024 * 1024 * 2};
            pg8::EpiBf16 E{(bf16_t*)(F.ws + WS_YB), 1024};
            { const int nU = pg8::build_units(utab, S, F.tid); pg8::gemm_phase<pg8::EpiBf16, false>(F.lds, F.tid, 1024, utab, nU, E, rowtab); } if (layer == 0) tail_convert(F, rbs, 4, 1); SEAM(pb + 2); }
        if (layer == 0) {
            if (IN(9)) { FRESH_IN(); phase_mid(F, rbs); SEAM(9); }
            if (IN(10)) { FRESH_IN(); pg8::SchedQKV S{(const char*)(F.ws + WS_H), (const char*)(F.ws + WS_HKV), (const char*)(F.ws + WS_WQ), (const char*)(F.ws + WS_WKV), F.G, (int)blockIdx.x};
                pg8::EpiQKV E{(bf16_t*)(F.ws + WS_Q1), (bf16_t*)(F.ws + WS_K1), (bf16_t*)(F.ws + WS_V1), F.inp(I_QNORM), F.inp(I_KNORM)};
                { const int nU = pg8::build_units(utab, S, F.tid); pg8::gemm_phase<pg8::EpiQKV, false>(F.lds, F.tid, 1024, utab, nU, E, rowtab); } SEAM(10); }
            if (IN(11)) { FRESH_IN();
                if (F.wave >= 4) __builtin_amdgcn_s_setprio(1);
                phase_attention(F); __builtin_amdgcn_s_setprio(0);
                SEAM(11); }
            if (IN(12)) { FRESH_IN(); pg8::SchedPlain S{(const char*)(F.ws + WS_AO), (const char*)(F.ws + WS_WAO), NTOK / 256, 4, 1024, F.G, (int)blockIdx.x};
                pg8::EpiResid<false> E{(const void*)(F.ws + WS_XB), (bf16_t*)(F.ws + WS_XB), (const float*)(F.ws + WS_MOD) + 16 * 6144 + 2048};
                { const int nU = pg8::build_units(utab, S, F.tid); pg8::gemm_phase<pg8::EpiResid<false>, false>(F.lds, F.tid, 1024, utab, nU, E, rowtab); } SEAM(12); }
        }
    }
    if (IN(16)) { FRESH_IN(); phase_final(F, rbs); }
#if defined(PROBE_A) || defined(PROBE_B)
    __syncthreads(); PROBE_STAMP(16);
#if defined(ATT_PROBE) || defined(RET_PROBE)
    if (blockIdx.x == 0) pr_a = __hip_atomic_load((unsigned long long*)(F.ctl + 8400), __ATOMIC_RELAXED, __HIP_MEMORY_SCOPE_AGENT);
#endif
#ifdef GEMM_PROBE
    if (blockIdx.x == 0) pr_a = g_pr;
#endif
#ifdef BAR_PROBE_AVG
    if (F.tid == 0) __hip_atomic_fetch_add((unsigned long long*)(F.ctl + 8400), pr_a, __ATOMIC_RELAXED, __HIP_MEMORY_SCOPE_AGENT);
    if (multi) { bar.bar = F.ctl + CW_BAR; xcd_barrier(bar); }
    if (blockIdx.x == 0) pr_a = __hip_atomic_load((unsigned long long*)(F.ctl + 8400), __ATOMIC_RELAXED, __HIP_MEMORY_SCOPE_AGENT) / 256ull;
#endif
    if (blockIdx.x == 0) { const unsigned long long qa = (pr_a + 500ull) / 1000ull, spin = (PROBE_MUL ? pr_a * PROBE_MUL : qa * 100000ull) + pr_b + PROBE_CONST, t0 = __builtin_amdgcn_s_memrealtime();
        while (__builtin_amdgcn_s_memrealtime() - t0 < spin) __builtin_amdgcn_s_sleep(8); }
#endif
#undef IN
#undef SEAM
#undef gw
#undef NGW
}

extern "C" void kernel_launch(void* const* d_in, const int* in_sizes, int n_in, void* d_out, int out_size, void* d_ws, size_t ws_size, hipStream_t stream) {
    static int grid = 0;
    if (grid == 0) {
        if (n_in != 26 || in_sizes[0] != NTOK * DM || out_size != NTOK * DM || ws_size < WS_END) {
            fprintf(stderr, "kernel_launch: unexpected shapes (n_in %d, in0 %d, out %d, ws %zu < %zu); nothing launched\n", n_in, n_in > 0 ? in_sizes[0] : -1, out_size, ws_size, (size_t)WS_END); grid = -1; return; }
        int dev = 0, cus = 0, per_cu = 0;
        if (hipGetDevice(&dev) != hipSuccess || hipDeviceGetAttribute(&cus, hipDeviceAttributeMultiprocessorCount, dev) != hipSuccess) { grid = -1; return; }
        if (hipFuncSetAttribute((const void*)yoco_fwd, hipFuncAttributeMaxDynamicSharedMemorySize, LDS_BYTES) != hipSuccess) { fprintf(stderr, "kernel_launch: hipFuncSetAttribute failed\n"); grid = -1; return; }
        if (hipOccupancyMaxActiveBlocksPerMultiprocessor(&per_cu, (const void*)yoco_fwd, NTHREADS, LDS_BYTES) != hipSuccess || per_cu < 1) { fprintf(stderr, "kernel_launch: occupancy query says %d blocks per CU\n", per_cu); (void)hipGetLastError(); grid = -1; return; }
        if (cus != 256) { fprintf(stderr, "kernel_launch: built for a 256-CU device (got %d)\n", cus); grid = -1; return; }
        grid = cus;
    }
    if (grid < 0) return;
    (void)hipMemsetAsync((char*)d_ws + WS_CTL, 0, CTL_ZERO_BYTES, stream);
    Args a{};
    for (int i = 0; i < 26; ++i) a.in[i] = (const float*)d_in[i];
    a.out = (float*)d_out; a.ws = (unsigned char*)d_ws;
    if (MK_N_LAUNCHES == 1) { a.ph_lo = 0; a.ph_hi = N_PHASES; hipLaunchKernelGGL(yoco_fwd, dim3(grid), dim3(NTHREADS), LDS_BYTES, stream, a); }
    else { for (int p = 0; p < N_PHASES; ++p) { a.ph_lo = p; a.ph_hi = p + 1; hipLaunchKernelGGL(yoco_fwd, dim3(grid), dim3(NTHREADS), LDS_BYTES, stream, a); } }
}
```
